# Optimizing an MI355X kernel written in HIP

```python
import math
import jax, jax.numpy as jnp
from jax import lax
import numpy as np

D_MODEL = 1024
BATCH = 32
SEQ = 2048
DEPTH = 1

HEAD_DIM = 64
N_HEADS_DIL = 8
N_HEADS_MOBA = 8
N_HEADS_SELF = N_HEADS_DIL + N_HEADS_MOBA
DIL_WIDTH = N_HEADS_DIL * HEAD_DIM
MOBA_WIDTH = N_HEADS_MOBA * HEAD_DIM
MIX_WIDTH = DIL_WIDTH + MOBA_WIDTH
DILATION_PAIRS = ((128, 1), (512, 4), (2048, 16))
MOBA_BLOCK = 256
MOBA_TOPK = 3
MOBA_QCHUNK = 16
N_BUCKETS = 32
MAX_DISTANCE = 2048
N_MEM = 256
N_HEADS_MEM = 4
HEAD_DIM_MEM = D_MODEL // N_HEADS_MEM
D_FF = 2816
CONV_WIDTH = 3
EPS = 1e-6
NEG_INF = -1e30

kernel_name = "hymba_dilated_moba_convffn_block"


def rmsnorm(x, g):
    xf = x.astype(jnp.float32)
    y = xf * lax.rsqrt(jnp.mean(xf * xf, axis=-1, keepdims=True) + EPS)
    return (y * g.astype(jnp.float32)).astype(x.dtype)


def rel_bucket(dist):
    max_exact = N_BUCKETS // 2
    n = jnp.maximum(dist, 0)
    nf = jnp.maximum(n, 1).astype(jnp.float32)
    large = max_exact + (jnp.log(nf / max_exact) / math.log(MAX_DISTANCE / max_exact)
                         * (N_BUCKETS - max_exact)).astype(jnp.int32)
    large = jnp.minimum(large, N_BUCKETS - 1)
    return jnp.where(n < max_exact, n, large)


def dilated_attention(q, k, v, bias_table):
    B, H, S, hd = q.shape
    scale = hd ** -0.5
    outs, lses = [], []
    for window, dil in DILATION_PAIRS:
        w_sub = window // dil
        L = S // dil
        nblk = -(-L // w_sub)
        Lp = nblk * w_sub

        def to_sub(t):
            t = t.reshape(B, H, L, dil, hd).transpose(0, 1, 3, 2, 4)
            t = jnp.pad(t, ((0, 0), (0, 0), (0, 0), (0, Lp - L), (0, 0)))
            return t.reshape(B, H, dil, nblk, w_sub, hd)

        def with_prev(t):
            prev = jnp.pad(t, ((0, 0), (0, 0), (0, 0), (1, 0), (0, 0), (0, 0)))[:, :, :, :-1]
            return jnp.concatenate([prev, t], axis=4)

        qs = to_sub(q)
        kb = with_prev(to_sub(k))
        vb = with_prev(to_sub(v))
        s = jnp.einsum('bhrnqd,bhrnkd->bhrnqk', qs, kb).astype(jnp.float32) * scale
        i = jnp.arange(w_sub)[:, None]
        j = jnp.arange(2 * w_sub)[None, :]
        diff = w_sub + i - j
        bias = bias_table[:, rel_bucket(diff * dil)].astype(jnp.float32)
        blk = jnp.arange(nblk)[:, None, None]
        valid = (diff >= 0) & (diff <= w_sub) & ((blk - 1) * w_sub + j >= 0)
        s = jnp.where(valid, s + bias[:, None, None], NEG_INF)
        m = jnp.max(s, axis=-1, keepdims=True)
        p = jnp.exp(s - m)
        den = jnp.sum(p, axis=-1, keepdims=True)
        o = jnp.einsum('bhrnqk,bhrnkd->bhrnqd', (p / den).astype(v.dtype), vb)
        lse = (m + jnp.log(den))[..., 0]
        o = o.reshape(B, H, dil, Lp, hd)[:, :, :, :L].transpose(0, 1, 3, 2, 4).reshape(B, H, S, hd)
        lse = lse.reshape(B, H, dil, Lp)[:, :, :, :L].transpose(0, 1, 3, 2).reshape(B, H, S)
        outs.append(o)
        lses.append(lse)
    wts = jax.nn.softmax(jnp.stack(lses), axis=0)
    out = jnp.einsum('pbhs,pbhsd->bhsd', wts, jnp.stack(outs).astype(jnp.float32))
    return out.astype(q.dtype)


def moba_attention(q, k, v, bias_table):
    B, H, S, hd = q.shape
    scale = hd ** -0.5
    nb = -(-S // MOBA_BLOCK)
    Sp = nb * MOBA_BLOCK
    pad = lambda t: jnp.pad(t, ((0, 0), (0, 0), (0, Sp - S), (0, 0)))
    qp, kp, vp = pad(q), pad(k), pad(v)
    kb = kp.reshape(B, H, nb, MOBA_BLOCK, hd)
    vb = vp.reshape(B, H, nb, MOBA_BLOCK, hd)
    k_mean = jnp.mean(kb.astype(jnp.float32), axis=3).astype(q.dtype)
    topk = min(MOBA_TOPK, nb)
    n_chunks = Sp // MOBA_QCHUNK
    qc = qp.reshape(B, H, n_chunks, MOBA_QCHUNK, hd).transpose(2, 0, 1, 3, 4)
    bi = jnp.arange(B)[:, None, None, None]
    hi = jnp.arange(H)[None, :, None, None]
    hi5 = jnp.arange(H)[None, :, None, None, None]
    bias_f = bias_table.astype(jnp.float32)

    def one_chunk(args):
        q_c, c = args
        t = c * MOBA_QCHUNK + jnp.arange(MOBA_QCHUNK)
        own = (c * MOBA_QCHUNK) // MOBA_BLOCK
        gate = jnp.einsum('bhqd,bhnd->bhqn', q_c, k_mean).astype(jnp.float32)
        gate = jnp.where(jnp.arange(nb) < own, gate, NEG_INF)
        _, idx = lax.top_k(gate, topk)
        sel_valid = jnp.arange(topk) < own
        k_sel = kb[bi, hi, idx]
        v_sel = vb[bi, hi, idx]
        s_sel = jnp.einsum('bhqd,bhqnkd->bhqnk', q_c, k_sel).astype(jnp.float32) * scale
        key_pos = idx[..., None] * MOBA_BLOCK + jnp.arange(MOBA_BLOCK)
        dist = t[:, None, None] - key_pos
        s_sel = jnp.where(sel_valid[:, None], s_sel + bias_f[hi5, rel_bucket(dist)], NEG_INF)
        k_own = lax.dynamic_slice_in_dim(kp, own * MOBA_BLOCK, MOBA_BLOCK, axis=2)
        v_own = lax.dynamic_slice_in_dim(vp, own * MOBA_BLOCK, MOBA_BLOCK, axis=2)
        s_own = jnp.einsum('bhqd,bhkd->bhqk', q_c, k_own).astype(jnp.float32) * scale
        dist_own = t[:, None] - (own * MOBA_BLOCK + jnp.arange(MOBA_BLOCK))[None, :]
        s_own = jnp.where(dist_own >= 0, s_own + bias_f[:, rel_bucket(dist_own)][None], NEG_INF)
        nsel = topk * MOBA_BLOCK
        s_all = jnp.concatenate([s_sel.reshape(B, H, MOBA_QCHUNK, nsel), s_own], axis=-1)
        p = jax.nn.softmax(s_all, axis=-1).astype(v.dtype)
        p_sel = p[..., :nsel].reshape(B, H, MOBA_QCHUNK, topk, MOBA_BLOCK)
        o = (jnp.einsum('bhqnk,bhqnkd->bhqd', p_sel, v_sel)
             + jnp.einsum('bhqk,bhkd->bhqd', p[..., nsel:], v_own))
        return o

    out = lax.map(one_chunk, (qc, jnp.arange(n_chunks)))
    return out.transpose(1, 2, 0, 3, 4).reshape(B, H, Sp, hd)[:, :, :S]


def memory_cross_attention(c, m, w_q, w_kv, w_o):
    B, S, D = c.shape
    qm = (c @ w_q).reshape(B, S, N_HEADS_MEM, HEAD_DIM_MEM)
    km, vm = jnp.split(m @ w_kv, 2, axis=-1)
    km = km.reshape(B, N_MEM, N_HEADS_MEM, HEAD_DIM_MEM)
    vm = vm.reshape(B, N_MEM, N_HEADS_MEM, HEAD_DIM_MEM)
    s = jnp.einsum('bqhd,bkhd->bhqk', qm, km).astype(jnp.float32) * (HEAD_DIM_MEM ** -0.5)
    p = jax.nn.softmax(s, axis=-1).astype(c.dtype)
    o = jnp.einsum('bhqk,bkhd->bqhd', p, vm).reshape(B, S, D)
    return o @ w_o


def conv_ffn(f, w_gate, w_up, conv_w, conv_b, w_down):
    S = f.shape[1]
    a = f @ w_gate
    ap = jnp.pad(a, ((0, 0), (CONV_WIDTH - 1, 0), (0, 0)))
    conv = conv_b
    for tap in range(CONV_WIDTH):
        conv = conv + ap[:, tap:tap + S] * conv_w[tap]
    return (jax.nn.silu(conv) * (f @ w_up)) @ w_down


def setup_inputs(seed: int = 0) -> dict:
    key = jax.random.key(seed)
    ks = jax.random.split(key, 20)
    f32 = jnp.float32
    nrm = lambda k, shape, scale: jax.random.normal(k, shape, f32) * scale
    gain = lambda k, shape: 1.0 + 0.02 * jax.random.normal(k, shape, f32)
    return {
        "x": nrm(ks[0], (BATCH, SEQ, D_MODEL), 1.0),
        "mem": nrm(ks[1], (BATCH, N_MEM, D_MODEL), 1.0),
        "w_in": nrm(ks[2], (DEPTH, D_MODEL, 3 * MIX_WIDTH), D_MODEL ** -0.5),
        "g_mix": gain(ks[3], (DEPTH, D_MODEL)),
        "g_out_dil": gain(ks[4], (DEPTH, DIL_WIDTH)),
        "g_out_moba": gain(ks[5], (DEPTH, MOBA_WIDTH)),
        "w_out": nrm(ks[6], (DEPTH, MIX_WIDTH, D_MODEL), MIX_WIDTH ** -0.5),
        "rel_bias": nrm(ks[7], (N_HEADS_SELF, N_BUCKETS), 0.5),
        "g_cross": gain(ks[8], (DEPTH, D_MODEL)),
        "g_mem": gain(ks[9], (DEPTH, D_MODEL)),
        "w_q_mem": nrm(ks[10], (DEPTH, D_MODEL, D_MODEL), D_MODEL ** -0.5),
        "w_kv_mem": nrm(ks[11], (DEPTH, D_MODEL, 2 * D_MODEL), D_MODEL ** -0.5),
        "w_o_mem": nrm(ks[12], (DEPTH, D_MODEL, D_MODEL), D_MODEL ** -0.5),
        "g_ffn": gain(ks[13], (DEPTH, D_MODEL)),
        "w_gate": nrm(ks[14], (DEPTH, D_MODEL, D_FF), D_MODEL ** -0.5),
        "w_up": nrm(ks[15], (DEPTH, D_MODEL, D_FF), D_MODEL ** -0.5),
        "conv_w": nrm(ks[16], (DEPTH, CONV_WIDTH, D_FF), CONV_WIDTH ** -0.5),
        "conv_b": nrm(ks[17], (DEPTH, D_FF), 0.02),
        "w_down": nrm(ks[18], (DEPTH, D_FF, D_MODEL), D_FF ** -0.5),
        "g_final": gain(ks[19], (D_MODEL,)),
    }


def reference(x, mem, w_in, g_mix, g_out_dil, g_out_moba, w_out, rel_bias, g_cross, g_mem,
              w_q_mem, w_kv_mem, w_o_mem, g_ffn, w_gate, w_up, conv_w, conv_b, w_down, g_final):
    B, S, _ = x.shape
    heads = lambda t, n: t.reshape(B, S, n, HEAD_DIM).transpose(0, 2, 1, 3)
    merge = lambda t, w: t.transpose(0, 2, 1, 3).reshape(B, S, w)
    h = x
    for l in range(DEPTH):
        u = rmsnorm(h, g_mix[l])
        qa, ka, va, qb, kb, vb = jnp.split(u @ w_in[l], 6, axis=-1)
        ya = dilated_attention(heads(qa, N_HEADS_DIL), heads(ka, N_HEADS_DIL),
                               heads(va, N_HEADS_DIL), rel_bias[:N_HEADS_DIL])
        yb = moba_attention(heads(qb, N_HEADS_MOBA), heads(kb, N_HEADS_MOBA),
                            heads(vb, N_HEADS_MOBA), rel_bias[N_HEADS_DIL:])
        y = jnp.concatenate([rmsnorm(merge(ya, DIL_WIDTH), g_out_dil[l]),
                             rmsnorm(merge(yb, MOBA_WIDTH), g_out_moba[l])], axis=-1)
        h = h + y @ w_out[l]
        h = h + memory_cross_attention(rmsnorm(h, g_cross[l]), rmsnorm(mem, g_mem[l]),
                                       w_q_mem[l], w_kv_mem[l], w_o_mem[l])
        h = h + conv_ffn(rmsnorm(h, g_ffn[l]), w_gate[l], w_up[l], conv_w[l], conv_b[l], w_down[l])
    return rmsnorm(h, g_final)
```

```cpp
#include <hip/hip_runtime.h>
#include <cstdio>
#include <cstdint>

typedef unsigned short bf16;
constexpr int BATCH = 32, SEQ = 2048, DM = 1024, NTOK = BATCH * SEQ;
constexpr int NMEM = 256, NMEMTOK = BATCH * NMEM, DFF = 2816;
constexpr int NQKV = 3072;
constexpr float EPS = 1e-6f;

constexpr size_t MiB = 1u << 20;
constexpr size_t WS_CTL = 0;
constexpr size_t WS_RS0 = 1 * MiB;
constexpr size_t WS_RSM = WS_RS0 + 256 * 1024;
constexpr size_t WS_SS1 = WS_RSM + 256 * 1024;
constexpr size_t WS_SS2 = WS_SS1 + 256 * 1024;
constexpr size_t WS_SS3 = WS_SS2 + 256 * 1024;
constexpr size_t WS_KMEAN = WS_SS3 + 256 * 1024;
constexpr size_t WS_LUT = WS_KMEAN + 512 * 1024;
constexpr size_t WS_WIN = 8 * MiB;
constexpr size_t WS_WOUT = WS_WIN + 6 * MiB;
constexpr size_t WS_WQ = WS_WOUT + 2 * MiB;
constexpr size_t WS_WKV = WS_WQ + 2 * MiB;
constexpr size_t WS_WO = WS_WKV + 4 * MiB;
constexpr size_t WS_WGU = WS_WO + 2 * MiB;
constexpr size_t WS_WD = WS_WGU + 11 * MiB;
constexpr size_t WS_MEMB = 48 * MiB;
constexpr size_t WS_KVM = 64 * MiB;
constexpr size_t WS_XB = 96 * MiB;
constexpr size_t WS_QKV = 224 * MiB;
constexpr size_t WS_Y = 608 * MiB;
constexpr size_t WS_YN = 224 * MiB;
constexpr size_t WS_H1 = 864 * MiB;
constexpr size_t WS_QM = 352 * MiB;
constexpr size_t WS_OM = 480 * MiB;
constexpr size_t WS_H2 = 608 * MiB;
constexpr size_t WS_ACT = 96 * MiB;
constexpr size_t WS_GU = 736 * MiB;
constexpr size_t WS_H3 = 448 * MiB;
constexpr size_t WS_END = 1024 * MiB;

__device__ __forceinline__ unsigned f2bf(float f) { unsigned u = __builtin_bit_cast(unsigned, f); return (u + 0x7fffu + ((u >> 16) & 1u)) >> 16; }
__device__ __forceinline__ float bf2f(bf16 b) { return __builtin_bit_cast(float, (unsigned)b << 16); }
__device__ __forceinline__ float wave_sum(float v) {
#pragma unroll
    for (int o = 1; o < 64; o <<= 1) v += __shfl_xor(v, o);
    return v;
}

__global__ void k_cast_rows(const float* __restrict__ x, bf16* __restrict__ xb, float* __restrict__ rs, int nrows) {
    const int wave = (blockIdx.x * blockDim.x + threadIdx.x) >> 6, lane = threadIdx.x & 63;
    if (wave >= nrows) return;
    const float* xr = x + (size_t)wave * DM; bf16* o = xb + (size_t)wave * DM;
    float s = 0.f;
    for (int j = 0; j < 4; ++j) { const float4 v = *(const float4*)(xr + j * 256 + lane * 4);
        s += v.x * v.x + v.y * v.y + v.z * v.z + v.w * v.w;
        uint2 w; w.x = f2bf(v.x) | (f2bf(v.y) << 16); w.y = f2bf(v.z) | (f2bf(v.w) << 16);
        *(uint2*)(o + j * 256 + lane * 4) = w; }
    s = wave_sum(s);
    if (lane == 0) rs[wave] = rsqrtf(s * (1.f / DM) + EPS);
}
__global__ void k_wt(const float* __restrict__ W, const float* __restrict__ W2, const float* __restrict__ g, const float* __restrict__ g2, int gsplit,
                     bf16* __restrict__ WT, int K, int N, int Nsrc, int mode) {
    const size_t idx = (size_t)blockIdx.x * blockDim.x + threadIdx.x;
    if (idx >= (size_t)K * N) return;
    const int n = (int)(idx / K), k = (int)(idx % K);
    const float* src = W; int col = n;
    if (mode == 1) { const int j = n >> 8, r = n & 255; if (r < 128) { col = 128 * j + r; } else { col = 128 * j + r - 128; src = W2; } }
    float gv = 1.f;
    if (g) gv = (g2 && k >= gsplit) ? g2[k - gsplit] : g[k];
    WT[idx] = (bf16)f2bf(src[(size_t)k * Nsrc + col] * gv);
}
__global__ void k_lut(const float* __restrict__ rel_bias, float* __restrict__ lut) {
    const int idx = blockIdx.x * blockDim.x + threadIdx.x; if (idx >= 16 * 2048) return;
    const int h = idx >> 11, n = idx & 2047;
    int b;
    if (n < 16) b = n; else { b = 16; const int T[15] = {22, 30, 40, 54, 73, 99, 134, 182, 246, 332, 450, 609, 825, 1117, 1513};
#pragma unroll
        for (int j = 0; j < 15; ++j) b += (n >= T[j]) ? 1 : 0; }
    lut[idx] = rel_bias[h * 32 + b];
}

struct EpiRowScale { bf16* O; const float* rs; const float* ss; int ldc; int pad;
    __device__ void operator()(int r, int c, float v) const { const float s = rs ? rs[r] : rsqrtf(ss[r] * (1.f / DM) + EPS); O[(size_t)r * ldc + c] = (bf16)f2bf(v * s); } };
struct EpiResid { bf16* O; const bf16* R; int ldc; int pad;
    __device__ void operator()(int r, int c, float v) const { O[(size_t)r * ldc + c] = (bf16)f2bf(v + bf2f(R[(size_t)r * ldc + c])); } };
template <class Epi> __global__ void __launch_bounds__(256) k_gemm(const bf16* __restrict__ A, const bf16* __restrict__ Bt, int K, Epi e, int row_base) {
    __shared__ float As[16][65], Bs[16][65];
    const int tx = threadIdx.x & 15, ty = threadIdx.x >> 4;
    const int row0 = blockIdx.y * 64, col0 = blockIdx.x * 64;
    float acc[4][4];
#pragma unroll
    for (int i = 0; i < 4; ++i)
#pragma unroll
        for (int j = 0; j < 4; ++j) acc[i][j] = 0.f;
    for (int k0 = 0; k0 < K; k0 += 16) {
#pragma unroll
        for (int i = 0; i < 4; ++i) { const int idx = threadIdx.x + 256 * i, r = idx >> 4, c = idx & 15;
            As[c][r] = bf2f(A[(size_t)(row_base + row0 + r) * K + k0 + c]); Bs[c][r] = bf2f(Bt[(size_t)(col0 + r) * K + k0 + c]); }
        __syncthreads();
#pragma unroll
        for (int kk = 0; kk < 16; ++kk) { float a[4], b[4];
#pragma unroll
            for (int i = 0; i < 4; ++i) { a[i] = As[kk][ty * 4 + i]; b[i] = Bs[kk][tx * 4 + i]; }
#pragma unroll
            for (int i = 0; i < 4; ++i)
#pragma unroll
                for (int j = 0; j < 4; ++j) acc[i][j] += a[i] * b[j]; }
        __syncthreads();
    }
#pragma unroll
    for (int i = 0; i < 4; ++i)
#pragma unroll
        for (int j = 0; j < 4; ++j) e(row_base + row0 + ty * 4 + i, col0 + tx * 4 + j, acc[i][j]);
}
__global__ void k_sumsq(const bf16* __restrict__ H, float* __restrict__ ss, int nrows) {
    const int wave = (blockIdx.x * blockDim.x + threadIdx.x) >> 6, lane = threadIdx.x & 63;
    if (wave >= nrows) return;
    const bf16* r = H + (size_t)wave * DM; float s = 0.f;
    for (int j = 0; j < 16; ++j) { const float v = bf2f(r[j * 64 + lane]); s += v * v; }
    s = wave_sum(s); if (lane == 0) ss[wave] = s;
}

__global__ void __launch_bounds__(256) k_dil_naive(const bf16* __restrict__ QKV, const float* __restrict__ lut, bf16* __restrict__ Y) {
    const int idx = blockIdx.x * blockDim.x + threadIdx.x;
    const int t = idx & 2047, h = (idx >> 11) & 7, b = idx >> 14;
    const size_t row = (size_t)b * SEQ + t;
    float q[64], o[64];
    const bf16* qp = QKV + row * NQKV + h * 64;
#pragma unroll
    for (int d = 0; d < 64; ++d) { q[d] = bf2f(qp[d]); o[d] = 0.f; }
    float m = -1e30f, l = 0.f;
    const float* lh = lut + h * 2048;
    for (int p = 0; p < 3; ++p) { const int dil = (p == 0) ? 1 : (p == 1 ? 4 : 16);
        for (int j = 0; j <= 128; ++j) { const int tk = t - j * dil; if (tk < 0) break;
            const bf16* kp = QKV + ((size_t)b * SEQ + tk) * NQKV + 512 + h * 64; const bf16* vp = kp + 512;
            float s = 0.f;
#pragma unroll
            for (int d = 0; d < 64; ++d) s += q[d] * bf2f(kp[d]);
            s = s * 0.125f + lh[j * dil];
            const float mn = fmaxf(m, s), a = __expf(m - mn), pe = __expf(s - mn);
            l = l * a + pe; m = mn;
#pragma unroll
            for (int d = 0; d < 64; ++d) o[d] = o[d] * a + pe * bf2f(vp[d]);
        } }
    const float il = 1.f / l; bf16* yp = Y + row * DM + h * 64;
#pragma unroll
    for (int d = 0; d < 64; ++d) yp[d] = (bf16)f2bf(o[d] * il);
}
__global__ void k_kmean(const bf16* __restrict__ QKV, float* __restrict__ km) {
    const int d = threadIdx.x, blk = blockIdx.x & 7, h = (blockIdx.x >> 3) & 7, b = blockIdx.x >> 6;
    float s = 0.f;
    for (int k = 0; k < 256; ++k) s += bf2f(QKV[((size_t)b * SEQ + blk * 256 + k) * NQKV + 2048 + h * 64 + d]);
    km[(((size_t)b * 8 + h) * 8 + blk) * 64 + d] = s * (1.f / 256.f);
}
__global__ void __launch_bounds__(256) k_moba_naive(const bf16* __restrict__ QKV, const float* __restrict__ km, const float* __restrict__ lut, bf16* __restrict__ Y) {
    const int idx = blockIdx.x * blockDim.x + threadIdx.x;
    const int t = idx & 2047, h = (idx >> 11) & 7, b = idx >> 14;
    const size_t row = (size_t)b * SEQ + t;
    float q[64], o[64];
    const bf16* qp = QKV + row * NQKV + 1536 + h * 64;
#pragma unroll
    for (int d = 0; d < 64; ++d) { q[d] = bf2f(qp[d]); o[d] = 0.f; }
    const int own = t >> 8;
    float g[8];
#pragma unroll
    for (int j = 0; j < 8; ++j) { const float* kmp = km + (((size_t)b * 8 + h) * 8 + j) * 64; float s = 0.f;
#pragma unroll
        for (int d = 0; d < 64; ++d) s += q[d] * kmp[d];
        g[j] = s; }
    unsigned sel = 0; const int nsel = own < 3 ? own : 3;
    for (int n = 0; n < nsel; ++n) { float best = -3e38f; int bi = 0;
#pragma unroll
        for (int j = 0; j < 8; ++j) if (j < own && !((sel >> j) & 1u) && g[j] > best) { best = g[j]; bi = j; }
        sel |= 1u << bi; }
    sel |= 1u << own;
    float m = -1e30f, l = 0.f;
    const float* lh = lut + (8 + h) * 2048;
    for (int blk = 0; blk <= own; ++blk) { if (!((sel >> blk) & 1u)) continue;
        for (int kk = 0; kk < 256; ++kk) { const int tk = blk * 256 + kk; if (tk > t) break;
            const bf16* kp = QKV + ((size_t)b * SEQ + tk) * NQKV + 2048 + h * 64; const bf16* vp = kp + 512;
            float s = 0.f;
#pragma unroll
            for (int d = 0; d < 64; ++d) s += q[d] * bf2f(kp[d]);
            s = s * 0.125f + lh[t - tk];
            const float mn = fmaxf(m, s), a = __expf(m - mn), pe = __expf(s - mn);
            l = l * a + pe; m = mn;
#pragma unroll
            for (int d = 0; d < 64; ++d) o[d] = o[d] * a + pe * bf2f(vp[d]);
        } }
    const float il = 1.f / l; bf16* yp = Y + row * DM + 512 + h * 64;
#pragma unroll
    for (int d = 0; d < 64; ++d) yp[d] = (bf16)f2bf(o[d] * il);
}
__global__ void k_attnnorm(const bf16* __restrict__ Y, bf16* __restrict__ YN, int nrows) {
    const int wave = (blockIdx.x * blockDim.x + threadIdx.x) >> 6, lane = threadIdx.x & 63;
    if (wave >= nrows) return;
    const bf16* r = Y + (size_t)wave * DM; bf16* o = YN + (size_t)wave * DM;
    for (int half = 0; half < 2; ++half) { float v[8]; float s = 0.f;
#pragma unroll
        for (int j = 0; j < 8; ++j) { v[j] = bf2f(r[half * 512 + j * 64 + lane]); s += v[j] * v[j]; }
        s = wave_sum(s); const float rs = rsqrtf(s * (1.f / 512.f) + EPS);
#pragma unroll
        for (int j = 0; j < 8; ++j) o[half * 512 + j * 64 + lane] = (bf16)f2bf(v[j] * rs); }
}
__global__ void __launch_bounds__(256) k_cross_naive(const bf16* __restrict__ QM, const bf16* __restrict__ KVM, bf16* __restrict__ OM) {
    __shared__ float qs[256], ps[256], red[8];
    const int row = blockIdx.x >> 2, h = blockIdx.x & 3, b = row >> 11, tid = threadIdx.x;
    qs[tid] = bf2f(QM[(size_t)row * DM + h * 256 + tid]);
    __syncthreads();
    const bf16* kp = KVM + ((size_t)b * NMEM + tid) * 2048 + h * 256;
    float s = 0.f;
    for (int d = 0; d < 256; ++d) s += qs[d] * bf2f(kp[d]);
    s *= 0.0625f;
    float mx = s;
#pragma unroll
    for (int o = 1; o < 64; o <<= 1) mx = fmaxf(mx, __shfl_xor(mx, o));
    if ((tid & 63) == 0) red[tid >> 6] = mx;
    __syncthreads();
    mx = fmaxf(fmaxf(red[0], red[1]), fmaxf(red[2], red[3]));
    const float p = __expf(s - mx);
    float sm = wave_sum(p);
    if ((tid & 63) == 0) red[4 + (tid >> 6)] = sm;
    ps[tid] = p;
    __syncthreads();
    sm = red[4] + red[5] + red[6] + red[7];
    float o = 0.f;
    for (int k = 0; k < 256; ++k) o += ps[k] * bf2f(KVM[((size_t)b * NMEM + k) * 2048 + 1024 + h * 256 + tid]);
    OM[(size_t)row * DM + h * 256 + tid] = (bf16)f2bf(o / sm);
}
__global__ void k_conv_naive(const bf16* __restrict__ GU, const float* __restrict__ cw, const float* __restrict__ cb, bf16* __restrict__ ACT, int row_base, int nrows) {
    const size_t idx = (size_t)blockIdx.x * blockDim.x + threadIdx.x; if (idx >= (size_t)nrows * DFF) return;
    const int lr = (int)(idx / DFF), c = (int)(idx % DFF), row = row_base + lr, t = row & 2047;
    const int j = c >> 7, r = c & 127; const size_t gcol = (size_t)j * 256 + r, ucol = gcol + 128;
    float conv = cb[c] + cw[2 * DFF + c] * bf2f(GU[(size_t)lr * 5632 + gcol]);
    if (t >= 1) conv += cw[1 * DFF + c] * bf2f(GU[(size_t)(lr - 1) * 5632 + gcol]);
    if (t >= 2) conv += cw[0 * DFF + c] * bf2f(GU[(size_t)(lr - 2) * 5632 + gcol]);
    const float sl = conv / (1.f + __expf(-conv));
    ACT[(size_t)row * DFF + c] = (bf16)f2bf(sl * bf2f(GU[(size_t)lr * 5632 + ucol]));
}
__global__ void k_final(const bf16* __restrict__ H3, const float* __restrict__ g, float* __restrict__ out, int nrows) {
    const int wave = (blockIdx.x * blockDim.x + threadIdx.x) >> 6, lane = threadIdx.x & 63;
    if (wave >= nrows) return;
    const bf16* r = H3 + (size_t)wave * DM; float v[16]; float s = 0.f;
#pragma unroll
    for (int j = 0; j < 16; ++j) { v[j] = bf2f(r[j * 64 + lane]); s += v[j] * v[j]; }
    s = wave_sum(s); const float rs = rsqrtf(s * (1.f / DM) + EPS);
#pragma unroll
    for (int j = 0; j < 16; ++j) out[(size_t)wave * DM + j * 64 + lane] = v[j] * rs * g[j * 64 + lane];
}

extern "C" void kernel_launch(void* const* d_in, const int* in_sizes, int n_in, void* d_out, int out_size, void* d_ws, size_t ws_size, hipStream_t stream) {
    if (n_in != 20 || ws_size < WS_END) { fprintf(stderr, "kernel_launch: unexpected n_in %d or ws_size %zu\n", n_in, ws_size); return; }
    const float* x = (const float*)d_in[0]; const float* mem = (const float*)d_in[1]; const float* w_in = (const float*)d_in[2];
    const float* g_mix = (const float*)d_in[3]; const float* g_od = (const float*)d_in[4]; const float* g_om = (const float*)d_in[5];
    const float* w_out = (const float*)d_in[6]; const float* rel_bias = (const float*)d_in[7]; const float* g_cross = (const float*)d_in[8];
    const float* g_mem = (const float*)d_in[9]; const float* w_q = (const float*)d_in[10]; const float* w_kv = (const float*)d_in[11];
    const float* w_o = (const float*)d_in[12]; const float* g_ffn = (const float*)d_in[13]; const float* w_gate = (const float*)d_in[14];
    const float* w_up = (const float*)d_in[15]; const float* conv_w = (const float*)d_in[16]; const float* conv_b = (const float*)d_in[17];
    const float* w_down = (const float*)d_in[18]; const float* g_final = (const float*)d_in[19];
    unsigned char* ws = (unsigned char*)d_ws;
    float* RS0 = (float*)(ws + WS_RS0); float* RSM = (float*)(ws + WS_RSM); float* SS1 = (float*)(ws + WS_SS1); float* SS2 = (float*)(ws + WS_SS2);
    float* KMEAN = (float*)(ws + WS_KMEAN); float* LUT = (float*)(ws + WS_LUT);
    bf16* WIN = (bf16*)(ws + WS_WIN); bf16* WOUT = (bf16*)(ws + WS_WOUT); bf16* WQ = (bf16*)(ws + WS_WQ); bf16* WKV = (bf16*)(ws + WS_WKV);
    bf16* WO = (bf16*)(ws + WS_WO); bf16* WGU = (bf16*)(ws + WS_WGU); bf16* WD = (bf16*)(ws + WS_WD);
    bf16* MEMB = (bf16*)(ws + WS_MEMB); bf16* KVM = (bf16*)(ws + WS_KVM); bf16* XB = (bf16*)(ws + WS_XB); bf16* QKV = (bf16*)(ws + WS_QKV);
    bf16* Y = (bf16*)(ws + WS_Y); bf16* YN = (bf16*)(ws + WS_YN); bf16* H1 = (bf16*)(ws + WS_H1); bf16* QM = (bf16*)(ws + WS_QM);
    bf16* OM = (bf16*)(ws + WS_OM); bf16* H2 = (bf16*)(ws + WS_H2); bf16* ACT = (bf16*)(ws + WS_ACT); bf16* GU = (bf16*)(ws + WS_GU); bf16* H3 = (bf16*)(ws + WS_H3);

    k_cast_rows<<<NTOK / 4, 256, 0, stream>>>(x, XB, RS0, NTOK);
    k_cast_rows<<<NMEMTOK / 4, 256, 0, stream>>>(mem, MEMB, RSM, NMEMTOK);
    k_lut<<<16 * 2048 / 256, 256, 0, stream>>>(rel_bias, LUT);
    auto wt = [&](const float* W, const float* W2, const float* g, const float* g2, int gsplit, bf16* WT, int K, int N, int Nsrc, int mode) {
        const size_t tot = (size_t)K * N; k_wt<<<(unsigned)((tot + 255) / 256), 256, 0, stream>>>(W, W2, g, g2, gsplit, WT, K, N, Nsrc, mode); };
    wt(w_in, nullptr, g_mix, nullptr, 0, WIN, 1024, 3072, 3072, 0);
    wt(w_out, nullptr, g_od, g_om, 512, WOUT, 1024, 1024, 1024, 0);
    wt(w_q, nullptr, g_cross, nullptr, 0, WQ, 1024, 1024, 1024, 0);
    wt(w_kv, nullptr, g_mem, nullptr, 0, WKV, 1024, 2048, 2048, 0);
    wt(w_o, nullptr, nullptr, nullptr, 0, WO, 1024, 1024, 1024, 0);
    wt(w_gate, w_up, g_ffn, nullptr, 0, WGU, 1024, 5632, 2816, 1);
    wt(w_down, nullptr, nullptr, nullptr, 0, WD, 2816, 1024, 1024, 0);
    k_gemm<EpiRowScale><<<dim3(NQKV / 64, NTOK / 64), 256, 0, stream>>>(XB, WIN, 1024, EpiRowScale{QKV, RS0, nullptr, NQKV, 0}, 0);
    k_gemm<EpiRowScale><<<dim3(2048 / 64, NMEMTOK / 64), 256, 0, stream>>>(MEMB, WKV, 1024, EpiRowScale{KVM, RSM, nullptr, 2048, 0}, 0);
    k_dil_naive<<<NTOK * 8 / 256, 256, 0, stream>>>(QKV, LUT, Y);
    k_kmean<<<32 * 8 * 8, 64, 0, stream>>>(QKV, KMEAN);
    k_moba_naive<<<NTOK * 8 / 256, 256, 0, stream>>>(QKV, KMEAN, LUT, Y);
    k_attnnorm<<<NTOK / 4, 256, 0, stream>>>(Y, YN, NTOK);
    k_gemm<EpiResid><<<dim3(DM / 64, NTOK / 64), 256, 0, stream>>>(YN, WOUT, 1024, EpiResid{H1, XB, DM, 0}, 0);
    k_sumsq<<<NTOK / 4, 256, 0, stream>>>(H1, SS1, NTOK);
    k_gemm<EpiRowScale><<<dim3(DM / 64, NTOK / 64), 256, 0, stream>>>(H1, WQ, 1024, EpiRowScale{QM, nullptr, SS1, DM, 0}, 0);
    k_cross_naive<<<NTOK * 4, 256, 0, stream>>>(QM, KVM, OM);
    k_gemm<EpiResid><<<dim3(DM / 64, NTOK / 64), 256, 0, stream>>>(OM, WO, 1024, EpiResid{H2, H1, DM, 0}, 0);
    k_sumsq<<<NTOK / 4, 256, 0, stream>>>(H2, SS2, NTOK);
    for (int c = 0; c < 4; ++c) { const int rb = c * 16384;
        k_gemm<EpiRowScale><<<dim3(5632 / 64, 16384 / 64), 256, 0, stream>>>(H2, WGU, 1024, EpiRowScale{GU - (size_t)rb * 5632, nullptr, SS2, 5632, 0}, rb);
        const size_t tot = (size_t)16384 * DFF; k_conv_naive<<<(unsigned)((tot + 255) / 256), 256, 0, stream>>>(GU, conv_w, conv_b, ACT, rb, 16384); }
    k_gemm<EpiResid><<<dim3(DM / 64, NTOK / 64), 256, 0, stream>>>(ACT, WD, DFF, EpiResid{H3, H2, DM, 0}, 0);
    k_final<<<NTOK / 4, 256, 0, stream>>>(H3, g_final, (float*)d_out, NTOK);
}
```

```cpp
#include <hip/hip_runtime.h>
#include <cstdio>
#include <cstdint>

typedef unsigned short bf16;
constexpr int BATCH = 32, SEQ = 2048, DM = 1024, NTOK = BATCH * SEQ;
constexpr int NMEM = 256, NMEMTOK = BATCH * NMEM, DFF = 2816;
constexpr int NQKV = 3072;
constexpr float EPS = 1e-6f;

constexpr size_t MiB = 1u << 20;
constexpr size_t WS_CTL = 0, CTL_ZERO_BYTES = 64 * 1024;
constexpr size_t WS_RS0 = 1 * MiB;
constexpr size_t WS_RSM = WS_RS0 + 256 * 1024;
constexpr size_t WS_SS1 = WS_RSM + 256 * 1024;
constexpr size_t WS_SS2 = WS_SS1 + 256 * 1024;
constexpr size_t WS_SS3 = WS_SS2 + 256 * 1024;
constexpr size_t WS_KMEAN = WS_SS3 + 256 * 1024;
constexpr size_t WS_LUT = WS_KMEAN + 512 * 1024;
constexpr size_t WS_KMP = 3 * MiB;
constexpr size_t WS_HALOG = 4 * MiB;
constexpr size_t WS_FIXG = WS_HALOG + 256 * 2 * 2816 * 4;
constexpr size_t WS_FIXU = WS_FIXG + 256 * 2 * 2816 * 4;
constexpr size_t WS_LSEP = 22 * MiB;
constexpr size_t WS_WIN = 28 * MiB;
constexpr size_t WS_WOUT = WS_WIN + 6 * MiB;
constexpr size_t WS_WQ = WS_WOUT + 2 * MiB;
constexpr size_t WS_WKV = WS_WQ + 2 * MiB;
constexpr size_t WS_WO = WS_WKV + 4 * MiB;
constexpr size_t WS_WGU = WS_WO + 2 * MiB;
constexpr size_t WS_WD = WS_WGU + 11 * MiB;
constexpr size_t WS_MEMB = 62 * MiB;
constexpr size_t WS_KVM = 78 * MiB;
constexpr size_t WS_XB = 112 * MiB;
constexpr size_t WS_QKV = 240 * MiB;
constexpr size_t WS_Y = 624 * MiB;
constexpr size_t WS_OP = 752 * MiB;
constexpr size_t WS_YN = 240 * MiB;
constexpr size_t WS_H1 = 880 * MiB;
constexpr size_t WS_QM = 368 * MiB;
constexpr size_t WS_OM = 496 * MiB;
constexpr size_t WS_H2 = 624 * MiB;
constexpr size_t WS_ACT = 112 * MiB;
constexpr size_t WS_GU = 752 * MiB;
constexpr size_t WS_H3 = 464 * MiB;
constexpr size_t WS_END = 1024 * MiB;
static_assert(WS_FIXU + 256 * 2 * 2816 * 4 <= WS_LSEP && WS_LSEP + 6 * MiB <= WS_WIN && WS_WD + 6 * MiB <= WS_MEMB, "ws map");

__device__ __forceinline__ unsigned f2bf(float f) { unsigned u = __builtin_bit_cast(unsigned, f); return (u + 0x7fffu + ((u >> 16) & 1u)) >> 16; }
__device__ __forceinline__ float bf2f(bf16 b) { return __builtin_bit_cast(float, (unsigned)b << 16); }
__device__ __forceinline__ float bflo(unsigned w) { return __builtin_bit_cast(float, w << 16); }
__device__ __forceinline__ float bfhi(unsigned w) { return __builtin_bit_cast(float, w & 0xffff0000u); }
__device__ __forceinline__ float wave_sum(float v) {
#pragma unroll
    for (int o = 1; o < 64; o <<= 1) v += __shfl_xor(v, o);
    return v;
}


__global__ void k_cast_rows(const float* __restrict__ x, bf16* __restrict__ xb, float* __restrict__ rs, int nrows) {
    const int wave = (blockIdx.x * blockDim.x + threadIdx.x) >> 6, lane = threadIdx.x & 63;
    if (wave >= nrows) return;
    const float* xr = x + (size_t)wave * DM; bf16* o = xb + (size_t)wave * DM;
    float s = 0.f;
    for (int j = 0; j < 4; ++j) { const float4 v = *(const float4*)(xr + j * 256 + lane * 4);
        s += v.x * v.x + v.y * v.y + v.z * v.z + v.w * v.w;
        uint2 w; w.x = f2bf(v.x) | (f2bf(v.y) << 16); w.y = f2bf(v.z) | (f2bf(v.w) << 16);
        *(uint2*)(o + j * 256 + lane * 4) = w; }
    s = wave_sum(s);
    if (lane == 0) rs[wave] = rsqrtf(s * (1.f / DM) + EPS);
}
__global__ void k_wt(const float* __restrict__ W, const float* __restrict__ W2, const float* __restrict__ g, const float* __restrict__ g2, int gsplit,
                     bf16* __restrict__ WT, int K, int N, int Nsrc, int mode) {
    const size_t idx = (size_t)blockIdx.x * blockDim.x + threadIdx.x;
    if (idx >= (size_t)K * N) return;
    const int n = (int)(idx / K), k = (int)(idx % K);
    const float* src = W; int col = n;
    if (mode == 1) { const int j = n >> 8, r = n & 255; if (r < 128) { col = 128 * j + r; } else { col = 128 * j + r - 128; src = W2; } }
    float gv = 1.f;
    if (g) gv = (g2 && k >= gsplit) ? g2[k - gsplit] : g[k];
    WT[idx] = (bf16)f2bf(src[(size_t)k * Nsrc + col] * gv);
}
__global__ void k_lut(const float* __restrict__ rel_bias, float* __restrict__ lut) {
    const int idx = blockIdx.x * blockDim.x + threadIdx.x; if (idx >= 16 * 2048) return;
    const int h = idx >> 11, n = idx & 2047;
    int b;
    if (n < 16) b = n; else { b = 16; const int T[15] = {22, 30, 40, 54, 73, 99, 134, 182, 246, 332, 450, 609, 825, 1117, 1513};
#pragma unroll
        for (int j = 0; j < 15; ++j) b += (n >= T[j]) ? 1 : 0; }
    lut[idx] = rel_bias[h * 32 + b];
}

struct EpiRowScale { bf16* O; const float* rs; const float* ss; int ldc; int pad;
    __device__ void operator()(int r, int c, float v) const { const float s = rs ? rs[r] : rsqrtf(ss[r] * (1.f / DM) + EPS); O[(size_t)r * ldc + c] = (bf16)f2bf(v * s); } };
struct EpiResid { bf16* O; const bf16* R; int ldc; int pad;
    __device__ void operator()(int r, int c, float v) const { O[(size_t)r * ldc + c] = (bf16)f2bf(v + bf2f(R[(size_t)r * ldc + c])); } };
template <class Epi> __global__ void __launch_bounds__(256) k_gemm(const bf16* __restrict__ A, const bf16* __restrict__ Bt, int K, Epi e, int row_base) {
    __shared__ float As[16][65], Bs[16][65];
    const int tx = threadIdx.x & 15, ty = threadIdx.x >> 4;
    const int row0 = blockIdx.y * 64, col0 = blockIdx.x * 64;
    float acc[4][4];
#pragma unroll
    for (int i = 0; i < 4; ++i)
#pragma unroll
        for (int j = 0; j < 4; ++j) acc[i][j] = 0.f;
    for (int k0 = 0; k0 < K; k0 += 16) {
#pragma unroll
        for (int i = 0; i < 4; ++i) { const int idx = threadIdx.x + 256 * i, r = idx >> 4, c = idx & 15;
            As[c][r] = bf2f(A[(size_t)(row_base + row0 + r) * K + k0 + c]); Bs[c][r] = bf2f(Bt[(size_t)(col0 + r) * K + k0 + c]); }
        __syncthreads();
#pragma unroll
        for (int kk = 0; kk < 16; ++kk) { float a[4], b[4];
#pragma unroll
            for (int i = 0; i < 4; ++i) { a[i] = As[kk][ty * 4 + i]; b[i] = Bs[kk][tx * 4 + i]; }
#pragma unroll
            for (int i = 0; i < 4; ++i)
#pragma unroll
                for (int j = 0; j < 4; ++j) acc[i][j] += a[i] * b[j]; }
        __syncthreads();
    }
#pragma unroll
    for (int i = 0; i < 4; ++i)
#pragma unroll
        for (int j = 0; j < 4; ++j) e(row_base + row0 + ty * 4 + i, col0 + tx * 4 + j, acc[i][j]);
}
__global__ void k_sumsq(const bf16* __restrict__ H, float* __restrict__ ss, int nrows) {
    const int wave = (blockIdx.x * blockDim.x + threadIdx.x) >> 6, lane = threadIdx.x & 63;
    if (wave >= nrows) return;
    const bf16* r = H + (size_t)wave * DM; float s = 0.f;
    for (int j = 0; j < 16; ++j) { const float v = bf2f(r[j * 64 + lane]); s += v * v; }
    s = wave_sum(s); if (lane == 0) ss[wave] = s;
}

__global__ void __launch_bounds__(256) k_dil_naive(const bf16* __restrict__ QKV, const float* __restrict__ lut, bf16* __restrict__ Y) {
    const int idx = blockIdx.x * blockDim.x + threadIdx.x;
    const int t = idx & 2047, h = (idx >> 11) & 7, b = idx >> 14;
    const size_t row = (size_t)b * SEQ + t;
    float q[64], o[64];
    const bf16* qp = QKV + row * NQKV + h * 64;
#pragma unroll
    for (int d = 0; d < 64; ++d) { q[d] = bf2f(qp[d]); o[d] = 0.f; }
    float m = -1e30f, l = 0.f;
    const float* lh = lut + h * 2048;
    for (int p = 0; p < 3; ++p) { const int dil = (p == 0) ? 1 : (p == 1 ? 4 : 16);
        for (int j = 0; j <= 128; ++j) { const int tk = t - j * dil; if (tk < 0) break;
            const bf16* kp = QKV + ((size_t)b * SEQ + tk) * NQKV + 512 + h * 64; const bf16* vp = kp + 512;
            float s = 0.f;
#pragma unroll
            for (int d = 0; d < 64; ++d) s += q[d] * bf2f(kp[d]);
            s = s * 0.125f + lh[j * dil];
            const float mn = fmaxf(m, s), a = __expf(m - mn), pe = __expf(s - mn);
            l = l * a + pe; m = mn;
#pragma unroll
            for (int d = 0; d < 64; ++d) o[d] = o[d] * a + pe * bf2f(vp[d]);
        } }
    const float il = 1.f / l; bf16* yp = Y + row * DM + h * 64;
#pragma unroll
    for (int d = 0; d < 64; ++d) yp[d] = (bf16)f2bf(o[d] * il);
}
__global__ void k_kmean(const bf16* __restrict__ QKV, float* __restrict__ km) {
    const int d = threadIdx.x, blk = blockIdx.x & 7, h = (blockIdx.x >> 3) & 7, b = blockIdx.x >> 6;
    float s = 0.f;
    for (int k = 0; k < 256; ++k) s += bf2f(QKV[((size_t)b * SEQ + blk * 256 + k) * NQKV + 2048 + h * 64 + d]);
    km[(((size_t)b * 8 + h) * 8 + blk) * 64 + d] = s * (1.f / 256.f);
}
__global__ void __launch_bounds__(256) k_moba_naive(const bf16* __restrict__ QKV, const float* __restrict__ km, const float* __restrict__ lut, bf16* __restrict__ Y) {
    const int idx = blockIdx.x * blockDim.x + threadIdx.x;
    const int t = idx & 2047, h = (idx >> 11) & 7, b = idx >> 14;
    const size_t row = (size_t)b * SEQ + t;
    float q[64], o[64];
    const bf16* qp = QKV + row * NQKV + 1536 + h * 64;
#pragma unroll
    for (int d = 0; d < 64; ++d) { q[d] = bf2f(qp[d]); o[d] = 0.f; }
    const int own = t >> 8;
    float g[8];
#pragma unroll
    for (int j = 0; j < 8; ++j) { const float* kmp = km + (((size_t)b * 8 + h) * 8 + j) * 64; float s = 0.f;
#pragma unroll
        for (int d = 0; d < 64; ++d) s += q[d] * kmp[d];
        g[j] = s; }
    unsigned sel = 0; const int nsel = own < 3 ? own : 3;
    for (int n = 0; n < nsel; ++n) { float best = -3e38f; int bi = 0;
#pragma unroll
        for (int j = 0; j < 8; ++j) if (j < own && !((sel >> j) & 1u) && g[j] > best) { best = g[j]; bi = j; }
        sel |= 1u << bi; }
    sel |= 1u << own;
    float m = -1e30f, l = 0.f;
    const float* lh = lut + (8 + h) * 2048;
    for (int blk = 0; blk <= own; ++blk) { if (!((sel >> blk) & 1u)) continue;
        for (int kk = 0; kk < 256; ++kk) { const int tk = blk * 256 + kk; if (tk > t) break;
            const bf16* kp = QKV + ((size_t)b * SEQ + tk) * NQKV + 2048 + h * 64; const bf16* vp = kp + 512;
            float s = 0.f;
#pragma unroll
            for (int d = 0; d < 64; ++d) s += q[d] * bf2f(kp[d]);
            s = s * 0.125f + lh[t - tk];
            const float mn = fmaxf(m, s), a = __expf(m - mn), pe = __expf(s - mn);
            l = l * a + pe; m = mn;
#pragma unroll
            for (int d = 0; d < 64; ++d) o[d] = o[d] * a + pe * bf2f(vp[d]);
        } }
    const float il = 1.f / l; bf16* yp = Y + row * DM + 512 + h * 64;
#pragma unroll
    for (int d = 0; d < 64; ++d) yp[d] = (bf16)f2bf(o[d] * il);
}
__global__ void k_attnnorm(const bf16* __restrict__ Y, bf16* __restrict__ YN, int nrows) {
    const int wave = (blockIdx.x * blockDim.x + threadIdx.x) >> 6, lane = threadIdx.x & 63;
    if (wave >= nrows) return;
    const bf16* r = Y + (size_t)wave * DM; bf16* o = YN + (size_t)wave * DM;
    for (int half = 0; half < 2; ++half) { float v[8]; float s = 0.f;
#pragma unroll
        for (int j = 0; j < 8; ++j) { v[j] = bf2f(r[half * 512 + j * 64 + lane]); s += v[j] * v[j]; }
        s = wave_sum(s); const float rs = rsqrtf(s * (1.f / 512.f) + EPS);
#pragma unroll
        for (int j = 0; j < 8; ++j) o[half * 512 + j * 64 + lane] = (bf16)f2bf(v[j] * rs); }
}
__global__ void __launch_bounds__(256) k_cross_naive(const bf16* __restrict__ QM, const bf16* __restrict__ KVM, bf16* __restrict__ OM) {
    __shared__ float qs[256], ps[256], red[8];
    const int row = blockIdx.x >> 2, h = blockIdx.x & 3, b = row >> 11, tid = threadIdx.x;
    qs[tid] = bf2f(QM[(size_t)row * DM + h * 256 + tid]);
    __syncthreads();
    const bf16* kp = KVM + ((size_t)b * NMEM + tid) * 2048 + h * 256;
    float s = 0.f;
    for (int d = 0; d < 256; ++d) s += qs[d] * bf2f(kp[d]);
    s *= 0.0625f;
    float mx = s;
#pragma unroll
    for (int o = 1; o < 64; o <<= 1) mx = fmaxf(mx, __shfl_xor(mx, o));
    if ((tid & 63) == 0) red[tid >> 6] = mx;
    __syncthreads();
    mx = fmaxf(fmaxf(red[0], red[1]), fmaxf(red[2], red[3]));
    const float p = __expf(s - mx);
    float sm = wave_sum(p);
    if ((tid & 63) == 0) red[4 + (tid >> 6)] = sm;
    ps[tid] = p;
    __syncthreads();
    sm = red[4] + red[5] + red[6] + red[7];
    float o = 0.f;
    for (int k = 0; k < 256; ++k) o += ps[k] * bf2f(KVM[((size_t)b * NMEM + k) * 2048 + 1024 + h * 256 + tid]);
    OM[(size_t)row * DM + h * 256 + tid] = (bf16)f2bf(o / sm);
}
__global__ void k_conv_naive(const bf16* __restrict__ GU, const float* __restrict__ cw, const float* __restrict__ cb, bf16* __restrict__ ACT, int row_base, int nrows) {
    const size_t idx = (size_t)blockIdx.x * blockDim.x + threadIdx.x; if (idx >= (size_t)nrows * DFF) return;
    const int lr = (int)(idx / DFF), c = (int)(idx % DFF), row = row_base + lr, t = row & 2047;
    const int j = c >> 7, r = c & 127; const size_t gcol = (size_t)j * 256 + r, ucol = gcol + 128;
    float conv = cb[c] + cw[2 * DFF + c] * bf2f(GU[(size_t)lr * 5632 + gcol]);
    if (t >= 1) conv += cw[1 * DFF + c] * bf2f(GU[(size_t)(lr - 1) * 5632 + gcol]);
    if (t >= 2) conv += cw[0 * DFF + c] * bf2f(GU[(size_t)(lr - 2) * 5632 + gcol]);
    const float sl = conv / (1.f + __expf(-conv));
    ACT[(size_t)row * DFF + c] = (bf16)f2bf(sl * bf2f(GU[(size_t)lr * 5632 + ucol]));
}
__global__ void k_final(const bf16* __restrict__ H3, const float* __restrict__ g, float* __restrict__ out, int nrows) {
    const int wave = (blockIdx.x * blockDim.x + threadIdx.x) >> 6, lane = threadIdx.x & 63;
    if (wave >= nrows) return;
    const bf16* r = H3 + (size_t)wave * DM; float v[16]; float s = 0.f;
#pragma unroll
    for (int j = 0; j < 16; ++j) { v[j] = bf2f(r[j * 64 + lane]); s += v[j] * v[j]; }
    s = wave_sum(s); const float rs = rsqrtf(s * (1.f / DM) + EPS);
#pragma unroll
    for (int j = 0; j < 16; ++j) out[(size_t)wave * DM + j * 64 + lane] = v[j] * rs * g[j * 64 + lane];
}


namespace pg8 {
#define PG8_LAS __attribute__((address_space(3)))
typedef unsigned short bf16_t;
typedef short bf16x8 __attribute__((ext_vector_type(8)));
typedef float f32x4 __attribute__((ext_vector_type(4)));
typedef unsigned u32x4 __attribute__((ext_vector_type(4)));
constexpr int BM = 256, BK = 64, HALF = 128, HTB = HALF * BK * 2  , STAGE_BYTES = 8 * HTB, NXCD = 8, WGM = 8;

__host__ __device__ __forceinline__ int lds_byte(int r, int c) { const int st = (r >> 4) * 2 + (c >> 5), rr = r & 15, cc = c & 31, ob = rr * 64 + cc * 2; return st * 1024 + (ob ^ (((ob >> 9) & 1) << 5)); }
__host__ __device__ __forceinline__ void stage_rc(int b, int& R, int& C) { const int st = b / 1024, sb = b % 1024, swz = sb ^ (((sb >> 9) & 1) << 5); R = (st >> 1) * 16 + swz / 64; C = (st & 1) * 32 + (swz % 64) / 2; }
__host__ __device__ __forceinline__ int perm32(int rho) { const int n = rho >> 4, i = rho & 15; return 8 * (i >> 2) + 4 * n + (i & 3); }

struct Unit { int pm, pn; };
struct Gemm { const bf16_t* A; const bf16_t* Bt; int M, N, K; };

struct StaticOrder {
    int nM, nN, nwg, G, c;
    __host__ __device__ void init(int M, int N, int G_, int c_) { nM = M / BM; nN = N / BM; nwg = nM * nN; G = G_; c = c_; }
    __host__ __device__ bool next(int i, Unit& u) const {
        const long L = (long)i * G + c; if (L >= nwg) return false;
        int wgid = (int)L; { const int q = nwg / NXCD, r = nwg % NXCD, xcd = wgid % NXCD, off = wgid / NXCD; wgid = (xcd < r ? xcd * (q + 1) : r * (q + 1) + (xcd - r) * q) + off; }
        const int nig = WGM * nN, gid = wgid / nig, fm = gid * WGM, gsz = (nM - fm) < WGM ? (nM - fm) : WGM;
        u.pm = fm + ((wgid % nig) % gsz); u.pn = (wgid % nig) / gsz; return true;
    }
    __device__ __forceinline__ void a_ready(const Unit&) const {}
    __device__ __forceinline__ void done(const Unit&) const {}
};


__device__ __forceinline__ unsigned cvt_pk_bf16(float lo, float hi) { unsigned r; asm volatile("v_cvt_pk_bf16_f32 %0, %1, %2" : "=v"(r) : "v"(lo), "v"(hi)); return r; }
__device__ __forceinline__ float lo_f(unsigned w) { return __builtin_bit_cast(float, w << 16); }
__device__ __forceinline__ float hi_f(unsigned w) { return __builtin_bit_cast(float, w & 0xffff0000u); }

struct EpiScale {
    static constexpr bool PERM = true, AFTER_DRAIN = false;
    bf16_t* O; const float* rs; float* kmp; int ldc; int mode;
    __device__ __forceinline__ void operator()(const f32x4 (&acc)[2][2][4][2], const Unit& u, int wr, int wc, int fr, int fq) const {
        const int row0 = u.pm * BM + wr * 64 + fr, col0 = u.pn * BM + wc * 32 + 8 * fq;
        const bool dokm = (kmp != nullptr) && (u.pn == 8 || u.pn == 9);
        float cs[2][8];
#pragma unroll
        for (int bj = 0; bj < 2; ++bj)
#pragma unroll
            for (int e = 0; e < 8; ++e) cs[bj][e] = 0.f;
#pragma unroll
        for (int ai = 0; ai < 2; ++ai)
#pragma unroll
            for (int m = 0; m < 4; ++m) { const int r = row0 + ai * HALF + m * 16; float s = rs[r]; if (mode) s = rsqrtf(s * (1.f / 1024.f) + 1e-6f);
                bf16_t* rowp = O + (size_t)r * ldc + col0;
#pragma unroll
                for (int bj = 0; bj < 2; ++bj) { const f32x4 v0 = acc[ai][bj][m][0] * s, v1 = acc[ai][bj][m][1] * s;
                    u32x4 w; w.x = cvt_pk_bf16(v0[0], v0[1]); w.y = cvt_pk_bf16(v0[2], v0[3]); w.z = cvt_pk_bf16(v1[0], v1[1]); w.w = cvt_pk_bf16(v1[2], v1[3]);
                    *(u32x4*)(rowp + bj * HALF) = w;
                    if (dokm) { cs[bj][0] += lo_f(w.x); cs[bj][1] += hi_f(w.x); cs[bj][2] += lo_f(w.y); cs[bj][3] += hi_f(w.y); cs[bj][4] += lo_f(w.z); cs[bj][5] += hi_f(w.z); cs[bj][6] += lo_f(w.w); cs[bj][7] += hi_f(w.w); } } }
        if (dokm) {
#pragma unroll
            for (int bj = 0; bj < 2; ++bj)
#pragma unroll
                for (int e = 0; e < 8; ++e) { float v = cs[bj][e]; v += __shfl_xor(v, 1); v += __shfl_xor(v, 2); v += __shfl_xor(v, 4); v += __shfl_xor(v, 8); cs[bj][e] = v; }
            if (fr == 0) { float* kp = kmp + (size_t)(u.pm * 2 + wr) * 512 + (u.pn - 8) * 256 + wc * 32 + 8 * fq;
#pragma unroll
                for (int bj = 0; bj < 2; ++bj) { *(f32x4*)(kp + bj * HALF) = (f32x4){cs[bj][0], cs[bj][1], cs[bj][2], cs[bj][3]}; *(f32x4*)(kp + bj * HALF + 4) = (f32x4){cs[bj][4], cs[bj][5], cs[bj][6], cs[bj][7]}; } }
        }
    }
};

struct EpiResid {
    static constexpr bool PERM = true, AFTER_DRAIN = false;
    bf16_t* O; const bf16_t* R; float* ss; int ldc; int pad;
    __device__ __forceinline__ void operator()(const f32x4 (&acc)[2][2][4][2], const Unit& u, int wr, int wc, int fr, int fq) const {
        const int row0 = u.pm * BM + wr * 64 + fr, col0 = u.pn * BM + wc * 32 + 8 * fq;
#pragma unroll
        for (int ai = 0; ai < 2; ++ai)
#pragma unroll
            for (int m = 0; m < 4; ++m) { const int r = row0 + ai * HALF + m * 16; const size_t off = (size_t)r * ldc + col0; float sq = 0.f;
#pragma unroll
                for (int bj = 0; bj < 2; ++bj) { const u32x4 rv = *(const u32x4*)(R + off + bj * HALF);
                    const f32x4 a0 = acc[ai][bj][m][0], a1 = acc[ai][bj][m][1];
                    u32x4 w; w.x = cvt_pk_bf16(a0[0] + lo_f(rv.x), a0[1] + hi_f(rv.x)); w.y = cvt_pk_bf16(a0[2] + lo_f(rv.y), a0[3] + hi_f(rv.y));
                    w.z = cvt_pk_bf16(a1[0] + lo_f(rv.z), a1[1] + hi_f(rv.z)); w.w = cvt_pk_bf16(a1[2] + lo_f(rv.w), a1[3] + hi_f(rv.w));
                    *(u32x4*)(O + off + bj * HALF) = w;
                    float t;
                    t = lo_f(w.x); sq += t * t; t = hi_f(w.x); sq += t * t; t = lo_f(w.y); sq += t * t; t = hi_f(w.y); sq += t * t;
                    t = lo_f(w.z); sq += t * t; t = hi_f(w.z); sq += t * t; t = lo_f(w.w); sq += t * t; t = hi_f(w.w); sq += t * t; }
                sq += __shfl_xor(sq, 16); sq += __shfl_xor(sq, 32);
                if (fq == 0) atomicAdd(ss + r, sq); }
    }
};

__device__ __forceinline__ float dpp_shr1(float oldv, float src) { return __builtin_bit_cast(float, __builtin_amdgcn_update_dpp(__builtin_bit_cast(int, oldv), __builtin_bit_cast(int, src), 0x111, 0xf, 0xf, false)); }
__device__ __forceinline__ float dpp_shr2(float oldv, float src) { return __builtin_bit_cast(float, __builtin_amdgcn_update_dpp(__builtin_bit_cast(int, oldv), __builtin_bit_cast(int, src), 0x112, 0xf, 0xf, false)); }
__device__ __forceinline__ float dpp_ror1(float src) { return __builtin_bit_cast(float, __builtin_amdgcn_update_dpp(0, __builtin_bit_cast(int, src), 0x121, 0xf, 0xf, false)); }
__device__ __forceinline__ float dpp_ror2(float src) { return __builtin_bit_cast(float, __builtin_amdgcn_update_dpp(0, __builtin_bit_cast(int, src), 0x122, 0xf, 0xf, false)); }
struct EpiFfn1 {
    static constexpr bool PERM = true, AFTER_DRAIN = false;
    bf16_t* ACT; const float* ss2; const float* cw; const float* cb; float* halog; float* fixg; float* fixu; PG8_LAS float* hl;
    __device__ __forceinline__ void operator()(const f32x4 (&acc)[2][2][4][2], const Unit& u, int wr, int wc, int fr, int fq) const {
        constexpr int FF = 2816;
        const int ch0 = u.pn * HALF + wc * 32 + 8 * fq;
        float rsv[2][4];
#pragma unroll
        for (int ai = 0; ai < 2; ++ai)
#pragma unroll
            for (int m = 0; m < 4; ++m) rsv[ai][m] = rsqrtf(ss2[u.pm * BM + ai * HALF + wr * 64 + m * 16 + fr] * (1.f / 1024.f) + 1e-6f);
        if (fr >= 14) {
#pragma unroll
            for (int ai = 0; ai < 2; ++ai) { const int G = 2 * ai + wr; PG8_LAS float* p = hl + (((G * 4 + wc) * 2 + (fr - 14)) * 4 + fq) * 8;
                *(PG8_LAS f32x4*)p = acc[ai][0][3][0] * rsv[ai][3]; *(PG8_LAS f32x4*)(p + 4) = acc[ai][0][3][1] * rsv[ai][3]; } }
        const f32x4 w0a = *(const f32x4*)(cw + ch0), w0b = *(const f32x4*)(cw + ch0 + 4), w1a = *(const f32x4*)(cw + FF + ch0), w1b = *(const f32x4*)(cw + FF + ch0 + 4);
        const f32x4 w2a = *(const f32x4*)(cw + 2 * FF + ch0), w2b = *(const f32x4*)(cw + 2 * FF + ch0 + 4), cba = *(const f32x4*)(cb + ch0), cbb = *(const f32x4*)(cb + ch0 + 4);
        asm volatile("s_waitcnt lgkmcnt(0)" ::: "memory"); __builtin_amdgcn_s_barrier(); asm volatile("" ::: "memory");
#pragma unroll
        for (int ai = 0; ai < 2; ++ai) { const int G = 2 * ai + wr;
            f32x4 pa = (f32x4){0.f, 0.f, 0.f, 0.f}, pb = pa;
            if (G > 0 && fr >= 14) { const PG8_LAS float* p = hl + ((((G - 1) * 4 + wc) * 2 + (fr - 14)) * 4 + fq) * 8; pa = *(const PG8_LAS f32x4*)p; pb = *(const PG8_LAS f32x4*)(p + 4); }
#pragma unroll
            for (int m = 0; m < 4; ++m) { const float s = rsv[ai][m]; const int r = u.pm * BM + ai * HALF + wr * 64 + m * 16 + fr;
                const f32x4 ga = acc[ai][0][m][0] * s, gb = acc[ai][0][m][1] * s, ua = acc[ai][1][m][0] * s, ub = acc[ai][1][m][1] * s;
                f32x4 oa, ob;
#pragma unroll
                for (int e = 0; e < 4; ++e) {
                    const float g1a = dpp_shr1(dpp_ror1(pa[e]), ga[e]), g2a = dpp_shr2(dpp_ror2(pa[e]), ga[e]);
                    const float g1b = dpp_shr1(dpp_ror1(pb[e]), gb[e]), g2b = dpp_shr2(dpp_ror2(pb[e]), gb[e]);
                    const float ca = cba[e] + w2a[e] * ga[e] + w1a[e] * g1a + w0a[e] * g2a, cbv = cbb[e] + w2b[e] * gb[e] + w1b[e] * g1b + w0b[e] * g2b;
                    oa[e] = ca / (1.f + __expf(-ca)) * ua[e]; ob[e] = cbv / (1.f + __expf(-cbv)) * ub[e]; }
                const bool defer = (G == 0 && m == 0 && fr < 2);
                if (defer) { float* pg = fixg + ((size_t)u.pm * 2 + fr) * FF + ch0; float* pu = fixu + ((size_t)u.pm * 2 + fr) * FF + ch0;
                    *(f32x4*)pg = ga; *(f32x4*)(pg + 4) = gb; *(f32x4*)pu = ua; *(f32x4*)(pu + 4) = ub; }
                else { u32x4 w; w.x = cvt_pk_bf16(oa[0], oa[1]); w.y = cvt_pk_bf16(oa[2], oa[3]); w.z = cvt_pk_bf16(ob[0], ob[1]); w.w = cvt_pk_bf16(ob[2], ob[3]);
                    *(u32x4*)(ACT + (size_t)r * FF + ch0) = w; }
                if (G == 3 && m == 3 && fr >= 14) { float* ph = halog + ((size_t)u.pm * 2 + (fr - 14)) * FF + ch0; *(f32x4*)ph = ga; *(f32x4*)(ph + 4) = gb; }
                pa = ga; pb = gb; } }
    }
};

template <class Epi, class Sched, bool ALIGN_EPI = false, bool SP2 = false>
__device__ __forceinline__ void gemm_phase(PG8_LAS unsigned char* lds, const Gemm g, const Sched& S, const Epi& E) {
    const int tid = threadIdx.x, wid = __builtin_amdgcn_readfirstlane(tid >> 6), lane = tid & 63, wr = wid >> 2, wc = wid & 3, fr = lane & 15, fq = lane >> 4;
    const int K = g.K, nt = K / BK;
    unsigned voffA[2], voffB[2];
#pragma unroll
    for (int i = 0; i < 2; ++i) { int R, C; stage_rc(tid * 16 + i * 8192, R, C); const int Rb = Epi::PERM ? ((R & ~31) + perm32(R & 31)) : R;
        voffA[i] = (unsigned)(R * K + C) * 2u; voffB[i] = (unsigned)(Rb * K + C) * 2u; }
    const size_t kstep = (size_t)(BK * 2);
    const size_t hstep = (size_t)HALF * K * 2;
    const size_t tstep = 2 * hstep;
    const unsigned ldsw = (unsigned)wid * 1024u;
    const int aoff = lds_byte(wr * 64 + fr, fq * 8), boff = lds_byte(wc * 32 + fr, fq * 8);
#define PG8_SA(b, h) (((b) * 2 + (h)) * HTB)
#define PG8_SB(b, h) ((4 + (b) * 2 + (h)) * HTB)
#define PG8_STAGE(bufoff, gbase, voff) do { _Pragma("unroll") for (int _i = 0; _i < 2; ++_i) \
        __builtin_amdgcn_global_load_lds((const unsigned*)((const char*)(gbase) + (voff)[_i]), (PG8_LAS unsigned*)(lds + (bufoff) + ldsw + _i * 8192), 16, 0, 0); } while (0)
#define PG8_LDA(dst, b, h) do { _Pragma("unroll") for (int m = 0; m < 4; ++m) _Pragma("unroll") for (int k = 0; k < 2; ++k) dst[m][k] = *(const PG8_LAS bf16x8*)(lds + PG8_SA(b, h) + aoff + m * 2048 + k * 1024); } while (0)
#define PG8_LDB(dst, b, h) do { _Pragma("unroll") for (int n = 0; n < 2; ++n) _Pragma("unroll") for (int k = 0; k < 2; ++k) dst[n][k] = *(const PG8_LAS bf16x8*)(lds + PG8_SB(b, h) + boff + n * 2048 + k * 1024); } while (0)
#define PG8_MMA(ai, bj, At, Bt) do { __builtin_amdgcn_s_setprio(1); _Pragma("unroll") for (int m = 0; m < 4; ++m) _Pragma("unroll") for (int n = 0; n < 2; ++n) _Pragma("unroll") for (int k = 0; k < 2; ++k) \
        acc[ai][bj][m][n] = __builtin_amdgcn_mfma_f32_16x16x32_bf16(Bt[n][k], At[m][k], acc[ai][bj][m][n], 0, 0, 0); __builtin_amdgcn_s_setprio(0); } while (0)
#define PG8_WAIT_V(n) asm volatile("s_waitcnt vmcnt(" #n ")" ::: "memory")
#define PG8_WAIT_L(n) asm volatile("s_waitcnt lgkmcnt(" #n ")" ::: "memory")
#define PG8_BAR __builtin_amdgcn_s_barrier()
#define PG8_SCHED __builtin_amdgcn_sched_barrier(0)
    Unit cur, nxt; int ui = 0;
    if (!S.next(0, cur)) return;
    f32x4 acc[2][2][4][2];
#pragma unroll
    for (int a = 0; a < 2; ++a)
#pragma unroll
        for (int b = 0; b < 2; ++b)
#pragma unroll
            for (int m = 0; m < 4; ++m)
#pragma unroll
                for (int n = 0; n < 2; ++n) acc[a][b][m][n] = (f32x4){0.f, 0.f, 0.f, 0.f};
    bf16x8 At[4][2], B0[2][2], B1[2][2];
    const char* cA = (const char*)g.A + (size_t)cur.pm * tstep; const char* cB = (const char*)g.Bt + (size_t)cur.pn * tstep;
    S.a_ready(cur);
    if constexpr (SP2) {
        PG8_STAGE(PG8_SB(0, 0), cB, voffB); PG8_STAGE(PG8_SB(0, 1), cB + hstep, voffB); PG8_STAGE(PG8_SA(0, 0), cA, voffA); PG8_STAGE(PG8_SA(0, 1), cA + hstep, voffA);
        if (wr == 1) PG8_BAR;
        PG8_WAIT_V(2); PG8_BAR;
        PG8_STAGE(PG8_SB(1, 0), cB + kstep, voffB); PG8_STAGE(PG8_SA(1, 0), cA + kstep, voffA); PG8_STAGE(PG8_SB(1, 1), cB + hstep + kstep, voffB);
        PG8_WAIT_V(6); PG8_BAR;
    } else {
        PG8_STAGE(PG8_SB(0, 0), cB, voffB); PG8_STAGE(PG8_SA(0, 0), cA, voffA); PG8_STAGE(PG8_SB(0, 1), cB + hstep, voffB); PG8_STAGE(PG8_SA(0, 1), cA + hstep, voffA);
        if (wr == 1) PG8_BAR;
        PG8_WAIT_V(4); PG8_BAR;
        PG8_STAGE(PG8_SB(1, 0), cB + kstep, voffB); PG8_STAGE(PG8_SA(1, 0), cA + kstep, voffA); PG8_STAGE(PG8_SB(1, 1), cB + hstep + kstep, voffB);
        PG8_WAIT_V(6); PG8_BAR;
    }
    for (;;) {
        const bool has_next = S.next(ui + 1, nxt);
        const char* nA = has_next ? (const char*)g.A + (size_t)nxt.pm * tstep : cA; const char* nB = has_next ? (const char*)g.Bt + (size_t)nxt.pn * tstep : cB;
        for (int t = 0; t < nt; t += 2) {
            const bool last = (t == nt - 2);
            const char* a1 = cA + (size_t)(t + 1) * kstep;
            const char* a2 = last ? nA : cA + (size_t)(t + 2) * kstep; const char* b2 = last ? nB : cB + (size_t)(t + 2) * kstep;
            const char* a3 = a2 + kstep; const char* b3 = b2 + kstep;
            if (last && has_next) S.a_ready(nxt);
            if constexpr (SP2) {
            PG8_LDB(B0, 0, 0); PG8_LDB(B1, 0, 1); PG8_SCHED; PG8_LDA(At, 0, 0); PG8_STAGE(PG8_SA(1, 1), a1 + hstep, voffA);
            PG8_WAIT_V(8); PG8_WAIT_L(0); PG8_BAR; PG8_MMA(0, 0, At, B0); PG8_MMA(0, 1, At, B1); PG8_BAR; PG8_SCHED;
            PG8_LDA(At, 0, 1); PG8_STAGE(PG8_SB(0, 0), b2, voffB); PG8_STAGE(PG8_SB(0, 1), b2 + hstep, voffB); PG8_STAGE(PG8_SA(0, 0), a2, voffA);
            PG8_WAIT_V(8); PG8_WAIT_L(0); PG8_BAR; PG8_MMA(1, 0, At, B0); PG8_MMA(1, 1, At, B1); PG8_BAR; PG8_SCHED;
            PG8_LDB(B0, 1, 0); PG8_LDB(B1, 1, 1); PG8_SCHED; PG8_LDA(At, 1, 0); PG8_STAGE(PG8_SA(0, 1), a2 + hstep, voffA);
            PG8_WAIT_V(8); PG8_WAIT_L(0); PG8_BAR; PG8_MMA(0, 0, At, B0); PG8_MMA(0, 1, At, B1); PG8_BAR; PG8_SCHED;
            PG8_LDA(At, 1, 1); PG8_STAGE(PG8_SB(1, 0), b3, voffB); PG8_STAGE(PG8_SB(1, 1), b3 + hstep, voffB); PG8_STAGE(PG8_SA(1, 0), a3, voffA);
            PG8_WAIT_V(8); PG8_WAIT_L(0); PG8_BAR; PG8_MMA(1, 0, At, B0); PG8_MMA(1, 1, At, B1); PG8_BAR; PG8_SCHED;
            } else {
            PG8_LDB(B0, 0, 0); PG8_SCHED; PG8_LDA(At, 0, 0); PG8_STAGE(PG8_SA(1, 1), a1 + hstep, voffA);
            PG8_WAIT_L(8); PG8_BAR; PG8_WAIT_L(0); PG8_MMA(0, 0, At, B0); PG8_BAR; PG8_SCHED;
            PG8_LDB(B1, 0, 1); PG8_STAGE(PG8_SB(0, 0), b2, voffB);
            PG8_BAR; PG8_WAIT_L(0); PG8_MMA(0, 1, At, B1); PG8_BAR;
            PG8_LDA(At, 0, 1); PG8_STAGE(PG8_SA(0, 0), a2, voffA);
            PG8_BAR; PG8_WAIT_L(0); PG8_MMA(1, 0, At, B0); PG8_BAR; PG8_SCHED;
            PG8_STAGE(PG8_SB(0, 1), b2 + hstep, voffB);
            PG8_WAIT_V(6); PG8_BAR; PG8_MMA(1, 1, At, B1); PG8_BAR;
            PG8_LDB(B0, 1, 0); PG8_SCHED; PG8_LDA(At, 1, 0); PG8_STAGE(PG8_SA(0, 1), a2 + hstep, voffA);
            PG8_WAIT_L(8); PG8_BAR; PG8_WAIT_L(0); PG8_MMA(0, 0, At, B0); PG8_BAR; PG8_SCHED;
            PG8_LDB(B1, 1, 1); PG8_STAGE(PG8_SB(1, 0), b3, voffB);
            PG8_BAR; PG8_WAIT_L(0); PG8_MMA(0, 1, At, B1); PG8_BAR;
            PG8_LDA(At, 1, 1); PG8_STAGE(PG8_SA(1, 0), a3, voffA);
            PG8_BAR; PG8_WAIT_L(0); PG8_MMA(1, 0, At, B0); PG8_BAR; PG8_SCHED;
            PG8_STAGE(PG8_SB(1, 1), b3 + hstep, voffB);
            PG8_WAIT_V(6); PG8_BAR; PG8_MMA(1, 1, At, B1); PG8_BAR;
            }
        }
        if constexpr (ALIGN_EPI) { if (wr == 0) PG8_BAR; }
        if constexpr (!Epi::AFTER_DRAIN) { E(acc, cur, wr, wc, fr, fq); S.done(cur); }
        if (!has_next) break;
#pragma unroll
        for (int a = 0; a < 2; ++a)
#pragma unroll
            for (int b = 0; b < 2; ++b)
#pragma unroll
                for (int m = 0; m < 4; ++m)
#pragma unroll
                    for (int n = 0; n < 2; ++n) acc[a][b][m][n] = (f32x4){0.f, 0.f, 0.f, 0.f};
        cur = nxt; cA = nA; cB = nB; ++ui;
        if constexpr (ALIGN_EPI) { if (wr == 1) PG8_BAR; }
    }
    PG8_WAIT_V(0);
    if constexpr (!ALIGN_EPI) { if (wr == 0) PG8_BAR; }
    PG8_BAR;
    if constexpr (Epi::AFTER_DRAIN) { E.fused(acc, cur, wr, wc, fr, fq, lds, wid, lane); S.done(cur); }
#undef PG8_SA
#undef PG8_SB
#undef PG8_STAGE
#undef PG8_LDA
#undef PG8_LDB
#undef PG8_MMA
#undef PG8_WAIT_V
#undef PG8_WAIT_L
#undef PG8_BAR
#undef PG8_SCHED
}
}


constexpr int NWAVES = 8;
constexpr int RING_OFF = 0, RING_BYTES = 131072;
constexpr int LDSX_OFF = RING_BYTES;
constexpr int MISC_OFF = RING_BYTES + 8192;
constexpr int LDS_BYTES = 147456;
static_assert(MISC_OFF + 128 <= LDS_BYTES, "LDS map");
constexpr int CW_BAR = 1024;

#define GAS __attribute__((address_space(1)))
#define LAS __attribute__((address_space(3)))
typedef unsigned v4u __attribute__((ext_vector_type(4)));
typedef float f32x4 __attribute__((ext_vector_type(4)));
typedef unsigned u32x2 __attribute__((ext_vector_type(2)));
typedef GAS unsigned gu32;
#define LDS_WAIT() asm volatile("s_waitcnt lgkmcnt(0)" ::: "memory")
#define VM_WAIT() asm volatile("s_waitcnt vmcnt(0)" ::: "memory")
__device__ __forceinline__ unsigned pk2(float lo, float hi) { return f2bf(lo) | (f2bf(hi) << 16); }

#define XB_TMO      128
#define XB_XCNT(j)  (256  + 64 * (j))
#define XB_XSUB(j)  (1280 + 64 * (j))
#define XB_XGEN(j)  (2304 + 64 * (j))
#define XB_TOP      3328
#define XB_TOPGEN   3392
#define XCD_BAR_WORDS 3456
#define XB_SPIN_CAP (1u << 18)

__device__ __forceinline__ unsigned xb_ld(unsigned* p)              { return __hip_atomic_load(p, __ATOMIC_RELAXED, __HIP_MEMORY_SCOPE_AGENT); }
__device__ __forceinline__ unsigned xb_add(unsigned* p, unsigned v) { return __hip_atomic_fetch_add(p, v, __ATOMIC_RELAXED, __HIP_MEMORY_SCOPE_AGENT); }
__device__ __forceinline__ unsigned xb_xcc_id() { return (unsigned)__builtin_amdgcn_s_getreg((3 << 11) | 20) & 0xFu; }
#define XB_SPIN(cond, bar) do { unsigned _sp = 0; while (cond) { __builtin_amdgcn_s_sleep(1); \
    if ((++_sp & 255u) == 0u) { if (xb_ld(&(bar)[XB_TMO])) break; if (_sp > XB_SPIN_CAP) { atomicAdd(&(bar)[XB_TMO], 1u); break; } } } } while (0)

struct XcdBarrier {
    unsigned* bar; unsigned x;
    volatile LAS unsigned* st;
};

__device__ __forceinline__ XcdBarrier xcd_barrier_post(unsigned* bar, volatile LAS unsigned* st) {
    XcdBarrier b; b.bar = bar; b.x = xb_xcc_id(); b.st = st;
    if (threadIdx.x == 0) (void)xb_add(&bar[XB_XCNT(b.x)], 1u);
    return b;
}
__device__ __forceinline__ void xcd_barrier_complete(unsigned* bar, unsigned x, unsigned& nloc, unsigned& nx) {
    const unsigned G = gridDim.x * gridDim.y * gridDim.z;
    unsigned sum, cnt, mine, sp = 0u;
    for (;;) {
        sum = 0u; cnt = 0u; mine = 0u;
#pragma unroll
        for (unsigned j = 0; j < 16; ++j) { const unsigned c = xb_ld(&bar[XB_XCNT(j)]); sum += c; cnt += (c > 0u) ? 1u : 0u; mine = (j == x) ? c : mine; }
        if (sum == G) break;
        __builtin_amdgcn_s_sleep(1);
        if ((++sp & 255u) == 0u) { if (xb_ld(&bar[XB_TMO])) break; if (sp > XB_SPIN_CAP) { atomicAdd(&bar[XB_TMO], 1u); break; } }
    }
    nloc = mine > 0u ? mine : 1u; nx = cnt > 0u ? cnt : 1u;
}

__device__ __forceinline__ void xcd_barrier(const XcdBarrier& b) {
    asm volatile("s_waitcnt vmcnt(0)" ::: "memory");
    __syncthreads();
    if (threadIdx.x == 0) {
        unsigned* bar = b.bar;
        __builtin_amdgcn_s_waitcnt(0);
        unsigned nloc = b.st[0], nx = b.st[1];
        if (nloc == 0u) { xcd_barrier_complete(bar, b.x, nloc, nx); b.st[0] = nloc; b.st[1] = nx; }
        const unsigned old = xb_add(&bar[XB_XSUB(b.x)], 1u);
        const unsigned gen = old / nloc;
        if (old + 1u == (gen + 1u) * nloc) {
            __builtin_amdgcn_fence(__ATOMIC_RELEASE, "agent");
            asm volatile("s_waitcnt vmcnt(0)" ::: "memory");
            const unsigned og = xb_add(&bar[XB_TOP], 1u);
            const unsigned tg = og / nx;
            if (og + 1u == (tg + 1u) * nx) xb_add(&bar[XB_TOPGEN], 1u);
            else XB_SPIN(xb_ld(&bar[XB_TOPGEN]) == tg, bar);
            __builtin_amdgcn_fence(__ATOMIC_ACQUIRE, "agent");
            xb_add(&bar[XB_XGEN(b.x)], 1u);
            asm volatile("s_waitcnt vmcnt(0)" ::: "memory");
        } else {
            XB_SPIN(xb_ld(&bar[XB_XGEN(b.x)]) == gen, bar);
            __builtin_amdgcn_fence(__ATOMIC_ACQUIRE, "agent");
            asm volatile("s_waitcnt vmcnt(0)" ::: "memory");
        }
    }
    __syncthreads();
}


struct Frame {
    LAS unsigned char* lds;
    int tid, lane, wave, vcu, G;
};
__device__ __forceinline__ void p0_titem(const float* __restrict__ W, int Nsrc, int nsrc0, int k0, const float* __restrict__ g, const float* __restrict__ g2, int gsplit,
                                         bf16* __restrict__ WT, int K, int ndst0, LAS float* scr, int lane) {
#pragma unroll 8
    for (int i = 0; i < 32; ++i) { const int kk = 2 * i + (lane >> 5); const int k = k0 + kk;
        float gv = 1.f; if (g) gv = (g2 && k >= gsplit) ? g2[k - gsplit] : g[k];
        scr[kk * 33 + (lane & 31)] = W[(size_t)k * Nsrc + nsrc0 + (lane & 31)] * gv; }
    LDS_WAIT(); asm volatile("" ::: "memory");
    const int c = lane & 7;
#pragma unroll
    for (int j = 0; j < 4; ++j) { const int n = (lane >> 3) + 8 * j; const LAS float* s = scr + (8 * c) * 33 + n;
        v4u o; o.x = pk2(s[0 * 33], s[1 * 33]); o.y = pk2(s[2 * 33], s[3 * 33]); o.z = pk2(s[4 * 33], s[5 * 33]); o.w = pk2(s[6 * 33], s[7 * 33]);
        *(GAS v4u*)(WT + (size_t)(ndst0 + n) * K + k0 + 8 * c) = o; }
    LDS_WAIT(); asm volatile("" ::: "memory");
}
__device__ __forceinline__ void p0_cast_row(const float* __restrict__ xrow, bf16* __restrict__ orow, float* __restrict__ rs, int lane) {
    const GAS f32x4* xr = (const GAS f32x4*)xrow + lane; float s = 0.f; f32x4 v[4];
#pragma unroll
    for (int j = 0; j < 4; ++j) { v[j] = xr[64 * j]; s += (v[j].x * v[j].x + v[j].y * v[j].y) + (v[j].z * v[j].z + v[j].w * v[j].w); }
    GAS unsigned long long* o8 = (GAS unsigned long long*)orow + lane;
#pragma unroll
    for (int j = 0; j < 4; ++j) o8[64 * j] = (unsigned long long)pk2(v[j].x, v[j].y) | ((unsigned long long)pk2(v[j].z, v[j].w) << 32);
    s = wave_sum(s);
    if (lane == 0) *rs = rsqrtf(s * (1.f / DM) + EPS);
}

struct Args { const float* in[20]; float* out; unsigned char* ws; int ph_lo, ph_hi; };
enum { PH_PRO = 0, PH_QKV = 1, PH_ATT = 2, PH_MERGE = 3, PH_OUT = 4, PH_QM = 5, PH_CROSS = 6, PH_OM = 7, PH_FFN1 = 8, PH_FIX = 9, PH_DOWN = 10, PH_FINAL = 11, PH_N = 12 };

__global__ void __launch_bounds__(NWAVES * 64, 2) mega(Args args) {
    extern __shared__ __attribute__((aligned(16))) unsigned char lds_raw[];
    Frame F;
    F.lds = (LAS unsigned char*)lds_raw;
    F.tid = threadIdx.x; F.lane = F.tid & 63; F.wave = __builtin_amdgcn_readfirstlane(F.tid >> 6);
    F.G = gridDim.x; { const int bx = blockIdx.x; F.vcu = (F.G % 8 == 0) ? (bx % 8) * (F.G / 8) + bx / 8 : bx; }
    unsigned char* ws = args.ws;
    volatile LAS unsigned* MISC = (volatile LAS unsigned*)(F.lds + MISC_OFF);
    for (int u = F.tid; u < (LDS_BYTES - MISC_OFF) / 4; u += NWAVES * 64) ((LAS unsigned*)(F.lds + MISC_OFF))[u] = 0u;
    __syncthreads();
    const int lo = args.ph_lo, hi = args.ph_hi;
    XcdBarrier bar; bar.bar = (unsigned*)(ws + WS_CTL) + CW_BAR; bar.x = 0; bar.st = nullptr;
    if (hi - lo > 1) bar = xcd_barrier_post((unsigned*)(ws + WS_CTL) + CW_BAR, MISC + 8);
#define IN(k) (lo <= (k) && (k) < hi)
#define SEAM(k) do { if (IN(k) && IN((k) + 1)) xcd_barrier(bar); } while (0)

    const float* x = args.in[0]; const float* mem = args.in[1]; const float* w_in = args.in[2]; const float* g_mix = args.in[3]; const float* g_od = args.in[4];
    const float* g_om = args.in[5]; const float* w_out = args.in[6]; const float* rel_bias = args.in[7]; const float* g_cross = args.in[8]; const float* g_mem = args.in[9];
    const float* w_q = args.in[10]; const float* w_kv = args.in[11]; const float* w_o = args.in[12]; const float* g_ffn = args.in[13]; const float* w_gate = args.in[14];
    const float* w_up = args.in[15]; const float* conv_w = args.in[16]; const float* conv_b = args.in[17]; const float* w_down = args.in[18]; const float* g_final = args.in[19];
    float* RS0 = (float*)(ws + WS_RS0); float* RSM = (float*)(ws + WS_RSM); float* SS1 = (float*)(ws + WS_SS1); float* SS2 = (float*)(ws + WS_SS2); float* SS3 = (float*)(ws + WS_SS3);
    float* LUT = (float*)(ws + WS_LUT); float* KMP = (float*)(ws + WS_KMP); float* HALOG = (float*)(ws + WS_HALOG); float* FIXG = (float*)(ws + WS_FIXG); float* FIXU = (float*)(ws + WS_FIXU);
    bf16* WIN = (bf16*)(ws + WS_WIN); bf16* WOUT = (bf16*)(ws + WS_WOUT); bf16* WQ = (bf16*)(ws + WS_WQ); bf16* WKV = (bf16*)(ws + WS_WKV);
    bf16* WO = (bf16*)(ws + WS_WO); bf16* WGU = (bf16*)(ws + WS_WGU); bf16* WD = (bf16*)(ws + WS_WD);
    bf16* MEMB = (bf16*)(ws + WS_MEMB); bf16* KVM = (bf16*)(ws + WS_KVM); bf16* XB = (bf16*)(ws + WS_XB); bf16* QKV = (bf16*)(ws + WS_QKV);
    bf16* YN = (bf16*)(ws + WS_YN); bf16* H1 = (bf16*)(ws + WS_H1); bf16* QM = (bf16*)(ws + WS_QM);
    bf16* OM = (bf16*)(ws + WS_OM); bf16* H2 = (bf16*)(ws + WS_H2); bf16* ACT = (bf16*)(ws + WS_ACT); bf16* H3 = (bf16*)(ws + WS_H3);
    const int gw = F.vcu * NWAVES + F.wave, NGW = F.G * NWAVES;
    const int gt = (int)blockIdx.x * (NWAVES * 64) + F.tid, NGT = F.G * NWAVES * 64;

    if (IN(PH_PRO)) {
        LAS float* scr = (LAS float*)(F.lds + RING_OFF + F.wave * 16384);
        constexpr int I_IN = 16 * 96, I_OUT = 16 * 32, I_Q = 16 * 32, I_KV = 16 * 64, I_O = 16 * 32, I_GU = 16 * 176, I_D = 44 * 32;
        constexpr int NITEMS = I_IN + I_OUT + I_Q + I_KV + I_O + I_GU + I_D;
        for (int it = gw; it < NITEMS; it += NGW) {
            int r = it;
            if (r < I_IN) { const int kb = r / 96, nb = r % 96; p0_titem(w_in, 3072, 32 * nb, 64 * kb, g_mix, nullptr, 0, WIN, 1024, 32 * nb, scr, F.lane); continue; } r -= I_IN;
            if (r < I_OUT) { const int kb = r / 32, nb = r % 32; p0_titem(w_out, 1024, 32 * nb, 64 * kb, g_od, g_om, 512, WOUT, 1024, 32 * nb, scr, F.lane); continue; } r -= I_OUT;
            if (r < I_Q) { const int kb = r / 32, nb = r % 32; p0_titem(w_q, 1024, 32 * nb, 64 * kb, g_cross, nullptr, 0, WQ, 1024, 32 * nb, scr, F.lane); continue; } r -= I_Q;
            if (r < I_KV) { const int kb = r / 64, nb = r % 64; p0_titem(w_kv, 2048, 32 * nb, 64 * kb, g_mem, nullptr, 0, WKV, 1024, 32 * nb, scr, F.lane); continue; } r -= I_KV;
            if (r < I_O) { const int kb = r / 32, nb = r % 32; p0_titem(w_o, 1024, 32 * nb, 64 * kb, nullptr, nullptr, 0, WO, 1024, 32 * nb, scr, F.lane); continue; } r -= I_O;
            if (r < I_GU) { const int kb = r / 176, nb = r % 176; const int nd = 32 * nb, j = nd >> 8, rr = nd & 255;
                const float* src = (rr < 128) ? w_gate : w_up; const int sc = 128 * j + (rr & 127);
                p0_titem(src, 2816, sc, 64 * kb, g_ffn, nullptr, 0, WGU, 1024, nd, scr, F.lane); continue; } r -= I_GU;
            { const int kb = r / 32, nb = r % 32; p0_titem(w_down, 1024, 32 * nb, 64 * kb, nullptr, nullptr, 0, WD, 2816, 32 * nb, scr, F.lane); }
        }
        for (int m = gw; m < NTOK; m += NGW) p0_cast_row(x + (size_t)m * DM, XB + (size_t)m * DM, RS0 + m, F.lane);
        for (int m = gw; m < NMEMTOK; m += NGW) p0_cast_row(mem + (size_t)m * DM, MEMB + (size_t)m * DM, RSM + m, F.lane);
        for (int i = gt; i < 16 * 2048; i += NGT) { const int h = i >> 11, n = i & 2047; int b;
            if (n < 16) b = n; else { b = 16 + (n >= 22) + (n >= 30) + (n >= 40) + (n >= 54) + (n >= 73) + (n >= 99) + (n >= 134) + (n >= 182) + (n >= 246) + (n >= 332) + (n >= 450) + (n >= 609) + (n >= 825) + (n >= 1117) + (n >= 1513); }
            LUT[i] = rel_bias[h * 32 + b]; }
        for (int i = gt; i < NTOK; i += NGT) { SS1[i] = 0.f; SS2[i] = 0.f; SS3[i] = 0.f; }
    }
    SEAM(PH_PRO);

    if (IN(PH_QKV)) {
        { pg8::Gemm g{XB, WIN, NTOK, NQKV, 1024}; pg8::StaticOrder S; S.init(NTOK, NQKV, F.G, (int)blockIdx.x);
          pg8::EpiScale E{QKV, RS0, KMP, NQKV, 0};
          pg8::gemm_phase<pg8::EpiScale, pg8::StaticOrder, true, true>(F.lds + RING_OFF, g, S, E); }
        { pg8::Gemm g{MEMB, WKV, NMEMTOK, 2048, 1024}; pg8::StaticOrder S; S.init(NMEMTOK, 2048, F.G, (int)blockIdx.x);
          pg8::EpiScale E{KVM, RSM, nullptr, 2048, 0};
          pg8::gemm_phase<pg8::EpiScale, pg8::StaticOrder, true, true>(F.lds + RING_OFF, g, S, E); }
    }
    SEAM(PH_QKV);

    SEAM(PH_ATT);

    SEAM(PH_MERGE);

    if (IN(PH_OUT)) {
        pg8::Gemm g{YN, WOUT, NTOK, DM, 1024}; pg8::StaticOrder S; S.init(NTOK, DM, F.G, (int)blockIdx.x);
        pg8::EpiResid E{H1, XB, SS1, DM, 0};
        pg8::gemm_phase<pg8::EpiResid, pg8::StaticOrder, true, true>(F.lds + RING_OFF, g, S, E);
    }
    SEAM(PH_OUT);
    if (IN(PH_QM)) {
        pg8::Gemm g{H1, WQ, NTOK, DM, 1024}; pg8::StaticOrder S; S.init(NTOK, DM, F.G, (int)blockIdx.x);
        pg8::EpiScale E{QM, SS1, nullptr, DM, 1};
        pg8::gemm_phase<pg8::EpiScale, pg8::StaticOrder, true, true>(F.lds + RING_OFF, g, S, E);
    }
    SEAM(PH_QM);

    SEAM(PH_CROSS);
    if (IN(PH_OM)) {
        pg8::Gemm g{OM, WO, NTOK, DM, 1024}; pg8::StaticOrder S; S.init(NTOK, DM, F.G, (int)blockIdx.x);
        pg8::EpiResid E{H2, H1, SS2, DM, 0};
        pg8::gemm_phase<pg8::EpiResid, pg8::StaticOrder, true, true>(F.lds + RING_OFF, g, S, E);
    }
    SEAM(PH_OM);
    if (IN(PH_FFN1)) {
        pg8::Gemm g{H2, WGU, NTOK, 5632, 1024}; pg8::StaticOrder S; S.init(NTOK, 5632, F.G, (int)blockIdx.x);
        pg8::EpiFfn1 E{ACT, SS2, conv_w, conv_b, HALOG, FIXG, FIXU, (LAS float*)(F.lds + LDSX_OFF)};
        pg8::gemm_phase<pg8::EpiFfn1, pg8::StaticOrder, true, true>(F.lds + RING_OFF, g, S, E);
    }
    SEAM(PH_FFN1);
    if (IN(PH_FIX)) {
        for (int i = gt; i < 256 * 2816; i += NGT) { const int pm = i / 2816, c = i % 2816;
            const float g0 = FIXG[((size_t)pm * 2 + 0) * 2816 + c], g1 = FIXG[((size_t)pm * 2 + 1) * 2816 + c];
            float hm1 = 0.f, hm2 = 0.f; if (pm & 7) { hm2 = HALOG[((size_t)(pm - 1) * 2 + 0) * 2816 + c]; hm1 = HALOG[((size_t)(pm - 1) * 2 + 1) * 2816 + c]; }
            const float w0 = conv_w[c], w1 = conv_w[2816 + c], w2 = conv_w[2 * 2816 + c], cbv = conv_b[c];
            const float c0 = cbv + w2 * g0 + w1 * hm1 + w0 * hm2, c1 = cbv + w2 * g1 + w1 * g0 + w0 * hm1;
            ACT[((size_t)pm * 256 + 0) * 2816 + c] = (bf16)f2bf(c0 / (1.f + __expf(-c0)) * FIXU[((size_t)pm * 2 + 0) * 2816 + c]);
            ACT[((size_t)pm * 256 + 1) * 2816 + c] = (bf16)f2bf(c1 / (1.f + __expf(-c1)) * FIXU[((size_t)pm * 2 + 1) * 2816 + c]); }
    }
    SEAM(PH_FIX);
    if (IN(PH_DOWN)) {
        pg8::Gemm g{ACT, WD, NTOK, DM, DFF}; pg8::StaticOrder S; S.init(NTOK, DM, F.G, (int)blockIdx.x);
        pg8::EpiResid E{H3, H2, SS3, DM, 0};
        pg8::gemm_phase<pg8::EpiResid, pg8::StaticOrder, true, true>(F.lds + RING_OFF, g, S, E);
    }
    SEAM(PH_DOWN);
    if (IN(PH_FINAL)) {
        for (int m = gw; m < NTOK; m += NGW) { const float rs = rsqrtf(SS3[m] * (1.f / DM) + EPS);
            const GAS u32x2* hr = (const GAS u32x2*)(H3 + (size_t)m * DM) + F.lane; GAS f32x4* o = (GAS f32x4*)(args.out + (size_t)m * DM) + F.lane; const GAS f32x4* gp = (const GAS f32x4*)g_final + F.lane;
#pragma unroll
            for (int j = 0; j < 4; ++j) { const u32x2 w = hr[64 * j]; const f32x4 gg = gp[64 * j];
                o[64 * j] = (f32x4){bflo(w.x) * rs * gg.x, bfhi(w.x) * rs * gg.y, bflo(w.y) * rs * gg.z, bfhi(w.y) * rs * gg.w}; } }
    }
#undef IN
#undef SEAM
}


extern "C" void kernel_launch(void* const* d_in, const int* in_sizes, int n_in, void* d_out, int out_size, void* d_ws, size_t ws_size, hipStream_t stream) {
    static int grid = 0;
    if (grid == 0) {
        if (n_in != 20 || in_sizes[0] != NTOK * DM || out_size != NTOK * DM || ws_size < WS_END) { fprintf(stderr, "kernel_launch: unexpected shapes (n_in %d, ws %zu); nothing launched\n", n_in, ws_size); grid = -1; return; }
        int dev = 0, cus = 0, per_cu = 0;
        if (hipGetDevice(&dev) != hipSuccess || hipDeviceGetAttribute(&cus, hipDeviceAttributeMultiprocessorCount, dev) != hipSuccess) { grid = -1; return; }
        if (hipFuncSetAttribute((const void*)mega, hipFuncAttributeMaxDynamicSharedMemorySize, LDS_BYTES) != hipSuccess) { fprintf(stderr, "kernel_launch: hipFuncSetAttribute failed\n"); grid = -1; return; }
        if (hipOccupancyMaxActiveBlocksPerMultiprocessor(&per_cu, (const void*)mega, NWAVES * 64, LDS_BYTES) != hipSuccess || per_cu < 1) fprintf(stderr, "kernel_launch: occupancy query says %d\n", per_cu);
        (void)hipGetLastError();
        grid = cus;
    }
    if (grid < 0) return;
    unsigned char* ws = (unsigned char*)d_ws;
    (void)hipMemsetAsync(ws + WS_CTL, 0, CTL_ZERO_BYTES, stream);
    Args a{};
    for (int i = 0; i < 20; ++i) a.in[i] = (const float*)d_in[i];
    a.out = (float*)d_out; a.ws = ws;
    auto run = [&](int lo, int hi) { a.ph_lo = lo; a.ph_hi = hi; hipLaunchKernelGGL(mega, dim3(grid), dim3(NWAVES * 64), LDS_BYTES, stream, a); };

    float* KMEAN = (float*)(ws + WS_KMEAN); float* LUT = (float*)(ws + WS_LUT);
    bf16* QKV = (bf16*)(ws + WS_QKV); bf16* Y = (bf16*)(ws + WS_Y); bf16* YN = (bf16*)(ws + WS_YN); bf16* QM = (bf16*)(ws + WS_QM); bf16* OM = (bf16*)(ws + WS_OM); bf16* KVM = (bf16*)(ws + WS_KVM);
run(PH_PRO, PH_PRO + 1); run(PH_QKV, PH_QKV + 1);
    k_dil_naive<<<NTOK * 8 / 256, 256, 0, stream>>>(QKV, LUT, Y);
    k_kmean<<<32 * 8 * 8, 64, 0, stream>>>(QKV, KMEAN);
    k_moba_naive<<<NTOK * 8 / 256, 256, 0, stream>>>(QKV, KMEAN, LUT, Y);
    k_attnnorm<<<NTOK / 4, 256, 0, stream>>>(Y, YN, NTOK);
run(PH_OUT, PH_OUT + 1); run(PH_QM, PH_QM + 1);
    k_cross_naive<<<NTOK * 4, 256, 0, stream>>>(QM, KVM, OM);
run(PH_OM, PH_OM + 1); run(PH_FFN1, PH_FFN1 + 1); run(PH_FIX, PH_FIX + 1); run(PH_DOWN, PH_DOWN + 1); run(PH_FINAL, PH_FINAL + 1);
}
```

```cpp
#include <hip/hip_runtime.h>
#include <cstdio>
#include <cstdint>

typedef unsigned short bf16;
constexpr int BATCH = 32, SEQ = 2048, DM = 1024, NTOK = BATCH * SEQ;
constexpr int NMEM = 256, NMEMTOK = BATCH * NMEM, DFF = 2816;
constexpr int NQKV = 3072;
constexpr float EPS = 1e-6f;

constexpr size_t MiB = 1u << 20;
constexpr size_t WS_CTL = 0, CTL_ZERO_BYTES = 64 * 1024;
constexpr size_t WS_RS0 = 1 * MiB;
constexpr size_t WS_RSM = WS_RS0 + 256 * 1024;
constexpr size_t WS_SS1 = WS_RSM + 256 * 1024;
constexpr size_t WS_SS2 = WS_SS1 + 256 * 1024;
constexpr size_t WS_SS3 = WS_SS2 + 256 * 1024;
constexpr size_t WS_KMEAN = WS_SS3 + 256 * 1024;
constexpr size_t WS_LUT = WS_KMEAN + 512 * 1024;
constexpr size_t WS_KMP = 3 * MiB;
constexpr size_t WS_HALOG = 4 * MiB;
constexpr size_t WS_FIXG = WS_HALOG + 256 * 2 * 2816 * 4;
constexpr size_t WS_FIXU = WS_FIXG + 256 * 2 * 2816 * 4;
constexpr size_t WS_LSEP = 22 * MiB;
constexpr size_t WS_WIN = 28 * MiB;
constexpr size_t WS_WOUT = WS_WIN + 6 * MiB;
constexpr size_t WS_WQ = WS_WOUT + 2 * MiB;
constexpr size_t WS_WKV = WS_WQ + 2 * MiB;
constexpr size_t WS_WO = WS_WKV + 4 * MiB;
constexpr size_t WS_WGU = WS_WO + 2 * MiB;
constexpr size_t WS_WD = WS_WGU + 11 * MiB;
constexpr size_t WS_MEMB = 62 * MiB;
constexpr size_t WS_KVM = 78 * MiB;
constexpr size_t WS_XB = 112 * MiB;
constexpr size_t WS_QKV = 240 * MiB;
constexpr size_t WS_Y = 624 * MiB;
constexpr size_t WS_OP = 752 * MiB;
constexpr size_t WS_YN = 240 * MiB;
constexpr size_t WS_H1 = 880 * MiB;
constexpr size_t WS_QM = 368 * MiB;
constexpr size_t WS_OM = 496 * MiB;
constexpr size_t WS_H2 = 624 * MiB;
constexpr size_t WS_ACT = 112 * MiB;
constexpr size_t WS_GU = 752 * MiB;
constexpr size_t WS_H3 = 464 * MiB;
constexpr size_t WS_END = 1024 * MiB;
static_assert(WS_FIXU + 256 * 2 * 2816 * 4 <= WS_LSEP && WS_LSEP + 6 * MiB <= WS_WIN && WS_WD + 6 * MiB <= WS_MEMB, "ws map");

__device__ __forceinline__ unsigned f2bf(float f) { unsigned u = __builtin_bit_cast(unsigned, f); return (u + 0x7fffu + ((u >> 16) & 1u)) >> 16; }
__device__ __forceinline__ float bf2f(bf16 b) { return __builtin_bit_cast(float, (unsigned)b << 16); }
__device__ __forceinline__ float bflo(unsigned w) { return __builtin_bit_cast(float, w << 16); }
__device__ __forceinline__ float bfhi(unsigned w) { return __builtin_bit_cast(float, w & 0xffff0000u); }
__device__ __forceinline__ float wave_sum(float v) {
#pragma unroll
    for (int o = 1; o < 64; o <<= 1) v += __shfl_xor(v, o);
    return v;
}


__global__ void k_cast_rows(const float* __restrict__ x, bf16* __restrict__ xb, float* __restrict__ rs, int nrows) {
    const int wave = (blockIdx.x * blockDim.x + threadIdx.x) >> 6, lane = threadIdx.x & 63;
    if (wave >= nrows) return;
    const float* xr = x + (size_t)wave * DM; bf16* o = xb + (size_t)wave * DM;
    float s = 0.f;
    for (int j = 0; j < 4; ++j) { const float4 v = *(const float4*)(xr + j * 256 + lane * 4);
        s += v.x * v.x + v.y * v.y + v.z * v.z + v.w * v.w;
        uint2 w; w.x = f2bf(v.x) | (f2bf(v.y) << 16); w.y = f2bf(v.z) | (f2bf(v.w) << 16);
        *(uint2*)(o + j * 256 + lane * 4) = w; }
    s = wave_sum(s);
    if (lane == 0) rs[wave] = rsqrtf(s * (1.f / DM) + EPS);
}
__global__ void k_wt(const float* __restrict__ W, const float* __restrict__ W2, const float* __restrict__ g, const float* __restrict__ g2, int gsplit,
                     bf16* __restrict__ WT, int K, int N, int Nsrc, int mode) {
    const size_t idx = (size_t)blockIdx.x * blockDim.x + threadIdx.x;
    if (idx >= (size_t)K * N) return;
    const int n = (int)(idx / K), k = (int)(idx % K);
    const float* src = W; int col = n;
    if (mode == 1) { const int j = n >> 8, r = n & 255; if (r < 128) { col = 128 * j + r; } else { col = 128 * j + r - 128; src = W2; } }
    float gv = 1.f;
    if (g) gv = (g2 && k >= gsplit) ? g2[k - gsplit] : g[k];
    WT[idx] = (bf16)f2bf(src[(size_t)k * Nsrc + col] * gv);
}
__global__ void k_lut(const float* __restrict__ rel_bias, float* __restrict__ lut) {
    const int idx = blockIdx.x * blockDim.x + threadIdx.x; if (idx >= 16 * 2048) return;
    const int h = idx >> 11, n = idx & 2047;
    int b;
    if (n < 16) b = n; else { b = 16; const int T[15] = {22, 30, 40, 54, 73, 99, 134, 182, 246, 332, 450, 609, 825, 1117, 1513};
#pragma unroll
        for (int j = 0; j < 15; ++j) b += (n >= T[j]) ? 1 : 0; }
    lut[idx] = rel_bias[h * 32 + b];
}

struct EpiRowScale { bf16* O; const float* rs; const float* ss; int ldc; int pad;
    __device__ void operator()(int r, int c, float v) const { const float s = rs ? rs[r] : rsqrtf(ss[r] * (1.f / DM) + EPS); O[(size_t)r * ldc + c] = (bf16)f2bf(v * s); } };
struct EpiResid { bf16* O; const bf16* R; int ldc; int pad;
    __device__ void operator()(int r, int c, float v) const { O[(size_t)r * ldc + c] = (bf16)f2bf(v + bf2f(R[(size_t)r * ldc + c])); } };
template <class Epi> __global__ void __launch_bounds__(256) k_gemm(const bf16* __restrict__ A, const bf16* __restrict__ Bt, int K, Epi e, int row_base) {
    __shared__ float As[16][65], Bs[16][65];
    const int tx = threadIdx.x & 15, ty = threadIdx.x >> 4;
    const int row0 = blockIdx.y * 64, col0 = blockIdx.x * 64;
    float acc[4][4];
#pragma unroll
    for (int i = 0; i < 4; ++i)
#pragma unroll
        for (int j = 0; j < 4; ++j) acc[i][j] = 0.f;
    for (int k0 = 0; k0 < K; k0 += 16) {
#pragma unroll
        for (int i = 0; i < 4; ++i) { const int idx = threadIdx.x + 256 * i, r = idx >> 4, c = idx & 15;
            As[c][r] = bf2f(A[(size_t)(row_base + row0 + r) * K + k0 + c]); Bs[c][r] = bf2f(Bt[(size_t)(col0 + r) * K + k0 + c]); }
        __syncthreads();
#pragma unroll
        for (int kk = 0; kk < 16; ++kk) { float a[4], b[4];
#pragma unroll
            for (int i = 0; i < 4; ++i) { a[i] = As[kk][ty * 4 + i]; b[i] = Bs[kk][tx * 4 + i]; }
#pragma unroll
            for (int i = 0; i < 4; ++i)
#pragma unroll
                for (int j = 0; j < 4; ++j) acc[i][j] += a[i] * b[j]; }
        __syncthreads();
    }
#pragma unroll
    for (int i = 0; i < 4; ++i)
#pragma unroll
        for (int j = 0; j < 4; ++j) e(row_base + row0 + ty * 4 + i, col0 + tx * 4 + j, acc[i][j]);
}
__global__ void k_sumsq(const bf16* __restrict__ H, float* __restrict__ ss, int nrows) {
    const int wave = (blockIdx.x * blockDim.x + threadIdx.x) >> 6, lane = threadIdx.x & 63;
    if (wave >= nrows) return;
    const bf16* r = H + (size_t)wave * DM; float s = 0.f;
    for (int j = 0; j < 16; ++j) { const float v = bf2f(r[j * 64 + lane]); s += v * v; }
    s = wave_sum(s); if (lane == 0) ss[wave] = s;
}

__global__ void __launch_bounds__(256) k_dil_naive(const bf16* __restrict__ QKV, const float* __restrict__ lut, bf16* __restrict__ Y) {
    const int idx = blockIdx.x * blockDim.x + threadIdx.x;
    const int t = idx & 2047, h = (idx >> 11) & 7, b = idx >> 14;
    const size_t row = (size_t)b * SEQ + t;
    float q[64], o[64];
    const bf16* qp = QKV + row * NQKV + h * 64;
#pragma unroll
    for (int d = 0; d < 64; ++d) { q[d] = bf2f(qp[d]); o[d] = 0.f; }
    float m = -1e30f, l = 0.f;
    const float* lh = lut + h * 2048;
    for (int p = 0; p < 3; ++p) { const int dil = (p == 0) ? 1 : (p == 1 ? 4 : 16);
        for (int j = 0; j <= 128; ++j) { const int tk = t - j * dil; if (tk < 0) break;
            const bf16* kp = QKV + ((size_t)b * SEQ + tk) * NQKV + 512 + h * 64; const bf16* vp = kp + 512;
            float s = 0.f;
#pragma unroll
            for (int d = 0; d < 64; ++d) s += q[d] * bf2f(kp[d]);
            s = s * 0.125f + lh[j * dil];
            const float mn = fmaxf(m, s), a = __expf(m - mn), pe = __expf(s - mn);
            l = l * a + pe; m = mn;
#pragma unroll
            for (int d = 0; d < 64; ++d) o[d] = o[d] * a + pe * bf2f(vp[d]);
        } }
    const float il = 1.f / l; bf16* yp = Y + row * DM + h * 64;
#pragma unroll
    for (int d = 0; d < 64; ++d) yp[d] = (bf16)f2bf(o[d] * il);
}
__global__ void k_kmean(const bf16* __restrict__ QKV, float* __restrict__ km) {
    const int d = threadIdx.x, blk = blockIdx.x & 7, h = (blockIdx.x >> 3) & 7, b = blockIdx.x >> 6;
    float s = 0.f;
    for (int k = 0; k < 256; ++k) s += bf2f(QKV[((size_t)b * SEQ + blk * 256 + k) * NQKV + 2048 + h * 64 + d]);
    km[(((size_t)b * 8 + h) * 8 + blk) * 64 + d] = s * (1.f / 256.f);
}
__global__ void __launch_bounds__(256) k_moba_naive(const bf16* __restrict__ QKV, const float* __restrict__ km, const float* __restrict__ lut, bf16* __restrict__ Y) {
    const int idx = blockIdx.x * blockDim.x + threadIdx.x;
    const int t = idx & 2047, h = (idx >> 11) & 7, b = idx >> 14;
    const size_t row = (size_t)b * SEQ + t;
    float q[64], o[64];
    const bf16* qp = QKV + row * NQKV + 1536 + h * 64;
#pragma unroll
    for (int d = 0; d < 64; ++d) { q[d] = bf2f(qp[d]); o[d] = 0.f; }
    const int own = t >> 8;
    float g[8];
#pragma unroll
    for (int j = 0; j < 8; ++j) { const float* kmp = km + (((size_t)b * 8 + h) * 8 + j) * 64; float s = 0.f;
#pragma unroll
        for (int d = 0; d < 64; ++d) s += q[d] * kmp[d];
        g[j] = s; }
    unsigned sel = 0; const int nsel = own < 3 ? own : 3;
    for (int n = 0; n < nsel; ++n) { float best = -3e38f; int bi = 0;
#pragma unroll
        for (int j = 0; j < 8; ++j) if (j < own && !((sel >> j) & 1u) && g[j] > best) { best = g[j]; bi = j; }
        sel |= 1u << bi; }
    sel |= 1u << own;
    float m = -1e30f, l = 0.f;
    const float* lh = lut + (8 + h) * 2048;
    for (int blk = 0; blk <= own; ++blk) { if (!((sel >> blk) & 1u)) continue;
        for (int kk = 0; kk < 256; ++kk) { const int tk = blk * 256 + kk; if (tk > t) break;
            const bf16* kp = QKV + ((size_t)b * SEQ + tk) * NQKV + 2048 + h * 64; const bf16* vp = kp + 512;
            float s = 0.f;
#pragma unroll
            for (int d = 0; d < 64; ++d) s += q[d] * bf2f(kp[d]);
            s = s * 0.125f + lh[t - tk];
            const float mn = fmaxf(m, s), a = __expf(m - mn), pe = __expf(s - mn);
            l = l * a + pe; m = mn;
#pragma unroll
            for (int d = 0; d < 64; ++d) o[d] = o[d] * a + pe * bf2f(vp[d]);
        } }
    const float il = 1.f / l; bf16* yp = Y + row * DM + 512 + h * 64;
#pragma unroll
    for (int d = 0; d < 64; ++d) yp[d] = (bf16)f2bf(o[d] * il);
}
__global__ void k_attnnorm(const bf16* __restrict__ Y, bf16* __restrict__ YN, int nrows) {
    const int wave = (blockIdx.x * blockDim.x + threadIdx.x) >> 6, lane = threadIdx.x & 63;
    if (wave >= nrows) return;
    const bf16* r = Y + (size_t)wave * DM; bf16* o = YN + (size_t)wave * DM;
    for (int half = 0; half < 2; ++half) { float v[8]; float s = 0.f;
#pragma unroll
        for (int j = 0; j < 8; ++j) { v[j] = bf2f(r[half * 512 + j * 64 + lane]); s += v[j] * v[j]; }
        s = wave_sum(s); const float rs = rsqrtf(s * (1.f / 512.f) + EPS);
#pragma unroll
        for (int j = 0; j < 8; ++j) o[half * 512 + j * 64 + lane] = (bf16)f2bf(v[j] * rs); }
}
__global__ void __launch_bounds__(256) k_cross_naive(const bf16* __restrict__ QM, const bf16* __restrict__ KVM, bf16* __restrict__ OM) {
    __shared__ float qs[256], ps[256], red[8];
    const int row = blockIdx.x >> 2, h = blockIdx.x & 3, b = row >> 11, tid = threadIdx.x;
    qs[tid] = bf2f(QM[(size_t)row * DM + h * 256 + tid]);
    __syncthreads();
    const bf16* kp = KVM + ((size_t)b * NMEM + tid) * 2048 + h * 256;
    float s = 0.f;
    for (int d = 0; d < 256; ++d) s += qs[d] * bf2f(kp[d]);
    s *= 0.0625f;
    float mx = s;
#pragma unroll
    for (int o = 1; o < 64; o <<= 1) mx = fmaxf(mx, __shfl_xor(mx, o));
    if ((tid & 63) == 0) red[tid >> 6] = mx;
    __syncthreads();
    mx = fmaxf(fmaxf(red[0], red[1]), fmaxf(red[2], red[3]));
    const float p = __expf(s - mx);
    float sm = wave_sum(p);
    if ((tid & 63) == 0) red[4 + (tid >> 6)] = sm;
    ps[tid] = p;
    __syncthreads();
    sm = red[4] + red[5] + red[6] + red[7];
    float o = 0.f;
    for (int k = 0; k < 256; ++k) o += ps[k] * bf2f(KVM[((size_t)b * NMEM + k) * 2048 + 1024 + h * 256 + tid]);
    OM[(size_t)row * DM + h * 256 + tid] = (bf16)f2bf(o / sm);
}
__global__ void k_conv_naive(const bf16* __restrict__ GU, const float* __restrict__ cw, const float* __restrict__ cb, bf16* __restrict__ ACT, int row_base, int nrows) {
    const size_t idx = (size_t)blockIdx.x * blockDim.x + threadIdx.x; if (idx >= (size_t)nrows * DFF) return;
    const int lr = (int)(idx / DFF), c = (int)(idx % DFF), row = row_base + lr, t = row & 2047;
    const int j = c >> 7, r = c & 127; const size_t gcol = (size_t)j * 256 + r, ucol = gcol + 128;
    float conv = cb[c] + cw[2 * DFF + c] * bf2f(GU[(size_t)lr * 5632 + gcol]);
    if (t >= 1) conv += cw[1 * DFF + c] * bf2f(GU[(size_t)(lr - 1) * 5632 + gcol]);
    if (t >= 2) conv += cw[0 * DFF + c] * bf2f(GU[(size_t)(lr - 2) * 5632 + gcol]);
    const float sl = conv / (1.f + __expf(-conv));
    ACT[(size_t)row * DFF + c] = (bf16)f2bf(sl * bf2f(GU[(size_t)lr * 5632 + ucol]));
}
__global__ void k_final(const bf16* __restrict__ H3, const float* __restrict__ g, float* __restrict__ out, int nrows) {
    const int wave = (blockIdx.x * blockDim.x + threadIdx.x) >> 6, lane = threadIdx.x & 63;
    if (wave >= nrows) return;
    const bf16* r = H3 + (size_t)wave * DM; float v[16]; float s = 0.f;
#pragma unroll
    for (int j = 0; j < 16; ++j) { v[j] = bf2f(r[j * 64 + lane]); s += v[j] * v[j]; }
    s = wave_sum(s); const float rs = rsqrtf(s * (1.f / DM) + EPS);
#pragma unroll
    for (int j = 0; j < 16; ++j) out[(size_t)wave * DM + j * 64 + lane] = v[j] * rs * g[j * 64 + lane];
}


namespace pg8 {
#define PG8_LAS __attribute__((address_space(3)))
typedef unsigned short bf16_t;
typedef short bf16x8 __attribute__((ext_vector_type(8)));
typedef float f32x4 __attribute__((ext_vector_type(4)));
typedef unsigned u32x4 __attribute__((ext_vector_type(4)));
constexpr int BM = 256, BK = 64, HALF = 128, HTB = HALF * BK * 2  , STAGE_BYTES = 8 * HTB, NXCD = 8, WGM = 8;

__host__ __device__ __forceinline__ int lds_byte(int r, int c) { const int st = (r >> 4) * 2 + (c >> 5), rr = r & 15, cc = c & 31, ob = rr * 64 + cc * 2; return st * 1024 + (ob ^ (((ob >> 9) & 1) << 5)); }
__host__ __device__ __forceinline__ void stage_rc(int b, int& R, int& C) { const int st = b / 1024, sb = b % 1024, swz = sb ^ (((sb >> 9) & 1) << 5); R = (st >> 1) * 16 + swz / 64; C = (st & 1) * 32 + (swz % 64) / 2; }
__host__ __device__ __forceinline__ int perm32(int rho) { const int n = rho >> 4, i = rho & 15; return 8 * (i >> 2) + 4 * n + (i & 3); }

struct Unit { int pm, pn; };
struct Gemm { const bf16_t* A; const bf16_t* Bt; int M, N, K; };

struct StaticOrder {
    int nM, nN, nwg, G, c;
    __host__ __device__ void init(int M, int N, int G_, int c_) { nM = M / BM; nN = N / BM; nwg = nM * nN; G = G_; c = c_; }
    __host__ __device__ bool next(int i, Unit& u) const {
        const long L = (long)i * G + c; if (L >= nwg) return false;
        int wgid = (int)L; { const int q = nwg / NXCD, r = nwg % NXCD, xcd = wgid % NXCD, off = wgid / NXCD; wgid = (xcd < r ? xcd * (q + 1) : r * (q + 1) + (xcd - r) * q) + off; }
        const int nig = WGM * nN, gid = wgid / nig, fm = gid * WGM, gsz = (nM - fm) < WGM ? (nM - fm) : WGM;
        u.pm = fm + ((wgid % nig) % gsz); u.pn = (wgid % nig) / gsz; return true;
    }
    __device__ __forceinline__ void a_ready(const Unit&) const {}
    __device__ __forceinline__ void done(const Unit&) const {}
};


__device__ __forceinline__ unsigned cvt_pk_bf16(float lo, float hi) { unsigned r; asm volatile("v_cvt_pk_bf16_f32 %0, %1, %2" : "=v"(r) : "v"(lo), "v"(hi)); return r; }
__device__ __forceinline__ float lo_f(unsigned w) { return __builtin_bit_cast(float, w << 16); }
__device__ __forceinline__ float hi_f(unsigned w) { return __builtin_bit_cast(float, w & 0xffff0000u); }

struct EpiScale {
    static constexpr bool PERM = true, AFTER_DRAIN = false;
    bf16_t* O; const float* rs; float* kmp; int ldc; int mode;
    __device__ __forceinline__ void operator()(const f32x4 (&acc)[2][2][4][2], const Unit& u, int wr, int wc, int fr, int fq) const {
        const int row0 = u.pm * BM + wr * 64 + fr, col0 = u.pn * BM + wc * 32 + 8 * fq;
        const bool dokm = (kmp != nullptr) && (u.pn == 8 || u.pn == 9);
        float cs[2][8];
#pragma unroll
        for (int bj = 0; bj < 2; ++bj)
#pragma unroll
            for (int e = 0; e < 8; ++e) cs[bj][e] = 0.f;
#pragma unroll
        for (int ai = 0; ai < 2; ++ai)
#pragma unroll
            for (int m = 0; m < 4; ++m) { const int r = row0 + ai * HALF + m * 16; float s = rs[r]; if (mode) s = rsqrtf(s * (1.f / 1024.f) + 1e-6f);
                bf16_t* rowp = O + (size_t)r * ldc + col0;
#pragma unroll
                for (int bj = 0; bj < 2; ++bj) { const f32x4 v0 = acc[ai][bj][m][0] * s, v1 = acc[ai][bj][m][1] * s;
                    u32x4 w; w.x = cvt_pk_bf16(v0[0], v0[1]); w.y = cvt_pk_bf16(v0[2], v0[3]); w.z = cvt_pk_bf16(v1[0], v1[1]); w.w = cvt_pk_bf16(v1[2], v1[3]);
                    *(u32x4*)(rowp + bj * HALF) = w;
                    if (dokm) { cs[bj][0] += lo_f(w.x); cs[bj][1] += hi_f(w.x); cs[bj][2] += lo_f(w.y); cs[bj][3] += hi_f(w.y); cs[bj][4] += lo_f(w.z); cs[bj][5] += hi_f(w.z); cs[bj][6] += lo_f(w.w); cs[bj][7] += hi_f(w.w); } } }
        if (dokm) {
#pragma unroll
            for (int bj = 0; bj < 2; ++bj)
#pragma unroll
                for (int e = 0; e < 8; ++e) { float v = cs[bj][e]; v += __shfl_xor(v, 1); v += __shfl_xor(v, 2); v += __shfl_xor(v, 4); v += __shfl_xor(v, 8); cs[bj][e] = v; }
            if (fr == 0) { float* kp = kmp + (size_t)(u.pm * 2 + wr) * 512 + (u.pn - 8) * 256 + wc * 32 + 8 * fq;
#pragma unroll
                for (int bj = 0; bj < 2; ++bj) { *(f32x4*)(kp + bj * HALF) = (f32x4){cs[bj][0], cs[bj][1], cs[bj][2], cs[bj][3]}; *(f32x4*)(kp + bj * HALF + 4) = (f32x4){cs[bj][4], cs[bj][5], cs[bj][6], cs[bj][7]}; } }
        }
    }
};

struct EpiResid {
    static constexpr bool PERM = true, AFTER_DRAIN = false;
    bf16_t* O; const bf16_t* R; float* ss; int ldc; int pad;
    __device__ __forceinline__ void operator()(const f32x4 (&acc)[2][2][4][2], const Unit& u, int wr, int wc, int fr, int fq) const {
        const int row0 = u.pm * BM + wr * 64 + fr, col0 = u.pn * BM + wc * 32 + 8 * fq;
#pragma unroll
        for (int ai = 0; ai < 2; ++ai)
#pragma unroll
            for (int m = 0; m < 4; ++m) { const int r = row0 + ai * HALF + m * 16; const size_t off = (size_t)r * ldc + col0; float sq = 0.f;
#pragma unroll
                for (int bj = 0; bj < 2; ++bj) { const u32x4 rv = *(const u32x4*)(R + off + bj * HALF);
                    const f32x4 a0 = acc[ai][bj][m][0], a1 = acc[ai][bj][m][1];
                    u32x4 w; w.x = cvt_pk_bf16(a0[0] + lo_f(rv.x), a0[1] + hi_f(rv.x)); w.y = cvt_pk_bf16(a0[2] + lo_f(rv.y), a0[3] + hi_f(rv.y));
                    w.z = cvt_pk_bf16(a1[0] + lo_f(rv.z), a1[1] + hi_f(rv.z)); w.w = cvt_pk_bf16(a1[2] + lo_f(rv.w), a1[3] + hi_f(rv.w));
                    *(u32x4*)(O + off + bj * HALF) = w;
                    float t;
                    t = lo_f(w.x); sq += t * t; t = hi_f(w.x); sq += t * t; t = lo_f(w.y); sq += t * t; t = hi_f(w.y); sq += t * t;
                    t = lo_f(w.z); sq += t * t; t = hi_f(w.z); sq += t * t; t = lo_f(w.w); sq += t * t; t = hi_f(w.w); sq += t * t; }
                sq += __shfl_xor(sq, 16); sq += __shfl_xor(sq, 32);
                if (fq == 0) atomicAdd(ss + r, sq); }
    }
};

__device__ __forceinline__ float dpp_shr1(float oldv, float src) { return __builtin_bit_cast(float, __builtin_amdgcn_update_dpp(__builtin_bit_cast(int, oldv), __builtin_bit_cast(int, src), 0x111, 0xf, 0xf, false)); }
__device__ __forceinline__ float dpp_shr2(float oldv, float src) { return __builtin_bit_cast(float, __builtin_amdgcn_update_dpp(__builtin_bit_cast(int, oldv), __builtin_bit_cast(int, src), 0x112, 0xf, 0xf, false)); }
__device__ __forceinline__ float dpp_ror1(float src) { return __builtin_bit_cast(float, __builtin_amdgcn_update_dpp(0, __builtin_bit_cast(int, src), 0x121, 0xf, 0xf, false)); }
__device__ __forceinline__ float dpp_ror2(float src) { return __builtin_bit_cast(float, __builtin_amdgcn_update_dpp(0, __builtin_bit_cast(int, src), 0x122, 0xf, 0xf, false)); }
struct EpiFfn1 {
    static constexpr bool PERM = true, AFTER_DRAIN = false;
    bf16_t* ACT; const float* ss2; const float* cw; const float* cb; float* halog; float* fixg; float* fixu; PG8_LAS float* hl;
    __device__ __forceinline__ void operator()(const f32x4 (&acc)[2][2][4][2], const Unit& u, int wr, int wc, int fr, int fq) const {
        constexpr int FF = 2816;
        const int ch0 = u.pn * HALF + wc * 32 + 8 * fq;
        float rsv[2][4];
#pragma unroll
        for (int ai = 0; ai < 2; ++ai)
#pragma unroll
            for (int m = 0; m < 4; ++m) rsv[ai][m] = rsqrtf(ss2[u.pm * BM + ai * HALF + wr * 64 + m * 16 + fr] * (1.f / 1024.f) + 1e-6f);
        if (fr >= 14) {
#pragma unroll
            for (int ai = 0; ai < 2; ++ai) { const int G = 2 * ai + wr; PG8_LAS float* p = hl + (((G * 4 + wc) * 2 + (fr - 14)) * 4 + fq) * 8;
                *(PG8_LAS f32x4*)p = acc[ai][0][3][0] * rsv[ai][3]; *(PG8_LAS f32x4*)(p + 4) = acc[ai][0][3][1] * rsv[ai][3]; } }
        const f32x4 w0a = *(const f32x4*)(cw + ch0), w0b = *(const f32x4*)(cw + ch0 + 4), w1a = *(const f32x4*)(cw + FF + ch0), w1b = *(const f32x4*)(cw + FF + ch0 + 4);
        const f32x4 w2a = *(const f32x4*)(cw + 2 * FF + ch0), w2b = *(const f32x4*)(cw + 2 * FF + ch0 + 4), cba = *(const f32x4*)(cb + ch0), cbb = *(const f32x4*)(cb + ch0 + 4);
        asm volatile("s_waitcnt lgkmcnt(0)" ::: "memory"); __builtin_amdgcn_s_barrier(); asm volatile("" ::: "memory");
#pragma unroll
        for (int ai = 0; ai < 2; ++ai) { const int G = 2 * ai + wr;
            f32x4 pa = (f32x4){0.f, 0.f, 0.f, 0.f}, pb = pa;
            if (G > 0 && fr >= 14) { const PG8_LAS float* p = hl + ((((G - 1) * 4 + wc) * 2 + (fr - 14)) * 4 + fq) * 8; pa = *(const PG8_LAS f32x4*)p; pb = *(const PG8_LAS f32x4*)(p + 4); }
#pragma unroll
            for (int m = 0; m < 4; ++m) { const float s = rsv[ai][m]; const int r = u.pm * BM + ai * HALF + wr * 64 + m * 16 + fr;
                const f32x4 ga = acc[ai][0][m][0] * s, gb = acc[ai][0][m][1] * s, ua = acc[ai][1][m][0] * s, ub = acc[ai][1][m][1] * s;
                f32x4 oa, ob;
#pragma unroll
                for (int e = 0; e < 4; ++e) {
                    const float g1a = dpp_shr1(dpp_ror1(pa[e]), ga[e]), g2a = dpp_shr2(dpp_ror2(pa[e]), ga[e]);
                    const float g1b = dpp_shr1(dpp_ror1(pb[e]), gb[e]), g2b = dpp_shr2(dpp_ror2(pb[e]), gb[e]);
                    const float ca = cba[e] + w2a[e] * ga[e] + w1a[e] * g1a + w0a[e] * g2a, cbv = cbb[e] + w2b[e] * gb[e] + w1b[e] * g1b + w0b[e] * g2b;
                    oa[e] = ca / (1.f + __expf(-ca)) * ua[e]; ob[e] = cbv / (1.f + __expf(-cbv)) * ub[e]; }
                const bool defer = (G == 0 && m == 0 && fr < 2);
                if (defer) { float* pg = fixg + ((size_t)u.pm * 2 + fr) * FF + ch0; float* pu = fixu + ((size_t)u.pm * 2 + fr) * FF + ch0;
                    *(f32x4*)pg = ga; *(f32x4*)(pg + 4) = gb; *(f32x4*)pu = ua; *(f32x4*)(pu + 4) = ub; }
                else { u32x4 w; w.x = cvt_pk_bf16(oa[0], oa[1]); w.y = cvt_pk_bf16(oa[2], oa[3]); w.z = cvt_pk_bf16(ob[0], ob[1]); w.w = cvt_pk_bf16(ob[2], ob[3]);
                    *(u32x4*)(ACT + (size_t)r * FF + ch0) = w; }
                if (G == 3 && m == 3 && fr >= 14) { float* ph = halog + ((size_t)u.pm * 2 + (fr - 14)) * FF + ch0; *(f32x4*)ph = ga; *(f32x4*)(ph + 4) = gb; }
                pa = ga; pb = gb; } }
    }
};

template <class Epi, class Sched, bool ALIGN_EPI = false, bool SP2 = false>
__device__ __forceinline__ void gemm_phase(PG8_LAS unsigned char* lds, const Gemm g, const Sched& S, const Epi& E) {
    const int tid = threadIdx.x, wid = __builtin_amdgcn_readfirstlane(tid >> 6), lane = tid & 63, wr = wid >> 2, wc = wid & 3, fr = lane & 15, fq = lane >> 4;
    const int K = g.K, nt = K / BK;
    unsigned voffA[2], voffB[2];
#pragma unroll
    for (int i = 0; i < 2; ++i) { int R, C; stage_rc(tid * 16 + i * 8192, R, C); const int Rb = Epi::PERM ? ((R & ~31) + perm32(R & 31)) : R;
        voffA[i] = (unsigned)(R * K + C) * 2u; voffB[i] = (unsigned)(Rb * K + C) * 2u; }
    const size_t kstep = (size_t)(BK * 2);
    const size_t hstep = (size_t)HALF * K * 2;
    const size_t tstep = 2 * hstep;
    const unsigned ldsw = (unsigned)wid * 1024u;
    const int aoff = lds_byte(wr * 64 + fr, fq * 8), boff = lds_byte(wc * 32 + fr, fq * 8);
#define PG8_SA(b, h) (((b) * 2 + (h)) * HTB)
#define PG8_SB(b, h) ((4 + (b) * 2 + (h)) * HTB)
#define PG8_STAGE(bufoff, gbase, voff) do { _Pragma("unroll") for (int _i = 0; _i < 2; ++_i) \
        __builtin_amdgcn_global_load_lds((const unsigned*)((const char*)(gbase) + (voff)[_i]), (PG8_LAS unsigned*)(lds + (bufoff) + ldsw + _i * 8192), 16, 0, 0); } while (0)
#define PG8_LDA(dst, b, h) do { _Pragma("unroll") for (int m = 0; m < 4; ++m) _Pragma("unroll") for (int k = 0; k < 2; ++k) dst[m][k] = *(const PG8_LAS bf16x8*)(lds + PG8_SA(b, h) + aoff + m * 2048 + k * 1024); } while (0)
#define PG8_LDB(dst, b, h) do { _Pragma("unroll") for (int n = 0; n < 2; ++n) _Pragma("unroll") for (int k = 0; k < 2; ++k) dst[n][k] = *(const PG8_LAS bf16x8*)(lds + PG8_SB(b, h) + boff + n * 2048 + k * 1024); } while (0)
#define PG8_MMA(ai, bj, At, Bt) do { __builtin_amdgcn_s_setprio(1); _Pragma("unroll") for (int m = 0; m < 4; ++m) _Pragma("unroll") for (int n = 0; n < 2; ++n) _Pragma("unroll") for (int k = 0; k < 2; ++k) \
        acc[ai][bj][m][n] = __builtin_amdgcn_mfma_f32_16x16x32_bf16(Bt[n][k], At[m][k], acc[ai][bj][m][n], 0, 0, 0); __builtin_amdgcn_s_setprio(0); } while (0)
#define PG8_WAIT_V(n) asm volatile("s_waitcnt vmcnt(" #n ")" ::: "memory")
#define PG8_WAIT_L(n) asm volatile("s_waitcnt lgkmcnt(" #n ")" ::: "memory")
#define PG8_BAR __builtin_amdgcn_s_barrier()
#define PG8_SCHED __builtin_amdgcn_sched_barrier(0)
    Unit cur, nxt; int ui = 0;
    if (!S.next(0, cur)) return;
    f32x4 acc[2][2][4][2];
#pragma unroll
    for (int a = 0; a < 2; ++a)
#pragma unroll
        for (int b = 0; b < 2; ++b)
#pragma unroll
            for (int m = 0; m < 4; ++m)
#pragma unroll
                for (int n = 0; n < 2; ++n) acc[a][b][m][n] = (f32x4){0.f, 0.f, 0.f, 0.f};
    bf16x8 At[4][2], B0[2][2], B1[2][2];
    const char* cA = (const char*)g.A + (size_t)cur.pm * tstep; const char* cB = (const char*)g.Bt + (size_t)cur.pn * tstep;
    S.a_ready(cur);
    if constexpr (SP2) {
        PG8_STAGE(PG8_SB(0, 0), cB, voffB); PG8_STAGE(PG8_SB(0, 1), cB + hstep, voffB); PG8_STAGE(PG8_SA(0, 0), cA, voffA); PG8_STAGE(PG8_SA(0, 1), cA + hstep, voffA);
        if (wr == 1) PG8_BAR;
        PG8_WAIT_V(2); PG8_BAR;
        PG8_STAGE(PG8_SB(1, 0), cB + kstep, voffB); PG8_STAGE(PG8_SA(1, 0), cA + kstep, voffA); PG8_STAGE(PG8_SB(1, 1), cB + hstep + kstep, voffB);
        PG8_WAIT_V(6); PG8_BAR;
    } else {
        PG8_STAGE(PG8_SB(0, 0), cB, voffB); PG8_STAGE(PG8_SA(0, 0), cA, voffA); PG8_STAGE(PG8_SB(0, 1), cB + hstep, voffB); PG8_STAGE(PG8_SA(0, 1), cA + hstep, voffA);
        if (wr == 1) PG8_BAR;
        PG8_WAIT_V(4); PG8_BAR;
        PG8_STAGE(PG8_SB(1, 0), cB + kstep, voffB); PG8_STAGE(PG8_SA(1, 0), cA + kstep, voffA); PG8_STAGE(PG8_SB(1, 1), cB + hstep + kstep, voffB);
        PG8_WAIT_V(6); PG8_BAR;
    }
    for (;;) {
        const bool has_next = S.next(ui + 1, nxt);
        const char* nA = has_next ? (const char*)g.A + (size_t)nxt.pm * tstep : cA; const char* nB = has_next ? (const char*)g.Bt + (size_t)nxt.pn * tstep : cB;
        for (int t = 0; t < nt; t += 2) {
            const bool last = (t == nt - 2);
            const char* a1 = cA + (size_t)(t + 1) * kstep;
            const char* a2 = last ? nA : cA + (size_t)(t + 2) * kstep; const char* b2 = last ? nB : cB + (size_t)(t + 2) * kstep;
            const char* a3 = a2 + kstep; const char* b3 = b2 + kstep;
            if (last && has_next) S.a_ready(nxt);
            if constexpr (SP2) {
            PG8_LDB(B0, 0, 0); PG8_LDB(B1, 0, 1); PG8_SCHED; PG8_LDA(At, 0, 0); PG8_STAGE(PG8_SA(1, 1), a1 + hstep, voffA);
            PG8_WAIT_V(8); PG8_WAIT_L(0); PG8_BAR; PG8_MMA(0, 0, At, B0); PG8_MMA(0, 1, At, B1); PG8_BAR; PG8_SCHED;
            PG8_LDA(At, 0, 1); PG8_STAGE(PG8_SB(0, 0), b2, voffB); PG8_STAGE(PG8_SB(0, 1), b2 + hstep, voffB); PG8_STAGE(PG8_SA(0, 0), a2, voffA);
            PG8_WAIT_V(8); PG8_WAIT_L(0); PG8_BAR; PG8_MMA(1, 0, At, B0); PG8_MMA(1, 1, At, B1); PG8_BAR; PG8_SCHED;
            PG8_LDB(B0, 1, 0); PG8_LDB(B1, 1, 1); PG8_SCHED; PG8_LDA(At, 1, 0); PG8_STAGE(PG8_SA(0, 1), a2 + hstep, voffA);
            PG8_WAIT_V(8); PG8_WAIT_L(0); PG8_BAR; PG8_MMA(0, 0, At, B0); PG8_MMA(0, 1, At, B1); PG8_BAR; PG8_SCHED;
            PG8_LDA(At, 1, 1); PG8_STAGE(PG8_SB(1, 0), b3, voffB); PG8_STAGE(PG8_SB(1, 1), b3 + hstep, voffB); PG8_STAGE(PG8_SA(1, 0), a3, voffA);
            PG8_WAIT_V(8); PG8_WAIT_L(0); PG8_BAR; PG8_MMA(1, 0, At, B0); PG8_MMA(1, 1, At, B1); PG8_BAR; PG8_SCHED;
            } else {
            PG8_LDB(B0, 0, 0); PG8_SCHED; PG8_LDA(At, 0, 0); PG8_STAGE(PG8_SA(1, 1), a1 + hstep, voffA);
            PG8_WAIT_L(8); PG8_BAR; PG8_WAIT_L(0); PG8_MMA(0, 0, At, B0); PG8_BAR; PG8_SCHED;
            PG8_LDB(B1, 0, 1); PG8_STAGE(PG8_SB(0, 0), b2, voffB);
            PG8_BAR; PG8_WAIT_L(0); PG8_MMA(0, 1, At, B1); PG8_BAR;
            PG8_LDA(At, 0, 1); PG8_STAGE(PG8_SA(0, 0), a2, voffA);
            PG8_BAR; PG8_WAIT_L(0); PG8_MMA(1, 0, At, B0); PG8_BAR; PG8_SCHED;
            PG8_STAGE(PG8_SB(0, 1), b2 + hstep, voffB);
            PG8_WAIT_V(6); PG8_BAR; PG8_MMA(1, 1, At, B1); PG8_BAR;
            PG8_LDB(B0, 1, 0); PG8_SCHED; PG8_LDA(At, 1, 0); PG8_STAGE(PG8_SA(0, 1), a2 + hstep, voffA);
            PG8_WAIT_L(8); PG8_BAR; PG8_WAIT_L(0); PG8_MMA(0, 0, At, B0); PG8_BAR; PG8_SCHED;
            PG8_LDB(B1, 1, 1); PG8_STAGE(PG8_SB(1, 0), b3, voffB);
            PG8_BAR; PG8_WAIT_L(0); PG8_MMA(0, 1, At, B1); PG8_BAR;
            PG8_LDA(At, 1, 1); PG8_STAGE(PG8_SA(1, 0), a3, voffA);
            PG8_BAR; PG8_WAIT_L(0); PG8_MMA(1, 0, At, B0); PG8_BAR; PG8_SCHED;
            PG8_STAGE(PG8_SB(1, 1), b3 + hstep, voffB);
            PG8_WAIT_V(6); PG8_BAR; PG8_MMA(1, 1, At, B1); PG8_BAR;
            }
        }
        if constexpr (ALIGN_EPI) { if (wr == 0) PG8_BAR; }
        if constexpr (!Epi::AFTER_DRAIN) { E(acc, cur, wr, wc, fr, fq); S.done(cur); }
        if (!has_next) break;
#pragma unroll
        for (int a = 0; a < 2; ++a)
#pragma unroll
            for (int b = 0; b < 2; ++b)
#pragma unroll
                for (int m = 0; m < 4; ++m)
#pragma unroll
                    for (int n = 0; n < 2; ++n) acc[a][b][m][n] = (f32x4){0.f, 0.f, 0.f, 0.f};
        cur = nxt; cA = nA; cB = nB; ++ui;
        if constexpr (ALIGN_EPI) { if (wr == 1) PG8_BAR; }
    }
    PG8_WAIT_V(0);
    if constexpr (!ALIGN_EPI) { if (wr == 0) PG8_BAR; }
    PG8_BAR;
    if constexpr (Epi::AFTER_DRAIN) { E.fused(acc, cur, wr, wc, fr, fq, lds, wid, lane); S.done(cur); }
#undef PG8_SA
#undef PG8_SB
#undef PG8_STAGE
#undef PG8_LDA
#undef PG8_LDB
#undef PG8_MMA
#undef PG8_WAIT_V
#undef PG8_WAIT_L
#undef PG8_BAR
#undef PG8_SCHED
}
}


constexpr int NWAVES = 8;
constexpr int RING_OFF = 0, RING_BYTES = 131072;
constexpr int LDSX_OFF = RING_BYTES;
constexpr int MISC_OFF = RING_BYTES + 8192;
constexpr int LDS_BYTES = 147456;
static_assert(MISC_OFF + 128 <= LDS_BYTES, "LDS map");
constexpr int CW_BAR = 1024;

#define GAS __attribute__((address_space(1)))
#define LAS __attribute__((address_space(3)))
typedef unsigned v4u __attribute__((ext_vector_type(4)));
typedef float f32x4 __attribute__((ext_vector_type(4)));
typedef unsigned u32x2 __attribute__((ext_vector_type(2)));
typedef GAS unsigned gu32;
#define LDS_WAIT() asm volatile("s_waitcnt lgkmcnt(0)" ::: "memory")
#define VM_WAIT() asm volatile("s_waitcnt vmcnt(0)" ::: "memory")
__device__ __forceinline__ unsigned pk2(float lo, float hi) { return f2bf(lo) | (f2bf(hi) << 16); }

#define XB_TMO      128
#define XB_XCNT(j)  (256  + 64 * (j))
#define XB_XSUB(j)  (1280 + 64 * (j))
#define XB_XGEN(j)  (2304 + 64 * (j))
#define XB_TOP      3328
#define XB_TOPGEN   3392
#define XCD_BAR_WORDS 3456
#define XB_SPIN_CAP (1u << 18)

__device__ __forceinline__ unsigned xb_ld(unsigned* p)              { return __hip_atomic_load(p, __ATOMIC_RELAXED, __HIP_MEMORY_SCOPE_AGENT); }
__device__ __forceinline__ unsigned xb_add(unsigned* p, unsigned v) { return __hip_atomic_fetch_add(p, v, __ATOMIC_RELAXED, __HIP_MEMORY_SCOPE_AGENT); }
__device__ __forceinline__ unsigned xb_xcc_id() { return (unsigned)__builtin_amdgcn_s_getreg((3 << 11) | 20) & 0xFu; }
#define XB_SPIN(cond, bar) do { unsigned _sp = 0; while (cond) { __builtin_amdgcn_s_sleep(1); \
    if ((++_sp & 255u) == 0u) { if (xb_ld(&(bar)[XB_TMO])) break; if (_sp > XB_SPIN_CAP) { atomicAdd(&(bar)[XB_TMO], 1u); break; } } } } while (0)

struct XcdBarrier {
    unsigned* bar; unsigned x;
    volatile LAS unsigned* st;
};

__device__ __forceinline__ XcdBarrier xcd_barrier_post(unsigned* bar, volatile LAS unsigned* st) {
    XcdBarrier b; b.bar = bar; b.x = xb_xcc_id(); b.st = st;
    if (threadIdx.x == 0) (void)xb_add(&bar[XB_XCNT(b.x)], 1u);
    return b;
}
__device__ __forceinline__ void xcd_barrier_complete(unsigned* bar, unsigned x, unsigned& nloc, unsigned& nx) {
    const unsigned G = gridDim.x * gridDim.y * gridDim.z;
    unsigned sum, cnt, mine, sp = 0u;
    for (;;) {
        sum = 0u; cnt = 0u; mine = 0u;
#pragma unroll
        for (unsigned j = 0; j < 16; ++j) { const unsigned c = xb_ld(&bar[XB_XCNT(j)]); sum += c; cnt += (c > 0u) ? 1u : 0u; mine = (j == x) ? c : mine; }
        if (sum == G) break;
        __builtin_amdgcn_s_sleep(1);
        if ((++sp & 255u) == 0u) { if (xb_ld(&bar[XB_TMO])) break; if (sp > XB_SPIN_CAP) { atomicAdd(&bar[XB_TMO], 1u); break; } }
    }
    nloc = mine > 0u ? mine : 1u; nx = cnt > 0u ? cnt : 1u;
}

__device__ __forceinline__ void xcd_barrier(const XcdBarrier& b) {
    asm volatile("s_waitcnt vmcnt(0)" ::: "memory");
    __syncthreads();
    if (threadIdx.x == 0) {
        unsigned* bar = b.bar;
        __builtin_amdgcn_s_waitcnt(0);
        unsigned nloc = b.st[0], nx = b.st[1];
        if (nloc == 0u) { xcd_barrier_complete(bar, b.x, nloc, nx); b.st[0] = nloc; b.st[1] = nx; }
        const unsigned old = xb_add(&bar[XB_XSUB(b.x)], 1u);
        const unsigned gen = old / nloc;
        if (old + 1u == (gen + 1u) * nloc) {
            __builtin_amdgcn_fence(__ATOMIC_RELEASE, "agent");
            asm volatile("s_waitcnt vmcnt(0)" ::: "memory");
            const unsigned og = xb_add(&bar[XB_TOP], 1u);
            const unsigned tg = og / nx;
            if (og + 1u == (tg + 1u) * nx) xb_add(&bar[XB_TOPGEN], 1u);
            else XB_SPIN(xb_ld(&bar[XB_TOPGEN]) == tg, bar);
            __builtin_amdgcn_fence(__ATOMIC_ACQUIRE, "agent");
            xb_add(&bar[XB_XGEN(b.x)], 1u);
            asm volatile("s_waitcnt vmcnt(0)" ::: "memory");
        } else {
            XB_SPIN(xb_ld(&bar[XB_XGEN(b.x)]) == gen, bar);
            __builtin_amdgcn_fence(__ATOMIC_ACQUIRE, "agent");
            asm volatile("s_waitcnt vmcnt(0)" ::: "memory");
        }
    }
    __syncthreads();
}


namespace att {
typedef short bf16x8 __attribute__((ext_vector_type(8)));
typedef short s16x4 __attribute__((ext_vector_type(4)));
typedef float f32x16 __attribute__((ext_vector_type(16)));
typedef unsigned u32x4 __attribute__((ext_vector_type(4)));
typedef unsigned u32x2 __attribute__((ext_vector_type(2)));
constexpr float LOG2E = 1.4426950408889634f;
__device__ __forceinline__ int kappa(int r) { return (r & ~12) | ((r & 4) << 1) | ((r & 8) >> 1); }
__device__ __forceinline__ f32x16 mfma32(bf16x8 a, bf16x8 b, f32x16 c) { return __builtin_amdgcn_mfma_f32_32x32x16_bf16(a, b, c, 0, 0, 0); }
__device__ __forceinline__ s16x4 vtr(const LAS unsigned char* p) { return __builtin_bit_cast(s16x4, __builtin_amdgcn_ds_read_tr16_b64_v4i16((LAS s16x4*)p)); }
__device__ __forceinline__ bf16x8 cat8(s16x4 a, s16x4 b) { return (bf16x8){a[0], a[1], a[2], a[3], b[0], b[1], b[2], b[3]}; }
__device__ __forceinline__ unsigned cvtpk(float lo, float hi) { unsigned r; asm volatile("v_cvt_pk_bf16_f32 %0, %1, %2" : "=v"(r) : "v"(lo), "v"(hi)); return r; }
__device__ __forceinline__ bf16x8 packp(const f32x16& p, int s) {
    u32x4 w; w.x = cvtpk(p[8 * s + 0], p[8 * s + 1]); w.y = cvtpk(p[8 * s + 2], p[8 * s + 3]); w.z = cvtpk(p[8 * s + 4], p[8 * s + 5]); w.w = cvtpk(p[8 * s + 6], p[8 * s + 7]);
    return __builtin_bit_cast(bf16x8, w);
}
__device__ __forceinline__ int tr_off(int lane, int VP) { const int hi = lane >> 5, blk = (lane >> 4) & 1, q4 = (lane & 15) >> 2, p4 = lane & 3; return (8 * hi + q4) * VP + (16 * blk + 4 * p4) * 2; }

constexpr int MB_KP = 144, MB_VP = 192;
constexpr int MB_K = 0, MB_V = 2 * 64 * MB_KP, MB_LUT = MB_V + 2 * 64 * MB_VP, MB_KM = MB_LUT + 8192, MB_END = MB_KM + 2048;
__device__ __forceinline__ void moba_phase(LAS unsigned char* lds, const bf16* __restrict__ QKV, const float* __restrict__ KMP, const float* __restrict__ LUT, bf16* __restrict__ Y, int vcu, int G) {
    const int tid = threadIdx.x, lane = tid & 63, r32 = lane & 31, hi = lane >> 5; const int w = __builtin_amdgcn_readfirstlane(tid >> 6);
    LAS float* lut2 = (LAS float*)(lds + MB_LUT); LAS float* km = (LAS float*)(lds + MB_KM);
    const int troff = tr_off(lane, MB_VP);
    for (int bh = vcu; bh < BATCH * 8; bh += G) { const int b = bh >> 3, h = bh & 7;
        __syncthreads();
        for (int i = tid; i < 2048; i += 512) lut2[i] = LUT[(8 + h) * 2048 + i] * LOG2E;
        { const int j = tid >> 6, d = tid & 63; km[tid] = (KMP[(size_t)((8 * b + j) * 2 + 0) * 512 + 64 * h + d] + KMP[(size_t)((8 * b + j) * 2 + 1) * 512 + 64 * h + d]) * (1.f / 256.f); }
        __syncthreads();
        const bf16* Qb = QKV + (size_t)b * SEQ * NQKV + 1536 + 64 * h; const bf16* Kb = QKV + (size_t)b * SEQ * NQKV + 2048 + 64 * h; const bf16* Vb = Kb + 512;
        for (int qb = 7; qb >= 0; --qb) {
            const int tq = 256 * qb + 32 * w + r32;
            bf16x8 qf[4];
#pragma unroll
            for (int d0 = 0; d0 < 4; ++d0) qf[d0] = *(const bf16x8*)(Qb + (size_t)tq * NQKV + 16 * d0 + 8 * hi);
            unsigned sel = 0;
            { float g[8];
#pragma unroll
              for (int j = 0; j < 8; ++j) g[j] = 0.f;
#pragma unroll
              for (int d0 = 0; d0 < 4; ++d0) { float qv[8];
#pragma unroll
                  for (int e = 0; e < 8; ++e) qv[e] = __builtin_bit_cast(float, (unsigned)(unsigned short)qf[d0][e] << 16);
#pragma unroll
                  for (int j = 0; j < 7; ++j) { const LAS float* kp = km + j * 64 + 16 * d0 + 8 * hi; const f32x4 k0 = *(const LAS f32x4*)kp, k1 = *(const LAS f32x4*)(kp + 4);
                      g[j] += qv[0] * k0[0] + qv[1] * k0[1] + qv[2] * k0[2] + qv[3] * k0[3] + qv[4] * k1[0] + qv[5] * k1[1] + qv[6] * k1[2] + qv[7] * k1[3]; } }
#pragma unroll
              for (int j = 0; j < 7; ++j) g[j] += __shfl_xor(g[j], 32);
              const int nsel = qb < 3 ? qb : 3;
              for (int n = 0; n < nsel; ++n) { float best = -3e38f; int bi = 0;
#pragma unroll
                  for (int j = 0; j < 7; ++j) if (j < qb && !((sel >> j) & 1u) && g[j] > best) { best = g[j]; bi = j; }
                  sel |= 1u << bi; } }
            float m_run = -1e30f, l_run = 0.f; f32x16 o0 = {}, o1 = {};
            const int NT = 4 * (qb + 1);
            const int skey = tid >> 3, sch = tid & 7;
            u32x4 kreg, vreg;
            { kreg = *(const u32x4*)(Kb + (size_t)skey * NQKV + 8 * sch); vreg = *(const u32x4*)(Vb + (size_t)skey * NQKV + 8 * sch);
              *(LAS u32x4*)(lds + MB_K + skey * MB_KP + sch * 16) = kreg; *(LAS u32x4*)(lds + MB_V + skey * MB_VP + sch * 16) = vreg; }
            __syncthreads();
            for (int T = 0; T < NT; ++T) {
                const int buf = T & 1, jb = T >> 2, key0 = 64 * T;
                if (T + 1 < NT) { const size_t ro = (size_t)(key0 + 64 + skey) * NQKV + 8 * sch; kreg = *(const u32x4*)(Kb + ro); vreg = *(const u32x4*)(Vb + ro); }
                bool active;
                if (jb < qb) active = __ballot((sel >> jb) & 1u) != 0ull; else active = (key0 - 256 * qb) <= 32 * w + 31;
                if (active) {
                    const LAS unsigned char* Kt = lds + MB_K + buf * (64 * MB_KP); const LAS unsigned char* Vt = lds + MB_V + buf * (64 * MB_VP);
                    f32x16 p0 = {}, p1 = {};
#pragma unroll
                    for (int d0 = 0; d0 < 4; ++d0) { const bf16x8 k0 = *(const LAS bf16x8*)(Kt + kappa(r32) * MB_KP + (2 * d0 + hi) * 16), k1 = *(const LAS bf16x8*)(Kt + (32 + kappa(r32)) * MB_KP + (2 * d0 + hi) * 16);
                        p0 = mfma32(k0, qf[d0], p0); p1 = mfma32(k1, qf[d0], p1); }
                    const bool past = jb < qb; const bool selb = (sel >> jb) & 1u;
                    float mx = -INFINITY;
#pragma unroll
                    for (int r = 0; r < 16; ++r) { const int kin = 16 * (r >> 3) + 8 * hi + (r & 7);
                        { const int dist = tq - (key0 + kin); const bool valid = past ? selb : (dist >= 0); const float s = p0[r] * (0.125f * LOG2E) + lut2[dist < 0 ? 0 : dist]; p0[r] = valid ? s : -INFINITY; mx = fmaxf(mx, p0[r]); }
                        { const int dist = tq - (key0 + 32 + kin); const bool valid = past ? selb : (dist >= 0); const float s = p1[r] * (0.125f * LOG2E) + lut2[dist < 0 ? 0 : dist]; p1[r] = valid ? s : -INFINITY; mx = fmaxf(mx, p1[r]); } }
                    mx = fmaxf(mx, __shfl_xor(mx, 32));
                    const float m_new = fmaxf(m_run, mx), alpha = __builtin_amdgcn_exp2f(m_run - m_new); m_run = m_new;
                    float ls = 0.f;
#pragma unroll
                    for (int r = 0; r < 16; ++r) { p0[r] = __builtin_amdgcn_exp2f(p0[r] - m_new); p1[r] = __builtin_amdgcn_exp2f(p1[r] - m_new); ls += p0[r] + p1[r]; }
                    l_run = l_run * alpha + ls;
#pragma unroll
                    for (int r = 0; r < 16; ++r) { o0[r] *= alpha; o1[r] *= alpha; }
                    const bf16x8 pf0 = packp(p0, 0), pf1 = packp(p0, 1), pf2 = packp(p1, 0), pf3 = packp(p1, 1);
#pragma unroll
                    for (int c = 0; c < 2; ++c) { const LAS unsigned char* vb = Vt + troff + c * 64;
                        const bf16x8 v0 = cat8(vtr(vb), vtr(vb + 4 * MB_VP)), v1 = cat8(vtr(vb + 16 * MB_VP), vtr(vb + 20 * MB_VP));
                        const bf16x8 v2 = cat8(vtr(vb + 32 * MB_VP), vtr(vb + 36 * MB_VP)), v3 = cat8(vtr(vb + 48 * MB_VP), vtr(vb + 52 * MB_VP));
                        if (c == 0) { o0 = mfma32(v0, pf0, o0); o0 = mfma32(v1, pf1, o0); o0 = mfma32(v2, pf2, o0); o0 = mfma32(v3, pf3, o0); }
                        else { o1 = mfma32(v0, pf0, o1); o1 = mfma32(v1, pf1, o1); o1 = mfma32(v2, pf2, o1); o1 = mfma32(v3, pf3, o1); } }
                }
                if (T + 1 < NT) { *(LAS u32x4*)(lds + MB_K + (buf ^ 1) * (64 * MB_KP) + skey * MB_KP + sch * 16) = kreg; *(LAS u32x4*)(lds + MB_V + (buf ^ 1) * (64 * MB_VP) + skey * MB_VP + sch * 16) = vreg; }
                __syncthreads();
            }
            const float inv = 1.f / (l_run + __shfl_xor(l_run, 32));
            bf16* yp = Y + ((size_t)b * SEQ + tq) * DM + 512 + 64 * h + 4 * hi;
#pragma unroll
            for (int g4 = 0; g4 < 4; ++g4) { u32x2 a, c2; a.x = cvtpk(o0[4 * g4] * inv, o0[4 * g4 + 1] * inv); a.y = cvtpk(o0[4 * g4 + 2] * inv, o0[4 * g4 + 3] * inv);
                c2.x = cvtpk(o1[4 * g4] * inv, o1[4 * g4 + 1] * inv); c2.y = cvtpk(o1[4 * g4 + 2] * inv, o1[4 * g4 + 3] * inv);
                *(u32x2*)(yp + 8 * g4) = a; *(u32x2*)(yp + 32 + 8 * g4) = c2; }
        }
    }
}

constexpr int DL_VP = 192, DL_LUT = 0, DL_V = 16384, DL_END = DL_V + 8 * 32 * DL_VP;
__device__ __forceinline__ void dil_phase(LAS unsigned char* lds, const bf16* __restrict__ QKV, const float* __restrict__ LUT, bf16* __restrict__ OP, float* __restrict__ LSEP, int vcu, int G) {
    const int tid = threadIdx.x, lane = tid & 63, r32 = lane & 31, hi = lane >> 5; const int w = __builtin_amdgcn_readfirstlane(tid >> 6);
    LAS float* dlut = (LAS float*)(lds + DL_LUT);
    __syncthreads();
    for (int i = tid; i < 8 * 3 * 132; i += 512) { const int dlt = i % 132, pp = (i / 132) % 3, hh = i / 396; const int dist = dlt * (pp == 0 ? 1 : (pp == 1 ? 4 : 16)); dlut[i] = (dlt <= 128 && dist < 2048) ? LUT[hh * 2048 + dist] * LOG2E : 0.f; }
    __syncthreads();
    LAS unsigned char* Vw = lds + DL_V + w * (32 * DL_VP);
    const int troff = tr_off(lane, DL_VP);
    for (int bh = vcu; bh < BATCH * 8; bh += G) { const int b = bh >> 3, h = bh & 7;
        const bf16* Qb = QKV + (size_t)b * SEQ * NQKV + 64 * h; const bf16* Kb = Qb + 512; const bf16* Vb = Qb + 1024;
        for (int it = 0; it < 24; ++it) { const int j = w + 8 * it, p = j >> 6, g = j & 63;
            const int dil = (p == 0) ? 1 : (p == 1 ? 4 : 16), res = g & (dil - 1), gi = (p == 0) ? g : (p == 1 ? (g >> 2) : (g >> 4));
            const int ms = 32 * gi + r32, tq = dil * ms + res;
            bf16x8 qf[4];
#pragma unroll
            for (int d0 = 0; d0 < 4; ++d0) qf[d0] = *(const bf16x8*)(Qb + (size_t)tq * NQKV + 16 * d0 + 8 * hi);
            const LAS float* lp = dlut + (h * 3 + p) * 132;
            float m_run = -1e30f, l_run = 0.f; f32x16 o0 = {}, o1 = {};
            for (int kt = 0; kt < 5; ++kt) { const int base = 32 * gi - 128 + 32 * kt; if (base < 0) continue;
                bf16x8 kf[4];
                { const size_t ro = (size_t)(dil * (base + kappa(r32)) + res) * NQKV + 8 * hi;
#pragma unroll
                  for (int d0 = 0; d0 < 4; ++d0) kf[d0] = *(const bf16x8*)(Kb + ro + 16 * d0); }
                u32x4 vr[4];
#pragma unroll
                for (int i4 = 0; i4 < 4; ++i4) { const int idx = lane + 64 * i4, key = idx >> 3, ch = idx & 7; vr[i4] = *(const u32x4*)(Vb + (size_t)(dil * (base + key) + res) * NQKV + 8 * ch); }
                asm volatile("" ::: "memory");
#pragma unroll
                for (int i4 = 0; i4 < 4; ++i4) { const int idx = lane + 64 * i4, key = idx >> 3, ch = idx & 7; *(LAS u32x4*)(Vw + key * DL_VP + ch * 16) = vr[i4]; }
                f32x16 p0 = {};
#pragma unroll
                for (int d0 = 0; d0 < 4; ++d0) p0 = mfma32(kf[d0], qf[d0], p0);
                float mx = -INFINITY;
#pragma unroll
                for (int r = 0; r < 16; ++r) { const int dlt = ms - (base + 16 * (r >> 3) + 8 * hi + (r & 7)); const bool valid = (dlt >= 0) && (dlt <= 128);
                    const float s = p0[r] * (0.125f * LOG2E) + lp[valid ? dlt : 0]; p0[r] = valid ? s : -INFINITY; mx = fmaxf(mx, p0[r]); }
                mx = fmaxf(mx, __shfl_xor(mx, 32));
                const float m_new = fmaxf(m_run, mx), alpha = __builtin_amdgcn_exp2f(m_run - m_new); m_run = m_new;
                float ls = 0.f;
#pragma unroll
                for (int r = 0; r < 16; ++r) { p0[r] = __builtin_amdgcn_exp2f(p0[r] - m_new); ls += p0[r]; }
                l_run = l_run * alpha + ls;
#pragma unroll
                for (int r = 0; r < 16; ++r) { o0[r] *= alpha; o1[r] *= alpha; }
                const bf16x8 pf0 = packp(p0, 0), pf1 = packp(p0, 1);
                asm volatile("s_waitcnt lgkmcnt(0)" ::: "memory");
#pragma unroll
                for (int c = 0; c < 2; ++c) { const LAS unsigned char* vb = Vw + troff + c * 64;
                    const bf16x8 v0 = cat8(vtr(vb), vtr(vb + 4 * DL_VP)), v1 = cat8(vtr(vb + 16 * DL_VP), vtr(vb + 20 * DL_VP));
                    if (c == 0) { o0 = mfma32(v0, pf0, o0); o0 = mfma32(v1, pf1, o0); } else { o1 = mfma32(v0, pf0, o1); o1 = mfma32(v1, pf1, o1); } }
                asm volatile("s_waitcnt lgkmcnt(0)" ::: "memory");
            }
            const float lt = l_run + __shfl_xor(l_run, 32), inv = 1.f / lt;
            const size_t row = (size_t)b * SEQ + tq;
            bf16* yp = OP + ((size_t)p * NTOK + row) * 512 + 64 * h + 4 * hi;
#pragma unroll
            for (int g4 = 0; g4 < 4; ++g4) { u32x2 a, c2; a.x = cvtpk(o0[4 * g4] * inv, o0[4 * g4 + 1] * inv); a.y = cvtpk(o0[4 * g4 + 2] * inv, o0[4 * g4 + 3] * inv);
                c2.x = cvtpk(o1[4 * g4] * inv, o1[4 * g4 + 1] * inv); c2.y = cvtpk(o1[4 * g4 + 2] * inv, o1[4 * g4 + 3] * inv);
                *(u32x2*)(yp + 8 * g4) = a; *(u32x2*)(yp + 32 + 8 * g4) = c2; }
            if (hi == 0) LSEP[((size_t)p * NTOK + row) * 8 + h] = m_run + __builtin_amdgcn_logf(lt);
        }
    }
}

__device__ __forceinline__ void merge_phase(const bf16* __restrict__ OP, const float* __restrict__ LSEP, const bf16* __restrict__ Y, bf16* __restrict__ YN, int gw, int NGW, int lane) {
    for (int m = gw; m < NTOK; m += NGW) { const int h = lane >> 3;
        const float l0 = LSEP[((size_t)0 * NTOK + m) * 8 + h], l1 = LSEP[((size_t)1 * NTOK + m) * 8 + h], l2 = LSEP[((size_t)2 * NTOK + m) * 8 + h];
        const float mx = fmaxf(l0, fmaxf(l1, l2)); float w0 = __builtin_amdgcn_exp2f(l0 - mx), w1 = __builtin_amdgcn_exp2f(l1 - mx), w2 = __builtin_amdgcn_exp2f(l2 - mx);
        const float iw = 1.f / (w0 + w1 + w2); w0 *= iw; w1 *= iw; w2 *= iw;
        const u32x4 a = *(const u32x4*)(OP + ((size_t)0 * NTOK + m) * 512 + 8 * lane), bq = *(const u32x4*)(OP + ((size_t)1 * NTOK + m) * 512 + 8 * lane), c = *(const u32x4*)(OP + ((size_t)2 * NTOK + m) * 512 + 8 * lane);
        const u32x4 yb = *(const u32x4*)(Y + (size_t)m * DM + 512 + 8 * lane);
        float v[8], u[8]; float sa = 0.f, sb = 0.f;
#pragma unroll
        for (int e = 0; e < 4; ++e) { v[2 * e] = w0 * bflo(a[e]) + w1 * bflo(bq[e]) + w2 * bflo(c[e]); v[2 * e + 1] = w0 * bfhi(a[e]) + w1 * bfhi(bq[e]) + w2 * bfhi(c[e]); u[2 * e] = bflo(yb[e]); u[2 * e + 1] = bfhi(yb[e]); }
#pragma unroll
        for (int e = 0; e < 8; ++e) { sa += v[e] * v[e]; sb += u[e] * u[e]; }
        sa = wave_sum(sa); sb = wave_sum(sb);
        const float ra = rsqrtf(sa * (1.f / 512.f) + EPS), rb = rsqrtf(sb * (1.f / 512.f) + EPS);
        u32x4 oa, ob;
#pragma unroll
        for (int e = 0; e < 4; ++e) { oa[e] = cvtpk(v[2 * e] * ra, v[2 * e + 1] * ra); ob[e] = cvtpk(u[2 * e] * rb, u[2 * e + 1] * rb); }
        *(u32x4*)(YN + (size_t)m * DM + 8 * lane) = oa; *(u32x4*)(YN + (size_t)m * DM + 512 + 8 * lane) = ob;
    }
}

constexpr int CR_KP = 272, CR_VP = 320, CR_K = 0, CR_V = 2 * 64 * CR_KP, CR_END = CR_V + 2 * 64 * CR_VP;
typedef __amdgpu_buffer_rsrc_t rsrc_t;
__device__ __forceinline__ rsrc_t mkrsrc(const void* base, unsigned bytes) { return __builtin_amdgcn_make_buffer_rsrc((void*)base, 0, bytes, 0x00020000); }
__device__ __forceinline__ u32x4 bld16(rsrc_t r, unsigned voff, unsigned soff) { return __builtin_bit_cast(u32x4, __builtin_amdgcn_raw_buffer_load_b128(r, voff, soff, 0)); }
__device__ __forceinline__ void cross_phase(LAS unsigned char* lds, const bf16* QM, const bf16* KVM, bf16* OM, int vcu, int G) {
    const int tid = threadIdx.x, lane = tid & 63, r32 = lane & 31, hi = lane >> 5; const int w = __builtin_amdgcn_readfirstlane(tid >> 6);
    const int troff = tr_off(lane, CR_VP);
    const int kkey = tid >> 3, kch = tid & 7;
    const unsigned soff = (unsigned)kkey * 4096u + (unsigned)kch * 16u;
    const unsigned qoff = (unsigned)(32 * w + r32) * 2048u + (unsigned)hi * 16u;
    const int kl0 = kkey * CR_KP + kch * 16, vl0 = kkey * CR_VP + kch * 16;
    const int kfo = kappa(r32) * CR_KP + hi * 16;
    const rsrc_t rK = mkrsrc(KVM, (unsigned)NMEMTOK * 4096u), rQ = mkrsrc(QM, (unsigned)NTOK * 2048u);
    for (int un = vcu * 4; un < BATCH * 4 * 8; un += G * 4) for (int ui = 0; ui < 4; ++ui) { const int u = un + ui, qblk = u & 7, hm = (u >> 3) & 3, b = u >> 5;
        const unsigned Qs = (unsigned)(((b * SEQ + 256 * qblk) * DM + 256 * hm) * 2);
        unsigned char* Os = (unsigned char*)(OM + ((size_t)b * SEQ + 256 * qblk) * DM + 256 * hm);
        const unsigned Ks = (unsigned)((b * NMEM * 2048 + 256 * hm) * 2), Vs = Ks + 2048u;
        f32x16 sc[8];
#pragma unroll
        for (int kt = 0; kt < 8; ++kt) sc[kt] = f32x16{};
        u32x4 r0, r1;
        __syncthreads();
        r0 = bld16(rK, soff, Ks); r1 = bld16(rK, soff, Ks + 128u);
        *(LAS u32x4*)(lds + CR_K + kl0) = r0; *(LAS u32x4*)(lds + CR_K + kl0 + 128) = r1;
        __syncthreads();
#pragma unroll
        for (int half = 0; half < 2; ++half) {
            bf16x8 qf[8];
#pragma unroll
            for (int d0 = 0; d0 < 8; ++d0) qf[d0] = __builtin_bit_cast(bf16x8, bld16(rQ, qoff, Qs + (unsigned)(256 * half + 32 * d0)));
#pragma unroll
            for (int kp = 0; kp < 4; ++kp) { const int step = half * 4 + kp, buf = step & 1;
                if (step + 1 < 8) { const int nh = (step + 1) >> 2, nk = (step + 1) & 3; const unsigned src = Ks + (unsigned)(nk * (64 * 4096) + 256 * nh); r0 = bld16(rK, soff, src); r1 = bld16(rK, soff, src + 128u); }
                else { r0 = bld16(rK, soff, Vs); r1 = bld16(rK, soff, Vs + 128u); }
                const LAS unsigned char* Kt = lds + CR_K + buf * (64 * CR_KP) + kfo;
#pragma unroll
                for (int d0 = 0; d0 < 8; ++d0) { sc[2 * kp] = mfma32(*(const LAS bf16x8*)(Kt + d0 * 32), qf[d0], sc[2 * kp]); sc[2 * kp + 1] = mfma32(*(const LAS bf16x8*)(Kt + 32 * CR_KP + d0 * 32), qf[d0], sc[2 * kp + 1]); if (d0 & 1) __builtin_amdgcn_sched_barrier(0); }
                if (step + 1 < 8) { *(LAS u32x4*)(lds + CR_K + (buf ^ 1) * (64 * CR_KP) + kl0) = r0; *(LAS u32x4*)(lds + CR_K + (buf ^ 1) * (64 * CR_KP) + kl0 + 128) = r1; }
                else { *(LAS u32x4*)(lds + CR_V + vl0) = r0; *(LAS u32x4*)(lds + CR_V + vl0 + 128) = r1; }
                __syncthreads();
            }
        }
        float mx = -INFINITY;
#pragma unroll
        for (int kt = 0; kt < 8; ++kt)
#pragma unroll
            for (int r = 0; r < 16; ++r) mx = fmaxf(mx, sc[kt][r]);
        mx = fmaxf(mx, __shfl_xor(mx, 32));
        const float c1 = 0.0625f * LOG2E, mo = mx * c1; float ls = 0.f;
        bf16x8 pf[8][2];
#pragma unroll
        for (int kt = 0; kt < 8; ++kt) {
#pragma unroll
            for (int r = 0; r < 16; ++r) { sc[kt][r] = __builtin_amdgcn_exp2f(sc[kt][r] * c1 - mo); ls += sc[kt][r]; }
            pf[kt][0] = packp(sc[kt], 0); pf[kt][1] = packp(sc[kt], 1); }
        const float inv = 1.f / (ls + __shfl_xor(ls, 32));
#pragma unroll
        for (int hv = 0; hv < 2; ++hv) {
            f32x16 o[4];
#pragma unroll
            for (int c = 0; c < 4; ++c) o[c] = f32x16{};
            if (hv == 1) { r0 = bld16(rK, soff, Vs + 256u); r1 = bld16(rK, soff, Vs + 384u);
                *(LAS u32x4*)(lds + CR_V + vl0) = r0; *(LAS u32x4*)(lds + CR_V + vl0 + 128) = r1; __syncthreads(); }
#pragma unroll
            for (int kp = 0; kp < 4; ++kp) { const int buf = kp & 1;
                if (kp + 1 < 4) { const unsigned src = Vs + (unsigned)((kp + 1) * (64 * 4096) + 256 * hv); r0 = bld16(rK, soff, src); r1 = bld16(rK, soff, src + 128u); }
                const LAS unsigned char* vb = lds + CR_V + buf * (64 * CR_VP) + troff;
#pragma unroll
                for (int t2 = 0; t2 < 2; ++t2)
#pragma unroll
                    for (int c = 0; c < 4; ++c) { const LAS unsigned char* vc = vb + t2 * 32 * CR_VP + c * 64;
                        const bf16x8 v0 = cat8(vtr(vc), vtr(vc + 4 * CR_VP)), v1 = cat8(vtr(vc + 16 * CR_VP), vtr(vc + 20 * CR_VP));
                        o[c] = mfma32(v0, pf[2 * kp + t2][0], o[c]); o[c] = mfma32(v1, pf[2 * kp + t2][1], o[c]); }
                if (kp + 1 < 4) { *(LAS u32x4*)(lds + CR_V + (buf ^ 1) * (64 * CR_VP) + vl0) = r0; *(LAS u32x4*)(lds + CR_V + (buf ^ 1) * (64 * CR_VP) + vl0 + 128) = r1; }
                __syncthreads();
            }
            unsigned char* yp = Os + 256 * hv + 8 * hi;
            const unsigned yo = (unsigned)(32 * w + r32) * 2048u;
#pragma unroll
            for (int c = 0; c < 4; ++c)
#pragma unroll
                for (int g4 = 0; g4 < 4; ++g4) { u32x2 a; a.x = cvtpk(o[c][4 * g4] * inv, o[c][4 * g4 + 1] * inv); a.y = cvtpk(o[c][4 * g4 + 2] * inv, o[c][4 * g4 + 3] * inv); *(u32x2*)(yp + 64 * c + 16 * g4 + yo) = a; }
        }
    }
}
}


struct Frame {
    LAS unsigned char* lds;
    int tid, lane, wave, vcu, G;
};
__device__ __forceinline__ void p0_titem(const float* __restrict__ W, int Nsrc, int nsrc0, int k0, const float* __restrict__ g, const float* __restrict__ g2, int gsplit,
                                         bf16* __restrict__ WT, int K, int ndst0, LAS float* scr, int lane) {
#pragma unroll 8
    for (int i = 0; i < 32; ++i) { const int kk = 2 * i + (lane >> 5); const int k = k0 + kk;
        float gv = 1.f; if (g) gv = (g2 && k >= gsplit) ? g2[k - gsplit] : g[k];
        scr[kk * 33 + (lane & 31)] = W[(size_t)k * Nsrc + nsrc0 + (lane & 31)] * gv; }
    LDS_WAIT(); asm volatile("" ::: "memory");
    const int c = lane & 7;
#pragma unroll
    for (int j = 0; j < 4; ++j) { const int n = (lane >> 3) + 8 * j; const LAS float* s = scr + (8 * c) * 33 + n;
        v4u o; o.x = pk2(s[0 * 33], s[1 * 33]); o.y = pk2(s[2 * 33], s[3 * 33]); o.z = pk2(s[4 * 33], s[5 * 33]); o.w = pk2(s[6 * 33], s[7 * 33]);
        *(GAS v4u*)(WT + (size_t)(ndst0 + n) * K + k0 + 8 * c) = o; }
    LDS_WAIT(); asm volatile("" ::: "memory");
}
__device__ __forceinline__ void p0_cast_row(const float* __restrict__ xrow, bf16* __restrict__ orow, float* __restrict__ rs, int lane) {
    const GAS f32x4* xr = (const GAS f32x4*)xrow + lane; float s = 0.f; f32x4 v[4];
#pragma unroll
    for (int j = 0; j < 4; ++j) { v[j] = xr[64 * j]; s += (v[j].x * v[j].x + v[j].y * v[j].y) + (v[j].z * v[j].z + v[j].w * v[j].w); }
    GAS unsigned long long* o8 = (GAS unsigned long long*)orow + lane;
#pragma unroll
    for (int j = 0; j < 4; ++j) o8[64 * j] = (unsigned long long)pk2(v[j].x, v[j].y) | ((unsigned long long)pk2(v[j].z, v[j].w) << 32);
    s = wave_sum(s);
    if (lane == 0) *rs = rsqrtf(s * (1.f / DM) + EPS);
}

struct Args { const float* in[20]; float* out; unsigned char* ws; int ph_lo, ph_hi, att_mask, pad; };
enum { PH_PRO = 0, PH_QKV = 1, PH_ATT = 2, PH_MERGE = 3, PH_OUT = 4, PH_QM = 5, PH_CROSS = 6, PH_OM = 7, PH_FFN1 = 8, PH_FIX = 9, PH_DOWN = 10, PH_FINAL = 11, PH_N = 12 };

__global__ void __launch_bounds__(NWAVES * 64, 2) mega(Args args) {
    extern __shared__ __attribute__((aligned(16))) unsigned char lds_raw[];
    Frame F;
    F.lds = (LAS unsigned char*)lds_raw;
    F.tid = threadIdx.x; F.lane = F.tid & 63; F.wave = __builtin_amdgcn_readfirstlane(F.tid >> 6);
    F.G = gridDim.x; { const int bx = blockIdx.x; F.vcu = (F.G % 8 == 0) ? (bx % 8) * (F.G / 8) + bx / 8 : bx; }
    unsigned char* ws = args.ws;
    volatile LAS unsigned* MISC = (volatile LAS unsigned*)(F.lds + MISC_OFF);
    for (int u = F.tid; u < (LDS_BYTES - MISC_OFF) / 4; u += NWAVES * 64) ((LAS unsigned*)(F.lds + MISC_OFF))[u] = 0u;
    __syncthreads();
    const int lo = args.ph_lo, hi = args.ph_hi;
    XcdBarrier bar; bar.bar = (unsigned*)(ws + WS_CTL) + CW_BAR; bar.x = 0; bar.st = nullptr;
    if (hi - lo > 1) bar = xcd_barrier_post((unsigned*)(ws + WS_CTL) + CW_BAR, MISC + 8);
#define IN(k) (lo <= (k) && (k) < hi)
#define SEAM(k) do { if (IN(k) && IN((k) + 1)) xcd_barrier(bar); } while (0)

    const float* x = args.in[0]; const float* mem = args.in[1]; const float* w_in = args.in[2]; const float* g_mix = args.in[3]; const float* g_od = args.in[4];
    const float* g_om = args.in[5]; const float* w_out = args.in[6]; const float* rel_bias = args.in[7]; const float* g_cross = args.in[8]; const float* g_mem = args.in[9];
    const float* w_q = args.in[10]; const float* w_kv = args.in[11]; const float* w_o = args.in[12]; const float* g_ffn = args.in[13]; const float* w_gate = args.in[14];
    const float* w_up = args.in[15]; const float* conv_w = args.in[16]; const float* conv_b = args.in[17]; const float* w_down = args.in[18]; const float* g_final = args.in[19];
    float* RS0 = (float*)(ws + WS_RS0); float* RSM = (float*)(ws + WS_RSM); float* SS1 = (float*)(ws + WS_SS1); float* SS2 = (float*)(ws + WS_SS2); float* SS3 = (float*)(ws + WS_SS3);
    float* LUT = (float*)(ws + WS_LUT); float* KMP = (float*)(ws + WS_KMP); float* HALOG = (float*)(ws + WS_HALOG); float* FIXG = (float*)(ws + WS_FIXG); float* FIXU = (float*)(ws + WS_FIXU);
    bf16* WIN = (bf16*)(ws + WS_WIN); bf16* WOUT = (bf16*)(ws + WS_WOUT); bf16* WQ = (bf16*)(ws + WS_WQ); bf16* WKV = (bf16*)(ws + WS_WKV);
    bf16* WO = (bf16*)(ws + WS_WO); bf16* WGU = (bf16*)(ws + WS_WGU); bf16* WD = (bf16*)(ws + WS_WD);
    bf16* MEMB = (bf16*)(ws + WS_MEMB); bf16* KVM = (bf16*)(ws + WS_KVM); bf16* XB = (bf16*)(ws + WS_XB); bf16* QKV = (bf16*)(ws + WS_QKV);
    bf16* YN = (bf16*)(ws + WS_YN); bf16* Y = (bf16*)(ws + WS_Y); bf16* OP = (bf16*)(ws + WS_OP); float* LSEP = (float*)(ws + WS_LSEP); bf16* H1 = (bf16*)(ws + WS_H1); bf16* QM = (bf16*)(ws + WS_QM);
    bf16* OM = (bf16*)(ws + WS_OM); bf16* H2 = (bf16*)(ws + WS_H2); bf16* ACT = (bf16*)(ws + WS_ACT); bf16* H3 = (bf16*)(ws + WS_H3);
    const int gw = F.vcu * NWAVES + F.wave, NGW = F.G * NWAVES;
    const int gt = (int)blockIdx.x * (NWAVES * 64) + F.tid, NGT = F.G * NWAVES * 64;

    if (IN(PH_PRO)) {
        LAS float* scr = (LAS float*)(F.lds + RING_OFF + F.wave * 16384);
        constexpr int I_IN = 16 * 96, I_OUT = 16 * 32, I_Q = 16 * 32, I_KV = 16 * 64, I_O = 16 * 32, I_GU = 16 * 176, I_D = 44 * 32;
        constexpr int NITEMS = I_IN + I_OUT + I_Q + I_KV + I_O + I_GU + I_D;
        for (int it = gw; it < NITEMS; it += NGW) {
            int r = it;
            if (r < I_IN) { const int kb = r / 96, nb = r % 96; p0_titem(w_in, 3072, 32 * nb, 64 * kb, g_mix, nullptr, 0, WIN, 1024, 32 * nb, scr, F.lane); continue; } r -= I_IN;
            if (r < I_OUT) { const int kb = r / 32, nb = r % 32; p0_titem(w_out, 1024, 32 * nb, 64 * kb, g_od, g_om, 512, WOUT, 1024, 32 * nb, scr, F.lane); continue; } r -= I_OUT;
            if (r < I_Q) { const int kb = r / 32, nb = r % 32; p0_titem(w_q, 1024, 32 * nb, 64 * kb, g_cross, nullptr, 0, WQ, 1024, 32 * nb, scr, F.lane); continue; } r -= I_Q;
            if (r < I_KV) { const int kb = r / 64, nb = r % 64; p0_titem(w_kv, 2048, 32 * nb, 64 * kb, g_mem, nullptr, 0, WKV, 1024, 32 * nb, scr, F.lane); continue; } r -= I_KV;
            if (r < I_O) { const int kb = r / 32, nb = r % 32; p0_titem(w_o, 1024, 32 * nb, 64 * kb, nullptr, nullptr, 0, WO, 1024, 32 * nb, scr, F.lane); continue; } r -= I_O;
            if (r < I_GU) { const int kb = r / 176, nb = r % 176; const int nd = 32 * nb, j = nd >> 8, rr = nd & 255;
                const float* src = (rr < 128) ? w_gate : w_up; const int sc = 128 * j + (rr & 127);
                p0_titem(src, 2816, sc, 64 * kb, g_ffn, nullptr, 0, WGU, 1024, nd, scr, F.lane); continue; } r -= I_GU;
            { const int kb = r / 32, nb = r % 32; p0_titem(w_down, 1024, 32 * nb, 64 * kb, nullptr, nullptr, 0, WD, 2816, 32 * nb, scr, F.lane); }
        }
        for (int m = gw; m < NTOK; m += NGW) p0_cast_row(x + (size_t)m * DM, XB + (size_t)m * DM, RS0 + m, F.lane);
        for (int m = gw; m < NMEMTOK; m += NGW) p0_cast_row(mem + (size_t)m * DM, MEMB + (size_t)m * DM, RSM + m, F.lane);
        for (int i = gt; i < 16 * 2048; i += NGT) { const int h = i >> 11, n = i & 2047; int b;
            if (n < 16) b = n; else { b = 16 + (n >= 22) + (n >= 30) + (n >= 40) + (n >= 54) + (n >= 73) + (n >= 99) + (n >= 134) + (n >= 182) + (n >= 246) + (n >= 332) + (n >= 450) + (n >= 609) + (n >= 825) + (n >= 1117) + (n >= 1513); }
            LUT[i] = rel_bias[h * 32 + b]; }
        for (int i = gt; i < NTOK; i += NGT) { SS1[i] = 0.f; SS2[i] = 0.f; SS3[i] = 0.f; }
    }
    SEAM(PH_PRO);

    if (IN(PH_QKV)) {
        { pg8::Gemm g{XB, WIN, NTOK, NQKV, 1024}; pg8::StaticOrder S; S.init(NTOK, NQKV, F.G, (int)blockIdx.x);
          pg8::EpiScale E{QKV, RS0, KMP, NQKV, 0};
          pg8::gemm_phase<pg8::EpiScale, pg8::StaticOrder, true, true>(F.lds + RING_OFF, g, S, E); }
        { pg8::Gemm g{MEMB, WKV, NMEMTOK, 2048, 1024}; pg8::StaticOrder S; S.init(NMEMTOK, 2048, F.G, (int)blockIdx.x);
          pg8::EpiScale E{KVM, RSM, nullptr, 2048, 0};
          pg8::gemm_phase<pg8::EpiScale, pg8::StaticOrder, true, true>(F.lds + RING_OFF, g, S, E); }
    }
    SEAM(PH_QKV);
        if (IN(PH_ATT)) {
        if (args.att_mask & 1) att::moba_phase(F.lds, QKV, KMP, LUT, Y, F.vcu, F.G);
        __syncthreads();
        if (args.att_mask & 2) att::dil_phase(F.lds, QKV, LUT, OP, LSEP, F.vcu, F.G);
    }

    SEAM(PH_ATT);
        if (IN(PH_MERGE)) att::merge_phase(OP, LSEP, Y, YN, gw, NGW, F.lane);

    SEAM(PH_MERGE);

    if (IN(PH_OUT)) {
        pg8::Gemm g{YN, WOUT, NTOK, DM, 1024}; pg8::StaticOrder S; S.init(NTOK, DM, F.G, (int)blockIdx.x);
        pg8::EpiResid E{H1, XB, SS1, DM, 0};
        pg8::gemm_phase<pg8::EpiResid, pg8::StaticOrder, true, true>(F.lds + RING_OFF, g, S, E);
    }
    SEAM(PH_OUT);
    if (IN(PH_QM)) {
        pg8::Gemm g{H1, WQ, NTOK, DM, 1024}; pg8::StaticOrder S; S.init(NTOK, DM, F.G, (int)blockIdx.x);
        pg8::EpiScale E{QM, SS1, nullptr, DM, 1};
        pg8::gemm_phase<pg8::EpiScale, pg8::StaticOrder, true, true>(F.lds + RING_OFF, g, S, E);
    }
    SEAM(PH_QM);
        if (IN(PH_CROSS)) att::cross_phase(F.lds, QM, KVM, OM, F.vcu, F.G);

    SEAM(PH_CROSS);
    if (IN(PH_OM)) {
        pg8::Gemm g{OM, WO, NTOK, DM, 1024}; pg8::StaticOrder S; S.init(NTOK, DM, F.G, (int)blockIdx.x);
        pg8::EpiResid E{H2, H1, SS2, DM, 0};
        pg8::gemm_phase<pg8::EpiResid, pg8::StaticOrder, true, true>(F.lds + RING_OFF, g, S, E);
    }
    SEAM(PH_OM);
    if (IN(PH_FFN1)) {
        pg8::Gemm g{H2, WGU, NTOK, 5632, 1024}; pg8::StaticOrder S; S.init(NTOK, 5632, F.G, (int)blockIdx.x);
        pg8::EpiFfn1 E{ACT, SS2, conv_w, conv_b, HALOG, FIXG, FIXU, (LAS float*)(F.lds + LDSX_OFF)};
        pg8::gemm_phase<pg8::EpiFfn1, pg8::StaticOrder, true, true>(F.lds + RING_OFF, g, S, E);
    }
    SEAM(PH_FFN1);
    if (IN(PH_FIX)) {
        for (int i = gt; i < 256 * 2816; i += NGT) { const int pm = i / 2816, c = i % 2816;
            const float g0 = FIXG[((size_t)pm * 2 + 0) * 2816 + c], g1 = FIXG[((size_t)pm * 2 + 1) * 2816 + c];
            float hm1 = 0.f, hm2 = 0.f; if (pm & 7) { hm2 = HALOG[((size_t)(pm - 1) * 2 + 0) * 2816 + c]; hm1 = HALOG[((size_t)(pm - 1) * 2 + 1) * 2816 + c]; }
            const float w0 = conv_w[c], w1 = conv_w[2816 + c], w2 = conv_w[2 * 2816 + c], cbv = conv_b[c];
            const float c0 = cbv + w2 * g0 + w1 * hm1 + w0 * hm2, c1 = cbv + w2 * g1 + w1 * g0 + w0 * hm1;
            ACT[((size_t)pm * 256 + 0) * 2816 + c] = (bf16)f2bf(c0 / (1.f + __expf(-c0)) * FIXU[((size_t)pm * 2 + 0) * 2816 + c]);
            ACT[((size_t)pm * 256 + 1) * 2816 + c] = (bf16)f2bf(c1 / (1.f + __expf(-c1)) * FIXU[((size_t)pm * 2 + 1) * 2816 + c]); }
    }
    SEAM(PH_FIX);
    if (IN(PH_DOWN)) {
        pg8::Gemm g{ACT, WD, NTOK, DM, DFF}; pg8::StaticOrder S; S.init(NTOK, DM, F.G, (int)blockIdx.x);
        pg8::EpiResid E{H3, H2, SS3, DM, 0};
        pg8::gemm_phase<pg8::EpiResid, pg8::StaticOrder, true, true>(F.lds + RING_OFF, g, S, E);
    }
    SEAM(PH_DOWN);
    if (IN(PH_FINAL)) {
        for (int m = gw; m < NTOK; m += NGW) { const float rs = rsqrtf(SS3[m] * (1.f / DM) + EPS);
            const GAS u32x2* hr = (const GAS u32x2*)(H3 + (size_t)m * DM) + F.lane; GAS f32x4* o = (GAS f32x4*)(args.out + (size_t)m * DM) + F.lane; const GAS f32x4* gp = (const GAS f32x4*)g_final + F.lane;
#pragma unroll
            for (int j = 0; j < 4; ++j) { const u32x2 w = hr[64 * j]; const f32x4 gg = gp[64 * j];
                o[64 * j] = (f32x4){bflo(w.x) * rs * gg.x, bfhi(w.x) * rs * gg.y, bflo(w.y) * rs * gg.z, bfhi(w.y) * rs * gg.w}; } }
    }
#undef IN
#undef SEAM
}


extern "C" void kernel_launch(void* const* d_in, const int* in_sizes, int n_in, void* d_out, int out_size, void* d_ws, size_t ws_size, hipStream_t stream) {
    static int grid = 0;
    if (grid == 0) {
        if (n_in != 20 || in_sizes[0] != NTOK * DM || out_size != NTOK * DM || ws_size < WS_END) { fprintf(stderr, "kernel_launch: unexpected shapes (n_in %d, ws %zu); nothing launched\n", n_in, ws_size); grid = -1; return; }
        int dev = 0, cus = 0, per_cu = 0;
        if (hipGetDevice(&dev) != hipSuccess || hipDeviceGetAttribute(&cus, hipDeviceAttributeMultiprocessorCount, dev) != hipSuccess) { grid = -1; return; }
        if (hipFuncSetAttribute((const void*)mega, hipFuncAttributeMaxDynamicSharedMemorySize, LDS_BYTES) != hipSuccess) { fprintf(stderr, "kernel_launch: hipFuncSetAttribute failed\n"); grid = -1; return; }
        if (hipOccupancyMaxActiveBlocksPerMultiprocessor(&per_cu, (const void*)mega, NWAVES * 64, LDS_BYTES) != hipSuccess || per_cu < 1) fprintf(stderr, "kernel_launch: occupancy query says %d\n", per_cu);
        (void)hipGetLastError();
        grid = cus;
    }
    if (grid < 0) return;
    unsigned char* ws = (unsigned char*)d_ws;
    (void)hipMemsetAsync(ws + WS_CTL, 0, CTL_ZERO_BYTES, stream);
    Args a{};
    for (int i = 0; i < 20; ++i) a.in[i] = (const float*)d_in[i];
    a.out = (float*)d_out; a.ws = ws; a.att_mask = 3;
    auto run = [&](int lo, int hi) { a.ph_lo = lo; a.ph_hi = hi; hipLaunchKernelGGL(mega, dim3(grid), dim3(NWAVES * 64), LDS_BYTES, stream, a); };
    run(0, PH_N);
}
```

```cpp
#include <hip/hip_runtime.h>
#include <cstdio>
#include <cstdint>

typedef unsigned short bf16;
constexpr int BATCH = 32, SEQ = 2048, DM = 1024, NTOK = BATCH * SEQ;
constexpr int NMEM = 256, NMEMTOK = BATCH * NMEM, DFF = 2816;
constexpr int NQKV = 3072;
constexpr float EPS = 1e-6f;

constexpr size_t MiB = 1u << 20;
constexpr size_t WS_CTL = 0, CTL_ZERO_BYTES = 64 * 1024;
constexpr size_t WS_RS0 = 1 * MiB;
constexpr size_t WS_RSM = WS_RS0 + 256 * 1024;
constexpr size_t WS_SS1 = WS_RSM + 256 * 1024;
constexpr size_t WS_SS2 = WS_SS1 + 256 * 1024;
constexpr size_t WS_SS3 = WS_SS2 + 256 * 1024;
constexpr size_t WS_KMEAN = WS_SS3 + 256 * 1024;
constexpr size_t WS_LUT = WS_KMEAN + 512 * 1024;
constexpr size_t WS_KMP = 3 * MiB;
constexpr size_t WS_HALOG = 4 * MiB;
constexpr size_t WS_FIXG = WS_HALOG + 256 * 2 * 2816 * 4;
constexpr size_t WS_FIXU = WS_FIXG + 256 * 2 * 2816 * 4;
constexpr size_t WS_DUMMY = 21 * MiB;
constexpr size_t WS_LSEP = 22 * MiB;
constexpr size_t WS_WIN = 28 * MiB;
constexpr size_t WS_WOUT = WS_WIN + 6 * MiB;
constexpr size_t WS_WQ = WS_WOUT + 2 * MiB;
constexpr size_t WS_WKV = WS_WQ + 2 * MiB;
constexpr size_t WS_WO = WS_WKV + 4 * MiB;
constexpr size_t WS_WGU = WS_WO + 2 * MiB;
constexpr size_t WS_WD = WS_WGU + 11 * MiB;
constexpr size_t WS_MEMB = 62 * MiB;
constexpr size_t WS_KVM = 78 * MiB;
constexpr size_t WS_XB = 112 * MiB;
constexpr size_t WS_QKV = 240 * MiB;
constexpr size_t WS_Y = 624 * MiB;
constexpr size_t WS_OP = 752 * MiB;
constexpr size_t WS_YN = 240 * MiB;
constexpr size_t WS_H1 = 880 * MiB;
constexpr size_t WS_QM = 368 * MiB;
constexpr size_t WS_OM = 496 * MiB;
constexpr size_t WS_H2 = 624 * MiB;
constexpr size_t WS_ACT = 112 * MiB;
constexpr size_t WS_GU = 752 * MiB;
constexpr size_t WS_H3 = 464 * MiB;
constexpr size_t WS_END = 1024 * MiB;
static_assert(WS_FIXU + 256 * 2 * 2816 * 4 <= WS_LSEP && WS_LSEP + 6 * MiB <= WS_WIN && WS_WD + 6 * MiB <= WS_MEMB, "ws map");

__device__ __forceinline__ unsigned f2bf(float f) { unsigned u = __builtin_bit_cast(unsigned, f); return (u + 0x7fffu + ((u >> 16) & 1u)) >> 16; }
__device__ __forceinline__ float bf2f(bf16 b) { return __builtin_bit_cast(float, (unsigned)b << 16); }
__device__ __forceinline__ float bflo(unsigned w) { return __builtin_bit_cast(float, w << 16); }
__device__ __forceinline__ float bfhi(unsigned w) { return __builtin_bit_cast(float, w & 0xffff0000u); }
__device__ __forceinline__ float wave_sum(float v) {
#pragma unroll
    for (int o = 1; o < 64; o <<= 1) v += __shfl_xor(v, o);
    return v;
}


__global__ void k_cast_rows(const float* __restrict__ x, bf16* __restrict__ xb, float* __restrict__ rs, int nrows) {
    const int wave = (blockIdx.x * blockDim.x + threadIdx.x) >> 6, lane = threadIdx.x & 63;
    if (wave >= nrows) return;
    const float* xr = x + (size_t)wave * DM; bf16* o = xb + (size_t)wave * DM;
    float s = 0.f;
    for (int j = 0; j < 4; ++j) { const float4 v = *(const float4*)(xr + j * 256 + lane * 4);
        s += v.x * v.x + v.y * v.y + v.z * v.z + v.w * v.w;
        uint2 w; w.x = f2bf(v.x) | (f2bf(v.y) << 16); w.y = f2bf(v.z) | (f2bf(v.w) << 16);
        *(uint2*)(o + j * 256 + lane * 4) = w; }
    s = wave_sum(s);
    if (lane == 0) rs[wave] = rsqrtf(s * (1.f / DM) + EPS);
}
__global__ void k_wt(const float* __restrict__ W, const float* __restrict__ W2, const float* __restrict__ g, const float* __restrict__ g2, int gsplit,
                     bf16* __restrict__ WT, int K, int N, int Nsrc, int mode) {
    const size_t idx = (size_t)blockIdx.x * blockDim.x + threadIdx.x;
    if (idx >= (size_t)K * N) return;
    const int n = (int)(idx / K), k = (int)(idx % K);
    const float* src = W; int col = n;
    if (mode == 1) { const int j = n >> 8, r = n & 255; if (r < 128) { col = 128 * j + r; } else { col = 128 * j + r - 128; src = W2; } }
    float gv = 1.f;
    if (g) gv = (g2 && k >= gsplit) ? g2[k - gsplit] : g[k];
    WT[idx] = (bf16)f2bf(src[(size_t)k * Nsrc + col] * gv);
}
__global__ void k_lut(const float* __restrict__ rel_bias, float* __restrict__ lut) {
    const int idx = blockIdx.x * blockDim.x + threadIdx.x; if (idx >= 16 * 2048) return;
    const int h = idx >> 11, n = idx & 2047;
    int b;
    if (n < 16) b = n; else { b = 16; const int T[15] = {22, 30, 40, 54, 73, 99, 134, 182, 246, 332, 450, 609, 825, 1117, 1513};
#pragma unroll
        for (int j = 0; j < 15; ++j) b += (n >= T[j]) ? 1 : 0; }
    lut[idx] = rel_bias[h * 32 + b];
}

struct EpiRowScale { bf16* O; const float* rs; const float* ss; int ldc; int pad;
    __device__ void operator()(int r, int c, float v) const { const float s = rs ? rs[r] : rsqrtf(ss[r] * (1.f / DM) + EPS); O[(size_t)r * ldc + c] = (bf16)f2bf(v * s); } };
struct EpiResid { bf16* O; const bf16* R; int ldc; int pad;
    __device__ void operator()(int r, int c, float v) const { O[(size_t)r * ldc + c] = (bf16)f2bf(v + bf2f(R[(size_t)r * ldc + c])); } };
template <class Epi> __global__ void __launch_bounds__(256) k_gemm(const bf16* __restrict__ A, const bf16* __restrict__ Bt, int K, Epi e, int row_base) {
    __shared__ float As[16][65], Bs[16][65];
    const int tx = threadIdx.x & 15, ty = threadIdx.x >> 4;
    const int row0 = blockIdx.y * 64, col0 = blockIdx.x * 64;
    float acc[4][4];
#pragma unroll
    for (int i = 0; i < 4; ++i)
#pragma unroll
        for (int j = 0; j < 4; ++j) acc[i][j] = 0.f;
    for (int k0 = 0; k0 < K; k0 += 16) {
#pragma unroll
        for (int i = 0; i < 4; ++i) { const int idx = threadIdx.x + 256 * i, r = idx >> 4, c = idx & 15;
            As[c][r] = bf2f(A[(size_t)(row_base + row0 + r) * K + k0 + c]); Bs[c][r] = bf2f(Bt[(size_t)(col0 + r) * K + k0 + c]); }
        __syncthreads();
#pragma unroll
        for (int kk = 0; kk < 16; ++kk) { float a[4], b[4];
#pragma unroll
            for (int i = 0; i < 4; ++i) { a[i] = As[kk][ty * 4 + i]; b[i] = Bs[kk][tx * 4 + i]; }
#pragma unroll
            for (int i = 0; i < 4; ++i)
#pragma unroll
                for (int j = 0; j < 4; ++j) acc[i][j] += a[i] * b[j]; }
        __syncthreads();
    }
#pragma unroll
    for (int i = 0; i < 4; ++i)
#pragma unroll
        for (int j = 0; j < 4; ++j) e(row_base + row0 + ty * 4 + i, col0 + tx * 4 + j, acc[i][j]);
}
__global__ void k_sumsq(const bf16* __restrict__ H, float* __restrict__ ss, int nrows) {
    const int wave = (blockIdx.x * blockDim.x + threadIdx.x) >> 6, lane = threadIdx.x & 63;
    if (wave >= nrows) return;
    const bf16* r = H + (size_t)wave * DM; float s = 0.f;
    for (int j = 0; j < 16; ++j) { const float v = bf2f(r[j * 64 + lane]); s += v * v; }
    s = wave_sum(s); if (lane == 0) ss[wave] = s;
}

__global__ void __launch_bounds__(256) k_dil_naive(const bf16* __restrict__ QKV, const float* __restrict__ lut, bf16* __restrict__ Y) {
    const int idx = blockIdx.x * blockDim.x + threadIdx.x;
    const int t = idx & 2047, h = (idx >> 11) & 7, b = idx >> 14;
    const size_t row = (size_t)b * SEQ + t;
    float q[64], o[64];
    const bf16* qp = QKV + row * NQKV + h * 64;
#pragma unroll
    for (int d = 0; d < 64; ++d) { q[d] = bf2f(qp[d]); o[d] = 0.f; }
    float m = -1e30f, l = 0.f;
    const float* lh = lut + h * 2048;
    for (int p = 0; p < 3; ++p) { const int dil = (p == 0) ? 1 : (p == 1 ? 4 : 16);
        for (int j = 0; j <= 128; ++j) { const int tk = t - j * dil; if (tk < 0) break;
            const bf16* kp = QKV + ((size_t)b * SEQ + tk) * NQKV + 512 + h * 64; const bf16* vp = kp + 512;
            float s = 0.f;
#pragma unroll
            for (int d = 0; d < 64; ++d) s += q[d] * bf2f(kp[d]);
            s = s * 0.125f + lh[j * dil];
            const float mn = fmaxf(m, s), a = __expf(m - mn), pe = __expf(s - mn);
            l = l * a + pe; m = mn;
#pragma unroll
            for (int d = 0; d < 64; ++d) o[d] = o[d] * a + pe * bf2f(vp[d]);
        } }
    const float il = 1.f / l; bf16* yp = Y + row * DM + h * 64;
#pragma unroll
    for (int d = 0; d < 64; ++d) yp[d] = (bf16)f2bf(o[d] * il);
}
__global__ void k_kmean(const bf16* __restrict__ QKV, float* __restrict__ km) {
    const int d = threadIdx.x, blk = blockIdx.x & 7, h = (blockIdx.x >> 3) & 7, b = blockIdx.x >> 6;
    float s = 0.f;
    for (int k = 0; k < 256; ++k) s += bf2f(QKV[((size_t)b * SEQ + blk * 256 + k) * NQKV + 2048 + h * 64 + d]);
    km[(((size_t)b * 8 + h) * 8 + blk) * 64 + d] = s * (1.f / 256.f);
}
__global__ void __launch_bounds__(256) k_moba_naive(const bf16* __restrict__ QKV, const float* __restrict__ km, const float* __restrict__ lut, bf16* __restrict__ Y) {
    const int idx = blockIdx.x * blockDim.x + threadIdx.x;
    const int t = idx & 2047, h = (idx >> 11) & 7, b = idx >> 14;
    const size_t row = (size_t)b * SEQ + t;
    float q[64], o[64];
    const bf16* qp = QKV + row * NQKV + 1536 + h * 64;
#pragma unroll
    for (int d = 0; d < 64; ++d) { q[d] = bf2f(qp[d]); o[d] = 0.f; }
    const int own = t >> 8;
    float g[8];
#pragma unroll
    for (int j = 0; j < 8; ++j) { const float* kmp = km + (((size_t)b * 8 + h) * 8 + j) * 64; float s = 0.f;
#pragma unroll
        for (int d = 0; d < 64; ++d) s += q[d] * kmp[d];
        g[j] = s; }
    unsigned sel = 0; const int nsel = own < 3 ? own : 3;
    for (int n = 0; n < nsel; ++n) { float best = -3e38f; int bi = 0;
#pragma unroll
        for (int j = 0; j < 8; ++j) if (j < own && !((sel >> j) & 1u) && g[j] > best) { best = g[j]; bi = j; }
        sel |= 1u << bi; }
    sel |= 1u << own;
    float m = -1e30f, l = 0.f;
    const float* lh = lut + (8 + h) * 2048;
    for (int blk = 0; blk <= own; ++blk) { if (!((sel >> blk) & 1u)) continue;
        for (int kk = 0; kk < 256; ++kk) { const int tk = blk * 256 + kk; if (tk > t) break;
            const bf16* kp = QKV + ((size_t)b * SEQ + tk) * NQKV + 2048 + h * 64; const bf16* vp = kp + 512;
            float s = 0.f;
#pragma unroll
            for (int d = 0; d < 64; ++d) s += q[d] * bf2f(kp[d]);
            s = s * 0.125f + lh[t - tk];
            const float mn = fmaxf(m, s), a = __expf(m - mn), pe = __expf(s - mn);
            l = l * a + pe; m = mn;
#pragma unroll
            for (int d = 0; d < 64; ++d) o[d] = o[d] * a + pe * bf2f(vp[d]);
        } }
    const float il = 1.f / l; bf16* yp = Y + row * DM + 512 + h * 64;
#pragma unroll
    for (int d = 0; d < 64; ++d) yp[d] = (bf16)f2bf(o[d] * il);
}
__global__ void k_attnnorm(const bf16* __restrict__ Y, bf16* __restrict__ YN, int nrows) {
    const int wave = (blockIdx.x * blockDim.x + threadIdx.x) >> 6, lane = threadIdx.x & 63;
    if (wave >= nrows) return;
    const bf16* r = Y + (size_t)wave * DM; bf16* o = YN + (size_t)wave * DM;
    for (int half = 0; half < 2; ++half) { float v[8]; float s = 0.f;
#pragma unroll
        for (int j = 0; j < 8; ++j) { v[j] = bf2f(r[half * 512 + j * 64 + lane]); s += v[j] * v[j]; }
        s = wave_sum(s); const float rs = rsqrtf(s * (1.f / 512.f) + EPS);
#pragma unroll
        for (int j = 0; j < 8; ++j) o[half * 512 + j * 64 + lane] = (bf16)f2bf(v[j] * rs); }
}
__global__ void __launch_bounds__(256) k_cross_naive(const bf16* __restrict__ QM, const bf16* __restrict__ KVM, bf16* __restrict__ OM) {
    __shared__ float qs[256], ps[256], red[8];
    const int row = blockIdx.x >> 2, h = blockIdx.x & 3, b = row >> 11, tid = threadIdx.x;
    qs[tid] = bf2f(QM[(size_t)row * DM + h * 256 + tid]);
    __syncthreads();
    const bf16* kp = KVM + ((size_t)b * NMEM + tid) * 2048 + h * 256;
    float s = 0.f;
    for (int d = 0; d < 256; ++d) s += qs[d] * bf2f(kp[d]);
    s *= 0.0625f;
    float mx = s;
#pragma unroll
    for (int o = 1; o < 64; o <<= 1) mx = fmaxf(mx, __shfl_xor(mx, o));
    if ((tid & 63) == 0) red[tid >> 6] = mx;
    __syncthreads();
    mx = fmaxf(fmaxf(red[0], red[1]), fmaxf(red[2], red[3]));
    const float p = __expf(s - mx);
    float sm = wave_sum(p);
    if ((tid & 63) == 0) red[4 + (tid >> 6)] = sm;
    ps[tid] = p;
    __syncthreads();
    sm = red[4] + red[5] + red[6] + red[7];
    float o = 0.f;
    for (int k = 0; k < 256; ++k) o += ps[k] * bf2f(KVM[((size_t)b * NMEM + k) * 2048 + 1024 + h * 256 + tid]);
    OM[(size_t)row * DM + h * 256 + tid] = (bf16)f2bf(o / sm);
}
__global__ void k_conv_naive(const bf16* __restrict__ GU, const float* __restrict__ cw, const float* __restrict__ cb, bf16* __restrict__ ACT, int row_base, int nrows) {
    const size_t idx = (size_t)blockIdx.x * blockDim.x + threadIdx.x; if (idx >= (size_t)nrows * DFF) return;
    const int lr = (int)(idx / DFF), c = (int)(idx % DFF), row = row_base + lr, t = row & 2047;
    const int j = c >> 7, r = c & 127; const size_t gcol = (size_t)j * 256 + r, ucol = gcol + 128;
    float conv = cb[c] + cw[2 * DFF + c] * bf2f(GU[(size_t)lr * 5632 + gcol]);
    if (t >= 1) conv += cw[1 * DFF + c] * bf2f(GU[(size_t)(lr - 1) * 5632 + gcol]);
    if (t >= 2) conv += cw[0 * DFF + c] * bf2f(GU[(size_t)(lr - 2) * 5632 + gcol]);
    const float sl = conv / (1.f + __expf(-conv));
    ACT[(size_t)row * DFF + c] = (bf16)f2bf(sl * bf2f(GU[(size_t)lr * 5632 + ucol]));
}
__global__ void k_final(const bf16* __restrict__ H3, const float* __restrict__ g, float* __restrict__ out, int nrows) {
    const int wave = (blockIdx.x * blockDim.x + threadIdx.x) >> 6, lane = threadIdx.x & 63;
    if (wave >= nrows) return;
    const bf16* r = H3 + (size_t)wave * DM; float v[16]; float s = 0.f;
#pragma unroll
    for (int j = 0; j < 16; ++j) { v[j] = bf2f(r[j * 64 + lane]); s += v[j] * v[j]; }
    s = wave_sum(s); const float rs = rsqrtf(s * (1.f / DM) + EPS);
#pragma unroll
    for (int j = 0; j < 16; ++j) out[(size_t)wave * DM + j * 64 + lane] = v[j] * rs * g[j * 64 + lane];
}


namespace pg8 {
#define PG8_LAS __attribute__((address_space(3)))
typedef unsigned short bf16_t;
typedef short bf16x8 __attribute__((ext_vector_type(8)));
typedef float f32x4 __attribute__((ext_vector_type(4)));
typedef unsigned u32x4 __attribute__((ext_vector_type(4)));
constexpr int BM = 256, BK = 64, HALF = 128, HTB = HALF * BK * 2  , STAGE_BYTES = 8 * HTB, NXCD = 8, WGM = 8;

__host__ __device__ __forceinline__ int lds_byte(int r, int c) { const int st = (r >> 4) * 2 + (c >> 5), rr = r & 15, cc = c & 31, ob = rr * 64 + cc * 2; return st * 1024 + (ob ^ (((ob >> 9) & 1) << 5)); }
__host__ __device__ __forceinline__ void stage_rc(int b, int& R, int& C) { const int st = b / 1024, sb = b % 1024, swz = sb ^ (((sb >> 9) & 1) << 5); R = (st >> 1) * 16 + swz / 64; C = (st & 1) * 32 + (swz % 64) / 2; }
__host__ __device__ __forceinline__ int perm32(int rho) { const int n = rho >> 4, i = rho & 15; return 8 * (i >> 2) + 4 * n + (i & 3); }

struct Unit { int pm, pn; };
struct Gemm { const bf16_t* A; const bf16_t* Bt; int M, N, K; };

struct StaticOrder {
    int nM, nN, nwg, G, c;
    __host__ __device__ void init(int M, int N, int G_, int c_) { nM = M / BM; nN = N / BM; nwg = nM * nN; G = G_; c = c_; }
    __host__ __device__ bool next(int i, Unit& u) const {
        const long L = (long)i * G + c; if (L >= nwg) return false;
        int wgid = (int)L; { const int q = nwg / NXCD, r = nwg % NXCD, xcd = wgid % NXCD, off = wgid / NXCD; wgid = (xcd < r ? xcd * (q + 1) : r * (q + 1) + (xcd - r) * q) + off; }
        const int nig = WGM * nN, gid = wgid / nig, fm = gid * WGM, gsz = (nM - fm) < WGM ? (nM - fm) : WGM;
        u.pm = fm + ((wgid % nig) % gsz); u.pn = (wgid % nig) / gsz; return true;
    }
    __device__ __forceinline__ void a_ready(const Unit&) const {}
    __device__ __forceinline__ void done(const Unit&) const {}
};


__device__ __forceinline__ unsigned cvt_pk_bf16(float lo, float hi) { unsigned r; asm volatile("v_cvt_pk_bf16_f32 %0, %1, %2" : "=v"(r) : "v"(lo), "v"(hi)); return r; }
__device__ __forceinline__ float lo_f(unsigned w) { return __builtin_bit_cast(float, w << 16); }
__device__ __forceinline__ float hi_f(unsigned w) { return __builtin_bit_cast(float, w & 0xffff0000u); }

struct EpiScale {
    static constexpr bool PERM = true, AFTER_DRAIN = false;
    bf16_t* O; const float* rs; float* kmp; int ldc; int mode;
    __device__ __forceinline__ void operator()(const f32x4 (&acc)[2][2][4][2], const Unit& u, int wr, int wc, int fr, int fq) const {
        const int row0 = u.pm * BM + wr * 64 + fr, col0 = u.pn * BM + wc * 32 + 8 * fq;
        const bool dokm = (kmp != nullptr) && (u.pn == 8 || u.pn == 9);
        const float qs = ((kmp != nullptr) && (u.pn < 2 || u.pn == 6 || u.pn == 7)) ? 0.125f * 1.4426950408889634f : 1.f;
        float cs[2][8];
#pragma unroll
        for (int bj = 0; bj < 2; ++bj)
#pragma unroll
            for (int e = 0; e < 8; ++e) cs[bj][e] = 0.f;
#pragma unroll
        for (int ai = 0; ai < 2; ++ai)
#pragma unroll
            for (int m = 0; m < 4; ++m) { const int r = row0 + ai * HALF + m * 16; float s = qs; if (mode == 1) s = rsqrtf(rs[r] * (1.f / 1024.f) + 1e-6f);
                bf16_t* rowp = O + (size_t)r * ldc + col0;
#pragma unroll
                for (int bj = 0; bj < 2; ++bj) { const f32x4 v0 = acc[ai][bj][m][0] * s, v1 = acc[ai][bj][m][1] * s;
                    u32x4 w; w.x = cvt_pk_bf16(v0[0], v0[1]); w.y = cvt_pk_bf16(v0[2], v0[3]); w.z = cvt_pk_bf16(v1[0], v1[1]); w.w = cvt_pk_bf16(v1[2], v1[3]);
                    *(u32x4*)(rowp + bj * HALF) = w;
                    if (dokm) { cs[bj][0] += lo_f(w.x); cs[bj][1] += hi_f(w.x); cs[bj][2] += lo_f(w.y); cs[bj][3] += hi_f(w.y); cs[bj][4] += lo_f(w.z); cs[bj][5] += hi_f(w.z); cs[bj][6] += lo_f(w.w); cs[bj][7] += hi_f(w.w); } } }
        if (dokm) {
#pragma unroll
            for (int bj = 0; bj < 2; ++bj)
#pragma unroll
                for (int e = 0; e < 8; ++e) { float v = cs[bj][e]; v += __shfl_xor(v, 1); v += __shfl_xor(v, 2); v += __shfl_xor(v, 4); v += __shfl_xor(v, 8); cs[bj][e] = v; }
            if (fr == 0) { float* kp = kmp + (size_t)(u.pm * 2 + wr) * 512 + (u.pn - 8) * 256 + wc * 32 + 8 * fq;
#pragma unroll
                for (int bj = 0; bj < 2; ++bj) { *(f32x4*)(kp + bj * HALF) = (f32x4){cs[bj][0], cs[bj][1], cs[bj][2], cs[bj][3]}; *(f32x4*)(kp + bj * HALF + 4) = (f32x4){cs[bj][4], cs[bj][5], cs[bj][6], cs[bj][7]}; } }
        }
    }
};

struct EpiResid {
    static constexpr bool PERM = true, AFTER_DRAIN = false;
    bf16_t* O; const bf16_t* R; float* ss; int ldc; int pad;
    __device__ __forceinline__ void operator()(const f32x4 (&acc)[2][2][4][2], const Unit& u, int wr, int wc, int fr, int fq) const {
        const int row0 = u.pm * BM + wr * 64 + fr, col0 = u.pn * BM + wc * 32 + 8 * fq;
#pragma unroll
        for (int ai = 0; ai < 2; ++ai)
#pragma unroll
            for (int m = 0; m < 4; ++m) { const int r = row0 + ai * HALF + m * 16; const size_t off = (size_t)r * ldc + col0; float sq = 0.f;
#pragma unroll
                for (int bj = 0; bj < 2; ++bj) { const u32x4 rv = *(const u32x4*)(R + off + bj * HALF);
                    const f32x4 a0 = acc[ai][bj][m][0], a1 = acc[ai][bj][m][1];
                    u32x4 w; w.x = cvt_pk_bf16(a0[0] + lo_f(rv.x), a0[1] + hi_f(rv.x)); w.y = cvt_pk_bf16(a0[2] + lo_f(rv.y), a0[3] + hi_f(rv.y));
                    w.z = cvt_pk_bf16(a1[0] + lo_f(rv.z), a1[1] + hi_f(rv.z)); w.w = cvt_pk_bf16(a1[2] + lo_f(rv.w), a1[3] + hi_f(rv.w));
                    *(u32x4*)(O + off + bj * HALF) = w;
                    float t;
                    t = lo_f(w.x); sq += t * t; t = hi_f(w.x); sq += t * t; t = lo_f(w.y); sq += t * t; t = hi_f(w.y); sq += t * t;
                    t = lo_f(w.z); sq += t * t; t = hi_f(w.z); sq += t * t; t = lo_f(w.w); sq += t * t; t = hi_f(w.w); sq += t * t; }
                sq += __shfl_xor(sq, 16); sq += __shfl_xor(sq, 32);
                if (fq == 0) atomicAdd(ss + r, sq); }
    }
};


struct EpiResidF32 {
    static constexpr bool PERM = true, AFTER_DRAIN = false;
    bf16_t* O; const float* R; float* ss; int ldc; int pad;
    __device__ __forceinline__ void operator()(const f32x4 (&acc)[2][2][4][2], const Unit& u, int wr, int wc, int fr, int fq) const {
        const int row0 = u.pm * BM + wr * 64 + fr, col0 = u.pn * BM + wc * 32 + 8 * fq;
#pragma unroll
        for (int ai = 0; ai < 2; ++ai)
#pragma unroll
            for (int m = 0; m < 4; ++m) { const int r = row0 + ai * HALF + m * 16; const size_t off = (size_t)r * ldc + col0; float sq = 0.f;
#pragma unroll
                for (int bj = 0; bj < 2; ++bj) { const f32x4 r0 = *(const f32x4*)(R + off + bj * HALF), r1 = *(const f32x4*)(R + off + bj * HALF + 4);
                    const f32x4 a0 = acc[ai][bj][m][0] + r0, a1 = acc[ai][bj][m][1] + r1;
                    u32x4 w; w.x = cvt_pk_bf16(a0[0], a0[1]); w.y = cvt_pk_bf16(a0[2], a0[3]); w.z = cvt_pk_bf16(a1[0], a1[1]); w.w = cvt_pk_bf16(a1[2], a1[3]);
                    *(u32x4*)(O + off + bj * HALF) = w;
                    float t;
                    t = lo_f(w.x); sq += t * t; t = hi_f(w.x); sq += t * t; t = lo_f(w.y); sq += t * t; t = hi_f(w.y); sq += t * t;
                    t = lo_f(w.z); sq += t * t; t = hi_f(w.z); sq += t * t; t = lo_f(w.w); sq += t * t; t = hi_f(w.w); sq += t * t; }
                sq += __shfl_xor(sq, 16); sq += __shfl_xor(sq, 32);
                if (fq == 0) atomicAdd(ss + r, sq); }
    }
};

__device__ __forceinline__ float dpp_shr1(float oldv, float src) { return __builtin_bit_cast(float, __builtin_amdgcn_update_dpp(__builtin_bit_cast(int, oldv), __builtin_bit_cast(int, src), 0x111, 0xf, 0xf, false)); }
__device__ __forceinline__ float dpp_shr2(float oldv, float src) { return __builtin_bit_cast(float, __builtin_amdgcn_update_dpp(__builtin_bit_cast(int, oldv), __builtin_bit_cast(int, src), 0x112, 0xf, 0xf, false)); }
__device__ __forceinline__ float dpp_ror1(float src) { return __builtin_bit_cast(float, __builtin_amdgcn_update_dpp(0, __builtin_bit_cast(int, src), 0x121, 0xf, 0xf, false)); }
__device__ __forceinline__ float dpp_ror2(float src) { return __builtin_bit_cast(float, __builtin_amdgcn_update_dpp(0, __builtin_bit_cast(int, src), 0x122, 0xf, 0xf, false)); }
struct EpiFfn1 {
    static constexpr bool PERM = true, AFTER_DRAIN = false;
    bf16_t* ACT; const float* ss2; const float* cw; const float* cb; float* halog; float* fixg; float* fixu; PG8_LAS float* hl;
    __device__ __forceinline__ void operator()(const f32x4 (&acc)[2][2][4][2], const Unit& u, int wr, int wc, int fr, int fq) const {
        constexpr int FF = 2816;
        const int ch0 = u.pn * HALF + wc * 32 + 8 * fq;
        float rsv[2][4];
#pragma unroll
        for (int ai = 0; ai < 2; ++ai)
#pragma unroll
            for (int m = 0; m < 4; ++m) rsv[ai][m] = rsqrtf(ss2[u.pm * BM + ai * HALF + wr * 64 + m * 16 + fr] * (1.f / 1024.f) + 1e-6f);
        if (fr >= 14) {
#pragma unroll
            for (int ai = 0; ai < 2; ++ai) { const int G = 2 * ai + wr; PG8_LAS float* p = hl + (((G * 4 + wc) * 2 + (fr - 14)) * 4 + fq) * 8;
                *(PG8_LAS f32x4*)p = acc[ai][0][3][0] * rsv[ai][3]; *(PG8_LAS f32x4*)(p + 4) = acc[ai][0][3][1] * rsv[ai][3]; } }
        const f32x4 w0a = *(const f32x4*)(cw + ch0), w0b = *(const f32x4*)(cw + ch0 + 4), w1a = *(const f32x4*)(cw + FF + ch0), w1b = *(const f32x4*)(cw + FF + ch0 + 4);
        const f32x4 w2a = *(const f32x4*)(cw + 2 * FF + ch0), w2b = *(const f32x4*)(cw + 2 * FF + ch0 + 4), cba = *(const f32x4*)(cb + ch0), cbb = *(const f32x4*)(cb + ch0 + 4);
        asm volatile("s_waitcnt lgkmcnt(0)" ::: "memory"); __builtin_amdgcn_s_barrier(); asm volatile("" ::: "memory");
#pragma unroll
        for (int ai = 0; ai < 2; ++ai) { const int G = 2 * ai + wr;
            f32x4 pa = (f32x4){0.f, 0.f, 0.f, 0.f}, pb = pa;
            if (G > 0 && fr >= 14) { const PG8_LAS float* p = hl + ((((G - 1) * 4 + wc) * 2 + (fr - 14)) * 4 + fq) * 8; pa = *(const PG8_LAS f32x4*)p; pb = *(const PG8_LAS f32x4*)(p + 4); }
#pragma unroll
            for (int m = 0; m < 4; ++m) { const float s = rsv[ai][m]; const int r = u.pm * BM + ai * HALF + wr * 64 + m * 16 + fr;
                const f32x4 ga = acc[ai][0][m][0] * s, gb = acc[ai][0][m][1] * s, ua = acc[ai][1][m][0] * s, ub = acc[ai][1][m][1] * s;
                f32x4 oa, ob;
#pragma unroll
                for (int e = 0; e < 4; ++e) {
                    const float g1a = dpp_shr1(dpp_ror1(pa[e]), ga[e]), g2a = dpp_shr2(dpp_ror2(pa[e]), ga[e]);
                    const float g1b = dpp_shr1(dpp_ror1(pb[e]), gb[e]), g2b = dpp_shr2(dpp_ror2(pb[e]), gb[e]);
                    const float ca = cba[e] + w2a[e] * ga[e] + w1a[e] * g1a + w0a[e] * g2a, cbv = cbb[e] + w2b[e] * gb[e] + w1b[e] * g1b + w0b[e] * g2b;
                    oa[e] = ca * __builtin_amdgcn_rcpf(1.f + __builtin_amdgcn_exp2f(ca * -1.4426950408889634f)) * ua[e]; ob[e] = cbv * __builtin_amdgcn_rcpf(1.f + __builtin_amdgcn_exp2f(cbv * -1.4426950408889634f)) * ub[e]; }
                const bool defer = (G == 0 && m == 0 && fr < 2);
                if (defer) { float* pg = fixg + ((size_t)u.pm * 2 + fr) * FF + ch0; float* pu = fixu + ((size_t)u.pm * 2 + fr) * FF + ch0;
                    *(f32x4*)pg = ga; *(f32x4*)(pg + 4) = gb; *(f32x4*)pu = ua; *(f32x4*)(pu + 4) = ub; }
                else { u32x4 w; w.x = cvt_pk_bf16(oa[0], oa[1]); w.y = cvt_pk_bf16(oa[2], oa[3]); w.z = cvt_pk_bf16(ob[0], ob[1]); w.w = cvt_pk_bf16(ob[2], ob[3]);
                    *(u32x4*)(ACT + (size_t)r * FF + ch0) = w; }
                if (G == 3 && m == 3 && fr >= 14) { float* ph = halog + ((size_t)u.pm * 2 + (fr - 14)) * FF + ch0; *(f32x4*)ph = ga; *(f32x4*)(ph + 4) = gb; }
                pa = ga; pb = gb; } }
    }
};

template <class Epi, class Sched, bool ALIGN_EPI = false, bool SP2 = false>
__device__ __forceinline__ void gemm_phase(PG8_LAS unsigned char* lds, const Gemm g, const Sched& S, const Epi& E) {
    const int tid = threadIdx.x, wid = __builtin_amdgcn_readfirstlane(tid >> 6), lane = tid & 63, wr = wid >> 2, wc = wid & 3, fr = lane & 15, fq = lane >> 4;
    const int K = g.K, nt = K / BK;
    unsigned voffA[2], voffB[2];
#pragma unroll
    for (int i = 0; i < 2; ++i) { int R, C; stage_rc(tid * 16 + i * 8192, R, C); const int Rb = Epi::PERM ? ((R & ~31) + perm32(R & 31)) : R;
        voffA[i] = (unsigned)(R * K + C) * 2u; voffB[i] = (unsigned)(Rb * K + C) * 2u; }
    const size_t kstep = (size_t)(BK * 2);
    const size_t hstep = (size_t)HALF * K * 2;
    const size_t tstep = 2 * hstep;
    const unsigned ldsw = (unsigned)wid * 1024u;
    const int aoff = lds_byte(wr * 64 + fr, fq * 8), boff = lds_byte(wc * 32 + fr, fq * 8);
#define PG8_SA(b, h) (((b) * 2 + (h)) * HTB)
#define PG8_SB(b, h) ((4 + (b) * 2 + (h)) * HTB)
#define PG8_STAGE(bufoff, gbase, voff) do { _Pragma("unroll") for (int _i = 0; _i < 2; ++_i) \
        __builtin_amdgcn_global_load_lds((const unsigned*)((const char*)(gbase) + (voff)[_i]), (PG8_LAS unsigned*)(lds + (bufoff) + ldsw + _i * 8192), 16, 0, 0); } while (0)
#define PG8_LDA(dst, b, h) do { _Pragma("unroll") for (int m = 0; m < 4; ++m) _Pragma("unroll") for (int k = 0; k < 2; ++k) dst[m][k] = *(const PG8_LAS bf16x8*)(lds + PG8_SA(b, h) + aoff + m * 2048 + k * 1024); } while (0)
#define PG8_LDB(dst, b, h) do { _Pragma("unroll") for (int n = 0; n < 2; ++n) _Pragma("unroll") for (int k = 0; k < 2; ++k) dst[n][k] = *(const PG8_LAS bf16x8*)(lds + PG8_SB(b, h) + boff + n * 2048 + k * 1024); } while (0)
#define PG8_MMA(ai, bj, At, Bt) do { __builtin_amdgcn_s_setprio(1); _Pragma("unroll") for (int m = 0; m < 4; ++m) _Pragma("unroll") for (int n = 0; n < 2; ++n) _Pragma("unroll") for (int k = 0; k < 2; ++k) \
        acc[ai][bj][m][n] = __builtin_amdgcn_mfma_f32_16x16x32_bf16(Bt[n][k], At[m][k], acc[ai][bj][m][n], 0, 0, 0); __builtin_amdgcn_s_setprio(0); } while (0)
#define PG8_WAIT_V(n) asm volatile("s_waitcnt vmcnt(" #n ")" ::: "memory")
#define PG8_WAIT_L(n) asm volatile("s_waitcnt lgkmcnt(" #n ")" ::: "memory")
#define PG8_BAR __builtin_amdgcn_s_barrier()
#define PG8_SCHED __builtin_amdgcn_sched_barrier(0)
    Unit cur, nxt; int ui = 0;
    if (!S.next(0, cur)) return;
    f32x4 acc[2][2][4][2];
#pragma unroll
    for (int a = 0; a < 2; ++a)
#pragma unroll
        for (int b = 0; b < 2; ++b)
#pragma unroll
            for (int m = 0; m < 4; ++m)
#pragma unroll
                for (int n = 0; n < 2; ++n) acc[a][b][m][n] = (f32x4){0.f, 0.f, 0.f, 0.f};
    bf16x8 At[4][2], B0[2][2], B1[2][2];
    const char* cA = (const char*)g.A + (size_t)cur.pm * tstep; const char* cB = (const char*)g.Bt + (size_t)cur.pn * tstep;
    S.a_ready(cur);
    if constexpr (SP2) {
        PG8_STAGE(PG8_SB(0, 0), cB, voffB); PG8_STAGE(PG8_SB(0, 1), cB + hstep, voffB); PG8_STAGE(PG8_SA(0, 0), cA, voffA); PG8_STAGE(PG8_SA(0, 1), cA + hstep, voffA);
        if (wr == 1) PG8_BAR;
        PG8_WAIT_V(2); PG8_BAR;
        PG8_STAGE(PG8_SB(1, 0), cB + kstep, voffB); PG8_STAGE(PG8_SA(1, 0), cA + kstep, voffA); PG8_STAGE(PG8_SB(1, 1), cB + hstep + kstep, voffB);
        PG8_WAIT_V(6); PG8_BAR;
    } else {
        PG8_STAGE(PG8_SB(0, 0), cB, voffB); PG8_STAGE(PG8_SA(0, 0), cA, voffA); PG8_STAGE(PG8_SB(0, 1), cB + hstep, voffB); PG8_STAGE(PG8_SA(0, 1), cA + hstep, voffA);
        if (wr == 1) PG8_BAR;
        PG8_WAIT_V(4); PG8_BAR;
        PG8_STAGE(PG8_SB(1, 0), cB + kstep, voffB); PG8_STAGE(PG8_SA(1, 0), cA + kstep, voffA); PG8_STAGE(PG8_SB(1, 1), cB + hstep + kstep, voffB);
        PG8_WAIT_V(6); PG8_BAR;
    }
    for (;;) {
        const bool has_next = S.next(ui + 1, nxt);
        const char* nA = has_next ? (const char*)g.A + (size_t)nxt.pm * tstep : cA; const char* nB = has_next ? (const char*)g.Bt + (size_t)nxt.pn * tstep : cB;
        for (int t = 0; t < nt; t += 2) {
            const bool last = (t == nt - 2);
            const char* a1 = cA + (size_t)(t + 1) * kstep;
            const char* a2 = last ? nA : cA + (size_t)(t + 2) * kstep; const char* b2 = last ? nB : cB + (size_t)(t + 2) * kstep;
            const char* a3 = a2 + kstep; const char* b3 = b2 + kstep;
            if (last && has_next) S.a_ready(nxt);
            if constexpr (SP2) {
            PG8_LDB(B0, 0, 0); PG8_LDB(B1, 0, 1); PG8_SCHED; PG8_LDA(At, 0, 0); PG8_STAGE(PG8_SA(1, 1), a1 + hstep, voffA);
            PG8_WAIT_V(8); PG8_WAIT_L(0); PG8_BAR; PG8_MMA(0, 0, At, B0); PG8_MMA(0, 1, At, B1); PG8_BAR; PG8_SCHED;
            PG8_LDA(At, 0, 1); PG8_STAGE(PG8_SB(0, 0), b2, voffB); PG8_STAGE(PG8_SB(0, 1), b2 + hstep, voffB); PG8_STAGE(PG8_SA(0, 0), a2, voffA);
            PG8_WAIT_V(8); PG8_WAIT_L(0); PG8_BAR; PG8_MMA(1, 0, At, B0); PG8_MMA(1, 1, At, B1); PG8_BAR; PG8_SCHED;
            PG8_LDB(B0, 1, 0); PG8_LDB(B1, 1, 1); PG8_SCHED; PG8_LDA(At, 1, 0); PG8_STAGE(PG8_SA(0, 1), a2 + hstep, voffA);
            PG8_WAIT_V(8); PG8_WAIT_L(0); PG8_BAR; PG8_MMA(0, 0, At, B0); PG8_MMA(0, 1, At, B1); PG8_BAR; PG8_SCHED;
            PG8_LDA(At, 1, 1); PG8_STAGE(PG8_SB(1, 0), b3, voffB); PG8_STAGE(PG8_SB(1, 1), b3 + hstep, voffB); PG8_STAGE(PG8_SA(1, 0), a3, voffA);
            PG8_WAIT_V(8); PG8_WAIT_L(0); PG8_BAR; PG8_MMA(1, 0, At, B0); PG8_MMA(1, 1, At, B1); PG8_BAR; PG8_SCHED;
            } else {
            PG8_LDB(B0, 0, 0); PG8_SCHED; PG8_LDA(At, 0, 0); PG8_STAGE(PG8_SA(1, 1), a1 + hstep, voffA);
            PG8_WAIT_L(8); PG8_BAR; PG8_WAIT_L(0); PG8_MMA(0, 0, At, B0); PG8_BAR; PG8_SCHED;
            PG8_LDB(B1, 0, 1); PG8_STAGE(PG8_SB(0, 0), b2, voffB);
            PG8_BAR; PG8_WAIT_L(0); PG8_MMA(0, 1, At, B1); PG8_BAR;
            PG8_LDA(At, 0, 1); PG8_STAGE(PG8_SA(0, 0), a2, voffA);
            PG8_BAR; PG8_WAIT_L(0); PG8_MMA(1, 0, At, B0); PG8_BAR; PG8_SCHED;
            PG8_STAGE(PG8_SB(0, 1), b2 + hstep, voffB);
            PG8_WAIT_V(6); PG8_BAR; PG8_MMA(1, 1, At, B1); PG8_BAR;
            PG8_LDB(B0, 1, 0); PG8_SCHED; PG8_LDA(At, 1, 0); PG8_STAGE(PG8_SA(0, 1), a2 + hstep, voffA);
            PG8_WAIT_L(8); PG8_BAR; PG8_WAIT_L(0); PG8_MMA(0, 0, At, B0); PG8_BAR; PG8_SCHED;
            PG8_LDB(B1, 1, 1); PG8_STAGE(PG8_SB(1, 0), b3, voffB);
            PG8_BAR; PG8_WAIT_L(0); PG8_MMA(0, 1, At, B1); PG8_BAR;
            PG8_LDA(At, 1, 1); PG8_STAGE(PG8_SA(1, 0), a3, voffA);
            PG8_BAR; PG8_WAIT_L(0); PG8_MMA(1, 0, At, B0); PG8_BAR; PG8_SCHED;
            PG8_STAGE(PG8_SB(1, 1), b3 + hstep, voffB);
            PG8_WAIT_V(6); PG8_BAR; PG8_MMA(1, 1, At, B1); PG8_BAR;
            }
        }
        if constexpr (ALIGN_EPI) { if (wr == 0) PG8_BAR; }
        if constexpr (!Epi::AFTER_DRAIN) { E(acc, cur, wr, wc, fr, fq); S.done(cur); }
        if (!has_next) break;
#pragma unroll
        for (int a = 0; a < 2; ++a)
#pragma unroll
            for (int b = 0; b < 2; ++b)
#pragma unroll
                for (int m = 0; m < 4; ++m)
#pragma unroll
                    for (int n = 0; n < 2; ++n) acc[a][b][m][n] = (f32x4){0.f, 0.f, 0.f, 0.f};
        cur = nxt; cA = nA; cB = nB; ++ui;
        if constexpr (ALIGN_EPI) { if (wr == 1) PG8_BAR; }
    }
    PG8_WAIT_V(0);
    if constexpr (!ALIGN_EPI) { if (wr == 0) PG8_BAR; }
    PG8_BAR;
    if constexpr (Epi::AFTER_DRAIN) { E.fused(acc, cur, wr, wc, fr, fq, lds, wid, lane); S.done(cur); }
#undef PG8_SA
#undef PG8_SB
#undef PG8_STAGE
#undef PG8_LDA
#undef PG8_LDB
#undef PG8_MMA
#undef PG8_WAIT_V
#undef PG8_WAIT_L
#undef PG8_BAR
#undef PG8_SCHED
}
}


constexpr int NWAVES = 8;
constexpr int RING_OFF = 0, RING_BYTES = 131072;
constexpr int LDSX_OFF = RING_BYTES;
constexpr int MISC_OFF = RING_BYTES + 8192;
constexpr int LDS_BYTES = 147456;
static_assert(MISC_OFF + 128 <= LDS_BYTES, "LDS map");
constexpr int CW_BAR = 1024;

#define GAS __attribute__((address_space(1)))
#define LAS __attribute__((address_space(3)))
typedef unsigned v4u __attribute__((ext_vector_type(4)));
typedef float f32x4 __attribute__((ext_vector_type(4)));
typedef unsigned u32x2 __attribute__((ext_vector_type(2)));
typedef GAS unsigned gu32;
#define LDS_WAIT() asm volatile("s_waitcnt lgkmcnt(0)" ::: "memory")
#define VM_WAIT() asm volatile("s_waitcnt vmcnt(0)" ::: "memory")
__device__ __forceinline__ unsigned pk2(float lo, float hi) { return f2bf(lo) | (f2bf(hi) << 16); }

#define XB_TMO      128
#define XB_XCNT(j)  (256  + 64 * (j))
#define XB_XSUB(j)  (1280 + 64 * (j))
#define XB_XGEN(j)  (2304 + 64 * (j))
#define XB_TOP      3328
#define XB_TOPGEN   3392
#define XCD_BAR_WORDS 3456
#define XB_SPIN_CAP (1u << 18)

__device__ __forceinline__ unsigned xb_ld(unsigned* p)              { return __hip_atomic_load(p, __ATOMIC_RELAXED, __HIP_MEMORY_SCOPE_AGENT); }
__device__ __forceinline__ unsigned xb_add(unsigned* p, unsigned v) { return __hip_atomic_fetch_add(p, v, __ATOMIC_RELAXED, __HIP_MEMORY_SCOPE_AGENT); }
__device__ __forceinline__ unsigned xb_xcc_id() { return (unsigned)__builtin_amdgcn_s_getreg((3 << 11) | 20) & 0xFu; }
#define XB_SPIN(cond, bar) do { unsigned _sp = 0; while (cond) { __builtin_amdgcn_s_sleep(1); \
    if ((++_sp & 255u) == 0u) { if (xb_ld(&(bar)[XB_TMO])) break; if (_sp > XB_SPIN_CAP) { atomicAdd(&(bar)[XB_TMO], 1u); break; } } } } while (0)

struct XcdBarrier {
    unsigned* bar; unsigned x;
    volatile LAS unsigned* st;
};

__device__ __forceinline__ XcdBarrier xcd_barrier_post(unsigned* bar, volatile LAS unsigned* st) {
    XcdBarrier b; b.bar = bar; b.x = xb_xcc_id(); b.st = st;
    if (threadIdx.x == 0) (void)xb_add(&bar[XB_XCNT(b.x)], 1u);
    return b;
}
__device__ __forceinline__ void xcd_barrier_complete(unsigned* bar, unsigned x, unsigned& nloc, unsigned& nx) {
    const unsigned G = gridDim.x * gridDim.y * gridDim.z;
    unsigned sum, cnt, mine, sp = 0u;
    for (;;) {
        sum = 0u; cnt = 0u; mine = 0u;
#pragma unroll
        for (unsigned j = 0; j < 16; ++j) { const unsigned c = xb_ld(&bar[XB_XCNT(j)]); sum += c; cnt += (c > 0u) ? 1u : 0u; mine = (j == x) ? c : mine; }
        if (sum == G) break;
        __builtin_amdgcn_s_sleep(1);
        if ((++sp & 255u) == 0u) { if (xb_ld(&bar[XB_TMO])) break; if (sp > XB_SPIN_CAP) { atomicAdd(&bar[XB_TMO], 1u); break; } }
    }
    nloc = mine > 0u ? mine : 1u; nx = cnt > 0u ? cnt : 1u;
}

__device__ __forceinline__ void xcd_barrier(const XcdBarrier& b) {
    asm volatile("s_waitcnt vmcnt(0)" ::: "memory");
    __syncthreads();
    if (threadIdx.x == 0) {
        unsigned* bar = b.bar;
        __builtin_amdgcn_s_waitcnt(0);
        unsigned nloc = b.st[0], nx = b.st[1];
        if (nloc == 0u) { xcd_barrier_complete(bar, b.x, nloc, nx); b.st[0] = nloc; b.st[1] = nx; }
        const unsigned old = xb_add(&bar[XB_XSUB(b.x)], 1u);
        const unsigned gen = old / nloc;
        if (old + 1u == (gen + 1u) * nloc) {
            __builtin_amdgcn_fence(__ATOMIC_RELEASE, "agent");
            asm volatile("s_waitcnt vmcnt(0)" ::: "memory");
            const unsigned og = xb_add(&bar[XB_TOP], 1u);
            const unsigned tg = og / nx;
            if (og + 1u == (tg + 1u) * nx) xb_add(&bar[XB_TOPGEN], 1u);
            else XB_SPIN(xb_ld(&bar[XB_TOPGEN]) == tg, bar);
            __builtin_amdgcn_fence(__ATOMIC_ACQUIRE, "agent");
            xb_add(&bar[XB_XGEN(b.x)], 1u);
            asm volatile("s_waitcnt vmcnt(0)" ::: "memory");
        } else {
            XB_SPIN(xb_ld(&bar[XB_XGEN(b.x)]) == gen, bar);
            __builtin_amdgcn_fence(__ATOMIC_ACQUIRE, "agent");
            asm volatile("s_waitcnt vmcnt(0)" ::: "memory");
        }
    }
    __syncthreads();
}


namespace att {
typedef short bf16x8 __attribute__((ext_vector_type(8)));
typedef short s16x4 __attribute__((ext_vector_type(4)));
typedef float f32x16 __attribute__((ext_vector_type(16)));
typedef unsigned u32x4 __attribute__((ext_vector_type(4)));
typedef unsigned u32x2 __attribute__((ext_vector_type(2)));
constexpr float LOG2E = 1.4426950408889634f;
__device__ __forceinline__ int kappa(int r) { return (r & ~12) | ((r & 4) << 1) | ((r & 8) >> 1); }
__device__ __forceinline__ f32x16 mfma32(bf16x8 a, bf16x8 b, f32x16 c) { return __builtin_amdgcn_mfma_f32_32x32x16_bf16(a, b, c, 0, 0, 0); }
__device__ __forceinline__ s16x4 vtr(const LAS unsigned char* p) { return __builtin_bit_cast(s16x4, __builtin_amdgcn_ds_read_tr16_b64_v4i16((LAS s16x4*)p)); }
__device__ __forceinline__ bf16x8 cat8(s16x4 a, s16x4 b) { return (bf16x8){a[0], a[1], a[2], a[3], b[0], b[1], b[2], b[3]}; }
__device__ __forceinline__ unsigned cvtpk(float lo, float hi) { unsigned r; asm volatile("v_cvt_pk_bf16_f32 %0, %1, %2" : "=v"(r) : "v"(lo), "v"(hi)); return r; }
__device__ __forceinline__ bf16x8 packp(const f32x16& p, int s) {
    u32x4 w; w.x = cvtpk(p[8 * s + 0], p[8 * s + 1]); w.y = cvtpk(p[8 * s + 2], p[8 * s + 3]); w.z = cvtpk(p[8 * s + 4], p[8 * s + 5]); w.w = cvtpk(p[8 * s + 6], p[8 * s + 7]);
    return __builtin_bit_cast(bf16x8, w);
}
__device__ __forceinline__ int tr_off(int lane, int VP) { const int hi = lane >> 5, blk = (lane >> 4) & 1, q4 = (lane & 15) >> 2, p4 = lane & 3; return (8 * hi + q4) * VP + (16 * blk + 4 * p4) * 2; }

constexpr int MB_KP = 144, MB_VP = 192, MB_TN = 2176;
constexpr int MB_K = 0, MB_V = 2 * 64 * MB_KP, MB_LUT = MB_V + 2 * 64 * MB_VP, MB_KM = MB_LUT + 4 * MB_TN * 4, MB_END = MB_KM + 2048;
__device__ __forceinline__ f32x16 ld_c16(const LAS unsigned char* p) {
    const f32x4 a = *(const LAS f32x4*)p, b = *(const LAS f32x4*)(p + 16), c = *(const LAS f32x4*)(p + 64), d = *(const LAS f32x4*)(p + 80);
    return (f32x16){a[0], a[1], a[2], a[3], b[0], b[1], b[2], b[3], c[0], c[1], c[2], c[3], d[0], d[1], d[2], d[3]};
}
__device__ __forceinline__ float max16(const f32x16& p) { return fmaxf(fmaxf(fmaxf(fmaxf(p[0], p[1]), fmaxf(p[2], p[3])), fmaxf(fmaxf(p[4], p[5]), fmaxf(p[6], p[7]))), fmaxf(fmaxf(fmaxf(p[8], p[9]), fmaxf(p[10], p[11])), fmaxf(fmaxf(p[12], p[13]), fmaxf(p[14], p[15])))); }
__device__ __forceinline__ void moba_phase(LAS unsigned char* lds, const bf16* QKV, const float* KMP, const float* LUT, bf16* Y, int vcu, int G) {
    const int tid = threadIdx.x, lane = tid & 63, r32 = lane & 31, hi = lane >> 5; const int w = __builtin_amdgcn_readfirstlane(tid >> 6);
    LAS float* tab = (LAS float*)(lds + MB_LUT); LAS float* km = (LAS float*)(lds + MB_KM);
    const int troff = tr_off(lane, MB_VP);
    for (int tau = vcu; tau < BATCH * 8 * 4; tau += G) { const int bh = tau >> 2, pr = tau & 3, b = bh >> 3, h = bh & 7;
        __syncthreads();
        for (int i = tid; i < 4 * MB_TN; i += 512) { const int sft = i / MB_TN, ii = i - sft * MB_TN, idx = 2047 - ii - sft; tab[i] = idx >= 0 ? LUT[(8 + h) * 2048 + idx] * LOG2E : -INFINITY; }
        { const int j = tid >> 6, d = tid & 63; km[tid] = (KMP[(size_t)((8 * b + j) * 2 + 0) * 512 + 64 * h + d] + KMP[(size_t)((8 * b + j) * 2 + 1) * 512 + 64 * h + d]) * (1.f / 256.f); }
        __syncthreads();
        const bf16* Qb = QKV + (size_t)b * SEQ * NQKV + 1536 + 64 * h; const bf16* Kb = QKV + (size_t)b * SEQ * NQKV + 2048 + 64 * h; const bf16* Vb = Kb + 512;
        for (int s2 = 0; s2 < 2; ++s2) { const int qb = s2 == 0 ? 7 - pr : pr;
            const int tq = 256 * qb + 32 * w + r32;
            bf16x8 qf[4];
#pragma unroll
            for (int d0 = 0; d0 < 4; ++d0) qf[d0] = *(const bf16x8*)(Qb + (size_t)tq * NQKV + 16 * d0 + 8 * hi);
            unsigned sel = 0;
            { float g[8];
#pragma unroll
              for (int j = 0; j < 8; ++j) g[j] = 0.f;
#pragma unroll
              for (int d0 = 0; d0 < 4; ++d0) { float qv[8];
#pragma unroll
                  for (int e = 0; e < 8; ++e) qv[e] = __builtin_bit_cast(float, (unsigned)(unsigned short)qf[d0][e] << 16);
#pragma unroll
                  for (int j = 0; j < 7; ++j) { const LAS float* kp = km + j * 64 + 16 * d0 + 8 * hi; const f32x4 k0 = *(const LAS f32x4*)kp, k1 = *(const LAS f32x4*)(kp + 4);
                      g[j] += qv[0] * k0[0] + qv[1] * k0[1] + qv[2] * k0[2] + qv[3] * k0[3] + qv[4] * k1[0] + qv[5] * k1[1] + qv[6] * k1[2] + qv[7] * k1[3]; } }
#pragma unroll
              for (int j = 0; j < 7; ++j) g[j] += __shfl_xor(g[j], 32);
              const int nsel = qb < 3 ? qb : 3;
              for (int n = 0; n < nsel; ++n) { float best = -3e38f; int bi = 0;
#pragma unroll
                  for (int j = 0; j < 7; ++j) if (j < qb && !((sel >> j) & 1u) && g[j] > best) { best = g[j]; bi = j; }
                  sel |= 1u << bi; }
              sel |= 1u << qb; }
            float m_run = -1e30f, l_run = 0.f; f32x16 o0 = {}, o1 = {};
            const int NT = 4 * (qb + 1);
            const int a0 = 2047 - tq + 8 * hi;
            const LAS unsigned char* cp = (const LAS unsigned char*)tab + (a0 & 3) * (MB_TN * 4) + (a0 & ~3) * 4;
            const int skey = tid >> 3, sch = tid & 7;
            u32x4 kreg, vreg, kreg2, vreg2;
            { kreg = *(const u32x4*)(Kb + (size_t)skey * NQKV + 8 * sch); vreg = *(const u32x4*)(Vb + (size_t)skey * NQKV + 8 * sch);
              *(LAS u32x4*)(lds + MB_K + skey * MB_KP + sch * 16) = kreg; *(LAS u32x4*)(lds + MB_V + skey * MB_VP + sch * 16) = vreg;
              const size_t ro = (size_t)(64 + skey) * NQKV + 8 * sch; kreg = *(const u32x4*)(Kb + ro); vreg = *(const u32x4*)(Vb + ro); kreg2 = kreg; vreg2 = vreg; }
            __syncthreads();
            for (int T = 0; T < NT; ++T) {
                const int buf = T & 1, jb = T >> 2, key0 = 64 * T;
                if (T + 2 < NT) { const size_t ro = (size_t)(key0 + 128 + skey) * NQKV + 8 * sch; kreg2 = *(const u32x4*)(Kb + ro); vreg2 = *(const u32x4*)(Vb + ro); }
                const bool selb = (sel >> jb) & 1u;
                bool active;
                if (jb < qb) active = __ballot(selb) != 0ull; else active = (key0 - 256 * qb) <= 32 * w + 31;
                if (active) {
                    const LAS unsigned char* Kt = lds + MB_K + buf * (64 * MB_KP); const LAS unsigned char* Vt = lds + MB_V + buf * (64 * MB_VP);
                    f32x16 p0 = ld_c16(cp + 256 * T), p1 = ld_c16(cp + 256 * T + 128);
#pragma unroll
                    for (int d0 = 0; d0 < 4; ++d0) { const bf16x8 k0 = *(const LAS bf16x8*)(Kt + kappa(r32) * MB_KP + (2 * d0 + hi) * 16), k1 = *(const LAS bf16x8*)(Kt + (32 + kappa(r32)) * MB_KP + (2 * d0 + hi) * 16);
                        p0 = mfma32(k0, qf[d0], p0); p1 = mfma32(k1, qf[d0], p1); }
                    float mx = fmaxf(max16(p0), max16(p1));
                    mx = selb ? mx : -INFINITY;
                    mx = fmaxf(mx, __shfl_xor(mx, 32));
                    const float m_new = fmaxf(m_run, mx);
                    if (__any(m_new > m_run)) { const float alpha = __builtin_amdgcn_exp2f(m_run - m_new); l_run *= alpha;
#pragma unroll
                        for (int r = 0; r < 16; ++r) { o0[r] *= alpha; o1[r] *= alpha; } }
                    m_run = m_new;
                    const float meff = selb ? m_new : INFINITY;
                    float ls = 0.f;
#pragma unroll
                    for (int r = 0; r < 16; ++r) { p0[r] = __builtin_amdgcn_exp2f(p0[r] - meff); p1[r] = __builtin_amdgcn_exp2f(p1[r] - meff); ls += p0[r] + p1[r]; }
                    l_run += ls;
                    const bf16x8 pf0 = packp(p0, 0), pf1 = packp(p0, 1), pf2 = packp(p1, 0), pf3 = packp(p1, 1);
#pragma unroll
                    for (int c = 0; c < 2; ++c) { const LAS unsigned char* vb = Vt + troff + c * 64;
                        const bf16x8 v0 = cat8(vtr(vb), vtr(vb + 4 * MB_VP)), v1 = cat8(vtr(vb + 16 * MB_VP), vtr(vb + 20 * MB_VP));
                        const bf16x8 v2 = cat8(vtr(vb + 32 * MB_VP), vtr(vb + 36 * MB_VP)), v3 = cat8(vtr(vb + 48 * MB_VP), vtr(vb + 52 * MB_VP));
                        if (c == 0) { o0 = mfma32(v0, pf0, o0); o0 = mfma32(v1, pf1, o0); o0 = mfma32(v2, pf2, o0); o0 = mfma32(v3, pf3, o0); }
                        else { o1 = mfma32(v0, pf0, o1); o1 = mfma32(v1, pf1, o1); o1 = mfma32(v2, pf2, o1); o1 = mfma32(v3, pf3, o1); } }
                }
                if (T + 1 < NT) { *(LAS u32x4*)(lds + MB_K + (buf ^ 1) * (64 * MB_KP) + skey * MB_KP + sch * 16) = kreg; *(LAS u32x4*)(lds + MB_V + (buf ^ 1) * (64 * MB_VP) + skey * MB_VP + sch * 16) = vreg; }
                __syncthreads();
                kreg = kreg2; vreg = vreg2;
            }
            const float inv = 1.f / (l_run + __shfl_xor(l_run, 32));
            bf16* yp = Y + ((size_t)b * SEQ + tq) * DM + 512 + 64 * h + 4 * hi;
#pragma unroll
            for (int g4 = 0; g4 < 4; ++g4) { u32x2 a, c2; a.x = cvtpk(o0[4 * g4] * inv, o0[4 * g4 + 1] * inv); a.y = cvtpk(o0[4 * g4 + 2] * inv, o0[4 * g4 + 3] * inv);
                c2.x = cvtpk(o1[4 * g4] * inv, o1[4 * g4 + 1] * inv); c2.y = cvtpk(o1[4 * g4 + 2] * inv, o1[4 * g4 + 3] * inv);
                *(u32x2*)(yp + 8 * g4) = a; *(u32x2*)(yp + 32 + 8 * g4) = c2; }
        }
    }
}

constexpr int DL_VP = 192, DL_LUT = 0, DL_TN = 192, DL_V = 16384, DL_SB = 65536, DL_SBP = 136, DL_SL = DL_SB + 512 * DL_SBP, DL_END = DL_SL + 2048;
static_assert(DL_END <= 139264, "dilated LDS map");
struct DilTile { bf16x8 kf[4]; u32x4 vr[4]; };
__device__ __forceinline__ void dil_load(DilTile& t, const bf16* Kb, const bf16* Vb, int dil, int res, int base, int lane, int r32, int hi) {
    const size_t ro = (size_t)(dil * (base + kappa(r32)) + res) * NQKV + 8 * hi;
#pragma unroll
    for (int d0 = 0; d0 < 4; ++d0) t.kf[d0] = *(const bf16x8*)(Kb + ro + 16 * d0);
#pragma unroll
    for (int i4 = 0; i4 < 4; ++i4) { const int idx = lane + 64 * i4, key = idx >> 3, ch = idx & 7; t.vr[i4] = *(const u32x4*)(Vb + (size_t)(dil * (base + key) + res) * NQKV + 8 * ch); }
}
__device__ __forceinline__ void dil_unit(const bf16* Qb, const bf16* Kb, const bf16* Vb, const LAS unsigned char* tb, LAS unsigned char* Vw, int troff, int dil, int res, int gi, int lane, int r32, int hi,
                                         f32x16& o0, f32x16& o1, float& lse) {
    const int ms = 32 * gi + r32, tq = dil * ms + res;
    bf16x8 qf[4];
#pragma unroll
    for (int d0 = 0; d0 < 4; ++d0) qf[d0] = *(const bf16x8*)(Qb + (size_t)tq * NQKV + 16 * d0 + 8 * hi);
    float m_run = -1e30f, l_run = 0.f; o0 = f32x16{}; o1 = f32x16{};
    const int kt0 = gi >= 4 ? 0 : 4 - gi;
    const int a0 = 31 - r32 + 8 * hi;
    const LAS unsigned char* cp = tb + (a0 & 3) * (DL_TN * 4) + (a0 & ~3) * 4;
    DilTile nx; dil_load(nx, Kb, Vb, dil, res, 32 * gi - 128 + 32 * kt0, lane, r32, hi);
    for (int kt = kt0; kt < 5; ++kt) { const int base = 32 * gi - 128 + 32 * kt;
        DilTile cu = nx;
        if (kt < 4) dil_load(nx, Kb, Vb, dil, res, base + 32, lane, r32, hi);
        asm volatile("" ::: "memory");
#pragma unroll
        for (int i4 = 0; i4 < 4; ++i4) { const int idx = lane + 64 * i4, key = idx >> 3, ch = idx & 7; *(LAS u32x4*)(Vw + key * DL_VP + ch * 16) = cu.vr[i4]; }
        f32x16 p0 = ld_c16(cp + 128 * kt);
#pragma unroll
        for (int d0 = 0; d0 < 4; ++d0) p0 = mfma32(cu.kf[d0], qf[d0], p0);
        float mx = max16(p0);
        mx = fmaxf(mx, __shfl_xor(mx, 32));
        const float m_new = fmaxf(m_run, mx);
        if (__any(m_new > m_run)) { const float alpha = __builtin_amdgcn_exp2f(m_run - m_new); l_run *= alpha;
#pragma unroll
            for (int r = 0; r < 16; ++r) { o0[r] *= alpha; o1[r] *= alpha; } }
        m_run = m_new;
        float ls = 0.f;
#pragma unroll
        for (int r = 0; r < 16; ++r) { p0[r] = __builtin_amdgcn_exp2f(p0[r] - m_new); ls += p0[r]; }
        l_run += ls;
        const bf16x8 pf0 = packp(p0, 0), pf1 = packp(p0, 1);
        asm volatile("s_waitcnt lgkmcnt(0)" ::: "memory");
#pragma unroll
        for (int c = 0; c < 2; ++c) { const LAS unsigned char* vb = Vw + troff + c * 64;
            const bf16x8 v0 = cat8(vtr(vb), vtr(vb + 4 * DL_VP)), v1 = cat8(vtr(vb + 16 * DL_VP), vtr(vb + 20 * DL_VP));
            if (c == 0) { o0 = mfma32(v0, pf0, o0); o0 = mfma32(v1, pf1, o0); } else { o1 = mfma32(v0, pf0, o1); o1 = mfma32(v1, pf1, o1); } }
        asm volatile("s_waitcnt lgkmcnt(0)" ::: "memory");
    }
    const float lt = l_run + __shfl_xor(l_run, 32), inv = 1.f / lt;
#pragma unroll
    for (int r = 0; r < 16; ++r) { o0[r] *= inv; o1[r] *= inv; }
    lse = m_run + __builtin_amdgcn_logf(lt);
}
__device__ __forceinline__ void sb_store(LAS unsigned char* sb, int lt, int hi, const f32x16& o0, const f32x16& o1) {
    LAS unsigned char* p = sb + lt * DL_SBP + 8 * hi;
#pragma unroll
    for (int g4 = 0; g4 < 4; ++g4) { u32x2 a, c2; a.x = cvtpk(o0[4 * g4], o0[4 * g4 + 1]); a.y = cvtpk(o0[4 * g4 + 2], o0[4 * g4 + 3]); c2.x = cvtpk(o1[4 * g4], o1[4 * g4 + 1]); c2.y = cvtpk(o1[4 * g4 + 2], o1[4 * g4 + 3]);
        *(LAS u32x2*)(p + 16 * g4) = a; *(LAS u32x2*)(p + 64 + 16 * g4) = c2; }
}
__device__ __forceinline__ void sb_merge(const LAS unsigned char* sb, int lt, int hi, float wa, float wb, f32x16& o0, f32x16& o1) {
    const LAS unsigned char* p = sb + lt * DL_SBP + 8 * hi;
#pragma unroll
    for (int g4 = 0; g4 < 4; ++g4) { const u32x2 a = *(const LAS u32x2*)(p + 16 * g4), c2 = *(const LAS u32x2*)(p + 64 + 16 * g4);
        o0[4 * g4] = wa * bflo(a.x) + wb * o0[4 * g4]; o0[4 * g4 + 1] = wa * bfhi(a.x) + wb * o0[4 * g4 + 1]; o0[4 * g4 + 2] = wa * bflo(a.y) + wb * o0[4 * g4 + 2]; o0[4 * g4 + 3] = wa * bfhi(a.y) + wb * o0[4 * g4 + 3];
        o1[4 * g4] = wa * bflo(c2.x) + wb * o1[4 * g4]; o1[4 * g4 + 1] = wa * bfhi(c2.x) + wb * o1[4 * g4 + 1]; o1[4 * g4 + 2] = wa * bflo(c2.y) + wb * o1[4 * g4 + 2]; o1[4 * g4 + 3] = wa * bfhi(c2.y) + wb * o1[4 * g4 + 3]; }
}
__device__ __forceinline__ void dil_phase(LAS unsigned char* lds, const bf16* QKV, const float* LUT, bf16* Y, int vcu, int G) {
    const int tid = threadIdx.x, lane = tid & 63, r32 = lane & 31, hi = lane >> 5; const int w = __builtin_amdgcn_readfirstlane(tid >> 6);
    LAS float* dtab = (LAS float*)(lds + DL_LUT);
    LAS unsigned char* Vw = lds + DL_V + w * (32 * DL_VP);
    LAS unsigned char* sb = lds + DL_SB; LAS float* sl = (LAS float*)(lds + DL_SL);
    const int troff = tr_off(lane, DL_VP);
    for (int bh = vcu; bh < BATCH * 8; bh += G) { const int b = bh >> 3, h = bh & 7;
        __syncthreads();
        for (int i = tid; i < 3 * 4 * DL_TN; i += 512) { const int ii = i % DL_TN, sft = (i / DL_TN) & 3, pp = i / (4 * DL_TN); const int dlt = 159 - ii - sft, dist = dlt * (pp == 0 ? 1 : (pp == 1 ? 4 : 16));
            dtab[i] = (dlt >= 0 && dlt <= 128 && dist < 2048) ? LUT[h * 2048 + dist] * LOG2E : -INFINITY; }
        __syncthreads();
        const bf16* Qb = QKV + (size_t)b * SEQ * NQKV + 64 * h; const bf16* Kb = Qb + 512; const bf16* Vb = Qb + 1024;
        const LAS unsigned char* tb0 = lds + DL_LUT;
        for (int sp = 0; sp < 4; ++sp) {
            for (int x = w; x < 16; x += 8) { f32x16 o0, o1; float lse;
                dil_unit(Qb, Kb, Vb, tb0 + 2 * (4 * DL_TN * 4), Vw, troff, 16, x, sp, lane, r32, hi, o0, o1, lse);
                const int lt = 16 * r32 + x; sb_store(sb, lt, hi, o0, o1); if (hi == 0) sl[lt] = lse; }
            __syncthreads();
            for (int x = w; x < 16; x += 8) { f32x16 o0, o1; float lse;
                dil_unit(Qb, Kb, Vb, tb0 + 1 * (4 * DL_TN * 4), Vw, troff, 4, x & 3, 4 * sp + (x >> 2), lane, r32, hi, o0, o1, lse);
                const int lt = 128 * (x >> 2) + 4 * r32 + (x & 3); const float ls = sl[lt], mx = fmaxf(ls, lse);
                float wa = __builtin_amdgcn_exp2f(ls - mx), wb = __builtin_amdgcn_exp2f(lse - mx); const float sw = wa + wb, isw = 1.f / sw; wa *= isw; wb *= isw;
                sb_merge(sb, lt, hi, wa, wb, o0, o1); sb_store(sb, lt, hi, o0, o1); if (hi == 0) sl[lt] = mx + __builtin_amdgcn_logf(sw); }
            __syncthreads();
            for (int x = w; x < 16; x += 8) { f32x16 o0, o1; float lse;
                dil_unit(Qb, Kb, Vb, tb0, Vw, troff, 1, 0, 16 * sp + x, lane, r32, hi, o0, o1, lse);
                const int lt = 32 * x + r32; const float ls = sl[lt], mx = fmaxf(ls, lse);
                float wa = __builtin_amdgcn_exp2f(ls - mx), wb = __builtin_amdgcn_exp2f(lse - mx); const float isw = 1.f / (wa + wb); wa *= isw; wb *= isw;
                sb_merge(sb, lt, hi, wa, wb, o0, o1);
                bf16* yp = Y + ((size_t)b * SEQ + 512 * sp + lt) * DM + 64 * h + 4 * hi;
#pragma unroll
                for (int g4 = 0; g4 < 4; ++g4) { u32x2 a, c2; a.x = cvtpk(o0[4 * g4], o0[4 * g4 + 1]); a.y = cvtpk(o0[4 * g4 + 2], o0[4 * g4 + 3]); c2.x = cvtpk(o1[4 * g4], o1[4 * g4 + 1]); c2.y = cvtpk(o1[4 * g4 + 2], o1[4 * g4 + 3]);
                    *(u32x2*)(yp + 8 * g4) = a; *(u32x2*)(yp + 32 + 8 * g4) = c2; } }
            __syncthreads();
        }
    }
}

__device__ __forceinline__ void merge_phase(const bf16* __restrict__ Y, bf16* __restrict__ YN, int gw, int NGW, int lane) {
    for (int m = gw; m < NTOK; m += NGW) {
        const u32x4 ya = *(const u32x4*)(Y + (size_t)m * DM + 8 * lane), yb = *(const u32x4*)(Y + (size_t)m * DM + 512 + 8 * lane);
        float v[8], u[8]; float sa = 0.f, sb = 0.f;
#pragma unroll
        for (int e = 0; e < 4; ++e) { v[2 * e] = bflo(ya[e]); v[2 * e + 1] = bfhi(ya[e]); u[2 * e] = bflo(yb[e]); u[2 * e + 1] = bfhi(yb[e]); }
#pragma unroll
        for (int e = 0; e < 8; ++e) { sa += v[e] * v[e]; sb += u[e] * u[e]; }
        sa = wave_sum(sa); sb = wave_sum(sb);
        const float ra = rsqrtf(sa * (1.f / 512.f) + EPS), rb = rsqrtf(sb * (1.f / 512.f) + EPS);
        u32x4 oa, ob;
#pragma unroll
        for (int e = 0; e < 4; ++e) { oa[e] = cvtpk(v[2 * e] * ra, v[2 * e + 1] * ra); ob[e] = cvtpk(u[2 * e] * rb, u[2 * e + 1] * rb); }
        *(u32x4*)(YN + (size_t)m * DM + 8 * lane) = oa; *(u32x4*)(YN + (size_t)m * DM + 512 + 8 * lane) = ob;
    }
}

constexpr int CR_KP = 272, CR_VP = 320, CR_K = 0, CR_V = 2 * 64 * CR_KP, CR_END = CR_V + 2 * 64 * CR_VP;
typedef __amdgpu_buffer_rsrc_t rsrc_t;
__device__ __forceinline__ rsrc_t mkrsrc(const void* base, unsigned bytes) { return __builtin_amdgcn_make_buffer_rsrc((void*)base, 0, bytes, 0x00020000); }
__device__ __forceinline__ u32x4 bld16(rsrc_t r, unsigned voff, unsigned soff) { return __builtin_bit_cast(u32x4, __builtin_amdgcn_raw_buffer_load_b128(r, voff, soff, 0)); }
__device__ __forceinline__ void cross_phase(LAS unsigned char* lds, const bf16* QM, const bf16* KVM, bf16* OM, int vcu, int G) {
    const int tid = threadIdx.x, lane = tid & 63, r32 = lane & 31, hi = lane >> 5; const int w = __builtin_amdgcn_readfirstlane(tid >> 6);
    const int troff = tr_off(lane, CR_VP);
    const int kkey = tid >> 3, kch = tid & 7;
    const unsigned soff = (unsigned)kkey * 4096u + (unsigned)kch * 16u;
    const unsigned qoff = (unsigned)(32 * w + r32) * 2048u + (unsigned)hi * 16u;
    const int kl0 = kkey * CR_KP + kch * 16, vl0 = kkey * CR_VP + kch * 16;
    const int kfo = kappa(r32) * CR_KP + hi * 16;
    const rsrc_t rK = mkrsrc(KVM, (unsigned)NMEMTOK * 4096u), rQ = mkrsrc(QM, (unsigned)NTOK * 2048u);
    for (int un = vcu * 4; un < BATCH * 4 * 8; un += G * 4) for (int ui = 0; ui < 4; ++ui) { const int u = un + ui, qblk = u & 7, hm = (u >> 3) & 3, b = u >> 5;
        const unsigned Qs = (unsigned)(((b * SEQ + 256 * qblk) * DM + 256 * hm) * 2);
        unsigned char* Os = (unsigned char*)(OM + ((size_t)b * SEQ + 256 * qblk) * DM + 256 * hm);
        const unsigned Ks = (unsigned)((b * NMEM * 2048 + 256 * hm) * 2), Vs = Ks + 2048u;
        f32x16 sc[8];
#pragma unroll
        for (int kt = 0; kt < 8; ++kt) sc[kt] = f32x16{};
        u32x4 r0, r1;
        __syncthreads();
        r0 = bld16(rK, soff, Ks); r1 = bld16(rK, soff, Ks + 128u);
        *(LAS u32x4*)(lds + CR_K + kl0) = r0; *(LAS u32x4*)(lds + CR_K + kl0 + 128) = r1;
        __syncthreads();
#pragma unroll
        for (int half = 0; half < 2; ++half) {
            bf16x8 qf[8];
#pragma unroll
            for (int d0 = 0; d0 < 8; ++d0) qf[d0] = __builtin_bit_cast(bf16x8, bld16(rQ, qoff, Qs + (unsigned)(256 * half + 32 * d0)));
#pragma unroll
            for (int kp = 0; kp < 4; ++kp) { const int step = half * 4 + kp, buf = step & 1;
                if (step + 1 < 8) { const int nh = (step + 1) >> 2, nk = (step + 1) & 3; const unsigned src = Ks + (unsigned)(nk * (64 * 4096) + 256 * nh); r0 = bld16(rK, soff, src); r1 = bld16(rK, soff, src + 128u); }
                else { r0 = bld16(rK, soff, Vs); r1 = bld16(rK, soff, Vs + 128u); }
                const LAS unsigned char* Kt = lds + CR_K + buf * (64 * CR_KP) + kfo;
#pragma unroll
                for (int d0 = 0; d0 < 8; ++d0) { sc[2 * kp] = mfma32(*(const LAS bf16x8*)(Kt + d0 * 32), qf[d0], sc[2 * kp]); sc[2 * kp + 1] = mfma32(*(const LAS bf16x8*)(Kt + 32 * CR_KP + d0 * 32), qf[d0], sc[2 * kp + 1]); if (d0 & 1) __builtin_amdgcn_sched_barrier(0); }
                if (step + 1 < 8) { *(LAS u32x4*)(lds + CR_K + (buf ^ 1) * (64 * CR_KP) + kl0) = r0; *(LAS u32x4*)(lds + CR_K + (buf ^ 1) * (64 * CR_KP) + kl0 + 128) = r1; }
                else { *(LAS u32x4*)(lds + CR_V + vl0) = r0; *(LAS u32x4*)(lds + CR_V + vl0 + 128) = r1; }
                __syncthreads();
            }
        }
        float mx = -INFINITY;
#pragma unroll
        for (int kt = 0; kt < 8; ++kt)
#pragma unroll
            for (int r = 0; r < 16; ++r) mx = fmaxf(mx, sc[kt][r]);
        mx = fmaxf(mx, __shfl_xor(mx, 32));
        const float c1 = 0.0625f * LOG2E, mo = mx * c1; float ls = 0.f;
        bf16x8 pf[8][2];
#pragma unroll
        for (int kt = 0; kt < 8; ++kt) {
#pragma unroll
            for (int r = 0; r < 16; ++r) { sc[kt][r] = __builtin_amdgcn_exp2f(sc[kt][r] * c1 - mo); ls += sc[kt][r]; }
            pf[kt][0] = packp(sc[kt], 0); pf[kt][1] = packp(sc[kt], 1); }
        const float inv = 1.f / (ls + __shfl_xor(ls, 32));
#pragma unroll
        for (int hv = 0; hv < 2; ++hv) {
            f32x16 o[4];
#pragma unroll
            for (int c = 0; c < 4; ++c) o[c] = f32x16{};
            if (hv == 1) { r0 = bld16(rK, soff, Vs + 256u); r1 = bld16(rK, soff, Vs + 384u);
                *(LAS u32x4*)(lds + CR_V + vl0) = r0; *(LAS u32x4*)(lds + CR_V + vl0 + 128) = r1; __syncthreads(); }
#pragma unroll
            for (int kp = 0; kp < 4; ++kp) { const int buf = kp & 1;
                if (kp + 1 < 4) { const unsigned src = Vs + (unsigned)((kp + 1) * (64 * 4096) + 256 * hv); r0 = bld16(rK, soff, src); r1 = bld16(rK, soff, src + 128u); }
                const LAS unsigned char* vb = lds + CR_V + buf * (64 * CR_VP) + troff;
#pragma unroll
                for (int t2 = 0; t2 < 2; ++t2)
#pragma unroll
                    for (int c = 0; c < 4; ++c) { const LAS unsigned char* vc = vb + t2 * 32 * CR_VP + c * 64;
                        const bf16x8 v0 = cat8(vtr(vc), vtr(vc + 4 * CR_VP)), v1 = cat8(vtr(vc + 16 * CR_VP), vtr(vc + 20 * CR_VP));
                        o[c] = mfma32(v0, pf[2 * kp + t2][0], o[c]); o[c] = mfma32(v1, pf[2 * kp + t2][1], o[c]); }
                if (kp + 1 < 4) { *(LAS u32x4*)(lds + CR_V + (buf ^ 1) * (64 * CR_VP) + vl0) = r0; *(LAS u32x4*)(lds + CR_V + (buf ^ 1) * (64 * CR_VP) + vl0 + 128) = r1; }
                __syncthreads();
            }
            unsigned char* yp = Os + 256 * hv + 8 * hi;
            const unsigned yo = (unsigned)(32 * w + r32) * 2048u;
#pragma unroll
            for (int c = 0; c < 4; ++c)
#pragma unroll
                for (int g4 = 0; g4 < 4; ++g4) { u32x2 a; a.x = cvtpk(o[c][4 * g4] * inv, o[c][4 * g4 + 1] * inv); a.y = cvtpk(o[c][4 * g4 + 2] * inv, o[c][4 * g4 + 3] * inv); *(u32x2*)(yp + 64 * c + 16 * g4 + yo) = a; }
        }
    }
}
}


struct Frame {
    LAS unsigned char* lds;
    int tid, lane, wave, vcu, G;
};
__device__ __forceinline__ void p0_titem(const float* __restrict__ W, int Nsrc, int nsrc0, int k0, const float* __restrict__ g, const float* __restrict__ g2, int gsplit,
                                         bf16* __restrict__ WT, int K, int ndst0, LAS float* scr, int lane) {
#pragma unroll 8
    for (int i = 0; i < 32; ++i) { const int kk = 2 * i + (lane >> 5); const int k = k0 + kk;
        float gv = 1.f; if (g) gv = (g2 && k >= gsplit) ? g2[k - gsplit] : g[k];
        scr[kk * 33 + (lane & 31)] = W[(size_t)k * Nsrc + nsrc0 + (lane & 31)] * gv; }
    LDS_WAIT(); asm volatile("" ::: "memory");
    const int c = lane & 7;
#pragma unroll
    for (int j = 0; j < 4; ++j) { const int n = (lane >> 3) + 8 * j; const LAS float* s = scr + (8 * c) * 33 + n;
        v4u o; o.x = pk2(s[0 * 33], s[1 * 33]); o.y = pk2(s[2 * 33], s[3 * 33]); o.z = pk2(s[4 * 33], s[5 * 33]); o.w = pk2(s[6 * 33], s[7 * 33]);
        *(GAS v4u*)(WT + (size_t)(ndst0 + n) * K + k0 + 8 * c) = o; }
    LDS_WAIT(); asm volatile("" ::: "memory");
}
__device__ __forceinline__ void p0_norm_rows2(const float* __restrict__ x0, const float* __restrict__ x1, bf16* __restrict__ o0, bf16* __restrict__ o1, int lane) {
    const GAS f32x4* a = (const GAS f32x4*)x0 + lane; const GAS f32x4* b = (const GAS f32x4*)x1 + lane; f32x4 v[4], u[4]; float s = 0.f, t = 0.f;
#pragma unroll
    for (int j = 0; j < 4; ++j) { v[j] = a[64 * j]; u[j] = b[64 * j]; }
#pragma unroll
    for (int j = 0; j < 4; ++j) { s += (v[j].x * v[j].x + v[j].y * v[j].y) + (v[j].z * v[j].z + v[j].w * v[j].w); t += (u[j].x * u[j].x + u[j].y * u[j].y) + (u[j].z * u[j].z + u[j].w * u[j].w); }
    s = wave_sum(s); t = wave_sum(t);
    const float rs = rsqrtf(s * (1.f / DM) + EPS), rt = rsqrtf(t * (1.f / DM) + EPS);
    GAS unsigned long long* p = (GAS unsigned long long*)o0 + lane; GAS unsigned long long* q = (GAS unsigned long long*)o1 + lane;
#pragma unroll
    for (int j = 0; j < 4; ++j) { p[64 * j] = (unsigned long long)pk2(v[j].x * rs, v[j].y * rs) | ((unsigned long long)pk2(v[j].z * rs, v[j].w * rs) << 32);
        q[64 * j] = (unsigned long long)pk2(u[j].x * rt, u[j].y * rt) | ((unsigned long long)pk2(u[j].z * rt, u[j].w * rt) << 32); }
}

struct Args { const float* in[20]; float* out; unsigned char* ws; int ph_lo, ph_hi, att_mask, ss_dummy, bar_idx, pad; };
enum { PH_PRO = 0, PH_QKV = 1, PH_ATT = 2, PH_MERGE = 3, PH_OUT = 4, PH_QM = 5, PH_CROSS = 6, PH_OM = 7, PH_FFN1 = 8, PH_FIX = 9, PH_DOWN = 10, PH_FINAL = 11, PH_N = 12 };

__global__ void __launch_bounds__(NWAVES * 64, 2) mega(Args args) {
    extern __shared__ __attribute__((aligned(16))) unsigned char lds_raw[];
    Frame F;
    F.lds = (LAS unsigned char*)lds_raw;
    F.tid = threadIdx.x; F.lane = F.tid & 63; F.wave = __builtin_amdgcn_readfirstlane(F.tid >> 6);
    F.G = gridDim.x; { const int bx = blockIdx.x; F.vcu = (F.G % 8 == 0) ? (bx % 8) * (F.G / 8) + bx / 8 : bx; }
    unsigned char* ws = args.ws;
    volatile LAS unsigned* MISC = (volatile LAS unsigned*)(F.lds + MISC_OFF);
    for (int u = F.tid; u < (LDS_BYTES - MISC_OFF) / 4; u += NWAVES * 64) ((LAS unsigned*)(F.lds + MISC_OFF))[u] = 0u;
    __syncthreads();
    const int lo = args.ph_lo, hi = args.ph_hi;
    unsigned* barw = (unsigned*)(ws + WS_CTL) + CW_BAR + args.bar_idx * XCD_BAR_WORDS;
    XcdBarrier bar; bar.bar = barw; bar.x = 0; bar.st = nullptr;
    if (hi - lo > 1) bar = xcd_barrier_post(barw, MISC + 8);
#define IN(k) (lo <= (k) && (k) < hi)
#define SEAM(k) do { if (IN(k) && IN((k) + 1)) xcd_barrier(bar); } while (0)

    const float* x = args.in[0]; const float* mem = args.in[1]; const float* w_in = args.in[2]; const float* g_mix = args.in[3]; const float* g_od = args.in[4];
    const float* g_om = args.in[5]; const float* w_out = args.in[6]; const float* rel_bias = args.in[7]; const float* g_cross = args.in[8]; const float* g_mem = args.in[9];
    const float* w_q = args.in[10]; const float* w_kv = args.in[11]; const float* w_o = args.in[12]; const float* g_ffn = args.in[13]; const float* w_gate = args.in[14];
    const float* w_up = args.in[15]; const float* conv_w = args.in[16]; const float* conv_b = args.in[17]; const float* w_down = args.in[18]; const float* g_final = args.in[19];
    float* RS0 = (float*)(ws + WS_RS0); float* RSM = (float*)(ws + WS_RSM); float* SS1 = (float*)(ws + WS_SS1); float* SS2 = (float*)(ws + WS_SS2); float* SS3 = (float*)(ws + WS_SS3);
    float* SA1 = SS1; float* SA2 = SS2; float* SA3 = SS3;
    if (args.ss_dummy) { SA1 = SA2 = SA3 = (float*)(ws + WS_DUMMY); }
    float* LUT = (float*)(ws + WS_LUT); float* KMP = (float*)(ws + WS_KMP); float* HALOG = (float*)(ws + WS_HALOG); float* FIXG = (float*)(ws + WS_FIXG); float* FIXU = (float*)(ws + WS_FIXU);
    bf16* WIN = (bf16*)(ws + WS_WIN); bf16* WOUT = (bf16*)(ws + WS_WOUT); bf16* WQ = (bf16*)(ws + WS_WQ); bf16* WKV = (bf16*)(ws + WS_WKV);
    bf16* WO = (bf16*)(ws + WS_WO); bf16* WGU = (bf16*)(ws + WS_WGU); bf16* WD = (bf16*)(ws + WS_WD);
    bf16* MEMB = (bf16*)(ws + WS_MEMB); bf16* KVM = (bf16*)(ws + WS_KVM); bf16* XB = (bf16*)(ws + WS_XB); bf16* QKV = (bf16*)(ws + WS_QKV);
    bf16* YN = (bf16*)(ws + WS_YN); bf16* Y = (bf16*)(ws + WS_Y); bf16* OP = (bf16*)(ws + WS_OP); float* LSEP = (float*)(ws + WS_LSEP); bf16* H1 = (bf16*)(ws + WS_H1); bf16* QM = (bf16*)(ws + WS_QM);
    bf16* OM = (bf16*)(ws + WS_OM); bf16* H2 = (bf16*)(ws + WS_H2); bf16* ACT = (bf16*)(ws + WS_ACT); bf16* H3 = (bf16*)(ws + WS_H3);
    const int gw = F.vcu * NWAVES + F.wave, NGW = F.G * NWAVES;
    const int gt = (int)blockIdx.x * (NWAVES * 64) + F.tid, NGT = F.G * NWAVES * 64;

    if (IN(PH_PRO)) {
        LAS float* scr = (LAS float*)(F.lds + RING_OFF + F.wave * 16384);
        constexpr int I_IN = 16 * 96, I_OUT = 16 * 32, I_Q = 16 * 32, I_KV = 16 * 64, I_O = 16 * 32, I_GU = 16 * 176, I_D = 44 * 32;
        constexpr int NITEMS = I_IN + I_OUT + I_Q + I_KV + I_O + I_GU + I_D;
        for (int it = gw; it < NITEMS; it += NGW) {
            int r = it;
            if (r < I_IN) { const int kb = r / 96, nb = r % 96; p0_titem(w_in, 3072, 32 * nb, 64 * kb, g_mix, nullptr, 0, WIN, 1024, 32 * nb, scr, F.lane); continue; } r -= I_IN;
            if (r < I_OUT) { const int kb = r / 32, nb = r % 32; p0_titem(w_out, 1024, 32 * nb, 64 * kb, g_od, g_om, 512, WOUT, 1024, 32 * nb, scr, F.lane); continue; } r -= I_OUT;
            if (r < I_Q) { const int kb = r / 32, nb = r % 32; p0_titem(w_q, 1024, 32 * nb, 64 * kb, g_cross, nullptr, 0, WQ, 1024, 32 * nb, scr, F.lane); continue; } r -= I_Q;
            if (r < I_KV) { const int kb = r / 64, nb = r % 64; p0_titem(w_kv, 2048, 32 * nb, 64 * kb, g_mem, nullptr, 0, WKV, 1024, 32 * nb, scr, F.lane); continue; } r -= I_KV;
            if (r < I_O) { const int kb = r / 32, nb = r % 32; p0_titem(w_o, 1024, 32 * nb, 64 * kb, nullptr, nullptr, 0, WO, 1024, 32 * nb, scr, F.lane); continue; } r -= I_O;
            if (r < I_GU) { const int kb = r / 176, nb = r % 176; const int nd = 32 * nb, j = nd >> 8, rr = nd & 255;
                const float* src = (rr < 128) ? w_gate : w_up; const int sc = 128 * j + (rr & 127);
                p0_titem(src, 2816, sc, 64 * kb, g_ffn, nullptr, 0, WGU, 1024, nd, scr, F.lane); continue; } r -= I_GU;
            { const int kb = r / 32, nb = r % 32; p0_titem(w_down, 1024, 32 * nb, 64 * kb, nullptr, nullptr, 0, WD, 2816, 32 * nb, scr, F.lane); }
        }
        for (int m = 2 * gw; m < NTOK; m += 2 * NGW) p0_norm_rows2(x + (size_t)m * DM, x + (size_t)(m + 1) * DM, XB + (size_t)m * DM, XB + (size_t)(m + 1) * DM, F.lane);
        for (int m = 2 * gw; m < NMEMTOK; m += 2 * NGW) p0_norm_rows2(mem + (size_t)m * DM, mem + (size_t)(m + 1) * DM, MEMB + (size_t)m * DM, MEMB + (size_t)(m + 1) * DM, F.lane);
        for (int i = gt; i < 16 * 2048; i += NGT) { const int h = i >> 11, n = i & 2047; int b;
            if (n < 16) b = n; else { b = 16 + (n >= 22) + (n >= 30) + (n >= 40) + (n >= 54) + (n >= 73) + (n >= 99) + (n >= 134) + (n >= 182) + (n >= 246) + (n >= 332) + (n >= 450) + (n >= 609) + (n >= 825) + (n >= 1117) + (n >= 1513); }
            LUT[i] = rel_bias[h * 32 + b]; }
        for (int i = gt; i < NTOK; i += NGT) { SA1[i] = 0.f; SA2[i] = 0.f; SA3[i] = 0.f; }
    }
    SEAM(PH_PRO);

    if (IN(PH_QKV)) {
        { pg8::Gemm g{XB, WIN, NTOK, NQKV, 1024}; pg8::StaticOrder S; S.init(NTOK, NQKV, F.G, (int)blockIdx.x);
          pg8::EpiScale E{QKV, RS0, KMP, NQKV, 0};
          pg8::gemm_phase<pg8::EpiScale, pg8::StaticOrder, true, true>(F.lds + RING_OFF, g, S, E); }
        { pg8::Gemm g{MEMB, WKV, NMEMTOK, 2048, 1024}; pg8::StaticOrder S; S.init(NMEMTOK, 2048, F.G, (int)blockIdx.x);
          pg8::EpiScale E{KVM, RSM, nullptr, 2048, 0};
          pg8::gemm_phase<pg8::EpiScale, pg8::StaticOrder, true, true>(F.lds + RING_OFF, g, S, E); }
    }
    SEAM(PH_QKV);
        if (IN(PH_ATT)) {
        if (args.att_mask & 1) att::moba_phase(F.lds, QKV, KMP, LUT, Y, F.vcu, F.G);
        __syncthreads();
        if (args.att_mask & 2) att::dil_phase(F.lds, QKV, LUT, Y, F.vcu, F.G);
    }

    SEAM(PH_ATT);
        if (IN(PH_MERGE)) att::merge_phase(Y, YN, gw, NGW, F.lane);

    SEAM(PH_MERGE);

    if (IN(PH_OUT)) {
        pg8::Gemm g{YN, WOUT, NTOK, DM, 1024}; pg8::StaticOrder S; S.init(NTOK, DM, F.G, (int)blockIdx.x);
        pg8::EpiResidF32 E{H1, x, SA1, DM, 0};
        pg8::gemm_phase<pg8::EpiResidF32, pg8::StaticOrder, true, true>(F.lds + RING_OFF, g, S, E);
    }
    SEAM(PH_OUT);
    if (IN(PH_QM)) {
        pg8::Gemm g{H1, WQ, NTOK, DM, 1024}; pg8::StaticOrder S; S.init(NTOK, DM, F.G, (int)blockIdx.x);
        pg8::EpiScale E{QM, SS1, nullptr, DM, 1};
        pg8::gemm_phase<pg8::EpiScale, pg8::StaticOrder, true, true>(F.lds + RING_OFF, g, S, E);
    }
    SEAM(PH_QM);
        if (IN(PH_CROSS)) att::cross_phase(F.lds, QM, KVM, OM, F.vcu, F.G);

    SEAM(PH_CROSS);
    if (IN(PH_OM)) {
        pg8::Gemm g{OM, WO, NTOK, DM, 1024}; pg8::StaticOrder S; S.init(NTOK, DM, F.G, (int)blockIdx.x);
        pg8::EpiResid E{H2, H1, SA2, DM, 0};
        pg8::gemm_phase<pg8::EpiResid, pg8::StaticOrder, true, true>(F.lds + RING_OFF, g, S, E);
    }
    SEAM(PH_OM);
    if (IN(PH_FFN1)) {
        pg8::Gemm g{H2, WGU, NTOK, 5632, 1024}; pg8::StaticOrder S; S.init(NTOK, 5632, F.G, (int)blockIdx.x);
        pg8::EpiFfn1 E{ACT, SS2, conv_w, conv_b, HALOG, FIXG, FIXU, (LAS float*)(F.lds + LDSX_OFF)};
        pg8::gemm_phase<pg8::EpiFfn1, pg8::StaticOrder, true, true>(F.lds + RING_OFF, g, S, E);
    }
    SEAM(PH_FFN1);
    if (IN(PH_FIX)) {
        for (int i = gt; i < 256 * 2816; i += NGT) { const int pm = i / 2816, c = i % 2816;
            const float g0 = FIXG[((size_t)pm * 2 + 0) * 2816 + c], g1 = FIXG[((size_t)pm * 2 + 1) * 2816 + c];
            float hm1 = 0.f, hm2 = 0.f; if (pm & 7) { hm2 = HALOG[((size_t)(pm - 1) * 2 + 0) * 2816 + c]; hm1 = HALOG[((size_t)(pm - 1) * 2 + 1) * 2816 + c]; }
            const float w0 = conv_w[c], w1 = conv_w[2816 + c], w2 = conv_w[2 * 2816 + c], cbv = conv_b[c];
            const float c0 = cbv + w2 * g0 + w1 * hm1 + w0 * hm2, c1 = cbv + w2 * g1 + w1 * g0 + w0 * hm1;
            ACT[((size_t)pm * 256 + 0) * 2816 + c] = (bf16)f2bf(c0 / (1.f + __expf(-c0)) * FIXU[((size_t)pm * 2 + 0) * 2816 + c]);
            ACT[((size_t)pm * 256 + 1) * 2816 + c] = (bf16)f2bf(c1 / (1.f + __expf(-c1)) * FIXU[((size_t)pm * 2 + 1) * 2816 + c]); }
    }
    SEAM(PH_FIX);
    if (IN(PH_DOWN)) {
        pg8::Gemm g{ACT, WD, NTOK, DM, DFF}; pg8::StaticOrder S; S.init(NTOK, DM, F.G, (int)blockIdx.x);
        pg8::EpiResid E{H3, H2, SA3, DM, 0};
        pg8::gemm_phase<pg8::EpiResid, pg8::StaticOrder, true, true>(F.lds + RING_OFF, g, S, E);
    }
    SEAM(PH_DOWN);
    if (IN(PH_FINAL)) {
        for (int m = gw; m < NTOK; m += NGW) { const float rs = rsqrtf(SS3[m] * (1.f / DM) + EPS);
            const GAS u32x2* hr = (const GAS u32x2*)(H3 + (size_t)m * DM) + F.lane; GAS f32x4* o = (GAS f32x4*)(args.out + (size_t)m * DM) + F.lane; const GAS f32x4* gp = (const GAS f32x4*)g_final + F.lane;
#pragma unroll
            for (int j = 0; j < 4; ++j) { const u32x2 w = hr[64 * j]; const f32x4 gg = gp[64 * j];
                o[64 * j] = (f32x4){bflo(w.x) * rs * gg.x, bfhi(w.x) * rs * gg.y, bflo(w.y) * rs * gg.z, bfhi(w.y) * rs * gg.w}; } }
    }
#undef IN
#undef SEAM
}


extern "C" void kernel_launch(void* const* d_in, const int* in_sizes, int n_in, void* d_out, int out_size, void* d_ws, size_t ws_size, hipStream_t stream) {
    static int grid = 0;
    if (grid == 0) {
        if (n_in != 20 || in_sizes[0] != NTOK * DM || out_size != NTOK * DM || ws_size < WS_END) { fprintf(stderr, "kernel_launch: unexpected shapes (n_in %d, ws %zu); nothing launched\n", n_in, ws_size); grid = -1; return; }
        int dev = 0, cus = 0, per_cu = 0;
        if (hipGetDevice(&dev) != hipSuccess || hipDeviceGetAttribute(&cus, hipDeviceAttributeMultiprocessorCount, dev) != hipSuccess) { grid = -1; return; }
        if (hipFuncSetAttribute((const void*)mega, hipFuncAttributeMaxDynamicSharedMemorySize, LDS_BYTES) != hipSuccess) { fprintf(stderr, "kernel_launch: hipFuncSetAttribute failed\n"); grid = -1; return; }
        if (hipOccupancyMaxActiveBlocksPerMultiprocessor(&per_cu, (const void*)mega, NWAVES * 64, LDS_BYTES) != hipSuccess || per_cu < 1) fprintf(stderr, "kernel_launch: occupancy query says %d\n", per_cu);
        (void)hipGetLastError();
        grid = cus;
    }
    if (grid < 0) return;
    unsigned char* ws = (unsigned char*)d_ws;
    (void)hipMemsetAsync(ws + WS_CTL, 0, CTL_ZERO_BYTES, stream);
    Args a{};
    for (int i = 0; i < 20; ++i) a.in[i] = (const float*)d_in[i];
    a.out = (float*)d_out; a.ws = ws; a.att_mask = 3;
    int nbar = 0;
    auto runx = [&](int lo, int hi, int mask, int dummy) { Args b2 = a; b2.bar_idx = (hi - lo > 1) ? nbar++ : 0; b2.ph_lo = lo; b2.ph_hi = hi; b2.att_mask = mask; b2.ss_dummy = dummy; hipLaunchKernelGGL(mega, dim3(grid), dim3(NWAVES * 64), LDS_BYTES, stream, b2); };
    auto run = [&](int lo, int hi) { runx(lo, hi, 3, 0); };
    run(0, PH_N);
}
```

```cpp
#include <hip/hip_runtime.h>
#include <cstdio>
#include <cstdint>

typedef unsigned short bf16;
constexpr int BATCH = 32, SEQ = 2048, DM = 1024, NTOK = BATCH * SEQ;
constexpr int NMEM = 256, NMEMTOK = BATCH * NMEM, DFF = 2816;
constexpr int NQKV = 3072;
constexpr float EPS = 1e-6f;

constexpr size_t MiB = 1u << 20;
constexpr size_t WS_CTL = 0, CTL_ZERO_BYTES = 64 * 1024;
constexpr size_t WS_RS0 = 1 * MiB;
constexpr size_t WS_RSM = WS_RS0 + 256 * 1024;
constexpr size_t WS_SS1 = WS_RSM + 256 * 1024;
constexpr size_t WS_SS2 = WS_SS1 + 256 * 1024;
constexpr size_t WS_SS3 = WS_SS2 + 256 * 1024;
constexpr size_t WS_SSA = 27 * MiB, WS_SSB = WS_SSA + 256 * 1024;
constexpr size_t WS_KMEAN = WS_SS3 + 256 * 1024;
constexpr size_t WS_LUT = WS_KMEAN + 512 * 1024;
constexpr size_t WS_KMP = 3 * MiB;
constexpr size_t WS_HALOG = 4 * MiB;
constexpr size_t WS_FIXG = WS_HALOG + 256 * 2 * 2816 * 4;
constexpr size_t WS_FIXU = WS_FIXG + 256 * 2 * 2816 * 4;
constexpr size_t WS_DUMMY = 21 * MiB;
constexpr size_t WS_PS = 22 * MiB;
constexpr size_t WS_LSEP = 23 * MiB;
constexpr size_t WS_WIN = 28 * MiB;
constexpr size_t WS_WOUT = WS_WIN + 6 * MiB;
constexpr size_t WS_WQ = WS_WOUT + 2 * MiB;
constexpr size_t WS_WKV = WS_WQ + 2 * MiB;
constexpr size_t WS_WO = WS_WKV + 4 * MiB;
constexpr size_t WS_WGU = WS_WO + 2 * MiB;
constexpr size_t WS_WD = WS_WGU + 11 * MiB;
constexpr size_t WS_MEMB = 62 * MiB;
constexpr size_t WS_KVM = 78 * MiB;
constexpr size_t WS_XB = 112 * MiB;
constexpr size_t WS_QKV = 240 * MiB;
constexpr size_t WS_Y = 624 * MiB;
constexpr size_t WS_OP = 752 * MiB;
constexpr size_t WS_YN = 240 * MiB;
constexpr size_t WS_H1 = 880 * MiB;
constexpr size_t WS_QM = 368 * MiB;
constexpr size_t WS_OM = 496 * MiB;
constexpr size_t WS_H2 = 624 * MiB;
constexpr size_t WS_ACT = 112 * MiB;
constexpr size_t WS_GU = 752 * MiB;
constexpr size_t WS_H3 = 464 * MiB;
constexpr size_t WS_END = 1024 * MiB;
static_assert(WS_FIXU + 256 * 2 * 2816 * 4 <= WS_LSEP && WS_LSEP + 5 * MiB <= WS_WIN && WS_WD + 6 * MiB <= WS_MEMB, "ws map");

__device__ __forceinline__ unsigned f2bf(float f) { unsigned u = __builtin_bit_cast(unsigned, f); return (u + 0x7fffu + ((u >> 16) & 1u)) >> 16; }
__device__ __forceinline__ float bf2f(bf16 b) { return __builtin_bit_cast(float, (unsigned)b << 16); }
__device__ __forceinline__ float bflo(unsigned w) { return __builtin_bit_cast(float, w << 16); }
__device__ __forceinline__ float bfhi(unsigned w) { return __builtin_bit_cast(float, w & 0xffff0000u); }
__device__ __forceinline__ float wave_sum(float v) {
#pragma unroll
    for (int o = 1; o < 64; o <<= 1) v += __shfl_xor(v, o);
    return v;
}


namespace pg8 {
#define PG8_LAS __attribute__((address_space(3)))
typedef unsigned short bf16_t;
typedef short bf16x8 __attribute__((ext_vector_type(8)));
typedef float f32x4 __attribute__((ext_vector_type(4)));
typedef unsigned u32x4 __attribute__((ext_vector_type(4)));
constexpr int BM = 256, BK = 64, HALF = 128, HTB = HALF * BK * 2  , STAGE_BYTES = 8 * HTB, NXCD = 8, WGM = 8;

__host__ __device__ __forceinline__ int lds_byte(int r, int c) { const int st = (r >> 4) * 2 + (c >> 5), rr = r & 15, cc = c & 31, ob = rr * 64 + cc * 2; return st * 1024 + (ob ^ (((ob >> 9) & 1) << 5)); }
__host__ __device__ __forceinline__ void stage_rc(int b, int& R, int& C) { const int st = b / 1024, sb = b % 1024, swz = sb ^ (((sb >> 9) & 1) << 5); R = (st >> 1) * 16 + swz / 64; C = (st & 1) * 32 + (swz % 64) / 2; }
__host__ __device__ __forceinline__ int perm32(int rho) { const int n = rho >> 4, i = rho & 15; return 8 * (i >> 2) + 4 * n + (i & 3); }

struct Unit { int pm, pn; };
struct Gemm { const bf16_t* A; const bf16_t* Bt; int M, N, K; };

struct StaticOrder {
    int nM, nN, nwg, G, c;
    __host__ __device__ void init(int M, int N, int G_, int c_) { nM = M / BM; nN = N / BM; nwg = nM * nN; G = G_; c = c_; }
    __host__ __device__ bool next(int i, Unit& u) const {
        const long L = (long)i * G + c; if (L >= nwg) return false;
        int wgid = (int)L; { const int q = nwg / NXCD, r = nwg % NXCD, xcd = wgid % NXCD, off = wgid / NXCD; wgid = (xcd < r ? xcd * (q + 1) : r * (q + 1) + (xcd - r) * q) + off; }
        const int nig = WGM * nN, gid = wgid / nig, fm = gid * WGM, gsz = (nM - fm) < WGM ? (nM - fm) : WGM;
        u.pm = fm + ((wgid % nig) % gsz); u.pn = (wgid % nig) / gsz; return true;
    }
    __device__ __forceinline__ void a_ready(const Unit&) const {}
    __device__ __forceinline__ void done(const Unit&) const {}
};


struct PanelOrder { int pm, nN;
    __device__ __forceinline__ bool next(int i, Unit& u) const { if (i >= nN) return false; int a = pm, b = i; asm volatile("" : "+s"(a), "+s"(b)); u.pm = a; u.pn = b; return true; }
    __device__ __forceinline__ void a_ready(const Unit&) const {}
    __device__ __forceinline__ void done(const Unit&) const {} };
__device__ __forceinline__ unsigned cvt_pk_bf16(float lo, float hi) { unsigned r; asm volatile("v_cvt_pk_bf16_f32 %0, %1, %2" : "=v"(r) : "v"(lo), "v"(hi)); return r; }
__device__ __forceinline__ float lo_f(unsigned w) { return __builtin_bit_cast(float, w << 16); }
__device__ __forceinline__ float hi_f(unsigned w) { return __builtin_bit_cast(float, w & 0xffff0000u); }

struct EpiScale {
    static constexpr bool PERM = true, AFTER_DRAIN = false, KSPLIT = false, PERM_A = false;
    bf16_t* O; const float* rs; float* kmp; int ldc; int mode;
    __device__ __forceinline__ void operator()(const f32x4 (&acc)[2][2][4][2], const Unit& u, int wr, int wc, int fr, int fq) const {
        if (mode & 64) return;
        const int row0 = u.pm * BM + wr * 64 + fr, col0 = u.pn * BM + wc * 32 + 8 * fq;
        const bool dokm = (kmp != nullptr) && (u.pn == 8 || u.pn == 9);
        const float qs = ((kmp != nullptr) && (u.pn < 2 || u.pn == 6 || u.pn == 7)) ? 0.125f * 1.4426950408889634f : 1.f;
        float cs[2][8];
#pragma unroll
        for (int bj = 0; bj < 2; ++bj)
#pragma unroll
            for (int e = 0; e < 8; ++e) cs[bj][e] = 0.f;
#pragma unroll
        for (int ai = 0; ai < 2; ++ai)
#pragma unroll
            for (int m = 0; m < 4; ++m) { const int r = row0 + ai * HALF + m * 16; float s = qs; if (mode == 1) s = rsqrtf(rs[r] * (1.f / 1024.f) + 1e-6f);
                bf16_t* rowp = (mode & 256) ? O + (size_t)(r & 255) * ldc + col0 : O + (size_t)r * ldc + col0;
#pragma unroll
                for (int bj = 0; bj < 2; ++bj) { const f32x4 v0 = acc[ai][bj][m][0] * s, v1 = acc[ai][bj][m][1] * s;
                    u32x4 w; w.x = cvt_pk_bf16(v0[0], v0[1]); w.y = cvt_pk_bf16(v0[2], v0[3]); w.z = cvt_pk_bf16(v1[0], v1[1]); w.w = cvt_pk_bf16(v1[2], v1[3]);
                    if (mode & 128) { asm volatile("" :: "v"(w.x), "v"(w.y), "v"(w.z), "v"(w.w)); } else *(u32x4*)(rowp + bj * HALF) = w;
                    if (dokm) { cs[bj][0] += lo_f(w.x); cs[bj][1] += hi_f(w.x); cs[bj][2] += lo_f(w.y); cs[bj][3] += hi_f(w.y); cs[bj][4] += lo_f(w.z); cs[bj][5] += hi_f(w.z); cs[bj][6] += lo_f(w.w); cs[bj][7] += hi_f(w.w); } } }
        if (dokm) {
#pragma unroll
            for (int bj = 0; bj < 2; ++bj)
#pragma unroll
                for (int e = 0; e < 8; ++e) { float v = cs[bj][e]; v += __shfl_xor(v, 1); v += __shfl_xor(v, 2); v += __shfl_xor(v, 4); v += __shfl_xor(v, 8); cs[bj][e] = v; }
            if (fr == 0) { float* kp = kmp + (size_t)(u.pm * 2 + wr) * 512 + (u.pn - 8) * 256 + wc * 32 + 8 * fq;
#pragma unroll
                for (int bj = 0; bj < 2; ++bj) { *(f32x4*)(kp + bj * HALF) = (f32x4){cs[bj][0], cs[bj][1], cs[bj][2], cs[bj][3]}; *(f32x4*)(kp + bj * HALF + 4) = (f32x4){cs[bj][4], cs[bj][5], cs[bj][6], cs[bj][7]}; } }
        }
    }
};

struct EpiResid {
    static constexpr bool PERM = true, AFTER_DRAIN = false, KSPLIT = false, PERM_A = false;
    bf16_t* O; const bf16_t* R; float* ss; int ldc; int pad;
    __device__ __forceinline__ void operator()(const f32x4 (&acc)[2][2][4][2], const Unit& u, int wr, int wc, int fr, int fq) const {
        const int row0 = u.pm * BM + wr * 64 + fr, col0 = u.pn * BM + wc * 32 + 8 * fq;
#pragma unroll
        for (int ai = 0; ai < 2; ++ai)
#pragma unroll
            for (int m = 0; m < 4; ++m) { const int r = row0 + ai * HALF + m * 16; const size_t off = (size_t)r * ldc + col0; float sq = 0.f;
#pragma unroll
                for (int bj = 0; bj < 2; ++bj) { const u32x4 rv = *(const u32x4*)(R + off + bj * HALF);
                    const f32x4 a0 = acc[ai][bj][m][0], a1 = acc[ai][bj][m][1];
                    u32x4 w; w.x = cvt_pk_bf16(a0[0] + lo_f(rv.x), a0[1] + hi_f(rv.x)); w.y = cvt_pk_bf16(a0[2] + lo_f(rv.y), a0[3] + hi_f(rv.y));
                    w.z = cvt_pk_bf16(a1[0] + lo_f(rv.z), a1[1] + hi_f(rv.z)); w.w = cvt_pk_bf16(a1[2] + lo_f(rv.w), a1[3] + hi_f(rv.w));
                    *(u32x4*)(O + off + bj * HALF) = w;
                    float t;
                    t = lo_f(w.x); sq += t * t; t = hi_f(w.x); sq += t * t; t = lo_f(w.y); sq += t * t; t = hi_f(w.y); sq += t * t;
                    t = lo_f(w.z); sq += t * t; t = hi_f(w.z); sq += t * t; t = lo_f(w.w); sq += t * t; t = hi_f(w.w); sq += t * t; }
                sq += __shfl_xor(sq, 16); sq += __shfl_xor(sq, 32);
                if (fq == 0) atomicAdd(ss + r, sq); }
    }
};


struct EpiResidF32 {
    static constexpr bool PERM = true, AFTER_DRAIN = false, KSPLIT = false, PERM_A = false;
    bf16_t* O; const float* R; float* ss; int ldc; int pad;
    __device__ __forceinline__ void operator()(const f32x4 (&acc)[2][2][4][2], const Unit& u, int wr, int wc, int fr, int fq) const {
        const int row0 = u.pm * BM + wr * 64 + fr, col0 = u.pn * BM + wc * 32 + 8 * fq;
#pragma unroll
        for (int ai = 0; ai < 2; ++ai)
#pragma unroll
            for (int m = 0; m < 4; ++m) { const int r = row0 + ai * HALF + m * 16; const size_t off = (size_t)r * ldc + col0; float sq = 0.f;
#pragma unroll
                for (int bj = 0; bj < 2; ++bj) { const f32x4 r0 = *(const f32x4*)(R + off + bj * HALF), r1 = *(const f32x4*)(R + off + bj * HALF + 4);
                    const f32x4 a0 = acc[ai][bj][m][0] + r0, a1 = acc[ai][bj][m][1] + r1;
                    u32x4 w; w.x = cvt_pk_bf16(a0[0], a0[1]); w.y = cvt_pk_bf16(a0[2], a0[3]); w.z = cvt_pk_bf16(a1[0], a1[1]); w.w = cvt_pk_bf16(a1[2], a1[3]);
                    *(u32x4*)(O + off + bj * HALF) = w;
                    float t;
                    t = lo_f(w.x); sq += t * t; t = hi_f(w.x); sq += t * t; t = lo_f(w.y); sq += t * t; t = hi_f(w.y); sq += t * t;
                    t = lo_f(w.z); sq += t * t; t = hi_f(w.z); sq += t * t; t = lo_f(w.w); sq += t * t; t = hi_f(w.w); sq += t * t; }
                sq += __shfl_xor(sq, 16); sq += __shfl_xor(sq, 32);
                if (fq == 0) atomicAdd(ss + r, sq); }
    }
};


struct EpiOutProj {
    static constexpr bool PERM = true, AFTER_DRAIN = false, KSPLIT = true, PERM_A = false;
    bf16_t* O; const float* R; float* ss; const float* ssa; const float* ssb; int ldc; int pad;
    __device__ __forceinline__ void mid(f32x4 (&acc)[2][2][4][2], const Unit& u, int wr, int fr) const {
        asm volatile("" : "+v"(fr));
#pragma unroll
        for (int ai = 0; ai < 2; ++ai) {
#pragma unroll
            for (int m = 0; m < 4; ++m) { const int r = u.pm * BM + ai * HALF + wr * 64 + m * 16 + fr;
                const float ratio = rsqrtf(ssa[r] * (1.f / 512.f) + 1e-6f) * sqrtf(ssb[r] * (1.f / 512.f) + 1e-6f);
#pragma unroll
                for (int bj = 0; bj < 2; ++bj) { acc[ai][bj][m][0] *= ratio; acc[ai][bj][m][1] *= ratio; } }
            asm volatile("" ::: "memory"); __builtin_amdgcn_sched_barrier(0); }
    }
    __device__ __forceinline__ void operator()(const f32x4 (&acc)[2][2][4][2], const Unit& u, int wr, int wc, int fr, int fq) const {
        const int row0 = u.pm * BM + wr * 64 + fr, col0 = u.pn * BM + wc * 32 + 8 * fq;
#pragma unroll
        for (int ai = 0; ai < 2; ++ai)
#pragma unroll
            for (int m = 0; m < 4; ++m) { const int r = row0 + ai * HALF + m * 16; const size_t off = (size_t)r * ldc + col0; float sq = 0.f;
                const float rsb = rsqrtf(ssb[r] * (1.f / 512.f) + 1e-6f);
#pragma unroll
                for (int bj = 0; bj < 2; ++bj) { const f32x4 r0 = *(const f32x4*)(R + off + bj * HALF), r1 = *(const f32x4*)(R + off + bj * HALF + 4);
                    const f32x4 a0 = acc[ai][bj][m][0] * rsb + r0, a1 = acc[ai][bj][m][1] * rsb + r1;
                    u32x4 w; w.x = cvt_pk_bf16(a0[0], a0[1]); w.y = cvt_pk_bf16(a0[2], a0[3]); w.z = cvt_pk_bf16(a1[0], a1[1]); w.w = cvt_pk_bf16(a1[2], a1[3]);
                    *(u32x4*)(O + off + bj * HALF) = w;
                    float t;
                    t = lo_f(w.x); sq += t * t; t = hi_f(w.x); sq += t * t; t = lo_f(w.y); sq += t * t; t = hi_f(w.y); sq += t * t;
                    t = lo_f(w.z); sq += t * t; t = hi_f(w.z); sq += t * t; t = lo_f(w.w); sq += t * t; t = hi_f(w.w); sq += t * t; }
                sq += __shfl_xor(sq, 16); sq += __shfl_xor(sq, 32);
                if (fq == 0) atomicAdd(ss + r, sq); }
    }
};

struct RoundOrder { StaticOrder S; int r;
    __device__ __forceinline__ bool next(int i, Unit& u) const { return i == 0 && S.next(r, u); }
    __device__ __forceinline__ void a_ready(const Unit&) const {}
    __device__ __forceinline__ void done(const Unit&) const {} };
template <class Bar> struct EpiFinal {
    static constexpr bool PERM = false, AFTER_DRAIN = true, KSPLIT = false, PERM_A = false;
    const bf16_t* R; float* out; const float* g; float* ps; const Bar* bar;
    __device__ __forceinline__ void fused(f32x4 (&acc)[2][2][4][2], const Unit& u, int wr, int wc, int fr, int fq, PG8_LAS unsigned char* lds, int wid, int lane) const {
        typedef unsigned u32x2v __attribute__((ext_vector_type(2)));
        PG8_LAS float* P = (PG8_LAS float*)lds;
        PG8_LAS float* S = (PG8_LAS float*)(lds + 4096);
        const int col0 = u.pn * BM + wc * 32 + 4 * fq, tid = wid * 64 + lane;
#pragma unroll
        for (int ai = 0; ai < 2; ++ai)
#pragma unroll
            for (int m = 0; m < 4; ++m) { const int rl = ai * HALF + wr * 64 + m * 16 + fr; const size_t off = (size_t)(u.pm * BM + rl) * 1024 + col0; float sq = 0.f;
#pragma unroll
                for (int bj = 0; bj < 2; ++bj)
#pragma unroll
                    for (int n = 0; n < 2; ++n) { const u32x2v rv = *(const u32x2v*)(R + off + bj * HALF + n * 16);
                        f32x4 v = acc[ai][bj][m][n]; v[0] += lo_f(rv.x); v[1] += hi_f(rv.x); v[2] += lo_f(rv.y); v[3] += hi_f(rv.y); acc[ai][bj][m][n] = v;
                        sq += (v[0] * v[0] + v[1] * v[1]) + (v[2] * v[2] + v[3] * v[3]); }
                sq += __shfl_xor(sq, 16); sq += __shfl_xor(sq, 32);
                if (fq == 0) P[rl * 4 + wc] = sq; }
        asm volatile("s_waitcnt lgkmcnt(0)" ::: "memory"); __builtin_amdgcn_s_barrier(); asm volatile("" ::: "memory");
        if (tid < 256) { const f32x4 p4 = *(const PG8_LAS f32x4*)(P + tid * 4); ps[(size_t)(u.pm * BM + tid) * 4 + u.pn] = (p4[0] + p4[1]) + (p4[2] + p4[3]); }
        xcd_barrier(*bar);
        if (tid < 256) { const f32x4 q4 = *(const f32x4*)(ps + (size_t)(u.pm * BM + tid) * 4); S[tid] = rsqrtf(((q4[0] + q4[1]) + (q4[2] + q4[3])) * (1.f / 1024.f) + 1e-6f); }
        asm volatile("s_waitcnt vmcnt(0) lgkmcnt(0)" ::: "memory"); __builtin_amdgcn_s_barrier(); asm volatile("" ::: "memory");
        f32x4 gv[2][2];
#pragma unroll
        for (int bj = 0; bj < 2; ++bj)
#pragma unroll
            for (int n = 0; n < 2; ++n) gv[bj][n] = *(const f32x4*)(g + col0 + bj * HALF + n * 16);
#pragma unroll
        for (int ai = 0; ai < 2; ++ai)
#pragma unroll
            for (int m = 0; m < 4; ++m) { const int rl = ai * HALF + wr * 64 + m * 16 + fr; const float rs = S[rl]; const size_t off = (size_t)(u.pm * BM + rl) * 1024 + col0;
#pragma unroll
                for (int bj = 0; bj < 2; ++bj)
#pragma unroll
                    for (int n = 0; n < 2; ++n) *(f32x4*)(out + off + bj * HALF + n * 16) = acc[ai][bj][m][n] * rs * gv[bj][n]; }
        asm volatile("s_waitcnt lgkmcnt(0)" ::: "memory"); __builtin_amdgcn_s_barrier(); asm volatile("" ::: "memory");
    }
};

__device__ __forceinline__ float dpp_shr1(float oldv, float src) { return __builtin_bit_cast(float, __builtin_amdgcn_update_dpp(__builtin_bit_cast(int, oldv), __builtin_bit_cast(int, src), 0x111, 0xf, 0xf, false)); }
__device__ __forceinline__ float dpp_shr2(float oldv, float src) { return __builtin_bit_cast(float, __builtin_amdgcn_update_dpp(__builtin_bit_cast(int, oldv), __builtin_bit_cast(int, src), 0x112, 0xf, 0xf, false)); }
__device__ __forceinline__ float dpp_ror1(float src) { return __builtin_bit_cast(float, __builtin_amdgcn_update_dpp(0, __builtin_bit_cast(int, src), 0x121, 0xf, 0xf, false)); }
__device__ __forceinline__ float dpp_ror2(float src) { return __builtin_bit_cast(float, __builtin_amdgcn_update_dpp(0, __builtin_bit_cast(int, src), 0x122, 0xf, 0xf, false)); }
struct EpiFfn1 {
    static constexpr bool PERM = true, AFTER_DRAIN = false, KSPLIT = false, PERM_A = true;
    bf16_t* ACT; const float* ss2; const float* cw; const float* cb; float* halog; float* fixg; float* fixu; PG8_LAS float* hl; int probe, pad;
    __device__ __forceinline__ void operator()(const f32x4 (&acc)[2][2][4][2], const Unit& u, int wr, int wc, int fr, int fq) const {
        constexpr int FF = 2816;
        if (probe & 1) return;
        const int ch0 = u.pn * HALF + wc * 32 + 8 * fq;
        float rsv[2][4];
#pragma unroll
        for (int ai = 0; ai < 2; ++ai) { const f32x4 s4 = *(const f32x4*)(ss2 + u.pm * BM + ai * HALF + wr * 64 + 4 * fr);
#pragma unroll
            for (int m = 0; m < 4; ++m) rsv[ai][m] = rsqrtf(s4[m] * (1.f / 1024.f) + 1e-6f); }
        if (fr == 15) {
#pragma unroll
            for (int ai = 0; ai < 2; ++ai) { const int G = 2 * ai + wr;
#pragma unroll
                for (int j = 0; j < 2; ++j) { PG8_LAS float* p = hl + (((G * 4 + wc) * 2 + j) * 4 + fq) * 8;
                    *(PG8_LAS f32x4*)p = acc[ai][0][2 + j][0] * rsv[ai][2 + j]; *(PG8_LAS f32x4*)(p + 4) = acc[ai][0][2 + j][1] * rsv[ai][2 + j]; } } }
        constexpr float L2E = 1.4426950408889634f, IL2E = 0.6931471805599453f;
        const f32x4 w0a = *(const f32x4*)(cw + ch0) * L2E, w0b = *(const f32x4*)(cw + ch0 + 4) * L2E, w1a = *(const f32x4*)(cw + FF + ch0) * L2E, w1b = *(const f32x4*)(cw + FF + ch0 + 4) * L2E;
        const f32x4 w2a = *(const f32x4*)(cw + 2 * FF + ch0) * L2E, w2b = *(const f32x4*)(cw + 2 * FF + ch0 + 4) * L2E, cba = *(const f32x4*)(cb + ch0) * L2E, cbb = *(const f32x4*)(cb + ch0 + 4) * L2E;
        asm volatile("s_waitcnt lgkmcnt(0)" ::: "memory"); __builtin_amdgcn_s_barrier(); asm volatile("" ::: "memory");
#pragma unroll
        for (int ai = 0; ai < 2; ++ai) { const int G = 2 * ai + wr; const int rbase = u.pm * BM + ai * HALF + wr * 64 + 4 * fr;
            f32x4 h2a = (f32x4){0.f, 0.f, 0.f, 0.f}, h2b = h2a, h3a = h2a, h3b = h2a;
            if (G > 0 && fr == 0) { const PG8_LAS float* p = hl + ((((G - 1) * 4 + wc) * 2) * 4 + fq) * 8; h2a = *(const PG8_LAS f32x4*)p; h2b = *(const PG8_LAS f32x4*)(p + 4); h3a = *(const PG8_LAS f32x4*)(p + 32); h3b = *(const PG8_LAS f32x4*)(p + 36); }
            f32x4 g[4][2], uu[4][2];
#pragma unroll
            for (int m = 0; m < 4; ++m) { const float s = rsv[ai][m]; g[m][0] = acc[ai][0][m][0] * s; g[m][1] = acc[ai][0][m][1] * s; uu[m][0] = acc[ai][1][m][0] * (s * IL2E); uu[m][1] = acc[ai][1][m][1] * (s * IL2E); }
            f32x4 s2[2], s3[2];
#pragma unroll
            for (int e = 0; e < 4; ++e) { s3[0][e] = dpp_shr1(h3a[e], g[3][0][e]); s3[1][e] = dpp_shr1(h3b[e], g[3][1][e]); s2[0][e] = dpp_shr1(h2a[e], g[2][0][e]); s2[1][e] = dpp_shr1(h2b[e], g[2][1][e]); }
#pragma unroll
            for (int m = 0; m < 4; ++m) {
                f32x4 o[2];
#pragma unroll
                for (int hx = 0; hx < 2; ++hx) { const f32x4 w0 = hx ? w0b : w0a, w1 = hx ? w1b : w1a, w2 = hx ? w2b : w2a, cbx = hx ? cbb : cba;
                    const f32x4 g1 = (m == 0) ? s3[hx] : g[m - 1][hx], g2 = (m == 0) ? s2[hx] : (m == 1 ? s3[hx] : g[m - 2][hx]);
#pragma unroll
                    for (int e = 0; e < 4; ++e) { const float c = __builtin_fmaf(w0[e], g2[e], __builtin_fmaf(w1[e], g1[e], __builtin_fmaf(w2[e], g[m][hx][e], cbx[e])));
                        o[hx][e] = c * __builtin_amdgcn_rcpf(1.f + __builtin_amdgcn_exp2f(-c)) * uu[m][hx][e]; } }
                const bool defer = (G == 0 && fr == 0 && m < 2);
                if (defer) { float* pg = fixg + ((size_t)u.pm * 2 + m) * FF + ch0; float* pu = fixu + ((size_t)u.pm * 2 + m) * FF + ch0;
                    *(f32x4*)pg = g[m][0]; *(f32x4*)(pg + 4) = g[m][1]; *(f32x4*)pu = uu[m][0] * L2E; *(f32x4*)(pu + 4) = uu[m][1] * L2E; }
                else { u32x4 w; w.x = cvt_pk_bf16(o[0][0], o[0][1]); w.y = cvt_pk_bf16(o[0][2], o[0][3]); w.z = cvt_pk_bf16(o[1][0], o[1][1]); w.w = cvt_pk_bf16(o[1][2], o[1][3]);
                    if (probe & 2) { asm volatile("" :: "v"(w.x), "v"(w.y), "v"(w.z), "v"(w.w)); } else *(u32x4*)(ACT + (size_t)(rbase + m) * FF + ch0) = w; }
                if (G == 3 && fr == 15 && m >= 2) { float* ph = halog + ((size_t)u.pm * 2 + (m - 2)) * FF + ch0; *(f32x4*)ph = g[m][0]; *(f32x4*)(ph + 4) = g[m][1]; } } }
    }
};

template <class Epi, class Sched, bool ALIGN_EPI = false, bool SP2 = false>
__device__ __forceinline__ void gemm_phase(PG8_LAS unsigned char* lds, const Gemm g, const Sched& S, const Epi& E) {
    int tid_ = threadIdx.x; asm volatile("" : "+v"(tid_));
    const int tid = tid_, wid = __builtin_amdgcn_readfirstlane(tid >> 6), lane = tid & 63, wr = wid >> 2, wc = wid & 3, fr = lane & 15, fq = lane >> 4;
    const int K = g.K, nt = K / BK;
    unsigned voffA[2], voffB[2];
#pragma unroll
    for (int i = 0; i < 2; ++i) { int R, C; stage_rc(tid * 16 + i * 8192, R, C); const int Rb = Epi::PERM ? ((R & ~31) + perm32(R & 31)) : R;
        const int Ra = Epi::PERM_A ? ((R & ~63) + 4 * (R & 15) + ((R >> 4) & 3)) : R;
        voffA[i] = (unsigned)(Ra * K + C) * 2u; voffB[i] = (unsigned)(Rb * K + C) * 2u; }
    const size_t kstep = (size_t)(BK * 2);
    const size_t hstep = (size_t)HALF * K * 2;
    const size_t tstep = 2 * hstep;
    const unsigned ldsw = (unsigned)wid * 1024u;
    const int aoff = lds_byte(wr * 64 + fr, fq * 8), boff = lds_byte(wc * 32 + fr, fq * 8);
#define PG8_SA(b, h) (((b) * 2 + (h)) * HTB)
#define PG8_SB(b, h) ((4 + (b) * 2 + (h)) * HTB)
#define PG8_STAGE(bufoff, gbase, voff) do { _Pragma("unroll") for (int _i = 0; _i < 2; ++_i) \
        __builtin_amdgcn_global_load_lds((const unsigned*)((const char*)(gbase) + (voff)[_i]), (PG8_LAS unsigned*)(lds + (bufoff) + ldsw + _i * 8192), 16, 0, 0); } while (0)
#define PG8_LDA(dst, b, h) do { _Pragma("unroll") for (int m = 0; m < 4; ++m) _Pragma("unroll") for (int k = 0; k < 2; ++k) dst[m][k] = *(const PG8_LAS bf16x8*)(lds + PG8_SA(b, h) + aoff + m * 2048 + k * 1024); } while (0)
#define PG8_LDB(dst, b, h) do { _Pragma("unroll") for (int n = 0; n < 2; ++n) _Pragma("unroll") for (int k = 0; k < 2; ++k) dst[n][k] = *(const PG8_LAS bf16x8*)(lds + PG8_SB(b, h) + boff + n * 2048 + k * 1024); } while (0)
#define PG8_MMA(ai, bj, At, Bt) do { __builtin_amdgcn_s_setprio(1); _Pragma("unroll") for (int m = 0; m < 4; ++m) _Pragma("unroll") for (int n = 0; n < 2; ++n) _Pragma("unroll") for (int k = 0; k < 2; ++k) \
        acc[ai][bj][m][n] = __builtin_amdgcn_mfma_f32_16x16x32_bf16(Bt[n][k], At[m][k], acc[ai][bj][m][n], 0, 0, 0); __builtin_amdgcn_s_setprio(0); } while (0)
#define PG8_WAIT_V(n) asm volatile("s_waitcnt vmcnt(" #n ")" ::: "memory")
#define PG8_WAIT_L(n) asm volatile("s_waitcnt lgkmcnt(" #n ")" ::: "memory")
#define PG8_BAR __builtin_amdgcn_s_barrier()
#define PG8_SCHED __builtin_amdgcn_sched_barrier(0)
    Unit cur, nxt; int ui = 0;
    if (!S.next(0, cur)) return;
    f32x4 acc[2][2][4][2];
#pragma unroll
    for (int a = 0; a < 2; ++a)
#pragma unroll
        for (int b = 0; b < 2; ++b)
#pragma unroll
            for (int m = 0; m < 4; ++m)
#pragma unroll
                for (int n = 0; n < 2; ++n) acc[a][b][m][n] = (f32x4){0.f, 0.f, 0.f, 0.f};
    bf16x8 At[4][2], B0[2][2], B1[2][2];
    const char* cA = (const char*)g.A + (size_t)cur.pm * tstep; const char* cB = (const char*)g.Bt + (size_t)cur.pn * tstep;
    S.a_ready(cur);
    if constexpr (SP2) {
        PG8_STAGE(PG8_SB(0, 0), cB, voffB); PG8_STAGE(PG8_SB(0, 1), cB + hstep, voffB); PG8_STAGE(PG8_SA(0, 0), cA, voffA); PG8_STAGE(PG8_SA(0, 1), cA + hstep, voffA);
        if (wr == 1) PG8_BAR;
        PG8_WAIT_V(2); PG8_BAR;
        PG8_STAGE(PG8_SB(1, 0), cB + kstep, voffB); PG8_STAGE(PG8_SA(1, 0), cA + kstep, voffA); PG8_STAGE(PG8_SB(1, 1), cB + hstep + kstep, voffB);
        PG8_WAIT_V(6); PG8_BAR;
    } else {
        PG8_STAGE(PG8_SB(0, 0), cB, voffB); PG8_STAGE(PG8_SA(0, 0), cA, voffA); PG8_STAGE(PG8_SB(0, 1), cB + hstep, voffB); PG8_STAGE(PG8_SA(0, 1), cA + hstep, voffA);
        if (wr == 1) PG8_BAR;
        PG8_WAIT_V(4); PG8_BAR;
        PG8_STAGE(PG8_SB(1, 0), cB + kstep, voffB); PG8_STAGE(PG8_SA(1, 0), cA + kstep, voffA); PG8_STAGE(PG8_SB(1, 1), cB + hstep + kstep, voffB);
        PG8_WAIT_V(6); PG8_BAR;
    }
    for (;;) {
        const bool has_next = S.next(ui + 1, nxt);
        const char* nA = has_next ? (const char*)g.A + (size_t)nxt.pm * tstep : cA; const char* nB = has_next ? (const char*)g.Bt + (size_t)nxt.pn * tstep : cB;
        for (int t = 0; t < nt; t += 2) {
            if constexpr (Epi::KSPLIT) { if (t == nt / 2) E.mid(acc, cur, wr, fr); }
            const bool last = (t == nt - 2);
            const char* a1 = cA + (size_t)(t + 1) * kstep;
            const char* a2 = last ? nA : cA + (size_t)(t + 2) * kstep; const char* b2 = last ? nB : cB + (size_t)(t + 2) * kstep;
            const char* a3 = a2 + kstep; const char* b3 = b2 + kstep;
            if (last && has_next) S.a_ready(nxt);
            if constexpr (SP2) {
            PG8_LDB(B0, 0, 0); PG8_LDB(B1, 0, 1); PG8_SCHED; PG8_LDA(At, 0, 0); PG8_STAGE(PG8_SA(1, 1), a1 + hstep, voffA);
            PG8_WAIT_V(8); PG8_WAIT_L(0); PG8_BAR; PG8_MMA(0, 0, At, B0); PG8_MMA(0, 1, At, B1); PG8_BAR; PG8_SCHED;
            PG8_LDA(At, 0, 1); PG8_STAGE(PG8_SB(0, 0), b2, voffB); PG8_STAGE(PG8_SB(0, 1), b2 + hstep, voffB); PG8_STAGE(PG8_SA(0, 0), a2, voffA);
            PG8_WAIT_V(8); PG8_WAIT_L(0); PG8_BAR; PG8_MMA(1, 0, At, B0); PG8_MMA(1, 1, At, B1); PG8_BAR; PG8_SCHED;
            PG8_LDB(B0, 1, 0); PG8_LDB(B1, 1, 1); PG8_SCHED; PG8_LDA(At, 1, 0); PG8_STAGE(PG8_SA(0, 1), a2 + hstep, voffA);
            PG8_WAIT_V(8); PG8_WAIT_L(0); PG8_BAR; PG8_MMA(0, 0, At, B0); PG8_MMA(0, 1, At, B1); PG8_BAR; PG8_SCHED;
            PG8_LDA(At, 1, 1); PG8_STAGE(PG8_SB(1, 0), b3, voffB); PG8_STAGE(PG8_SB(1, 1), b3 + hstep, voffB); PG8_STAGE(PG8_SA(1, 0), a3, voffA);
            PG8_WAIT_V(8); PG8_WAIT_L(0); PG8_BAR; PG8_MMA(1, 0, At, B0); PG8_MMA(1, 1, At, B1); PG8_BAR; PG8_SCHED;
            } else {
            PG8_LDB(B0, 0, 0); PG8_SCHED; PG8_LDA(At, 0, 0); PG8_STAGE(PG8_SA(1, 1), a1 + hstep, voffA);
            PG8_WAIT_L(8); PG8_BAR; PG8_WAIT_L(0); PG8_MMA(0, 0, At, B0); PG8_BAR; PG8_SCHED;
            PG8_LDB(B1, 0, 1); PG8_STAGE(PG8_SB(0, 0), b2, voffB);
            PG8_BAR; PG8_WAIT_L(0); PG8_MMA(0, 1, At, B1); PG8_BAR;
            PG8_LDA(At, 0, 1); PG8_STAGE(PG8_SA(0, 0), a2, voffA);
            PG8_BAR; PG8_WAIT_L(0); PG8_MMA(1, 0, At, B0); PG8_BAR; PG8_SCHED;
            PG8_STAGE(PG8_SB(0, 1), b2 + hstep, voffB);
            PG8_WAIT_V(6); PG8_BAR; PG8_MMA(1, 1, At, B1); PG8_BAR;
            PG8_LDB(B0, 1, 0); PG8_SCHED; PG8_LDA(At, 1, 0); PG8_STAGE(PG8_SA(0, 1), a2 + hstep, voffA);
            PG8_WAIT_L(8); PG8_BAR; PG8_WAIT_L(0); PG8_MMA(0, 0, At, B0); PG8_BAR; PG8_SCHED;
            PG8_LDB(B1, 1, 1); PG8_STAGE(PG8_SB(1, 0), b3, voffB);
            PG8_BAR; PG8_WAIT_L(0); PG8_MMA(0, 1, At, B1); PG8_BAR;
            PG8_LDA(At, 1, 1); PG8_STAGE(PG8_SA(1, 0), a3, voffA);
            PG8_BAR; PG8_WAIT_L(0); PG8_MMA(1, 0, At, B0); PG8_BAR; PG8_SCHED;
            PG8_STAGE(PG8_SB(1, 1), b3 + hstep, voffB);
            PG8_WAIT_V(6); PG8_BAR; PG8_MMA(1, 1, At, B1); PG8_BAR;
            }
        }
        if constexpr (ALIGN_EPI) { if (wr == 0) PG8_BAR; }
        if constexpr (!Epi::AFTER_DRAIN) { E(acc, cur, wr, wc, fr, fq); S.done(cur); }
        if (!has_next) break;
#pragma unroll
        for (int a = 0; a < 2; ++a)
#pragma unroll
            for (int b = 0; b < 2; ++b)
#pragma unroll
                for (int m = 0; m < 4; ++m)
#pragma unroll
                    for (int n = 0; n < 2; ++n) acc[a][b][m][n] = (f32x4){0.f, 0.f, 0.f, 0.f};
        cur = nxt; cA = nA; cB = nB; ++ui;
        if constexpr (ALIGN_EPI) { if (wr == 1) PG8_BAR; }
    }
    PG8_WAIT_V(0);
    if constexpr (!ALIGN_EPI) { if (wr == 0) PG8_BAR; }
    PG8_BAR;
    if constexpr (Epi::AFTER_DRAIN) { E.fused(acc, cur, wr, wc, fr, fq, lds, wid, lane); S.done(cur); }
#undef PG8_SA
#undef PG8_SB
#undef PG8_STAGE
#undef PG8_LDA
#undef PG8_LDB
#undef PG8_MMA
#undef PG8_WAIT_V
#undef PG8_WAIT_L
#undef PG8_BAR
#undef PG8_SCHED
}
}


constexpr int NWAVES = 8;
constexpr int RING_OFF = 0, RING_BYTES = 131072;
constexpr int LDSX_OFF = RING_BYTES;
constexpr int MISC_OFF = RING_BYTES + 8192;
constexpr int LDS_BYTES = 147456;
static_assert(MISC_OFF + 128 <= LDS_BYTES, "LDS map");
constexpr int CW_BAR = 1024;
constexpr int CW_FLAG = 16384;

#define GAS __attribute__((address_space(1)))
#define LAS __attribute__((address_space(3)))
typedef unsigned v4u __attribute__((ext_vector_type(4)));
typedef float f32x4 __attribute__((ext_vector_type(4)));
typedef unsigned u32x2 __attribute__((ext_vector_type(2)));
typedef GAS unsigned gu32;
#define LDS_WAIT() asm volatile("s_waitcnt lgkmcnt(0)" ::: "memory")
#define VM_WAIT() asm volatile("s_waitcnt vmcnt(0)" ::: "memory")
__device__ __forceinline__ unsigned pk2(float lo, float hi) { return f2bf(lo) | (f2bf(hi) << 16); }

#define XB_TMO      128
#define XB_XCNT(j)  (256  + 64 * (j))
#define XB_XSUB(j)  (1280 + 64 * (j))
#define XB_XGEN(j)  (2304 + 64 * (j))
#define XB_TOP      3328
#define XB_TOPGEN   3392
#define XCD_BAR_WORDS 3456
#define XB_SPIN_CAP (1u << 18)

__device__ __forceinline__ unsigned xb_ld(unsigned* p)              { return __hip_atomic_load(p, __ATOMIC_RELAXED, __HIP_MEMORY_SCOPE_AGENT); }
__device__ __forceinline__ unsigned xb_add(unsigned* p, unsigned v) { return __hip_atomic_fetch_add(p, v, __ATOMIC_RELAXED, __HIP_MEMORY_SCOPE_AGENT); }
__device__ __forceinline__ unsigned xb_xcc_id() { return (unsigned)__builtin_amdgcn_s_getreg((3 << 11) | 20) & 0xFu; }
#define XB_SPIN(cond, bar) do { unsigned _sp = 0; while (cond) { __builtin_amdgcn_s_sleep(1); \
    if ((++_sp & 255u) == 0u) { if (xb_ld(&(bar)[XB_TMO])) break; if (_sp > XB_SPIN_CAP) { atomicAdd(&(bar)[XB_TMO], 1u); break; } } } } while (0)

struct XcdBarrier {
    unsigned* bar; unsigned x;
    volatile LAS unsigned* st;
};

__device__ __forceinline__ XcdBarrier xcd_barrier_post(unsigned* bar, volatile LAS unsigned* st) {
    XcdBarrier b; b.bar = bar; b.x = xb_xcc_id(); b.st = st;
    if (threadIdx.x == 0) (void)xb_add(&bar[XB_XCNT(b.x)], 1u);
    return b;
}
__device__ __forceinline__ void xcd_barrier_complete(unsigned* bar, unsigned x, unsigned& nloc, unsigned& nx) {
    const unsigned G = gridDim.x * gridDim.y * gridDim.z;
    unsigned sum, cnt, mine, sp = 0u;
    for (;;) {
        sum = 0u; cnt = 0u; mine = 0u;
#pragma unroll
        for (unsigned j = 0; j < 16; ++j) { const unsigned c = xb_ld(&bar[XB_XCNT(j)]); sum += c; cnt += (c > 0u) ? 1u : 0u; mine = (j == x) ? c : mine; }
        if (sum == G) break;
        __builtin_amdgcn_s_sleep(1);
        if ((++sp & 255u) == 0u) { if (xb_ld(&bar[XB_TMO])) break; if (sp > XB_SPIN_CAP) { atomicAdd(&bar[XB_TMO], 1u); break; } }
    }
    nloc = mine > 0u ? mine : 1u; nx = cnt > 0u ? cnt : 1u;
}

__device__ __forceinline__ void xcd_barrier(const XcdBarrier& b) {
    asm volatile("s_waitcnt vmcnt(0)" ::: "memory");
    __syncthreads();
    if (threadIdx.x == 0) {
        unsigned* bar = b.bar;
        __builtin_amdgcn_s_waitcnt(0);
        unsigned nloc = b.st[0], nx = b.st[1];
        if (nloc == 0u) { xcd_barrier_complete(bar, b.x, nloc, nx); b.st[0] = nloc; b.st[1] = nx; }
        const unsigned old = xb_add(&bar[XB_XSUB(b.x)], 1u);
        const unsigned gen = old / nloc;
        if (old + 1u == (gen + 1u) * nloc) {
            __builtin_amdgcn_fence(__ATOMIC_RELEASE, "agent");
            asm volatile("s_waitcnt vmcnt(0)" ::: "memory");
            const unsigned og = xb_add(&bar[XB_TOP], 1u);
            const unsigned tg = og / nx;
            if (og + 1u == (tg + 1u) * nx) xb_add(&bar[XB_TOPGEN], 1u);
            else XB_SPIN(xb_ld(&bar[XB_TOPGEN]) == tg, bar);
            __builtin_amdgcn_fence(__ATOMIC_ACQUIRE, "agent");
            xb_add(&bar[XB_XGEN(b.x)], 1u);
            asm volatile("s_waitcnt vmcnt(0)" ::: "memory");
        } else {
            XB_SPIN(xb_ld(&bar[XB_XGEN(b.x)]) == gen, bar);
            __builtin_amdgcn_fence(__ATOMIC_ACQUIRE, "agent");
            asm volatile("s_waitcnt vmcnt(0)" ::: "memory");
        }
    }
    __syncthreads();
}


namespace att {
typedef short bf16x8 __attribute__((ext_vector_type(8)));
typedef short s16x4 __attribute__((ext_vector_type(4)));
typedef float f32x16 __attribute__((ext_vector_type(16)));
typedef unsigned u32x4 __attribute__((ext_vector_type(4)));
typedef unsigned u32x2 __attribute__((ext_vector_type(2)));
constexpr float LOG2E = 1.4426950408889634f;
#define LBAR() do { asm volatile("s_waitcnt lgkmcnt(0)" ::: "memory"); __builtin_amdgcn_s_barrier(); asm volatile("" ::: "memory"); } while (0)
__device__ __forceinline__ int kappa(int r) { return (r & ~12) | ((r & 4) << 1) | ((r & 8) >> 1); }
__device__ __forceinline__ f32x16 mfma32(bf16x8 a, bf16x8 b, f32x16 c) { return __builtin_amdgcn_mfma_f32_32x32x16_bf16(a, b, c, 0, 0, 0); }
__device__ __forceinline__ s16x4 vtr(const LAS unsigned char* p) { return __builtin_bit_cast(s16x4, __builtin_amdgcn_ds_read_tr16_b64_v4i16((LAS s16x4*)p)); }
__device__ __forceinline__ bf16x8 cat8(s16x4 a, s16x4 b) { return (bf16x8){a[0], a[1], a[2], a[3], b[0], b[1], b[2], b[3]}; }
typedef float f32x2_t __attribute__((ext_vector_type(2))); typedef __bf16 bf16x2_t __attribute__((ext_vector_type(2)));
__device__ __forceinline__ unsigned cvtpk(float lo, float hi) { unsigned r; asm("v_cvt_pk_bf16_f32 %0, %1, %2" : "=v"(r) : "v"(lo), "v"(hi)); return r; }
__device__ __forceinline__ float xhalf_max(float v) { return fmaxf(v, __shfl_xor(v, 32)); }
__device__ __forceinline__ float xhalf_sum(float v) { return v + __shfl_xor(v, 32); }
__device__ __forceinline__ bf16x8 packp(const f32x16& p, int s) {
    u32x4 w; w.x = cvtpk(p[8 * s + 0], p[8 * s + 1]); w.y = cvtpk(p[8 * s + 2], p[8 * s + 3]); w.z = cvtpk(p[8 * s + 4], p[8 * s + 5]); w.w = cvtpk(p[8 * s + 6], p[8 * s + 7]);
    return __builtin_bit_cast(bf16x8, w);
}
__device__ __forceinline__ int tr_off(int lane, int VP) { const int hi = lane >> 5, blk = (lane >> 4) & 1, q4 = (lane & 15) >> 2, p4 = lane & 3; return (8 * hi + q4) * VP + (16 * blk + 4 * p4) * 2; }


#define TR_RD(DST, ADDR, OFF) asm volatile("ds_read_b64_tr_b16 %0, %1 offset:%2" : "=v"(DST) : "v"(ADDR), "i"(OFF))
#define TR_WAIT(N, A, B) asm volatile("s_waitcnt lgkmcnt(" #N ")" : "+v"(A), "+v"(B))
#define PV_CHAIN2(ACC, ADDR, VP, F0, F1) do { s16x4 l0, h0, l1, h1; const unsigned ad_ = (ADDR); \
    TR_RD(l0, ad_, 0 * (VP)); TR_RD(h0, ad_, 4 * (VP)); TR_RD(l1, ad_, 16 * (VP)); TR_RD(h1, ad_, 20 * (VP)); \
    TR_WAIT(2, l0, h0); ACC = mfma32(cat8(l0, h0), F0, ACC); TR_WAIT(0, l1, h1); ACC = mfma32(cat8(l1, h1), F1, ACC); } while (0)
#define PV_CHAIN8(ACC, ADDR, VP, F0, F1, F2, F3, F4, F5, F6, F7) do { s16x4 l0, h0, l1, h1, l2, h2, l3, h3, l4, h4, l5, h5, l6, h6, l7, h7; const unsigned ad_ = (ADDR); \
    TR_RD(l0, ad_, 0 * (VP)); TR_RD(h0, ad_, 4 * (VP)); TR_RD(l1, ad_, 16 * (VP)); TR_RD(h1, ad_, 20 * (VP)); TR_RD(l2, ad_, 32 * (VP)); TR_RD(h2, ad_, 36 * (VP)); TR_RD(l3, ad_, 48 * (VP)); TR_RD(h3, ad_, 52 * (VP)); \
    TR_RD(l4, ad_, 64 * (VP)); TR_RD(h4, ad_, 68 * (VP)); TR_RD(l5, ad_, 80 * (VP)); TR_RD(h5, ad_, 84 * (VP)); TR_RD(l6, ad_, 96 * (VP)); TR_RD(h6, ad_, 100 * (VP)); TR_RD(l7, ad_, 112 * (VP)); TR_RD(h7, ad_, 116 * (VP)); \
    TR_WAIT(14, l0, h0); ACC = mfma32(cat8(l0, h0), F0, ACC); TR_WAIT(12, l1, h1); ACC = mfma32(cat8(l1, h1), F1, ACC); TR_WAIT(10, l2, h2); ACC = mfma32(cat8(l2, h2), F2, ACC); TR_WAIT(8, l3, h3); ACC = mfma32(cat8(l3, h3), F3, ACC); \
    TR_WAIT(6, l4, h4); ACC = mfma32(cat8(l4, h4), F4, ACC); TR_WAIT(4, l5, h5); ACC = mfma32(cat8(l5, h5), F5, ACC); TR_WAIT(2, l6, h6); ACC = mfma32(cat8(l6, h6), F6, ACC); TR_WAIT(0, l7, h7); ACC = mfma32(cat8(l7, h7), F7, ACC); } while (0)

constexpr int MB_KP = 144, MB_VP = 192, MB_TN = 2256, MB_TK = 128;
constexpr int MB_K = 0, MB_V = 2 * MB_TK * MB_KP, MB_LUT = MB_V + 2 * MB_TK * MB_VP, MB_KM = MB_LUT + 4 * MB_TN * 4, MB_END = MB_KM + 2048;
__device__ __forceinline__ f32x16 ld_c16(const LAS unsigned char* p) {
    const f32x4 a = *(const LAS f32x4*)p, b = *(const LAS f32x4*)(p + 16), c = *(const LAS f32x4*)(p + 64), d = *(const LAS f32x4*)(p + 80);
    return (f32x16){a[0], a[1], a[2], a[3], b[0], b[1], b[2], b[3], c[0], c[1], c[2], c[3], d[0], d[1], d[2], d[3]};
}
__device__ __forceinline__ float max16(const f32x16& p) { return fmaxf(fmaxf(fmaxf(fmaxf(p[0], p[1]), fmaxf(p[2], p[3])), fmaxf(fmaxf(p[4], p[5]), fmaxf(p[6], p[7]))), fmaxf(fmaxf(fmaxf(p[8], p[9]), fmaxf(p[10], p[11])), fmaxf(fmaxf(p[12], p[13]), fmaxf(p[14], p[15])))); }
__device__ __forceinline__ void moba_phase(LAS unsigned char* lds, const bf16* QKV, const float* KMP, const float* LUT, bf16* Y, float* SSB, int vcu, int G, int variant) {
    const int tid = threadIdx.x, lane = tid & 63, r32 = lane & 31, hi = lane >> 5; const int w = __builtin_amdgcn_readfirstlane(tid >> 6);
    LAS float* tab = (LAS float*)(lds + MB_LUT); LAS float* km = (LAS float*)(lds + MB_KM);
    const int troff = tr_off(lane, MB_VP);
    int htab = -1;
    for (int tau = vcu; tau < BATCH * 8 * 4; tau += G) { const int bh = tau >> 2, pr = tau & 3, b = bh >> 3, h = bh & 7;
        __syncthreads();
        if (h != htab) { htab = h; float tv[18];
#pragma unroll
            for (int j = 0; j < 18; ++j) { const int i = tid + 512 * j, sft = i / MB_TN, ii = i - sft * MB_TN, idx = 2047 - ii - sft; tv[j] = (i < 4 * MB_TN && idx >= 0) ? LUT[(8 + h) * 2048 + idx] * LOG2E : -INFINITY; }
#pragma unroll
            for (int j = 0; j < 18; ++j) { const int i = tid + 512 * j; if (i < 4 * MB_TN) tab[i] = tv[j]; } }
        { const int j = tid >> 6, d = tid & 63; km[tid] = (KMP[(size_t)((8 * b + j) * 2 + 0) * 512 + 64 * h + d] + KMP[(size_t)((8 * b + j) * 2 + 1) * 512 + 64 * h + d]) * (1.f / 256.f); }
        __syncthreads();
        const bf16* Qb = QKV + (size_t)b * SEQ * NQKV + 1536 + 64 * h; const bf16* Kb = QKV + (size_t)b * SEQ * NQKV + 2048 + 64 * h; const bf16* Vb = Kb + 512;
        for (int s2 = 0; s2 < 2; ++s2) { const int qb = s2 == 0 ? 7 - pr : pr;
            const int tq = 256 * qb + 32 * w + r32;
            bf16x8 qf[4];
#pragma unroll
            for (int d0 = 0; d0 < 4; ++d0) qf[d0] = *(const bf16x8*)(Qb + (size_t)tq * NQKV + 16 * d0 + 8 * hi);
            unsigned sel = 0;
            { float g[8];
#pragma unroll
              for (int j = 0; j < 8; ++j) g[j] = 0.f;
#pragma unroll
              for (int d0 = 0; d0 < 4; ++d0) { float qv[8];
#pragma unroll
                  for (int e = 0; e < 8; ++e) qv[e] = __builtin_bit_cast(float, (unsigned)(unsigned short)qf[d0][e] << 16);
#pragma unroll
                  for (int j = 0; j < 7; ++j) { const LAS float* kp = km + j * 64 + 16 * d0 + 8 * hi; const f32x4 k0 = *(const LAS f32x4*)kp, k1 = *(const LAS f32x4*)(kp + 4);
                      g[j] += qv[0] * k0[0] + qv[1] * k0[1] + qv[2] * k0[2] + qv[3] * k0[3] + qv[4] * k1[0] + qv[5] * k1[1] + qv[6] * k1[2] + qv[7] * k1[3]; } }
#pragma unroll
              for (int j = 0; j < 7; ++j) g[j] += __shfl_xor(g[j], 32);
              const int nsel = qb < 3 ? qb : 3;
              for (int n = 0; n < nsel; ++n) { float best = -3e38f; int bi = 0;
#pragma unroll
                  for (int j = 0; j < 7; ++j) if (j < qb && !((sel >> j) & 1u) && g[j] > best) { best = g[j]; bi = j; }
                  sel |= 1u << bi; }
              sel |= 1u << qb; }
            float l_run = 0.f; f32x16 o0 = {}, o1 = {};
            const int NT = 2 * (qb + 1);
            const int a0 = 2047 - tq + 8 * hi;
            const LAS unsigned char* cp = (const LAS unsigned char*)tab + (a0 & 3) * (MB_TN * 4) + (a0 & ~3) * 4;
            const int skey = tid >> 3, sch = tid & 7;
            const size_t srow = (size_t)skey * NQKV + 8 * sch;
#define MB_GLD(T_) do { if ((T_) < NT) { const size_t ro_ = srow + (size_t)(T_) * MB_TK * NQKV; k0r = *(const u32x4*)(Kb + ro_); k1r = *(const u32x4*)(Kb + ro_ + (size_t)64 * NQKV); v0r = *(const u32x4*)(Vb + ro_); v1r = *(const u32x4*)(Vb + ro_ + (size_t)64 * NQKV); } } while (0)
#define MB_ST(T_) do { if ((T_) < NT) { LAS unsigned char* kd_ = lds + MB_K + ((T_) & 1) * (MB_TK * MB_KP) + skey * MB_KP + sch * 16; LAS unsigned char* vd_ = lds + MB_V + ((T_) & 1) * (MB_TK * MB_VP) + skey * MB_VP + sch * 16; \
                    *(LAS u32x4*)kd_ = k0r; *(LAS u32x4*)(kd_ + 64 * MB_KP) = k1r; *(LAS u32x4*)vd_ = v0r; *(LAS u32x4*)(vd_ + 64 * MB_VP) = v1r; } } while (0)
#define MB_ACT(T_) (((T_) >> 1) < qb ? (__ballot((sel >> ((T_) >> 1)) & 1u) != 0ull) : ((MB_TK * (T_) - 256 * qb) <= 32 * w + 31))
            u32x4 k0r = {}, k1r = {}, v0r = {}, v1r = {};
            MB_GLD(0); MB_ST(0); MB_GLD(1);
            LBAR();
            for (int T = 0; T < NT; ++T) {
                if (MB_ACT(T)) {
                    const LAS unsigned char* Kt = lds + MB_K + (T & 1) * (MB_TK * MB_KP) + kappa(r32) * MB_KP + hi * 16; const LAS unsigned char* Vt = lds + MB_V + (T & 1) * (MB_TK * MB_VP) + troff;
                    const bool selb = (sel >> (T >> 1)) & 1u;
                    const LAS unsigned char* ct = selb ? cp + 512 * T : (const LAS unsigned char*)tab + 2048 * 4;
                    f32x16 p0 = ld_c16(ct), p1 = ld_c16(ct + 128), p2 = ld_c16(ct + 256), p3 = ld_c16(ct + 384);
                    if (!(variant & 4)) {
#pragma unroll
                        for (int d0 = 0; d0 < 4; ++d0) { const bf16x8 ka = *(const LAS bf16x8*)(Kt + d0 * 32), kb = *(const LAS bf16x8*)(Kt + 32 * MB_KP + d0 * 32), kc = *(const LAS bf16x8*)(Kt + 64 * MB_KP + d0 * 32), kd = *(const LAS bf16x8*)(Kt + 96 * MB_KP + d0 * 32);
                            p0 = mfma32(ka, qf[d0], p0); p1 = mfma32(kb, qf[d0], p1); p2 = mfma32(kc, qf[d0], p2); p3 = mfma32(kd, qf[d0], p3); } }
                    float ls0 = 0.f, ls1 = 0.f;
                    if (!(variant & 1)) {
#pragma unroll
                        for (int r = 0; r < 16; ++r) { p0[r] = __builtin_amdgcn_exp2f(p0[r]); p1[r] = __builtin_amdgcn_exp2f(p1[r]); p2[r] = __builtin_amdgcn_exp2f(p2[r]); p3[r] = __builtin_amdgcn_exp2f(p3[r]); ls0 += p0[r] + p1[r]; ls1 += p2[r] + p3[r]; } }
                    l_run += ls0 + ls1;
                    if (!(variant & 2)) {
                        const bf16x8 f0 = packp(p0, 0), f1 = packp(p0, 1), f2 = packp(p1, 0), f3 = packp(p1, 1), f4 = packp(p2, 0), f5 = packp(p2, 1), f6 = packp(p3, 0), f7 = packp(p3, 1);
                        const unsigned va = (unsigned)(size_t)Vt;
                        PV_CHAIN8(o0, va, MB_VP, f0, f1, f2, f3, f4, f5, f6, f7);
                        PV_CHAIN8(o1, va + 64u, MB_VP, f0, f1, f2, f3, f4, f5, f6, f7); }
                }
                MB_ST(T + 1);
                if (!(variant & 16)) LBAR();
                if (!(variant & 8)) MB_GLD(T + 2);
            }
#undef MB_GLD
#undef MB_ST
#undef MB_ACT
            const float inv = 1.f / xhalf_sum(l_run);
            bf16* yp = Y + ((size_t)b * SEQ + tq) * DM + 512 + 64 * h + 4 * hi; float sq = 0.f;
#pragma unroll
            for (int g4 = 0; g4 < 4; ++g4) { u32x2 a, c2; a.x = cvtpk(o0[4 * g4] * inv, o0[4 * g4 + 1] * inv); a.y = cvtpk(o0[4 * g4 + 2] * inv, o0[4 * g4 + 3] * inv);
                c2.x = cvtpk(o1[4 * g4] * inv, o1[4 * g4 + 1] * inv); c2.y = cvtpk(o1[4 * g4 + 2] * inv, o1[4 * g4 + 3] * inv);
                *(u32x2*)(yp + 8 * g4) = a; *(u32x2*)(yp + 32 + 8 * g4) = c2;
                sq += bflo(a.x) * bflo(a.x) + bfhi(a.x) * bfhi(a.x) + bflo(a.y) * bflo(a.y) + bfhi(a.y) * bfhi(a.y) + bflo(c2.x) * bflo(c2.x) + bfhi(c2.x) * bfhi(c2.x) + bflo(c2.y) * bflo(c2.y) + bfhi(c2.y) * bfhi(c2.y); }
            sq = xhalf_sum(sq); if (hi == 0 && SSB) atomicAdd(SSB + (size_t)b * SEQ + tq, sq);
        }
    }
}

constexpr int DL_VP = 192, DL_KP = 144, DL_LUT = 0, DL_TN = 208, DL_V = 16384, DL_SB = 65536, DL_SBP = 136, DL_SL = DL_SB + 512 * DL_SBP, DL_END = DL_SL + 2048;
static_assert(DL_END <= 139264, "dilated LDS map");
struct DilTile { u32x4 kr[4]; u32x4 vr[4]; };
__device__ __forceinline__ void dil_load(DilTile& t, const bf16* Kb, const bf16* Vb, int dil, int res, int base, int lane) {
#pragma unroll
    for (int i4 = 0; i4 < 4; ++i4) { const int idx = lane + 64 * i4, key = idx >> 3, ch = idx & 7; const size_t o = (size_t)(dil * (base + key) + res) * NQKV + 8 * ch;
        t.kr[i4] = *(const u32x4*)(Kb + o); t.vr[i4] = *(const u32x4*)(Vb + o); }
}
__device__ __forceinline__ void dil_unit(const bf16* Qb, const bf16* Kb, const bf16* Vb, const LAS unsigned char* tb, LAS unsigned char* Vw, int troff, int dil, int res, int gi, int lane, int r32, int hi,
                                         f32x16& o0, f32x16& o1, float& lse) {
    const int ms = 32 * gi + r32, tq = dil * ms + res;
    u32x4 qr[4];
#pragma unroll
    for (int i4 = 0; i4 < 4; ++i4) { const int idx = lane + 64 * i4, qrow = idx >> 3, ch = idx & 7; qr[i4] = *(const u32x4*)(Qb + (size_t)(dil * (32 * gi + qrow) + res) * NQKV + 8 * ch); }
    float l_run = 0.f; o0 = f32x16{}; o1 = f32x16{};
    const int kt0 = gi >= 4 ? 0 : 4 - gi;
    const int a0 = 31 - r32 + 8 * hi;
    const LAS unsigned char* cp = tb + (a0 & 3) * (DL_TN * 4) + (a0 & ~3) * 4;
    DilTile nx, nx2; dil_load(nx, Kb, Vb, dil, res, 32 * gi - 128 + 32 * kt0, lane); nx2 = nx;
    if (kt0 < 4) dil_load(nx2, Kb, Vb, dil, res, 32 * gi - 128 + 32 * (kt0 + 1), lane);
    bf16x8 qf[4];
#pragma unroll
    for (int i4 = 0; i4 < 4; ++i4) { const int idx = lane + 64 * i4, qrow = idx >> 3, ch = idx & 7; *(LAS u32x4*)(Vw + qrow * DL_KP + ch * 16) = qr[i4]; }
#pragma unroll
    for (int d0 = 0; d0 < 4; ++d0) qf[d0] = *(const LAS bf16x8*)(Vw + r32 * DL_KP + hi * 16 + d0 * 32);
#pragma unroll 1
    for (int kt = kt0; kt < 5; ++kt) { const int base = 32 * gi - 128 + 32 * kt;
        DilTile cu = nx; nx = nx2;
        if (kt < 3) dil_load(nx2, Kb, Vb, dil, res, base + 64, lane);
        asm volatile("" ::: "memory");
#pragma unroll
        for (int i4 = 0; i4 < 4; ++i4) { const int idx = lane + 64 * i4, key = idx >> 3, ch = idx & 7; *(LAS u32x4*)(Vw + key * DL_KP + ch * 16) = cu.kr[i4]; }
        bf16x8 kf[4];
#pragma unroll
        for (int d0 = 0; d0 < 4; ++d0) kf[d0] = *(const LAS bf16x8*)(Vw + kappa(r32) * DL_KP + hi * 16 + d0 * 32);
#pragma unroll
        for (int i4 = 0; i4 < 4; ++i4) { const int idx = lane + 64 * i4, key = idx >> 3, ch = idx & 7; *(LAS u32x4*)(Vw + key * DL_VP + ch * 16) = cu.vr[i4]; }
        f32x16 p0 = ld_c16(cp + 128 * kt);
#pragma unroll
        for (int d0 = 0; d0 < 4; ++d0) p0 = mfma32(kf[d0], qf[d0], p0);
        float ls = 0.f;
#pragma unroll
        for (int r = 0; r < 16; ++r) { p0[r] = __builtin_amdgcn_exp2f(p0[r]); ls += p0[r]; }
        l_run += ls;
        const bf16x8 pf0 = packp(p0, 0), pf1 = packp(p0, 1);
        asm volatile("s_waitcnt lgkmcnt(0)" ::: "memory");
#pragma unroll
        for (int c = 0; c < 2; ++c) { const LAS unsigned char* vb = Vw + troff + c * 64;
            const bf16x8 v0 = cat8(vtr(vb), vtr(vb + 4 * DL_VP)), v1 = cat8(vtr(vb + 16 * DL_VP), vtr(vb + 20 * DL_VP));
            if (c == 0) { o0 = mfma32(v0, pf0, o0); o0 = mfma32(v1, pf1, o0); } else { o1 = mfma32(v0, pf0, o1); o1 = mfma32(v1, pf1, o1); } }
        asm volatile("s_waitcnt lgkmcnt(0)" ::: "memory");
    }
    const float lt = xhalf_sum(l_run), inv = 1.f / lt;
#pragma unroll
    for (int r = 0; r < 16; ++r) { o0[r] *= inv; o1[r] *= inv; }
    lse = __builtin_amdgcn_logf(lt);
}
__device__ __forceinline__ void sb_store(LAS unsigned char* sb, int lt, int hi, const f32x16& o0, const f32x16& o1) {
    LAS unsigned char* p = sb + lt * DL_SBP + 8 * hi;
#pragma unroll
    for (int g4 = 0; g4 < 4; ++g4) { u32x2 a, c2; a.x = cvtpk(o0[4 * g4], o0[4 * g4 + 1]); a.y = cvtpk(o0[4 * g4 + 2], o0[4 * g4 + 3]); c2.x = cvtpk(o1[4 * g4], o1[4 * g4 + 1]); c2.y = cvtpk(o1[4 * g4 + 2], o1[4 * g4 + 3]);
        *(LAS u32x2*)(p + 16 * g4) = a; *(LAS u32x2*)(p + 64 + 16 * g4) = c2; }
}
__device__ __forceinline__ void sb_merge(const LAS unsigned char* sb, int lt, int hi, float wa, float wb, f32x16& o0, f32x16& o1) {
    const LAS unsigned char* p = sb + lt * DL_SBP + 8 * hi;
#pragma unroll
    for (int g4 = 0; g4 < 4; ++g4) { const u32x2 a = *(const LAS u32x2*)(p + 16 * g4), c2 = *(const LAS u32x2*)(p + 64 + 16 * g4);
        o0[4 * g4] = wa * bflo(a.x) + wb * o0[4 * g4]; o0[4 * g4 + 1] = wa * bfhi(a.x) + wb * o0[4 * g4 + 1]; o0[4 * g4 + 2] = wa * bflo(a.y) + wb * o0[4 * g4 + 2]; o0[4 * g4 + 3] = wa * bfhi(a.y) + wb * o0[4 * g4 + 3];
        o1[4 * g4] = wa * bflo(c2.x) + wb * o1[4 * g4]; o1[4 * g4 + 1] = wa * bfhi(c2.x) + wb * o1[4 * g4 + 1]; o1[4 * g4 + 2] = wa * bflo(c2.y) + wb * o1[4 * g4 + 2]; o1[4 * g4 + 3] = wa * bfhi(c2.y) + wb * o1[4 * g4 + 3]; }
}
__device__ __forceinline__ void dil_phase(LAS unsigned char* lds, const bf16* QKV, const float* LUT, bf16* Y, float* SSA, int vcu, int G) {
    const int tid = threadIdx.x, lane = tid & 63, r32 = lane & 31, hi = lane >> 5; const int w = __builtin_amdgcn_readfirstlane(tid >> 6);
    LAS float* dtab = (LAS float*)(lds + DL_LUT);
    LAS unsigned char* Vw = lds + DL_V + w * (32 * DL_VP);
    LAS unsigned char* sb = lds + DL_SB; LAS float* sl = (LAS float*)(lds + DL_SL);
    const int troff = tr_off(lane, DL_VP);
    for (int bh = vcu; bh < BATCH * 8; bh += G) { const int b = bh >> 3, h = bh & 7;
        __syncthreads();
        for (int i = tid; i < 3 * 4 * DL_TN; i += 512) { const int ii = i % DL_TN, sft = (i / DL_TN) & 3, pp = i / (4 * DL_TN); const int dlt = 159 - ii - sft, dist = dlt * (pp == 0 ? 1 : (pp == 1 ? 4 : 16));
            dtab[i] = (dlt >= 0 && dlt <= 128 && dist < 2048) ? LUT[h * 2048 + dist] * LOG2E : -INFINITY; }
        __syncthreads();
        const bf16* Qb = QKV + (size_t)b * SEQ * NQKV + 64 * h; const bf16* Kb = Qb + 512; const bf16* Vb = Qb + 1024;
        const LAS unsigned char* tb0 = lds + DL_LUT;
        for (int sp = 0; sp < 4; ++sp) {
            for (int x = w; x < 16; x += 8) { f32x16 o0, o1; float lse;
                dil_unit(Qb, Kb, Vb, tb0 + 2 * (4 * DL_TN * 4), Vw, troff, 16, x, sp, lane, r32, hi, o0, o1, lse);
                const int lt = 16 * r32 + x; sb_store(sb, lt, hi, o0, o1); if (hi == 0) sl[lt] = lse; }
            __syncthreads();
            for (int x = w; x < 16; x += 8) { f32x16 o0, o1; float lse;
                dil_unit(Qb, Kb, Vb, tb0 + 1 * (4 * DL_TN * 4), Vw, troff, 4, x & 3, 4 * sp + (x >> 2), lane, r32, hi, o0, o1, lse);
                const int lt = 128 * (x >> 2) + 4 * r32 + (x & 3); const float ls = sl[lt], mx = fmaxf(ls, lse);
                float wa = __builtin_amdgcn_exp2f(ls - mx), wb = __builtin_amdgcn_exp2f(lse - mx); const float sw = wa + wb, isw = 1.f / sw; wa *= isw; wb *= isw;
                sb_merge(sb, lt, hi, wa, wb, o0, o1); sb_store(sb, lt, hi, o0, o1); if (hi == 0) sl[lt] = mx + __builtin_amdgcn_logf(sw); }
            __syncthreads();
            for (int x = w; x < 16; x += 8) { f32x16 o0, o1; float lse;
                dil_unit(Qb, Kb, Vb, tb0, Vw, troff, 1, 0, 16 * sp + x, lane, r32, hi, o0, o1, lse);
                const int lt = 32 * x + r32; const float ls = sl[lt], mx = fmaxf(ls, lse);
                float wa = __builtin_amdgcn_exp2f(ls - mx), wb = __builtin_amdgcn_exp2f(lse - mx); const float isw = 1.f / (wa + wb); wa *= isw; wb *= isw;
                sb_merge(sb, lt, hi, wa, wb, o0, o1);
                sb_store(sb, lt, hi, o0, o1); }
            __syncthreads();
#pragma unroll
            for (int j = 0; j < 8; ++j) { const int idx = tid + 512 * j, row = idx >> 3, ch = idx & 7;
                const LAS unsigned char* p = sb + row * DL_SBP + ch * 16; const u32x2 a = *(const LAS u32x2*)p, c2 = *(const LAS u32x2*)(p + 8);
                u32x4 v; v[0] = a.x; v[1] = a.y; v[2] = c2.x; v[3] = c2.y;
                *(u32x4*)(Y + ((size_t)b * SEQ + 512 * sp + row) * DM + 64 * h + 8 * ch) = v;
                float sq = bflo(a.x) * bflo(a.x) + bfhi(a.x) * bfhi(a.x) + bflo(a.y) * bflo(a.y) + bfhi(a.y) * bfhi(a.y) + bflo(c2.x) * bflo(c2.x) + bfhi(c2.x) * bfhi(c2.x) + bflo(c2.y) * bflo(c2.y) + bfhi(c2.y) * bfhi(c2.y);
                sq += __shfl_xor(sq, 1); sq += __shfl_xor(sq, 2); sq += __shfl_xor(sq, 4);
                if (ch == 0) atomicAdd(SSA + (size_t)b * SEQ + 512 * sp + row, sq); }
            __syncthreads();
        }
    }
}

__device__ __forceinline__ void merge_phase(const bf16* __restrict__ Y, bf16* __restrict__ YN, int gw, int NGW, int lane) {
    for (int m = gw; m < NTOK; m += NGW) {
        const u32x4 ya = *(const u32x4*)(Y + (size_t)m * DM + 8 * lane), yb = *(const u32x4*)(Y + (size_t)m * DM + 512 + 8 * lane);
        float v[8], u[8]; float sa = 0.f, sb = 0.f;
#pragma unroll
        for (int e = 0; e < 4; ++e) { v[2 * e] = bflo(ya[e]); v[2 * e + 1] = bfhi(ya[e]); u[2 * e] = bflo(yb[e]); u[2 * e + 1] = bfhi(yb[e]); }
#pragma unroll
        for (int e = 0; e < 8; ++e) { sa += v[e] * v[e]; sb += u[e] * u[e]; }
        sa = wave_sum(sa); sb = wave_sum(sb);
        const float ra = rsqrtf(sa * (1.f / 512.f) + EPS), rb = rsqrtf(sb * (1.f / 512.f) + EPS);
        u32x4 oa, ob;
#pragma unroll
        for (int e = 0; e < 4; ++e) { oa[e] = cvtpk(v[2 * e] * ra, v[2 * e + 1] * ra); ob[e] = cvtpk(u[2 * e] * rb, u[2 * e + 1] * rb); }
        *(u32x4*)(YN + (size_t)m * DM + 8 * lane) = oa; *(u32x4*)(YN + (size_t)m * DM + 512 + 8 * lane) = ob;
    }
}

constexpr int CR_KP = 272, CR_VP = 320, CR_K = 0, CR_V = 2 * 64 * CR_KP, CR_END = CR_V + 2 * 64 * CR_VP, CR_OP = 272;
static_assert(4 * 32 * CR_OP <= CR_V && CR_END + 4 * 32 * CR_OP <= 139264, "cross LDS map");
typedef __amdgpu_buffer_rsrc_t rsrc_t;
__device__ __forceinline__ rsrc_t mkrsrc(const void* base, unsigned bytes) { return __builtin_amdgcn_make_buffer_rsrc((void*)base, 0, bytes, 0x00020000); }
__device__ __forceinline__ u32x4 bld16(rsrc_t r, unsigned voff, unsigned soff) { return __builtin_bit_cast(u32x4, __builtin_amdgcn_raw_buffer_load_b128(r, voff, soff, 0)); }
__device__ __forceinline__ void cross_phase(LAS unsigned char* lds, const bf16* QM, const bf16* KVM, bf16* OM, int vcu, int G, int pv) {
    const int tid = threadIdx.x, lane = tid & 63, r32 = lane & 31, hi = lane >> 5; const int w = __builtin_amdgcn_readfirstlane(tid >> 6);
    const int troff = tr_off(lane, CR_VP);
    const int kkey = tid >> 3, kch = tid & 7;
    const unsigned soff = (unsigned)kkey * 4096u + (unsigned)kch * 16u;
    const unsigned qoff = (unsigned)(32 * w + r32) * 2048u + (unsigned)hi * 16u;
    const int kl0 = kkey * CR_KP + kch * 16, vl0 = kkey * CR_VP + kch * 16;
    const int kfo = kappa(r32) * CR_KP + hi * 16;
    const rsrc_t rK = mkrsrc(KVM, (unsigned)NMEMTOK * 4096u), rQ = mkrsrc(QM, (unsigned)NTOK * 2048u);
    LAS unsigned char* Tw = lds + (w < 4 ? CR_K + w * (32 * CR_OP) : CR_END + (w - 4) * (32 * CR_OP));
    for (int un = vcu * 4; un < BATCH * 4 * 8; un += G * 4) for (int ui = 0; ui < 4; ++ui) { const int u = un + ui, qblk = u & 7, hm = (u >> 3) & 3, b = u >> 5;
        const unsigned Qs = (unsigned)(((b * SEQ + 256 * qblk) * DM + 256 * hm) * 2);
        unsigned char* Os = (unsigned char*)(OM + ((size_t)b * SEQ + 256 * qblk) * DM + 256 * hm);
        const unsigned Ks = (unsigned)((b * NMEM * 2048 + 256 * hm) * 2), Vs = Ks + 2048u;
        f32x16 sc[8];
#pragma unroll
        for (int kt = 0; kt < 8; ++kt) sc[kt] = f32x16{};
        u32x4 r0, r1;
        __syncthreads();
        r0 = bld16(rK, soff, Ks); r1 = bld16(rK, soff, Ks + 128u);
        *(LAS u32x4*)(lds + CR_K + kl0) = r0; *(LAS u32x4*)(lds + CR_K + kl0 + 128) = r1;
        __syncthreads();
#pragma unroll
        for (int half = 0; half < 2; ++half) {
            bf16x8 qf[8];
#pragma unroll
            for (int d0 = 0; d0 < 8; ++d0) qf[d0] = __builtin_bit_cast(bf16x8, bld16(rQ, qoff, Qs + (unsigned)(256 * half + 32 * d0)));
#pragma unroll
            for (int kp = 0; kp < 4; ++kp) { const int step = half * 4 + kp, buf = step & 1;
                if (!(pv & 2)) { if (step + 1 < 8) { const int nh = (step + 1) >> 2, nk = (step + 1) & 3; const unsigned src = Ks + (unsigned)(nk * (64 * 4096) + 256 * nh); r0 = bld16(rK, soff, src); r1 = bld16(rK, soff, src + 128u); }
                else { r0 = bld16(rK, soff, Vs); r1 = bld16(rK, soff, Vs + 128u); } }
                const LAS unsigned char* Kt = lds + CR_K + buf * (64 * CR_KP) + kfo;
#pragma unroll
                for (int d0 = 0; d0 < 8; ++d0) { sc[2 * kp] = mfma32(*(const LAS bf16x8*)(Kt + d0 * 32), qf[d0], sc[2 * kp]); sc[2 * kp + 1] = mfma32(*(const LAS bf16x8*)(Kt + 32 * CR_KP + d0 * 32), qf[d0], sc[2 * kp + 1]); if (d0 & 1) __builtin_amdgcn_sched_barrier(0); }
                if (step + 1 < 8) { *(LAS u32x4*)(lds + CR_K + (buf ^ 1) * (64 * CR_KP) + kl0) = r0; *(LAS u32x4*)(lds + CR_K + (buf ^ 1) * (64 * CR_KP) + kl0 + 128) = r1; }
                else { *(LAS u32x4*)(lds + CR_V + vl0) = r0; *(LAS u32x4*)(lds + CR_V + vl0 + 128) = r1; }
                LBAR();
            }
        }
        const float c1 = 0.0625f * LOG2E, mo = 0.f; float ls = 0.f;
        bf16x8 pf[8][2];
#pragma unroll
        for (int kt = 0; kt < 8; ++kt) {
#pragma unroll
            for (int r = 0; r < 16; ++r) { sc[kt][r] = __builtin_amdgcn_exp2f(sc[kt][r] * c1 - mo); ls += sc[kt][r]; }
            pf[kt][0] = packp(sc[kt], 0); pf[kt][1] = packp(sc[kt], 1); }
        const float inv = 1.f / xhalf_sum(ls);
#pragma unroll
        for (int hv = 0; hv < 2; ++hv) {
            f32x16 o[4];
#pragma unroll
            for (int c = 0; c < 4; ++c) o[c] = f32x16{};
            if (hv == 1) { if (!(pv & 2)) { r0 = bld16(rK, soff, Vs + 256u); r1 = bld16(rK, soff, Vs + 384u); }
                *(LAS u32x4*)(lds + CR_V + vl0) = r0; *(LAS u32x4*)(lds + CR_V + vl0 + 128) = r1; LBAR(); }
#pragma unroll
            for (int kp = 0; kp < 4; ++kp) { const int buf = kp & 1;
                if (kp + 1 < 4 && !(pv & 2)) { const unsigned src = Vs + (unsigned)((kp + 1) * (64 * 4096) + 256 * hv); r0 = bld16(rK, soff, src); r1 = bld16(rK, soff, src + 128u); }
                const LAS unsigned char* vb = lds + CR_V + buf * (64 * CR_VP) + troff;
#pragma unroll
                for (int t2 = 0; t2 < 2; ++t2) { const unsigned va = (unsigned)(size_t)(vb + t2 * 32 * CR_VP);
                    s16x4 l0, h0, l1, h1, l2, h2, l3, h3, l4, h4, l5, h5, l6, h6, l7, h7;
                    TR_RD(l0, va, 0 * CR_VP); TR_RD(h0, va, 4 * CR_VP); TR_RD(l1, va, 16 * CR_VP); TR_RD(h1, va, 20 * CR_VP); TR_RD(l2, va, 64 + 0 * CR_VP); TR_RD(h2, va, 64 + 4 * CR_VP); TR_RD(l3, va, 64 + 16 * CR_VP); TR_RD(h3, va, 64 + 20 * CR_VP);
                    TR_RD(l4, va, 128 + 0 * CR_VP); TR_RD(h4, va, 128 + 4 * CR_VP); TR_RD(l5, va, 128 + 16 * CR_VP); TR_RD(h5, va, 128 + 20 * CR_VP); TR_RD(l6, va, 192 + 0 * CR_VP); TR_RD(h6, va, 192 + 4 * CR_VP); TR_RD(l7, va, 192 + 16 * CR_VP); TR_RD(h7, va, 192 + 20 * CR_VP);
                    const bf16x8 q0 = pf[2 * kp + t2][0], q1 = pf[2 * kp + t2][1];
                    TR_WAIT(14, l0, h0); o[0] = mfma32(cat8(l0, h0), q0, o[0]); TR_WAIT(12, l1, h1); o[0] = mfma32(cat8(l1, h1), q1, o[0]); TR_WAIT(10, l2, h2); o[1] = mfma32(cat8(l2, h2), q0, o[1]); TR_WAIT(8, l3, h3); o[1] = mfma32(cat8(l3, h3), q1, o[1]);
                    TR_WAIT(6, l4, h4); o[2] = mfma32(cat8(l4, h4), q0, o[2]); TR_WAIT(4, l5, h5); o[2] = mfma32(cat8(l5, h5), q1, o[2]); TR_WAIT(2, l6, h6); o[3] = mfma32(cat8(l6, h6), q0, o[3]); TR_WAIT(0, l7, h7); o[3] = mfma32(cat8(l7, h7), q1, o[3]); }
                if (kp + 1 < 4) { *(LAS u32x4*)(lds + CR_V + (buf ^ 1) * (64 * CR_VP) + vl0) = r0; *(LAS u32x4*)(lds + CR_V + (buf ^ 1) * (64 * CR_VP) + vl0 + 128) = r1; }
                LBAR();
            }
            if (!(pv & 1)) {
#pragma unroll
                for (int c = 0; c < 4; ++c)
#pragma unroll
                    for (int g4 = 0; g4 < 4; ++g4) { u32x2 a; a.x = cvtpk(o[c][4 * g4] * inv, o[c][4 * g4 + 1] * inv); a.y = cvtpk(o[c][4 * g4 + 2] * inv, o[c][4 * g4 + 3] * inv); *(LAS u32x2*)(Tw + r32 * CR_OP + 64 * c + 16 * g4 + 8 * hi) = a; }
                unsigned char* yp = Os + 256 * hv + (lane & 15) * 16 + (size_t)(32 * w + (lane >> 4)) * 2048;
#pragma unroll
                for (int j = 0; j < 8; ++j) { const u32x4 v = *(const LAS u32x4*)(Tw + ((lane >> 4) + 4 * j) * CR_OP + (lane & 15) * 16); *(u32x4*)(yp + (size_t)j * (4 * 2048)) = v; }
            }
        }
    }
}
}


struct Frame {
    LAS unsigned char* lds;
    int tid, lane, wave, vcu, G;
};
__device__ __forceinline__ void p0_titem(const float* __restrict__ W, int Nsrc, int nsrc0, int k0, const float* __restrict__ g, const float* __restrict__ g2, int gsplit,
                                         bf16* __restrict__ WT, int K, int ndst0, LAS float* scr, int lane) {
#pragma unroll 8
    for (int i = 0; i < 32; ++i) { const int kk = 2 * i + (lane >> 5); const int k = k0 + kk;
        float gv = 1.f; if (g) gv = (g2 && k >= gsplit) ? g2[k - gsplit] : g[k];
        scr[kk * 33 + (lane & 31)] = W[(size_t)k * Nsrc + nsrc0 + (lane & 31)] * gv; }
    LDS_WAIT(); asm volatile("" ::: "memory");
    const int c = lane & 7;
#pragma unroll
    for (int j = 0; j < 4; ++j) { const int n = (lane >> 3) + 8 * j; const LAS float* s = scr + (8 * c) * 33 + n;
        v4u o; o.x = pk2(s[0 * 33], s[1 * 33]); o.y = pk2(s[2 * 33], s[3 * 33]); o.z = pk2(s[4 * 33], s[5 * 33]); o.w = pk2(s[6 * 33], s[7 * 33]);
        *(GAS v4u*)(WT + (size_t)(ndst0 + n) * K + k0 + 8 * c) = o; }
    LDS_WAIT(); asm volatile("" ::: "memory");
}
__device__ __forceinline__ void p0_norm_rows2(const float* __restrict__ x0, const float* __restrict__ x1, bf16* __restrict__ o0, bf16* __restrict__ o1, int lane) {
    const GAS f32x4* a = (const GAS f32x4*)x0 + lane; const GAS f32x4* b = (const GAS f32x4*)x1 + lane; f32x4 v[4], u[4]; float s = 0.f, t = 0.f;
#pragma unroll
    for (int j = 0; j < 4; ++j) { v[j] = a[64 * j]; u[j] = b[64 * j]; }
#pragma unroll
    for (int j = 0; j < 4; ++j) { s += (v[j].x * v[j].x + v[j].y * v[j].y) + (v[j].z * v[j].z + v[j].w * v[j].w); t += (u[j].x * u[j].x + u[j].y * u[j].y) + (u[j].z * u[j].z + u[j].w * u[j].w); }
    s = wave_sum(s); t = wave_sum(t);
    const float rs = rsqrtf(s * (1.f / DM) + EPS), rt = rsqrtf(t * (1.f / DM) + EPS);
    GAS unsigned long long* p = (GAS unsigned long long*)o0 + lane; GAS unsigned long long* q = (GAS unsigned long long*)o1 + lane;
#pragma unroll
    for (int j = 0; j < 4; ++j) { p[64 * j] = (unsigned long long)pk2(v[j].x * rs, v[j].y * rs) | ((unsigned long long)pk2(v[j].z * rs, v[j].w * rs) << 32);
        q[64 * j] = (unsigned long long)pk2(u[j].x * rt, u[j].y * rt) | ((unsigned long long)pk2(u[j].z * rt, u[j].w * rt) << 32); }
}

struct Args { const float* in[20]; float* out; unsigned char* ws; int ph_lo, ph_hi, att_mask, ss_dummy, bar_idx, variant; };
enum { PH_PRO = 0, PH_QKV = 1, PH_ATT = 2, PH_MERGE = 3, PH_OUT = 4, PH_QM = 5, PH_CROSS = 6, PH_OM = 7, PH_FFN1 = 8, PH_FIX = 9, PH_DOWN = 10, PH_N = 11 };

__global__ void __launch_bounds__(NWAVES * 64, 2) mega(Args args) {
    extern __shared__ __attribute__((aligned(16))) unsigned char lds_raw[];
    Frame F;
    F.lds = (LAS unsigned char*)lds_raw;
    F.tid = threadIdx.x; F.lane = F.tid & 63; F.wave = __builtin_amdgcn_readfirstlane(F.tid >> 6);
    F.G = gridDim.x; { const int bx = blockIdx.x; F.vcu = (F.G % 8 == 0) ? (bx % 8) * (F.G / 8) + bx / 8 : bx; }
    unsigned char* ws = args.ws;
    volatile LAS unsigned* MISC = (volatile LAS unsigned*)(F.lds + MISC_OFF);
    for (int u = F.tid; u < (LDS_BYTES - MISC_OFF) / 4; u += NWAVES * 64) ((LAS unsigned*)(F.lds + MISC_OFF))[u] = 0u;
    __syncthreads();
    const int lo = args.ph_lo, hi = args.ph_hi;
    unsigned* barw = (unsigned*)(ws + WS_CTL) + CW_BAR + args.bar_idx * XCD_BAR_WORDS;
    XcdBarrier bar; bar.bar = barw; bar.x = 0; bar.st = nullptr;
    if (hi - lo > 1 || (lo <= PH_DOWN && PH_DOWN < hi)) bar = xcd_barrier_post(barw, MISC + 8);
#define IN(k) (lo <= (k) && (k) < hi)
#define SEAM(k) do { if (IN(k) && IN((k) + 1)) xcd_barrier(bar); } while (0)

    const float* x = args.in[0]; const float* mem = args.in[1]; const float* w_in = args.in[2]; const float* g_mix = args.in[3]; const float* g_od = args.in[4];
    const float* g_om = args.in[5]; const float* w_out = args.in[6]; const float* rel_bias = args.in[7]; const float* g_cross = args.in[8]; const float* g_mem = args.in[9];
    const float* w_q = args.in[10]; const float* w_kv = args.in[11]; const float* w_o = args.in[12]; const float* g_ffn = args.in[13]; const float* w_gate = args.in[14];
    const float* w_up = args.in[15]; const float* conv_w = args.in[16]; const float* conv_b = args.in[17]; const float* w_down = args.in[18]; const float* g_final = args.in[19];
    float* RS0 = (float*)(ws + WS_RS0); float* RSM = (float*)(ws + WS_RSM); float* SS1 = (float*)(ws + WS_SS1); float* SS2 = (float*)(ws + WS_SS2); float* SS3 = (float*)(ws + WS_SS3);
    float* SSA = (float*)(ws + WS_SSA); float* SSB = (float*)(ws + WS_SSB);
    float* SA1 = SS1; float* SA2 = SS2; float* SA3 = SS3; float* SAA = SSA; float* SAB = SSB;
    if (0) { SA1 = SA2 = SA3 = SAA = SAB = (float*)(ws + WS_DUMMY); }
    float* LUT = (float*)(ws + WS_LUT); float* KMP = (float*)(ws + WS_KMP); float* HALOG = (float*)(ws + WS_HALOG); float* FIXG = (float*)(ws + WS_FIXG); float* FIXU = (float*)(ws + WS_FIXU); float* PS = (float*)(ws + WS_PS);
    bf16* WIN = (bf16*)(ws + WS_WIN); bf16* WOUT = (bf16*)(ws + WS_WOUT); bf16* WQ = (bf16*)(ws + WS_WQ); bf16* WKV = (bf16*)(ws + WS_WKV);
    bf16* WO = (bf16*)(ws + WS_WO); bf16* WGU = (bf16*)(ws + WS_WGU); bf16* WD = (bf16*)(ws + WS_WD);
    bf16* MEMB = (bf16*)(ws + WS_MEMB); bf16* KVM = (bf16*)(ws + WS_KVM); bf16* XB = (bf16*)(ws + WS_XB); bf16* QKV = (bf16*)(ws + WS_QKV);
    bf16* YN = (bf16*)(ws + WS_YN); bf16* Y = (bf16*)(ws + WS_Y); bf16* OP = (bf16*)(ws + WS_OP); float* LSEP = (float*)(ws + WS_LSEP); bf16* H1 = (bf16*)(ws + WS_H1); bf16* QM = (bf16*)(ws + WS_QM);
    bf16* OM = (bf16*)(ws + WS_OM); bf16* H2 = (bf16*)(ws + WS_H2); bf16* ACT = (bf16*)(ws + WS_ACT); bf16* H3 = (bf16*)(ws + WS_H3);
    const int gw = F.vcu * NWAVES + F.wave, NGW = F.G * NWAVES;
    const int gt = (int)blockIdx.x * (NWAVES * 64) + F.tid, NGT = F.G * NWAVES * 64;

    if (IN(PH_PRO)) {
        LAS float* scr = (LAS float*)(F.lds + RING_OFF + F.wave * 16384);
        constexpr int I_IN = 16 * 96, I_OUT = 16 * 32, I_Q = 16 * 32, I_KV = 16 * 64, I_O = 16 * 32, I_GU = 16 * 176, I_D = 44 * 32;
        constexpr int NITEMS = I_IN + I_OUT + I_Q + I_KV + I_O + I_GU + I_D;
        for (int it = gw; it < NITEMS; it += NGW) {
            int r = it;
            if (r < I_IN) { const int kb = r / 96, nb = r % 96; p0_titem(w_in, 3072, 32 * nb, 64 * kb, g_mix, nullptr, 0, WIN, 1024, 32 * nb, scr, F.lane); continue; } r -= I_IN;
            if (r < I_OUT) { const int kb = r / 32, nb = r % 32; p0_titem(w_out, 1024, 32 * nb, 64 * kb, g_od, g_om, 512, WOUT, 1024, 32 * nb, scr, F.lane); continue; } r -= I_OUT;
            if (r < I_Q) { const int kb = r / 32, nb = r % 32; p0_titem(w_q, 1024, 32 * nb, 64 * kb, g_cross, nullptr, 0, WQ, 1024, 32 * nb, scr, F.lane); continue; } r -= I_Q;
            if (r < I_KV) { const int kb = r / 64, nb = r % 64; p0_titem(w_kv, 2048, 32 * nb, 64 * kb, g_mem, nullptr, 0, WKV, 1024, 32 * nb, scr, F.lane); continue; } r -= I_KV;
            if (r < I_O) { const int kb = r / 32, nb = r % 32; p0_titem(w_o, 1024, 32 * nb, 64 * kb, nullptr, nullptr, 0, WO, 1024, 32 * nb, scr, F.lane); continue; } r -= I_O;
            if (r < I_GU) { const int kb = r / 176, nb = r % 176; const int nd = 32 * nb, j = nd >> 8, rr = nd & 255;
                const float* src = (rr < 128) ? w_gate : w_up; const int sc = 128 * j + (rr & 127);
                p0_titem(src, 2816, sc, 64 * kb, g_ffn, nullptr, 0, WGU, 1024, nd, scr, F.lane); continue; } r -= I_GU;
            { const int kb = r / 32, nb = r % 32; p0_titem(w_down, 1024, 32 * nb, 64 * kb, nullptr, nullptr, 0, WD, 2816, 32 * nb, scr, F.lane); }
        }
        for (int m = 2 * gw; m < NTOK; m += 2 * NGW) p0_norm_rows2(x + (size_t)m * DM, x + (size_t)(m + 1) * DM, XB + (size_t)m * DM, XB + (size_t)(m + 1) * DM, F.lane);
        for (int m = 2 * gw; m < NMEMTOK; m += 2 * NGW) p0_norm_rows2(mem + (size_t)m * DM, mem + (size_t)(m + 1) * DM, MEMB + (size_t)m * DM, MEMB + (size_t)(m + 1) * DM, F.lane);
        for (int i = gt; i < 16 * 2048; i += NGT) { const int h = i >> 11, n = i & 2047; int b;
            if (n < 16) b = n; else { b = 16 + (n >= 22) + (n >= 30) + (n >= 40) + (n >= 54) + (n >= 73) + (n >= 99) + (n >= 134) + (n >= 182) + (n >= 246) + (n >= 332) + (n >= 450) + (n >= 609) + (n >= 825) + (n >= 1117) + (n >= 1513); }
            LUT[i] = rel_bias[h * 32 + b]; }
        for (int i = gt; i < NTOK; i += NGT) { SA1[i] = 0.f; SA2[i] = 0.f; SAA[i] = 0.f; SAB[i] = 0.f; }
    }
    SEAM(PH_PRO);

#define STAGGER(ticks) do { const unsigned long long t0_ = __builtin_amdgcn_s_memrealtime(); const unsigned long long d_ = (unsigned long long)((F.vcu & 3) * (ticks)); \
        while (__builtin_amdgcn_s_memrealtime() - t0_ < d_) __builtin_amdgcn_s_sleep(32); } while (0)
    if (IN(PH_QKV)) {
        { pg8::Gemm g{XB, WIN, NTOK, NQKV, 1024}; pg8::StaticOrder S; S.init(NTOK, NQKV, F.G, (int)blockIdx.x);
          pg8::EpiScale E{(0   & 128) ? (bf16*)(ws + WS_H1) : QKV, RS0, (0   & 128) ? nullptr : KMP, NQKV, ((0   & 32) ? 64 : 0) | ((0   & 64) ? 128 : 0) | ((0   & 128) ? 256 : 0)};
          pg8::gemm_phase<pg8::EpiScale, pg8::StaticOrder, true, true>(F.lds + RING_OFF, g, S, E); }
        { pg8::Gemm g{MEMB, WKV, NMEMTOK, 2048, 1024}; pg8::StaticOrder S; S.init(NMEMTOK, 2048, F.G, (int)blockIdx.x);
          pg8::EpiScale E{KVM, RSM, nullptr, 2048, 0};
          pg8::gemm_phase<pg8::EpiScale, pg8::StaticOrder, true, true>(F.lds + RING_OFF, g, S, E); }
    }
    SEAM(PH_QKV);
        if (IN(PH_ATT)) {
        if (3 & 1) att::moba_phase(F.lds, QKV, KMP, LUT, 0   ? (bf16*)(ws + WS_H1) : Y, 0   ? nullptr : SAB, F.vcu, F.G, 0  );
        __syncthreads();
        if (3 & 2) att::dil_phase(F.lds, QKV, LUT, Y, SAA, F.vcu, F.G);
    }

    SEAM(PH_ATT);

    if (IN(PH_OUT)) {
        pg8::Gemm g{Y, WOUT, NTOK, DM, 1024}; pg8::StaticOrder S; S.init(NTOK, DM, F.G, (int)blockIdx.x);
        pg8::EpiOutProj E{H1, x, SA1, SSA, SSB, DM, 0};
        pg8::gemm_phase<pg8::EpiOutProj, pg8::StaticOrder, true, true>(F.lds + RING_OFF, g, S, E);
    }
    SEAM(PH_OUT);
    if (IN(PH_QM)) {
        pg8::Gemm g{H1, WQ, NTOK, DM, 1024}; pg8::StaticOrder S; S.init(NTOK, DM, F.G, (int)blockIdx.x);
        pg8::EpiScale E{QM, SS1, nullptr, DM, 1};
        pg8::gemm_phase<pg8::EpiScale, pg8::StaticOrder, true, true>(F.lds + RING_OFF, g, S, E);
    }
    SEAM(PH_QM);
        if (IN(PH_CROSS)) att::cross_phase(F.lds, QM, KVM, OM, F.vcu, F.G, (0   >> 12) & 3);

    SEAM(PH_CROSS);
    if (IN(PH_OM)) {
        pg8::Gemm g{OM, WO, NTOK, DM, 1024}; pg8::StaticOrder S; S.init(NTOK, DM, F.G, (int)blockIdx.x);
        pg8::EpiResid E{H2, H1, SA2, DM, 0};
        pg8::gemm_phase<pg8::EpiResid, pg8::StaticOrder, true, true>(F.lds + RING_OFF, g, S, E);
    }
    SEAM(PH_OM);
    if (IN(PH_FFN1)) {
        pg8::Gemm g{H2, WGU, NTOK, 5632, 1024}; pg8::StaticOrder S; S.init(NTOK, 5632, F.G, (int)blockIdx.x);
        pg8::EpiFfn1 E{ACT, SS2, conv_w, conv_b, HALOG, FIXG, FIXU, (LAS float*)(F.lds + LDSX_OFF), (0   >> 8) & 3, 0};
        pg8::gemm_phase<pg8::EpiFfn1, pg8::StaticOrder, true, true>(F.lds + RING_OFF, g, S, E);
    }
    SEAM(PH_FFN1);
    if (IN(PH_FIX)) {
        for (int i = gt; i < 256 * 2816; i += NGT) { const int pm = i / 2816, c = i % 2816;
            const float g0 = FIXG[((size_t)pm * 2 + 0) * 2816 + c], g1 = FIXG[((size_t)pm * 2 + 1) * 2816 + c];
            float hm1 = 0.f, hm2 = 0.f; if (pm & 7) { hm2 = HALOG[((size_t)(pm - 1) * 2 + 0) * 2816 + c]; hm1 = HALOG[((size_t)(pm - 1) * 2 + 1) * 2816 + c]; }
            const float w0 = conv_w[c], w1 = conv_w[2816 + c], w2 = conv_w[2 * 2816 + c], cbv = conv_b[c];
            const float c0 = cbv + w2 * g0 + w1 * hm1 + w0 * hm2, c1 = cbv + w2 * g1 + w1 * g0 + w0 * hm1;
            ACT[((size_t)pm * 256 + 0) * 2816 + c] = (bf16)f2bf(c0 / (1.f + __expf(-c0)) * FIXU[((size_t)pm * 2 + 0) * 2816 + c]);
            ACT[((size_t)pm * 256 + 1) * 2816 + c] = (bf16)f2bf(c1 / (1.f + __expf(-c1)) * FIXU[((size_t)pm * 2 + 1) * 2816 + c]); }
    }
    SEAM(PH_FIX);
    if (IN(PH_DOWN)) {
        pg8::Gemm g{ACT, WD, NTOK, DM, DFF}; pg8::StaticOrder S0; S0.init(NTOK, DM, F.G, (int)blockIdx.x);
        pg8::EpiFinal<XcdBarrier> E{H2, args.out, g_final, PS, &bar};
        { pg8::RoundOrder S{S0, 0}; pg8::gemm_phase<pg8::EpiFinal<XcdBarrier>, pg8::RoundOrder, false, true>(F.lds + RING_OFF, g, S, E); }
        __syncthreads();
        { pg8::RoundOrder S{S0, 1}; pg8::gemm_phase<pg8::EpiFinal<XcdBarrier>, pg8::RoundOrder, false, true>(F.lds + RING_OFF, g, S, E); }
        __syncthreads();
        { pg8::RoundOrder S{S0, 2}; pg8::gemm_phase<pg8::EpiFinal<XcdBarrier>, pg8::RoundOrder, false, true>(F.lds + RING_OFF, g, S, E); }
        __syncthreads();
        { pg8::RoundOrder S{S0, 3}; pg8::gemm_phase<pg8::EpiFinal<XcdBarrier>, pg8::RoundOrder, false, true>(F.lds + RING_OFF, g, S, E); }
    }
#undef IN
#undef SEAM
}


extern "C" void kernel_launch(void* const* d_in, const int* in_sizes, int n_in, void* d_out, int out_size, void* d_ws, size_t ws_size, hipStream_t stream) {
    static int grid = 0;
    if (grid == 0) {
        if (n_in != 20 || in_sizes[0] != NTOK * DM || out_size != NTOK * DM || ws_size < WS_END) { fprintf(stderr, "kernel_launch: unexpected shapes (n_in %d, ws %zu); nothing launched\n", n_in, ws_size); grid = -1; return; }
        int dev = 0, cus = 0, per_cu = 0;
        if (hipGetDevice(&dev) != hipSuccess || hipDeviceGetAttribute(&cus, hipDeviceAttributeMultiprocessorCount, dev) != hipSuccess) { grid = -1; return; }
        if (hipFuncSetAttribute((const void*)mega, hipFuncAttributeMaxDynamicSharedMemorySize, LDS_BYTES) != hipSuccess) { fprintf(stderr, "kernel_launch: hipFuncSetAttribute failed\n"); grid = -1; return; }
        if (hipOccupancyMaxActiveBlocksPerMultiprocessor(&per_cu, (const void*)mega, NWAVES * 64, LDS_BYTES) != hipSuccess || per_cu < 1) fprintf(stderr, "kernel_launch: occupancy query says %d\n", per_cu);
        (void)hipGetLastError();
        grid = cus;
        if (grid != NTOK / 256) { fprintf(stderr, "kernel_launch: this kernel needs exactly %d workgroups (one per CU of a 256-CU device); found %d CUs\n", NTOK / 256, cus); grid = NTOK / 256; }
    }
    if (grid < 0) return;
    unsigned char* ws = (unsigned char*)d_ws;
    (void)hipMemsetAsync(ws + WS_CTL, 0, CTL_ZERO_BYTES, stream);
    Args a{};
    for (int i = 0; i < 20; ++i) a.in[i] = (const float*)d_in[i];
    a.out = (float*)d_out; a.ws = ws; a.att_mask = 3;
    int nbar = 0;
    auto runx = [&](int lo, int hi, int mask, int dummy, int variant = 0) { Args b2 = a; b2.variant = variant; b2.bar_idx = (hi - lo > 1 || (lo <= PH_DOWN && PH_DOWN < hi)) ? nbar++ : 0; b2.ph_lo = lo; b2.ph_hi = hi; b2.att_mask = mask; b2.ss_dummy = dummy; hipLaunchKernelGGL(mega, dim3(grid), dim3(NWAVES * 64), LDS_BYTES, stream, b2); };
    auto run = [&](int lo, int hi) { runx(lo, hi, 3, 0); };
    run(0, PH_N);
}
```

```cpp
#include <hip/hip_runtime.h>
#include <cstdio>
#include <cstdint>

typedef unsigned short bf16;
constexpr int BATCH = 32, SEQ = 2048, DM = 1024, NTOK = BATCH * SEQ;
constexpr int NMEM = 256, NMEMTOK = BATCH * NMEM, DFF = 2816;
constexpr int NQKV = 3072;
constexpr float EPS = 1e-6f;

constexpr size_t MiB = 1u << 20;
constexpr size_t WS_CTL = 0, CTL_ZERO_BYTES = 64 * 1024;
constexpr size_t WS_RS0 = 1 * MiB;
constexpr size_t WS_RSM = WS_RS0 + 256 * 1024;
constexpr size_t WS_SS1 = WS_RSM + 256 * 1024;
constexpr size_t WS_SS2 = WS_SS1 + 256 * 1024;
constexpr size_t WS_SS3 = WS_SS2 + 256 * 1024;
constexpr size_t WS_SSA = 27 * MiB, WS_SSB = WS_SSA + 256 * 1024;
constexpr size_t WS_KMEAN = WS_SS3 + 256 * 1024;
constexpr size_t WS_LUT = WS_KMEAN + 512 * 1024;
constexpr size_t WS_KMP = 3 * MiB;
constexpr size_t WS_HALOG = 4 * MiB;
constexpr size_t WS_FIXG = WS_HALOG + 256 * 2 * 2816 * 4;
constexpr size_t WS_FIXU = WS_FIXG + 256 * 2 * 2816 * 4;
constexpr size_t WS_DUMMY = 21 * MiB;
constexpr size_t WS_PS = 22 * MiB;
constexpr size_t WS_LSEP = 23 * MiB;
constexpr size_t WS_WIN = 28 * MiB;
constexpr size_t WS_WOUT = WS_WIN + 6 * MiB;
constexpr size_t WS_WQ = WS_WOUT + 2 * MiB;
constexpr size_t WS_WKV = WS_WQ + 2 * MiB;
constexpr size_t WS_WO = WS_WKV + 4 * MiB;
constexpr size_t WS_WGU = WS_WO + 2 * MiB;
constexpr size_t WS_WD = WS_WGU + 11 * MiB;
constexpr size_t WS_MEMB = 62 * MiB;
constexpr size_t WS_KVM = 78 * MiB;
constexpr size_t WS_XB = 112 * MiB;
constexpr size_t WS_QKV = 240 * MiB;
constexpr size_t WS_Y = 624 * MiB;
constexpr size_t WS_OP = 752 * MiB;
constexpr size_t WS_YN = 240 * MiB;
constexpr size_t WS_H1 = 880 * MiB;
constexpr size_t WS_QM = 368 * MiB;
constexpr size_t WS_OM = 496 * MiB;
constexpr size_t WS_H2 = 624 * MiB;
constexpr size_t WS_ACT = 112 * MiB;
constexpr size_t WS_GU = 752 * MiB;
constexpr size_t WS_H3 = 464 * MiB;
constexpr size_t WS_END = 1024 * MiB;
static_assert(WS_FIXU + 256 * 2 * 2816 * 4 <= WS_LSEP && WS_LSEP + 5 * MiB <= WS_WIN && WS_WD + 6 * MiB <= WS_MEMB, "ws map");

__device__ __forceinline__ unsigned f2bf(float f) { unsigned u = __builtin_bit_cast(unsigned, f); return (u + 0x7fffu + ((u >> 16) & 1u)) >> 16; }
__device__ __forceinline__ float bf2f(bf16 b) { return __builtin_bit_cast(float, (unsigned)b << 16); }
__device__ __forceinline__ float bflo(unsigned w) { return __builtin_bit_cast(float, w << 16); }
__device__ __forceinline__ float bfhi(unsigned w) { return __builtin_bit_cast(float, w & 0xffff0000u); }
__device__ __forceinline__ float wave_sum(float v) {
#pragma unroll
    for (int o = 1; o < 64; o <<= 1) v += __shfl_xor(v, o);
    return v;
}


namespace pg8 {
#define PG8_LAS __attribute__((address_space(3)))
typedef unsigned short bf16_t;
typedef short bf16x8 __attribute__((ext_vector_type(8)));
typedef float f32x4 __attribute__((ext_vector_type(4)));
typedef unsigned u32x4 __attribute__((ext_vector_type(4)));
constexpr int BM = 256, BK = 64, HALF = 128, HTB = HALF * BK * 2  , STAGE_BYTES = 8 * HTB, NXCD = 8, WGM = 8;

__host__ __device__ __forceinline__ int lds_byte(int r, int c) { const int st = (r >> 4) * 2 + (c >> 5), rr = r & 15, cc = c & 31, ob = rr * 64 + cc * 2; return st * 1024 + (ob ^ (((ob >> 9) & 1) << 5)); }
__host__ __device__ __forceinline__ void stage_rc(int b, int& R, int& C) { const int st = b / 1024, sb = b % 1024, swz = sb ^ (((sb >> 9) & 1) << 5); R = (st >> 1) * 16 + swz / 64; C = (st & 1) * 32 + (swz % 64) / 2; }
__host__ __device__ __forceinline__ int perm32(int rho) { const int n = rho >> 4, i = rho & 15; return 8 * (i >> 2) + 4 * n + (i & 3); }

struct Unit { int pm, pn; };
struct Gemm { const bf16_t* A; const bf16_t* Bt; int M, N, K; };

struct StaticOrder {
    int nM, nN, nwg, G, c;
    __host__ __device__ void init(int M, int N, int G_, int c_) { nM = M / BM; nN = N / BM; nwg = nM * nN; G = G_; c = c_; }
    __host__ __device__ bool next(int i, Unit& u) const {
        const long L = (long)i * G + c; if (L >= nwg) return false;
        int wgid = (int)L; { const int q = nwg / NXCD, r = nwg % NXCD, xcd = wgid % NXCD, off = wgid / NXCD; wgid = (xcd < r ? xcd * (q + 1) : r * (q + 1) + (xcd - r) * q) + off; }
        const int nig = WGM * nN, gid = wgid / nig, fm = gid * WGM, gsz = (nM - fm) < WGM ? (nM - fm) : WGM;
        u.pm = fm + ((wgid % nig) % gsz); u.pn = (wgid % nig) / gsz; return true;
    }
    __device__ __forceinline__ void a_ready(const Unit&) const {}
    __device__ __forceinline__ void done(const Unit&) const {}
};


struct PanelOrder { int pm, nN;
    __device__ __forceinline__ bool next(int i, Unit& u) const { if (i >= nN) return false; int a = pm, b = i; asm volatile("" : "+s"(a), "+s"(b)); u.pm = a; u.pn = b; return true; }
    __device__ __forceinline__ void a_ready(const Unit&) const {}
    __device__ __forceinline__ void done(const Unit&) const {} };
__device__ __forceinline__ unsigned cvt_pk_bf16(float lo, float hi) { unsigned r; asm volatile("v_cvt_pk_bf16_f32 %0, %1, %2" : "=v"(r) : "v"(lo), "v"(hi)); return r; }
__device__ __forceinline__ float lo_f(unsigned w) { return __builtin_bit_cast(float, w << 16); }
__device__ __forceinline__ float hi_f(unsigned w) { return __builtin_bit_cast(float, w & 0xffff0000u); }

struct EpiScale {
    static constexpr bool PERM = true, AFTER_DRAIN = false, KSPLIT = false, PERM_A = false;
    bf16_t* O; const float* rs; float* kmp; int ldc; int mode;
    __device__ __forceinline__ void operator()(const f32x4 (&acc)[2][2][4][2], const Unit& u, int wr, int wc, int fr, int fq) const {
        if (mode & 64) return;
        const int row0 = u.pm * BM + wr * 64 + fr, col0 = u.pn * BM + wc * 32 + 8 * fq;
        const bool dokm = (kmp != nullptr) && (u.pn == 8 || u.pn == 9);
        const float qs = ((kmp != nullptr) && (u.pn < 2 || u.pn == 6 || u.pn == 7)) ? 0.125f * 1.4426950408889634f : 1.f;
        float cs[2][8];
#pragma unroll
        for (int bj = 0; bj < 2; ++bj)
#pragma unroll
            for (int e = 0; e < 8; ++e) cs[bj][e] = 0.f;
#pragma unroll
        for (int ai = 0; ai < 2; ++ai)
#pragma unroll
            for (int m = 0; m < 4; ++m) { const int r = row0 + ai * HALF + m * 16; float s = qs; if (mode == 1) s = rsqrtf(rs[r] * (1.f / 1024.f) + 1e-6f);
                bf16_t* rowp = (mode & 256) ? O + (size_t)(r & 255) * ldc + col0 : O + (size_t)r * ldc + col0;
#pragma unroll
                for (int bj = 0; bj < 2; ++bj) { const f32x4 v0 = acc[ai][bj][m][0] * s, v1 = acc[ai][bj][m][1] * s;
                    u32x4 w; w.x = cvt_pk_bf16(v0[0], v0[1]); w.y = cvt_pk_bf16(v0[2], v0[3]); w.z = cvt_pk_bf16(v1[0], v1[1]); w.w = cvt_pk_bf16(v1[2], v1[3]);
                    if (mode & 128) { asm volatile("" :: "v"(w.x), "v"(w.y), "v"(w.z), "v"(w.w)); } else *(u32x4*)(rowp + bj * HALF) = w;
                    if (dokm) { cs[bj][0] += lo_f(w.x); cs[bj][1] += hi_f(w.x); cs[bj][2] += lo_f(w.y); cs[bj][3] += hi_f(w.y); cs[bj][4] += lo_f(w.z); cs[bj][5] += hi_f(w.z); cs[bj][6] += lo_f(w.w); cs[bj][7] += hi_f(w.w); } } }
        if (dokm) {
#pragma unroll
            for (int bj = 0; bj < 2; ++bj)
#pragma unroll
                for (int e = 0; e < 8; ++e) { float v = cs[bj][e]; v += __shfl_xor(v, 1); v += __shfl_xor(v, 2); v += __shfl_xor(v, 4); v += __shfl_xor(v, 8); cs[bj][e] = v; }
            if (fr == 0) { float* kp = kmp + (size_t)(u.pm * 2 + wr) * 512 + (u.pn - 8) * 256 + wc * 32 + 8 * fq;
#pragma unroll
                for (int bj = 0; bj < 2; ++bj) { *(f32x4*)(kp + bj * HALF) = (f32x4){cs[bj][0], cs[bj][1], cs[bj][2], cs[bj][3]}; *(f32x4*)(kp + bj * HALF + 4) = (f32x4){cs[bj][4], cs[bj][5], cs[bj][6], cs[bj][7]}; } }
        }
    }
};

struct EpiResid {
    static constexpr bool PERM = true, AFTER_DRAIN = false, KSPLIT = false, PERM_A = false;
    bf16_t* O; const bf16_t* R; float* ss; int ldc; int pad;
    __device__ __forceinline__ void operator()(const f32x4 (&acc)[2][2][4][2], const Unit& u, int wr, int wc, int fr, int fq) const {
        const int row0 = u.pm * BM + wr * 64 + fr, col0 = u.pn * BM + wc * 32 + 8 * fq;
#pragma unroll
        for (int ai = 0; ai < 2; ++ai)
#pragma unroll
            for (int m = 0; m < 4; ++m) { const int r = row0 + ai * HALF + m * 16; const size_t off = (size_t)r * ldc + col0; float sq = 0.f;
#pragma unroll
                for (int bj = 0; bj < 2; ++bj) { const u32x4 rv = *(const u32x4*)(R + off + bj * HALF);
                    const f32x4 a0 = acc[ai][bj][m][0], a1 = acc[ai][bj][m][1];
                    u32x4 w; w.x = cvt_pk_bf16(a0[0] + lo_f(rv.x), a0[1] + hi_f(rv.x)); w.y = cvt_pk_bf16(a0[2] + lo_f(rv.y), a0[3] + hi_f(rv.y));
                    w.z = cvt_pk_bf16(a1[0] + lo_f(rv.z), a1[1] + hi_f(rv.z)); w.w = cvt_pk_bf16(a1[2] + lo_f(rv.w), a1[3] + hi_f(rv.w));
                    *(u32x4*)(O + off + bj * HALF) = w;
                    float t;
                    t = lo_f(w.x); sq += t * t; t = hi_f(w.x); sq += t * t; t = lo_f(w.y); sq += t * t; t = hi_f(w.y); sq += t * t;
                    t = lo_f(w.z); sq += t * t; t = hi_f(w.z); sq += t * t; t = lo_f(w.w); sq += t * t; t = hi_f(w.w); sq += t * t; }
                sq += __shfl_xor(sq, 16); sq += __shfl_xor(sq, 32);
                if (fq == 0) atomicAdd(ss + r, sq); }
    }
};


struct EpiResidF32 {
    static constexpr bool PERM = true, AFTER_DRAIN = false, KSPLIT = false, PERM_A = false;
    bf16_t* O; const float* R; float* ss; int ldc; int pad;
    __device__ __forceinline__ void operator()(const f32x4 (&acc)[2][2][4][2], const Unit& u, int wr, int wc, int fr, int fq) const {
        const int row0 = u.pm * BM + wr * 64 + fr, col0 = u.pn * BM + wc * 32 + 8 * fq;
#pragma unroll
        for (int ai = 0; ai < 2; ++ai)
#pragma unroll
            for (int m = 0; m < 4; ++m) { const int r = row0 + ai * HALF + m * 16; const size_t off = (size_t)r * ldc + col0; float sq = 0.f;
#pragma unroll
                for (int bj = 0; bj < 2; ++bj) { const f32x4 r0 = *(const f32x4*)(R + off + bj * HALF), r1 = *(const f32x4*)(R + off + bj * HALF + 4);
                    const f32x4 a0 = acc[ai][bj][m][0] + r0, a1 = acc[ai][bj][m][1] + r1;
                    u32x4 w; w.x = cvt_pk_bf16(a0[0], a0[1]); w.y = cvt_pk_bf16(a0[2], a0[3]); w.z = cvt_pk_bf16(a1[0], a1[1]); w.w = cvt_pk_bf16(a1[2], a1[3]);
                    *(u32x4*)(O + off + bj * HALF) = w;
                    float t;
                    t = lo_f(w.x); sq += t * t; t = hi_f(w.x); sq += t * t; t = lo_f(w.y); sq += t * t; t = hi_f(w.y); sq += t * t;
                    t = lo_f(w.z); sq += t * t; t = hi_f(w.z); sq += t * t; t = lo_f(w.w); sq += t * t; t = hi_f(w.w); sq += t * t; }
                sq += __shfl_xor(sq, 16); sq += __shfl_xor(sq, 32);
                if (fq == 0) atomicAdd(ss + r, sq); }
    }
};


struct EpiOutProj {
    static constexpr bool PERM = true, AFTER_DRAIN = false, KSPLIT = true, PERM_A = false;
    bf16_t* O; const float* R; float* ss; const float* ssa; const float* ssb; int ldc; int pad;
    __device__ __forceinline__ void mid(f32x4 (&acc)[2][2][4][2], const Unit& u, int wr, int fr) const {
        asm volatile("" : "+v"(fr));
#pragma unroll
        for (int ai = 0; ai < 2; ++ai) {
#pragma unroll
            for (int m = 0; m < 4; ++m) { const int r = u.pm * BM + ai * HALF + wr * 64 + m * 16 + fr;
                const float ratio = rsqrtf(ssa[r] * (1.f / 512.f) + 1e-6f) * sqrtf(ssb[r] * (1.f / 512.f) + 1e-6f);
#pragma unroll
                for (int bj = 0; bj < 2; ++bj) { acc[ai][bj][m][0] *= ratio; acc[ai][bj][m][1] *= ratio; } }
            asm volatile("" ::: "memory"); __builtin_amdgcn_sched_barrier(0); }
    }
    __device__ __forceinline__ void operator()(const f32x4 (&acc)[2][2][4][2], const Unit& u, int wr, int wc, int fr, int fq) const {
        const int row0 = u.pm * BM + wr * 64 + fr, col0 = u.pn * BM + wc * 32 + 8 * fq;
#pragma unroll
        for (int ai = 0; ai < 2; ++ai)
#pragma unroll
            for (int m = 0; m < 4; ++m) { const int r = row0 + ai * HALF + m * 16; const size_t off = (size_t)r * ldc + col0; float sq = 0.f;
                const float rsb = rsqrtf(ssb[r] * (1.f / 512.f) + 1e-6f);
#pragma unroll
                for (int bj = 0; bj < 2; ++bj) { const f32x4 r0 = *(const f32x4*)(R + off + bj * HALF), r1 = *(const f32x4*)(R + off + bj * HALF + 4);
                    const f32x4 a0 = acc[ai][bj][m][0] * rsb + r0, a1 = acc[ai][bj][m][1] * rsb + r1;
                    u32x4 w; w.x = cvt_pk_bf16(a0[0], a0[1]); w.y = cvt_pk_bf16(a0[2], a0[3]); w.z = cvt_pk_bf16(a1[0], a1[1]); w.w = cvt_pk_bf16(a1[2], a1[3]);
                    *(u32x4*)(O + off + bj * HALF) = w;
                    float t;
                    t = lo_f(w.x); sq += t * t; t = hi_f(w.x); sq += t * t; t = lo_f(w.y); sq += t * t; t = hi_f(w.y); sq += t * t;
                    t = lo_f(w.z); sq += t * t; t = hi_f(w.z); sq += t * t; t = lo_f(w.w); sq += t * t; t = hi_f(w.w); sq += t * t; }
                sq += __shfl_xor(sq, 16); sq += __shfl_xor(sq, 32);
                if (fq == 0) atomicAdd(ss + r, sq); }
    }
};

struct RoundOrder { StaticOrder S; int r;
    __device__ __forceinline__ bool next(int i, Unit& u) const { return i == 0 && S.next(r, u); }
    __device__ __forceinline__ void a_ready(const Unit&) const {}
    __device__ __forceinline__ void done(const Unit&) const {} };
template <class Bar> struct EpiFinal {
    static constexpr bool PERM = false, AFTER_DRAIN = true, KSPLIT = false, PERM_A = false;
    const bf16_t* R; float* out; const float* g; float* ps; const Bar* bar;
    __device__ __forceinline__ void fused(f32x4 (&acc)[2][2][4][2], const Unit& u, int wr, int wc, int fr, int fq, PG8_LAS unsigned char* lds, int wid, int lane) const {
        typedef unsigned u32x2v __attribute__((ext_vector_type(2)));
        PG8_LAS float* P = (PG8_LAS float*)lds;
        PG8_LAS float* S = (PG8_LAS float*)(lds + 4096);
        const int col0 = u.pn * BM + wc * 32 + 4 * fq, tid = wid * 64 + lane;
#pragma unroll
        for (int ai = 0; ai < 2; ++ai)
#pragma unroll
            for (int m = 0; m < 4; ++m) { const int rl = ai * HALF + wr * 64 + m * 16 + fr; const size_t off = (size_t)(u.pm * BM + rl) * 1024 + col0; float sq = 0.f;
#pragma unroll
                for (int bj = 0; bj < 2; ++bj)
#pragma unroll
                    for (int n = 0; n < 2; ++n) { const u32x2v rv = *(const u32x2v*)(R + off + bj * HALF + n * 16);
                        f32x4 v = acc[ai][bj][m][n]; v[0] += lo_f(rv.x); v[1] += hi_f(rv.x); v[2] += lo_f(rv.y); v[3] += hi_f(rv.y); acc[ai][bj][m][n] = v;
                        sq += (v[0] * v[0] + v[1] * v[1]) + (v[2] * v[2] + v[3] * v[3]); }
                sq += __shfl_xor(sq, 16); sq += __shfl_xor(sq, 32);
                if (fq == 0) P[rl * 4 + wc] = sq; }
        asm volatile("s_waitcnt lgkmcnt(0)" ::: "memory"); __builtin_amdgcn_s_barrier(); asm volatile("" ::: "memory");
        if (tid < 256) { const f32x4 p4 = *(const PG8_LAS f32x4*)(P + tid * 4); ps[(size_t)(u.pm * BM + tid) * 4 + u.pn] = (p4[0] + p4[1]) + (p4[2] + p4[3]); }
        xcd_barrier(*bar);
        if (tid < 256) { const f32x4 q4 = *(const f32x4*)(ps + (size_t)(u.pm * BM + tid) * 4); S[tid] = rsqrtf(((q4[0] + q4[1]) + (q4[2] + q4[3])) * (1.f / 1024.f) + 1e-6f); }
        asm volatile("s_waitcnt vmcnt(0) lgkmcnt(0)" ::: "memory"); __builtin_amdgcn_s_barrier(); asm volatile("" ::: "memory");
        f32x4 gv[2][2];
#pragma unroll
        for (int bj = 0; bj < 2; ++bj)
#pragma unroll
            for (int n = 0; n < 2; ++n) gv[bj][n] = *(const f32x4*)(g + col0 + bj * HALF + n * 16);
#pragma unroll
        for (int ai = 0; ai < 2; ++ai)
#pragma unroll
            for (int m = 0; m < 4; ++m) { const int rl = ai * HALF + wr * 64 + m * 16 + fr; const float rs = S[rl]; const size_t off = (size_t)(u.pm * BM + rl) * 1024 + col0;
#pragma unroll
                for (int bj = 0; bj < 2; ++bj)
#pragma unroll
                    for (int n = 0; n < 2; ++n) *(f32x4*)(out + off + bj * HALF + n * 16) = acc[ai][bj][m][n] * rs * gv[bj][n]; }
        asm volatile("s_waitcnt lgkmcnt(0)" ::: "memory"); __builtin_amdgcn_s_barrier(); asm volatile("" ::: "memory");
    }
};

__device__ __forceinline__ float dpp_shr1(float oldv, float src) { return __builtin_bit_cast(float, __builtin_amdgcn_update_dpp(__builtin_bit_cast(int, oldv), __builtin_bit_cast(int, src), 0x111, 0xf, 0xf, false)); }
__device__ __forceinline__ float dpp_shr2(float oldv, float src) { return __builtin_bit_cast(float, __builtin_amdgcn_update_dpp(__builtin_bit_cast(int, oldv), __builtin_bit_cast(int, src), 0x112, 0xf, 0xf, false)); }
__device__ __forceinline__ float dpp_ror1(float src) { return __builtin_bit_cast(float, __builtin_amdgcn_update_dpp(0, __builtin_bit_cast(int, src), 0x121, 0xf, 0xf, false)); }
__device__ __forceinline__ float dpp_ror2(float src) { return __builtin_bit_cast(float, __builtin_amdgcn_update_dpp(0, __builtin_bit_cast(int, src), 0x122, 0xf, 0xf, false)); }
struct EpiFfn1 {
    static constexpr bool PERM = true, AFTER_DRAIN = false, KSPLIT = false, PERM_A = true;
    bf16_t* ACT; const float* ss2; const float* cw; const float* cb; float* halog; float* fixg; float* fixu; PG8_LAS float* hl; int probe, pad;
    __device__ __forceinline__ void operator()(const f32x4 (&acc)[2][2][4][2], const Unit& u, int wr, int wc, int fr, int fq) const {
        constexpr int FF = 2816;
        if (probe & 1) return;
        const int ch0 = u.pn * HALF + wc * 32 + 8 * fq;
        float rsv[2][4];
#pragma unroll
        for (int ai = 0; ai < 2; ++ai) { const f32x4 s4 = *(const f32x4*)(ss2 + u.pm * BM + ai * HALF + wr * 64 + 4 * fr);
#pragma unroll
            for (int m = 0; m < 4; ++m) rsv[ai][m] = rsqrtf(s4[m] * (1.f / 1024.f) + 1e-6f); }
        if (fr == 15) {
#pragma unroll
            for (int ai = 0; ai < 2; ++ai) { const int G = 2 * ai + wr;
#pragma unroll
                for (int j = 0; j < 2; ++j) { PG8_LAS float* p = hl + (((G * 4 + wc) * 2 + j) * 4 + fq) * 8;
                    *(PG8_LAS f32x4*)p = acc[ai][0][2 + j][0] * rsv[ai][2 + j]; *(PG8_LAS f32x4*)(p + 4) = acc[ai][0][2 + j][1] * rsv[ai][2 + j]; } } }
        constexpr float L2E = 1.4426950408889634f, IL2E = 0.6931471805599453f;
        const f32x4 w0a = *(const f32x4*)(cw + ch0) * L2E, w0b = *(const f32x4*)(cw + ch0 + 4) * L2E, w1a = *(const f32x4*)(cw + FF + ch0) * L2E, w1b = *(const f32x4*)(cw + FF + ch0 + 4) * L2E;
        const f32x4 w2a = *(const f32x4*)(cw + 2 * FF + ch0) * L2E, w2b = *(const f32x4*)(cw + 2 * FF + ch0 + 4) * L2E, cba = *(const f32x4*)(cb + ch0) * L2E, cbb = *(const f32x4*)(cb + ch0 + 4) * L2E;
        asm volatile("s_waitcnt lgkmcnt(0)" ::: "memory"); __builtin_amdgcn_s_barrier(); asm volatile("" ::: "memory");
#pragma unroll
        for (int ai = 0; ai < 2; ++ai) { const int G = 2 * ai + wr; const int rbase = u.pm * BM + ai * HALF + wr * 64 + 4 * fr;
            f32x4 h2a = (f32x4){0.f, 0.f, 0.f, 0.f}, h2b = h2a, h3a = h2a, h3b = h2a;
            if (G > 0 && fr == 0) { const PG8_LAS float* p = hl + ((((G - 1) * 4 + wc) * 2) * 4 + fq) * 8; h2a = *(const PG8_LAS f32x4*)p; h2b = *(const PG8_LAS f32x4*)(p + 4); h3a = *(const PG8_LAS f32x4*)(p + 32); h3b = *(const PG8_LAS f32x4*)(p + 36); }
            f32x4 g[4][2], uu[4][2];
#pragma unroll
            for (int m = 0; m < 4; ++m) { const float s = rsv[ai][m]; g[m][0] = acc[ai][0][m][0] * s; g[m][1] = acc[ai][0][m][1] * s; uu[m][0] = acc[ai][1][m][0] * (s * IL2E); uu[m][1] = acc[ai][1][m][1] * (s * IL2E); }
            f32x4 s2[2], s3[2];
#pragma unroll
            for (int e = 0; e < 4; ++e) { s3[0][e] = dpp_shr1(h3a[e], g[3][0][e]); s3[1][e] = dpp_shr1(h3b[e], g[3][1][e]); s2[0][e] = dpp_shr1(h2a[e], g[2][0][e]); s2[1][e] = dpp_shr1(h2b[e], g[2][1][e]); }
#pragma unroll
            for (int m = 0; m < 4; ++m) {
                f32x4 o[2];
#pragma unroll
                for (int hx = 0; hx < 2; ++hx) { const f32x4 w0 = hx ? w0b : w0a, w1 = hx ? w1b : w1a, w2 = hx ? w2b : w2a, cbx = hx ? cbb : cba;
                    const f32x4 g1 = (m == 0) ? s3[hx] : g[m - 1][hx], g2 = (m == 0) ? s2[hx] : (m == 1 ? s3[hx] : g[m - 2][hx]);
#pragma unroll
                    for (int e = 0; e < 4; ++e) { const float c = __builtin_fmaf(w0[e], g2[e], __builtin_fmaf(w1[e], g1[e], __builtin_fmaf(w2[e], g[m][hx][e], cbx[e])));
                        o[hx][e] = c * __builtin_amdgcn_rcpf(1.f + __builtin_amdgcn_exp2f(-c)) * uu[m][hx][e]; } }
                const bool defer = (G == 0 && fr == 0 && m < 2);
                if (defer) { float* pg = fixg + ((size_t)u.pm * 2 + m) * FF + ch0; float* pu = fixu + ((size_t)u.pm * 2 + m) * FF + ch0;
                    *(f32x4*)pg = g[m][0]; *(f32x4*)(pg + 4) = g[m][1]; *(f32x4*)pu = uu[m][0] * L2E; *(f32x4*)(pu + 4) = uu[m][1] * L2E; }
                else { u32x4 w; w.x = cvt_pk_bf16(o[0][0], o[0][1]); w.y = cvt_pk_bf16(o[0][2], o[0][3]); w.z = cvt_pk_bf16(o[1][0], o[1][1]); w.w = cvt_pk_bf16(o[1][2], o[1][3]);
                    if (probe & 2) { asm volatile("" :: "v"(w.x), "v"(w.y), "v"(w.z), "v"(w.w)); } else *(u32x4*)(ACT + (size_t)(rbase + m) * FF + ch0) = w; }
                if (G == 3 && fr == 15 && m >= 2) { float* ph = halog + ((size_t)u.pm * 2 + (m - 2)) * FF + ch0; *(f32x4*)ph = g[m][0]; *(f32x4*)(ph + 4) = g[m][1]; } } }
    }
};

template <class Epi, class Sched, bool ALIGN_EPI = false, bool SP2 = false>
__device__ __forceinline__ void gemm_phase(PG8_LAS unsigned char* lds, const Gemm g, const Sched& S, const Epi& E) {
    int tid_ = threadIdx.x; asm volatile("" : "+v"(tid_));
    const int tid = tid_, wid = __builtin_amdgcn_readfirstlane(tid >> 6), lane = tid & 63, wr = wid >> 2, wc = wid & 3, fr = lane & 15, fq = lane >> 4;
    const int K = g.K, nt = K / BK;
    unsigned voffA[2], voffB[2];
#pragma unroll
    for (int i = 0; i < 2; ++i) { int R, C; stage_rc(tid * 16 + i * 8192, R, C); const int Rb = Epi::PERM ? ((R & ~31) + perm32(R & 31)) : R;
        const int Ra = Epi::PERM_A ? ((R & ~63) + 4 * (R & 15) + ((R >> 4) & 3)) : R;
        voffA[i] = (unsigned)(Ra * K + C) * 2u; voffB[i] = (unsigned)(Rb * K + C) * 2u; }
    const size_t kstep = (size_t)(BK * 2);
    const size_t hstep = (size_t)HALF * K * 2;
    const size_t tstep = 2 * hstep;
    const unsigned ldsw = (unsigned)wid * 1024u;
    const int aoff = lds_byte(wr * 64 + fr, fq * 8), boff = lds_byte(wc * 32 + fr, fq * 8);
#define PG8_SA(b, h) (((b) * 2 + (h)) * HTB)
#define PG8_SB(b, h) ((4 + (b) * 2 + (h)) * HTB)
#define PG8_STAGE(bufoff, gbase, voff) do { _Pragma("unroll") for (int _i = 0; _i < 2; ++_i) \
        __builtin_amdgcn_global_load_lds((const unsigned*)((const char*)(gbase) + (voff)[_i]), (PG8_LAS unsigned*)(lds + (bufoff) + ldsw + _i * 8192), 16, 0, 0); } while (0)
#define PG8_LDA(dst, b, h) do { _Pragma("unroll") for (int m = 0; m < 4; ++m) _Pragma("unroll") for (int k = 0; k < 2; ++k) dst[m][k] = *(const PG8_LAS bf16x8*)(lds + PG8_SA(b, h) + aoff + m * 2048 + k * 1024); } while (0)
#define PG8_LDB(dst, b, h) do { _Pragma("unroll") for (int n = 0; n < 2; ++n) _Pragma("unroll") for (int k = 0; k < 2; ++k) dst[n][k] = *(const PG8_LAS bf16x8*)(lds + PG8_SB(b, h) + boff + n * 2048 + k * 1024); } while (0)
#define PG8_MMA(ai, bj, At, Bt) do { __builtin_amdgcn_s_setprio(1); _Pragma("unroll") for (int m = 0; m < 4; ++m) _Pragma("unroll") for (int n = 0; n < 2; ++n) _Pragma("unroll") for (int k = 0; k < 2; ++k) \
        acc[ai][bj][m][n] = __builtin_amdgcn_mfma_f32_16x16x32_bf16(Bt[n][k], At[m][k], acc[ai][bj][m][n], 0, 0, 0); __builtin_amdgcn_s_setprio(0); } while (0)
#define PG8_WAIT_V(n) asm volatile("s_waitcnt vmcnt(" #n ")" ::: "memory")
#define PG8_WAIT_L(n) asm volatile("s_waitcnt lgkmcnt(" #n ")" ::: "memory")
#define PG8_BAR __builtin_amdgcn_s_barrier()
#define PG8_SCHED __builtin_amdgcn_sched_barrier(0)
    Unit cur, nxt; int ui = 0;
    if (!S.next(0, cur)) return;
    f32x4 acc[2][2][4][2];
#pragma unroll
    for (int a = 0; a < 2; ++a)
#pragma unroll
        for (int b = 0; b < 2; ++b)
#pragma unroll
            for (int m = 0; m < 4; ++m)
#pragma unroll
                for (int n = 0; n < 2; ++n) acc[a][b][m][n] = (f32x4){0.f, 0.f, 0.f, 0.f};
    bf16x8 At[4][2], B0[2][2], B1[2][2];
    const char* cA = (const char*)g.A + (size_t)cur.pm * tstep; const char* cB = (const char*)g.Bt + (size_t)cur.pn * tstep;
    S.a_ready(cur);
    if constexpr (SP2) {
        PG8_STAGE(PG8_SB(0, 0), cB, voffB); PG8_STAGE(PG8_SB(0, 1), cB + hstep, voffB); PG8_STAGE(PG8_SA(0, 0), cA, voffA); PG8_STAGE(PG8_SA(0, 1), cA + hstep, voffA);
        if (wr == 1) PG8_BAR;
        PG8_WAIT_V(2); PG8_BAR;
        PG8_STAGE(PG8_SB(1, 0), cB + kstep, voffB); PG8_STAGE(PG8_SA(1, 0), cA + kstep, voffA); PG8_STAGE(PG8_SB(1, 1), cB + hstep + kstep, voffB);
        PG8_WAIT_V(6); PG8_BAR;
    } else {
        PG8_STAGE(PG8_SB(0, 0), cB, voffB); PG8_STAGE(PG8_SA(0, 0), cA, voffA); PG8_STAGE(PG8_SB(0, 1), cB + hstep, voffB); PG8_STAGE(PG8_SA(0, 1), cA + hstep, voffA);
        if (wr == 1) PG8_BAR;
        PG8_WAIT_V(4); PG8_BAR;
        PG8_STAGE(PG8_SB(1, 0), cB + kstep, voffB); PG8_STAGE(PG8_SA(1, 0), cA + kstep, voffA); PG8_STAGE(PG8_SB(1, 1), cB + hstep + kstep, voffB);
        PG8_WAIT_V(6); PG8_BAR;
    }
    for (;;) {
        const bool has_next = S.next(ui + 1, nxt);
        const char* nA = has_next ? (const char*)g.A + (size_t)nxt.pm * tstep : cA; const char* nB = has_next ? (const char*)g.Bt + (size_t)nxt.pn * tstep : cB;
        for (int t = 0; t < nt; t += 2) {
            if constexpr (Epi::KSPLIT) { if (t == nt / 2) E.mid(acc, cur, wr, fr); }
            const bool last = (t == nt - 2);
            const char* a1 = cA + (size_t)(t + 1) * kstep;
            const char* a2 = last ? nA : cA + (size_t)(t + 2) * kstep; const char* b2 = last ? nB : cB + (size_t)(t + 2) * kstep;
            const char* a3 = a2 + kstep; const char* b3 = b2 + kstep;
            if (last && has_next) S.a_ready(nxt);
            if constexpr (SP2) {
            PG8_LDB(B0, 0, 0); PG8_LDB(B1, 0, 1); PG8_SCHED; PG8_LDA(At, 0, 0); PG8_STAGE(PG8_SA(1, 1), a1 + hstep, voffA);
            PG8_WAIT_V(8); PG8_WAIT_L(0); PG8_BAR; PG8_MMA(0, 0, At, B0); PG8_MMA(0, 1, At, B1); PG8_BAR; PG8_SCHED;
            PG8_LDA(At, 0, 1); PG8_STAGE(PG8_SB(0, 0), b2, voffB); PG8_STAGE(PG8_SB(0, 1), b2 + hstep, voffB); PG8_STAGE(PG8_SA(0, 0), a2, voffA);
            PG8_WAIT_V(8); PG8_WAIT_L(0); PG8_BAR; PG8_MMA(1, 0, At, B0); PG8_MMA(1, 1, At, B1); PG8_BAR; PG8_SCHED;
            PG8_LDB(B0, 1, 0); PG8_LDB(B1, 1, 1); PG8_SCHED; PG8_LDA(At, 1, 0); PG8_STAGE(PG8_SA(0, 1), a2 + hstep, voffA);
            PG8_WAIT_V(8); PG8_WAIT_L(0); PG8_BAR; PG8_MMA(0, 0, At, B0); PG8_MMA(0, 1, At, B1); PG8_BAR; PG8_SCHED;
            PG8_LDA(At, 1, 1); PG8_STAGE(PG8_SB(1, 0), b3, voffB); PG8_STAGE(PG8_SB(1, 1), b3 + hstep, voffB); PG8_STAGE(PG8_SA(1, 0), a3, voffA);
            PG8_WAIT_V(8); PG8_WAIT_L(0); PG8_BAR; PG8_MMA(1, 0, At, B0); PG8_MMA(1, 1, At, B1); PG8_BAR; PG8_SCHED;
            } else {
            PG8_LDB(B0, 0, 0); PG8_SCHED; PG8_LDA(At, 0, 0); PG8_STAGE(PG8_SA(1, 1), a1 + hstep, voffA);
            PG8_WAIT_L(8); PG8_BAR; PG8_WAIT_L(0); PG8_MMA(0, 0, At, B0); PG8_BAR; PG8_SCHED;
            PG8_LDB(B1, 0, 1); PG8_STAGE(PG8_SB(0, 0), b2, voffB);
            PG8_BAR; PG8_WAIT_L(0); PG8_MMA(0, 1, At, B1); PG8_BAR;
            PG8_LDA(At, 0, 1); PG8_STAGE(PG8_SA(0, 0), a2, voffA);
            PG8_BAR; PG8_WAIT_L(0); PG8_MMA(1, 0, At, B0); PG8_BAR; PG8_SCHED;
            PG8_STAGE(PG8_SB(0, 1), b2 + hstep, voffB);
            PG8_WAIT_V(6); PG8_BAR; PG8_MMA(1, 1, At, B1); PG8_BAR;
            PG8_LDB(B0, 1, 0); PG8_SCHED; PG8_LDA(At, 1, 0); PG8_STAGE(PG8_SA(0, 1), a2 + hstep, voffA);
            PG8_WAIT_L(8); PG8_BAR; PG8_WAIT_L(0); PG8_MMA(0, 0, At, B0); PG8_BAR; PG8_SCHED;
            PG8_LDB(B1, 1, 1); PG8_STAGE(PG8_SB(1, 0), b3, voffB);
            PG8_BAR; PG8_WAIT_L(0); PG8_MMA(0, 1, At, B1); PG8_BAR;
            PG8_LDA(At, 1, 1); PG8_STAGE(PG8_SA(1, 0), a3, voffA);
            PG8_BAR; PG8_WAIT_L(0); PG8_MMA(1, 0, At, B0); PG8_BAR; PG8_SCHED;
            PG8_STAGE(PG8_SB(1, 1), b3 + hstep, voffB);
            PG8_WAIT_V(6); PG8_BAR; PG8_MMA(1, 1, At, B1); PG8_BAR;
            }
        }
        if constexpr (ALIGN_EPI) { if (wr == 0) PG8_BAR; }
        if constexpr (!Epi::AFTER_DRAIN) { E(acc, cur, wr, wc, fr, fq); S.done(cur); }
        if (!has_next) break;
#pragma unroll
        for (int a = 0; a < 2; ++a)
#pragma unroll
            for (int b = 0; b < 2; ++b)
#pragma unroll
                for (int m = 0; m < 4; ++m)
#pragma unroll
                    for (int n = 0; n < 2; ++n) acc[a][b][m][n] = (f32x4){0.f, 0.f, 0.f, 0.f};
        cur = nxt; cA = nA; cB = nB; ++ui;
        if constexpr (ALIGN_EPI) { if (wr == 1) PG8_BAR; }
    }
    PG8_WAIT_V(0);
    if constexpr (!ALIGN_EPI) { if (wr == 0) PG8_BAR; }
    PG8_BAR;
    if constexpr (Epi::AFTER_DRAIN) { E.fused(acc, cur, wr, wc, fr, fq, lds, wid, lane); S.done(cur); }
#undef PG8_SA
#undef PG8_SB
#undef PG8_STAGE
#undef PG8_LDA
#undef PG8_LDB
#undef PG8_MMA
#undef PG8_WAIT_V
#undef PG8_WAIT_L
#undef PG8_BAR
#undef PG8_SCHED
}
}


constexpr int NWAVES = 8;
constexpr int RING_OFF = 0, RING_BYTES = 131072;
constexpr int LDSX_OFF = RING_BYTES;
constexpr int MISC_OFF = RING_BYTES + 8192;
constexpr int LDS_BYTES = 147456;
static_assert(MISC_OFF + 128 <= LDS_BYTES, "LDS map");
constexpr int CW_BAR = 1024;
constexpr int CW_FLAG = 16384;

#define GAS __attribute__((address_space(1)))
#define LAS __attribute__((address_space(3)))
typedef unsigned v4u __attribute__((ext_vector_type(4)));
typedef float f32x4 __attribute__((ext_vector_type(4)));
typedef unsigned u32x2 __attribute__((ext_vector_type(2)));
typedef GAS unsigned gu32;
#define LDS_WAIT() asm volatile("s_waitcnt lgkmcnt(0)" ::: "memory")
#define VM_WAIT() asm volatile("s_waitcnt vmcnt(0)" ::: "memory")
__device__ __forceinline__ unsigned pk2(float lo, float hi) { return f2bf(lo) | (f2bf(hi) << 16); }

#define XB_TMO      128
#define XB_XCNT(j)  (256  + 64 * (j))
#define XB_XSUB(j)  (1280 + 64 * (j))
#define XB_XGEN(j)  (2304 + 64 * (j))
#define XB_TOP      3328
#define XB_TOPGEN   3392
#define XCD_BAR_WORDS 3456
#define XB_SPIN_CAP (1u << 18)

__device__ __forceinline__ unsigned xb_ld(unsigned* p)              { return __hip_atomic_load(p, __ATOMIC_RELAXED, __HIP_MEMORY_SCOPE_AGENT); }
__device__ __forceinline__ unsigned xb_add(unsigned* p, unsigned v) { return __hip_atomic_fetch_add(p, v, __ATOMIC_RELAXED, __HIP_MEMORY_SCOPE_AGENT); }
__device__ __forceinline__ unsigned xb_xcc_id() { return (unsigned)__builtin_amdgcn_s_getreg((3 << 11) | 20) & 0xFu; }
#define XB_SPIN(cond, bar) do { unsigned _sp = 0; while (cond) { __builtin_amdgcn_s_sleep(1); \
    if ((++_sp & 255u) == 0u) { if (xb_ld(&(bar)[XB_TMO])) break; if (_sp > XB_SPIN_CAP) { atomicAdd(&(bar)[XB_TMO], 1u); break; } } } } while (0)

struct XcdBarrier {
    unsigned* bar; unsigned x;
    volatile LAS unsigned* st;
};

__device__ __forceinline__ XcdBarrier xcd_barrier_post(unsigned* bar, volatile LAS unsigned* st) {
    XcdBarrier b; b.bar = bar; b.x = xb_xcc_id(); b.st = st;
    if (threadIdx.x == 0) (void)xb_add(&bar[XB_XCNT(b.x)], 1u);
    return b;
}
__device__ __forceinline__ void xcd_barrier_complete(unsigned* bar, unsigned x, unsigned& nloc, unsigned& nx) {
    const unsigned G = gridDim.x * gridDim.y * gridDim.z;
    unsigned sum, cnt, mine, sp = 0u;
    for (;;) {
        sum = 0u; cnt = 0u; mine = 0u;
#pragma unroll
        for (unsigned j = 0; j < 16; ++j) { const unsigned c = xb_ld(&bar[XB_XCNT(j)]); sum += c; cnt += (c > 0u) ? 1u : 0u; mine = (j == x) ? c : mine; }
        if (sum == G) break;
        __builtin_amdgcn_s_sleep(1);
        if ((++sp & 255u) == 0u) { if (xb_ld(&bar[XB_TMO])) break; if (sp > XB_SPIN_CAP) { atomicAdd(&bar[XB_TMO], 1u); break; } }
    }
    nloc = mine > 0u ? mine : 1u; nx = cnt > 0u ? cnt : 1u;
}

__device__ __forceinline__ void xcd_barrier(const XcdBarrier& b) {
    asm volatile("s_waitcnt vmcnt(0)" ::: "memory");
    __syncthreads();
    if (threadIdx.x == 0) {
        unsigned* bar = b.bar;
        __builtin_amdgcn_s_waitcnt(0);
        unsigned nloc = b.st[0], nx = b.st[1];
        if (nloc == 0u) { xcd_barrier_complete(bar, b.x, nloc, nx); b.st[0] = nloc; b.st[1] = nx; }
        const unsigned old = xb_add(&bar[XB_XSUB(b.x)], 1u);
        const unsigned gen = old / nloc;
        if (old + 1u == (gen + 1u) * nloc) {
            __builtin_amdgcn_fence(__ATOMIC_RELEASE, "agent");
            asm volatile("s_waitcnt vmcnt(0)" ::: "memory");
            const unsigned og = xb_add(&bar[XB_TOP], 1u);
            const unsigned tg = og / nx;
            if (og + 1u == (tg + 1u) * nx) xb_add(&bar[XB_TOPGEN], 1u);
            else XB_SPIN(xb_ld(&bar[XB_TOPGEN]) == tg, bar);
            __builtin_amdgcn_fence(__ATOMIC_ACQUIRE, "agent");
            xb_add(&bar[XB_XGEN(b.x)], 1u);
            asm volatile("s_waitcnt vmcnt(0)" ::: "memory");
        } else {
            XB_SPIN(xb_ld(&bar[XB_XGEN(b.x)]) == gen, bar);
            __builtin_amdgcn_fence(__ATOMIC_ACQUIRE, "agent");
            asm volatile("s_waitcnt vmcnt(0)" ::: "memory");
        }
    }
    __syncthreads();
}


namespace att {
typedef short bf16x8 __attribute__((ext_vector_type(8)));
typedef short s16x4 __attribute__((ext_vector_type(4)));
typedef float f32x16 __attribute__((ext_vector_type(16)));
typedef unsigned u32x4 __attribute__((ext_vector_type(4)));
typedef unsigned u32x2 __attribute__((ext_vector_type(2)));
constexpr float LOG2E = 1.4426950408889634f;
#define LBAR() do { asm volatile("s_waitcnt lgkmcnt(0)" ::: "memory"); __builtin_amdgcn_s_barrier(); asm volatile("" ::: "memory"); } while (0)
__device__ __forceinline__ int kappa(int r) { return (r & ~12) | ((r & 4) << 1) | ((r & 8) >> 1); }
__device__ __forceinline__ f32x16 mfma32(bf16x8 a, bf16x8 b, f32x16 c) { return __builtin_amdgcn_mfma_f32_32x32x16_bf16(a, b, c, 0, 0, 0); }
__device__ __forceinline__ s16x4 vtr(const LAS unsigned char* p) { return __builtin_bit_cast(s16x4, __builtin_amdgcn_ds_read_tr16_b64_v4i16((LAS s16x4*)p)); }
__device__ __forceinline__ bf16x8 cat8(s16x4 a, s16x4 b) { return (bf16x8){a[0], a[1], a[2], a[3], b[0], b[1], b[2], b[3]}; }
typedef float f32x2_t __attribute__((ext_vector_type(2))); typedef __bf16 bf16x2_t __attribute__((ext_vector_type(2)));
__device__ __forceinline__ unsigned cvtpk(float lo, float hi) { const f32x2_t v = {lo, hi}; return __builtin_bit_cast(unsigned, __builtin_convertvector(v, bf16x2_t)); }
__device__ __forceinline__ float xhalf_max(float v) { return fmaxf(v, __shfl_xor(v, 32)); }
__device__ __forceinline__ float xhalf_sum(float v) { return v + __shfl_xor(v, 32); }
__device__ __forceinline__ bf16x8 packp(const f32x16& p, int s) {
    u32x4 w; w.x = cvtpk(p[8 * s + 0], p[8 * s + 1]); w.y = cvtpk(p[8 * s + 2], p[8 * s + 3]); w.z = cvtpk(p[8 * s + 4], p[8 * s + 5]); w.w = cvtpk(p[8 * s + 6], p[8 * s + 7]);
    return __builtin_bit_cast(bf16x8, w);
}
__device__ __forceinline__ int tr_off(int lane, int VP) { const int hi = lane >> 5, blk = (lane >> 4) & 1, q4 = (lane & 15) >> 2, p4 = lane & 3; return (8 * hi + q4) * VP + (16 * blk + 4 * p4) * 2; }


#define TR_RD(DST, ADDR, OFF) asm volatile("ds_read_b64_tr_b16 %0, %1 offset:%2" : "=v"(DST) : "v"(ADDR), "i"(OFF))
#define TR_WAIT(N, A, B) asm volatile("s_waitcnt lgkmcnt(" #N ")" : "+v"(A), "+v"(B))
#define PV_CHAIN2(ACC, ADDR, VP, F0, F1) do { s16x4 l0, h0, l1, h1; const unsigned ad_ = (ADDR); \
    TR_RD(l0, ad_, 0 * (VP)); TR_RD(h0, ad_, 4 * (VP)); TR_RD(l1, ad_, 16 * (VP)); TR_RD(h1, ad_, 20 * (VP)); \
    TR_WAIT(2, l0, h0); ACC = mfma32(cat8(l0, h0), F0, ACC); TR_WAIT(0, l1, h1); ACC = mfma32(cat8(l1, h1), F1, ACC); } while (0)
#define PV_CHAIN8(ACC, ADDR, VP, F0, F1, F2, F3, F4, F5, F6, F7) do { s16x4 l0, h0, l1, h1, l2, h2, l3, h3, l4, h4, l5, h5, l6, h6, l7, h7; const unsigned ad_ = (ADDR); \
    TR_RD(l0, ad_, 0 * (VP)); TR_RD(h0, ad_, 4 * (VP)); TR_RD(l1, ad_, 16 * (VP)); TR_RD(h1, ad_, 20 * (VP)); TR_RD(l2, ad_, 32 * (VP)); TR_RD(h2, ad_, 36 * (VP)); TR_RD(l3, ad_, 48 * (VP)); TR_RD(h3, ad_, 52 * (VP)); \
    TR_RD(l4, ad_, 64 * (VP)); TR_RD(h4, ad_, 68 * (VP)); TR_RD(l5, ad_, 80 * (VP)); TR_RD(h5, ad_, 84 * (VP)); TR_RD(l6, ad_, 96 * (VP)); TR_RD(h6, ad_, 100 * (VP)); TR_RD(l7, ad_, 112 * (VP)); TR_RD(h7, ad_, 116 * (VP)); \
    TR_WAIT(14, l0, h0); ACC = mfma32(cat8(l0, h0), F0, ACC); TR_WAIT(12, l1, h1); ACC = mfma32(cat8(l1, h1), F1, ACC); TR_WAIT(10, l2, h2); ACC = mfma32(cat8(l2, h2), F2, ACC); TR_WAIT(8, l3, h3); ACC = mfma32(cat8(l3, h3), F3, ACC); \
    TR_WAIT(6, l4, h4); ACC = mfma32(cat8(l4, h4), F4, ACC); TR_WAIT(4, l5, h5); ACC = mfma32(cat8(l5, h5), F5, ACC); TR_WAIT(2, l6, h6); ACC = mfma32(cat8(l6, h6), F6, ACC); TR_WAIT(0, l7, h7); ACC = mfma32(cat8(l7, h7), F7, ACC); } while (0)

constexpr int MB_KP = 144, MB_VP = 192, MB_TN = 2256, MB_TK = 128;
constexpr int MB_K = 0, MB_V = 2 * MB_TK * MB_KP, MB_LUT = MB_V + 2 * MB_TK * MB_VP, MB_KM = MB_LUT + 4 * MB_TN * 4, MB_END = MB_KM + 2048;
__device__ __forceinline__ f32x16 ld_c16(const LAS unsigned char* p) {
    const f32x4 a = *(const LAS f32x4*)p, b = *(const LAS f32x4*)(p + 16), c = *(const LAS f32x4*)(p + 64), d = *(const LAS f32x4*)(p + 80);
    return (f32x16){a[0], a[1], a[2], a[3], b[0], b[1], b[2], b[3], c[0], c[1], c[2], c[3], d[0], d[1], d[2], d[3]};
}
__device__ __forceinline__ float max16(const f32x16& p) { return fmaxf(fmaxf(fmaxf(fmaxf(p[0], p[1]), fmaxf(p[2], p[3])), fmaxf(fmaxf(p[4], p[5]), fmaxf(p[6], p[7]))), fmaxf(fmaxf(fmaxf(p[8], p[9]), fmaxf(p[10], p[11])), fmaxf(fmaxf(p[12], p[13]), fmaxf(p[14], p[15])))); }
__device__ __forceinline__ void moba_phase(LAS unsigned char* lds, const bf16* QKV, const float* KMP, const float* LUT, bf16* Y, float* SSB, int vcu, int G, int variant) {
    const int tid = threadIdx.x, lane = tid & 63, r32 = lane & 31, hi = lane >> 5; const int w = __builtin_amdgcn_readfirstlane(tid >> 6);
    LAS float* tab = (LAS float*)(lds + MB_LUT); LAS float* km = (LAS float*)(lds + MB_KM);
    const int troff = tr_off(lane, MB_VP);
    int htab = -1;
    for (int tau = vcu; tau < BATCH * 8 * 4; tau += G) { const int bh = tau >> 2, pr = tau & 3, b = bh >> 3, h = bh & 7;
        __syncthreads();
        if (h != htab) { htab = h; float tv[18];
#pragma unroll
            for (int j = 0; j < 18; ++j) { const int i = tid + 512 * j, sft = i / MB_TN, ii = i - sft * MB_TN, idx = 2047 - ii - sft; tv[j] = (i < 4 * MB_TN && idx >= 0) ? LUT[(8 + h) * 2048 + idx] * LOG2E : -INFINITY; }
#pragma unroll
            for (int j = 0; j < 18; ++j) { const int i = tid + 512 * j; if (i < 4 * MB_TN) tab[i] = tv[j]; } }
        { const int j = tid >> 6, d = tid & 63; km[tid] = (KMP[(size_t)((8 * b + j) * 2 + 0) * 512 + 64 * h + d] + KMP[(size_t)((8 * b + j) * 2 + 1) * 512 + 64 * h + d]) * (1.f / 256.f); }
        __syncthreads();
        const bf16* Qb = QKV + (size_t)b * SEQ * NQKV + 1536 + 64 * h; const bf16* Kb = QKV + (size_t)b * SEQ * NQKV + 2048 + 64 * h; const bf16* Vb = Kb + 512;
        for (int s2 = 0; s2 < 2; ++s2) { const int qb = s2 == 0 ? 7 - pr : pr;
            const int tq = 256 * qb + 32 * w + r32;
            bf16x8 qf[4];
#pragma unroll
            for (int d0 = 0; d0 < 4; ++d0) qf[d0] = *(const bf16x8*)(Qb + (size_t)tq * NQKV + 16 * d0 + 8 * hi);
            unsigned sel = 0;
            { float g[8];
#pragma unroll
              for (int j = 0; j < 8; ++j) g[j] = 0.f;
#pragma unroll
              for (int d0 = 0; d0 < 4; ++d0) { float qv[8];
#pragma unroll
                  for (int e = 0; e < 8; ++e) qv[e] = __builtin_bit_cast(float, (unsigned)(unsigned short)qf[d0][e] << 16);
#pragma unroll
                  for (int j = 0; j < 7; ++j) { const LAS float* kp = km + j * 64 + 16 * d0 + 8 * hi; const f32x4 k0 = *(const LAS f32x4*)kp, k1 = *(const LAS f32x4*)(kp + 4);
                      g[j] += qv[0] * k0[0] + qv[1] * k0[1] + qv[2] * k0[2] + qv[3] * k0[3] + qv[4] * k1[0] + qv[5] * k1[1] + qv[6] * k1[2] + qv[7] * k1[3]; } }
#pragma unroll
              for (int j = 0; j < 7; ++j) g[j] += __shfl_xor(g[j], 32);
              const int nsel = qb < 3 ? qb : 3;
              for (int n = 0; n < nsel; ++n) { float best = -3e38f; int bi = 0;
#pragma unroll
                  for (int j = 0; j < 7; ++j) if (j < qb && !((sel >> j) & 1u) && g[j] > best) { best = g[j]; bi = j; }
                  sel |= 1u << bi; }
              sel |= 1u << qb; }
            float l_run = 0.f; f32x16 o0 = {}, o1 = {};
            const int NT = 2 * (qb + 1);
            const int a0 = 2047 - tq + 8 * hi;
            const LAS unsigned char* cp = (const LAS unsigned char*)tab + (a0 & 3) * (MB_TN * 4) + (a0 & ~3) * 4;
            const int skey = tid >> 3, sch = tid & 7;
            const size_t srow = (size_t)skey * NQKV + 8 * sch;
#define MB_GLD(T_) do { if ((T_) < NT) { const size_t ro_ = srow + (size_t)(T_) * MB_TK * NQKV; k0r = *(const u32x4*)(Kb + ro_); k1r = *(const u32x4*)(Kb + ro_ + (size_t)64 * NQKV); v0r = *(const u32x4*)(Vb + ro_); v1r = *(const u32x4*)(Vb + ro_ + (size_t)64 * NQKV); } } while (0)
#define MB_ST(T_) do { if ((T_) < NT) { LAS unsigned char* kd_ = lds + MB_K + ((T_) & 1) * (MB_TK * MB_KP) + skey * MB_KP + sch * 16; LAS unsigned char* vd_ = lds + MB_V + ((T_) & 1) * (MB_TK * MB_VP) + skey * MB_VP + sch * 16; \
                    *(LAS u32x4*)kd_ = k0r; *(LAS u32x4*)(kd_ + 64 * MB_KP) = k1r; *(LAS u32x4*)vd_ = v0r; *(LAS u32x4*)(vd_ + 64 * MB_VP) = v1r; } } while (0)
#define MB_ACT(T_) (((T_) >> 1) < qb ? (__ballot((sel >> ((T_) >> 1)) & 1u) != 0ull) : ((MB_TK * (T_) - 256 * qb) <= 32 * w + 31))
            u32x4 k0r = {}, k1r = {}, v0r = {}, v1r = {};
            MB_GLD(0); MB_ST(0); MB_GLD(1);
            LBAR();
            for (int T = 0; T < NT; ++T) {
                if (MB_ACT(T)) {
                    const LAS unsigned char* Kt = lds + MB_K + (T & 1) * (MB_TK * MB_KP) + kappa(r32) * MB_KP + hi * 16; const LAS unsigned char* Vt = lds + MB_V + (T & 1) * (MB_TK * MB_VP) + troff;
                    const bool selb = (sel >> (T >> 1)) & 1u;
                    const LAS unsigned char* ct = selb ? cp + 512 * T : (const LAS unsigned char*)tab + 2048 * 4;
                    f32x16 p0 = ld_c16(ct), p1 = ld_c16(ct + 128), p2 = ld_c16(ct + 256), p3 = ld_c16(ct + 384);
                    if (!(variant & 4)) {
#pragma unroll
                        for (int d0 = 0; d0 < 4; ++d0) { const bf16x8 ka = *(const LAS bf16x8*)(Kt + d0 * 32), kb = *(const LAS bf16x8*)(Kt + 32 * MB_KP + d0 * 32), kc = *(const LAS bf16x8*)(Kt + 64 * MB_KP + d0 * 32), kd = *(const LAS bf16x8*)(Kt + 96 * MB_KP + d0 * 32);
                            p0 = mfma32(ka, qf[d0], p0); p1 = mfma32(kb, qf[d0], p1); p2 = mfma32(kc, qf[d0], p2); p3 = mfma32(kd, qf[d0], p3); } }
                    float ls0 = 0.f, ls1 = 0.f;
                    if (!(variant & 1)) {
#pragma unroll
                        for (int r = 0; r < 16; ++r) { p0[r] = __builtin_amdgcn_exp2f(p0[r]); p1[r] = __builtin_amdgcn_exp2f(p1[r]); p2[r] = __builtin_amdgcn_exp2f(p2[r]); p3[r] = __builtin_amdgcn_exp2f(p3[r]); ls0 += p0[r] + p1[r]; ls1 += p2[r] + p3[r]; } }
                    l_run += ls0 + ls1;
                    if (!(variant & 2)) {
                        const bf16x8 f0 = packp(p0, 0), f1 = packp(p0, 1), f2 = packp(p1, 0), f3 = packp(p1, 1), f4 = packp(p2, 0), f5 = packp(p2, 1), f6 = packp(p3, 0), f7 = packp(p3, 1);
                        const unsigned va = (unsigned)(size_t)Vt;
                        PV_CHAIN8(o0, va, MB_VP, f0, f1, f2, f3, f4, f5, f6, f7);
                        PV_CHAIN8(o1, va + 64u, MB_VP, f0, f1, f2, f3, f4, f5, f6, f7); }
                }
                MB_ST(T + 1);
                if (!(variant & 16)) LBAR();
                if (!(variant & 8)) MB_GLD(T + 2);
            }
#undef MB_GLD
#undef MB_ST
#undef MB_ACT
            const float inv = 1.f / xhalf_sum(l_run);
            bf16* yp = Y + ((size_t)b * SEQ + tq) * DM + 512 + 64 * h + 4 * hi; float sq = 0.f;
#pragma unroll
            for (int g4 = 0; g4 < 4; ++g4) { u32x2 a, c2; a.x = cvtpk(o0[4 * g4] * inv, o0[4 * g4 + 1] * inv); a.y = cvtpk(o0[4 * g4 + 2] * inv, o0[4 * g4 + 3] * inv);
                c2.x = cvtpk(o1[4 * g4] * inv, o1[4 * g4 + 1] * inv); c2.y = cvtpk(o1[4 * g4 + 2] * inv, o1[4 * g4 + 3] * inv);
                *(u32x2*)(yp + 8 * g4) = a; *(u32x2*)(yp + 32 + 8 * g4) = c2;
                sq += bflo(a.x) * bflo(a.x) + bfhi(a.x) * bfhi(a.x) + bflo(a.y) * bflo(a.y) + bfhi(a.y) * bfhi(a.y) + bflo(c2.x) * bflo(c2.x) + bfhi(c2.x) * bfhi(c2.x) + bflo(c2.y) * bflo(c2.y) + bfhi(c2.y) * bfhi(c2.y); }
            sq = xhalf_sum(sq); if (hi == 0 && SSB) atomicAdd(SSB + (size_t)b * SEQ + tq, sq);
        }
    }
}

constexpr int DL_VP = 192, DL_KP = 144, DL_LUT = 0, DL_TN = 208, DL_V = 16384, DL_SB = 65536, DL_SBP = 136, DL_SL = DL_SB + 512 * DL_SBP, DL_END = DL_SL + 2048;
static_assert(DL_END <= 139264, "dilated LDS map");
struct DilTile { u32x4 kr[4]; u32x4 vr[4]; };
__device__ __forceinline__ void dil_load(DilTile& t, const bf16* Kb, const bf16* Vb, int dil, int res, int base, int lane) {
#pragma unroll
    for (int i4 = 0; i4 < 4; ++i4) { const int idx = lane + 64 * i4, key = idx >> 3, ch = idx & 7; const size_t o = (size_t)(dil * (base + key) + res) * NQKV + 8 * ch;
        t.kr[i4] = *(const u32x4*)(Kb + o); t.vr[i4] = *(const u32x4*)(Vb + o); }
}
__device__ __forceinline__ void dil_unit(const bf16* Qb, const bf16* Kb, const bf16* Vb, const LAS unsigned char* tb, LAS unsigned char* Vw, int troff, int dil, int res, int gi, int lane, int r32, int hi,
                                         f32x16& o0, f32x16& o1, float& lse) {
    const int ms = 32 * gi + r32, tq = dil * ms + res;
    u32x4 qr[4];
    int lg = lane; asm volatile("" : "+v"(lg));
#pragma unroll
    for (int i4 = 0; i4 < 4; ++i4) { const int idx = lg + 64 * i4, qrow = idx >> 3, ch = idx & 7; qr[i4] = *(const u32x4*)(Qb + (size_t)(dil * (32 * gi + qrow) + res) * NQKV + 8 * ch); }
    float l_run = 0.f; o0 = f32x16{}; o1 = f32x16{};
    const int kt0 = gi >= 4 ? 0 : 4 - gi;
    const int a0 = 31 - r32 + 8 * hi;
    const LAS unsigned char* cp = tb + (a0 & 3) * (DL_TN * 4) + (a0 & ~3) * 4;
    DilTile nx, nx2; dil_load(nx, Kb, Vb, dil, res, 32 * gi - 128 + 32 * kt0, lg); nx2 = nx;
    if (kt0 < 4) dil_load(nx2, Kb, Vb, dil, res, 32 * gi - 128 + 32 * (kt0 + 1), lg);
    bf16x8 qf[4];
#pragma unroll
    for (int i4 = 0; i4 < 4; ++i4) { const int idx = lane + 64 * i4, qrow = idx >> 3, ch = idx & 7; *(LAS u32x4*)(Vw + qrow * DL_KP + ch * 16) = qr[i4]; }
#pragma unroll
    for (int d0 = 0; d0 < 4; ++d0) qf[d0] = *(const LAS bf16x8*)(Vw + r32 * DL_KP + hi * 16 + d0 * 32);
#pragma unroll 1
    for (int kt = kt0; kt < 5; ++kt) { const int base = 32 * gi - 128 + 32 * kt;
        DilTile cu = nx; nx = nx2;
        if (kt < 3) dil_load(nx2, Kb, Vb, dil, res, base + 64, lg);
        asm volatile("" ::: "memory");
#pragma unroll
        for (int i4 = 0; i4 < 4; ++i4) { const int idx = lane + 64 * i4, key = idx >> 3, ch = idx & 7; *(LAS u32x4*)(Vw + key * DL_KP + ch * 16) = cu.kr[i4]; }
        bf16x8 kf[4];
#pragma unroll
        for (int d0 = 0; d0 < 4; ++d0) kf[d0] = *(const LAS bf16x8*)(Vw + kappa(r32) * DL_KP + hi * 16 + d0 * 32);
#pragma unroll
        for (int i4 = 0; i4 < 4; ++i4) { const int idx = lane + 64 * i4, key = idx >> 3, ch = idx & 7; *(LAS u32x4*)(Vw + key * DL_VP + ch * 16) = cu.vr[i4]; }
        f32x16 p0 = ld_c16(cp + 128 * kt);
#pragma unroll
        for (int d0 = 0; d0 < 4; ++d0) p0 = mfma32(kf[d0], qf[d0], p0);
        float ls = 0.f;
#pragma unroll
        for (int r = 0; r < 16; ++r) { p0[r] = __builtin_amdgcn_exp2f(p0[r]); ls += p0[r]; }
        l_run += ls;
        const bf16x8 pf0 = packp(p0, 0), pf1 = packp(p0, 1);
        asm volatile("s_waitcnt lgkmcnt(0)" ::: "memory");
#pragma unroll
        for (int c = 0; c < 2; ++c) { const LAS unsigned char* vb = Vw + troff + c * 64;
            const bf16x8 v0 = cat8(vtr(vb), vtr(vb + 4 * DL_VP)), v1 = cat8(vtr(vb + 16 * DL_VP), vtr(vb + 20 * DL_VP));
            if (c == 0) { o0 = mfma32(v0, pf0, o0); o0 = mfma32(v1, pf1, o0); } else { o1 = mfma32(v0, pf0, o1); o1 = mfma32(v1, pf1, o1); } }
        asm volatile("s_waitcnt lgkmcnt(0)" ::: "memory");
    }
    const float lt = xhalf_sum(l_run), inv = 1.f / lt;
#pragma unroll
    for (int r = 0; r < 16; ++r) { o0[r] *= inv; o1[r] *= inv; }
    lse = __builtin_amdgcn_logf(lt);
}
template <bool DA, bool DB>
__device__ __forceinline__ void dil_step2(DilTile& cu, const bf16* Kb, const bf16* Vb, int dil, int res, int nbase, int lg, LAS unsigned char* Vw, int troff, const LAS unsigned char* cp, int kt, int lane, int r32, int hi,
                                          const bf16x8 (&qa)[4], const bf16x8 (&qb)[4], f32x16& a0, f32x16& a1, float& la, f32x16& b0, f32x16& b1, float& lb) {
#pragma unroll
    for (int i4 = 0; i4 < 4; ++i4) { const int idx = lane + 64 * i4, key = idx >> 3, ch = idx & 7; *(LAS u32x4*)(Vw + key * DL_KP + ch * 16) = cu.kr[i4]; }
    bf16x8 kf[4];
#pragma unroll
    for (int d0 = 0; d0 < 4; ++d0) kf[d0] = *(const LAS bf16x8*)(Vw + kappa(r32) * DL_KP + hi * 16 + d0 * 32);
#pragma unroll
    for (int i4 = 0; i4 < 4; ++i4) { const int idx = lane + 64 * i4, key = idx >> 3, ch = idx & 7; *(LAS u32x4*)(Vw + key * DL_VP + ch * 16) = cu.vr[i4]; }
    if (DA) dil_load(cu, Kb, Vb, dil, res, nbase, lg);
    asm volatile("" ::: "memory");
    f32x16 pa = {}, pb = {};
    if (DA) pa = ld_c16(cp + 128 * kt);
    if (DB) pb = ld_c16(cp + 128 * (kt - 1));
#pragma unroll
    for (int d0 = 0; d0 < 4; ++d0) { if (DA) pa = mfma32(kf[d0], qa[d0], pa); if (DB) pb = mfma32(kf[d0], qb[d0], pb); }
    float lsa = 0.f, lsb = 0.f;
#pragma unroll
    for (int r = 0; r < 16; ++r) { if (DA) { pa[r] = __builtin_amdgcn_exp2f(pa[r]); lsa += pa[r]; } if (DB) { pb[r] = __builtin_amdgcn_exp2f(pb[r]); lsb += pb[r]; } }
    la += lsa; lb += lsb;
    const bf16x8 fa0 = packp(pa, 0), fa1 = packp(pa, 1), fb0 = packp(pb, 0), fb1 = packp(pb, 1);
    asm volatile("s_waitcnt lgkmcnt(0)" ::: "memory");
#pragma unroll
    for (int c = 0; c < 2; ++c) { const LAS unsigned char* vb = Vw + troff + c * 64;
        const bf16x8 v0 = cat8(vtr(vb), vtr(vb + 4 * DL_VP)), v1 = cat8(vtr(vb + 16 * DL_VP), vtr(vb + 20 * DL_VP));
        if (c == 0) { if (DA) { a0 = mfma32(v0, fa0, a0); a0 = mfma32(v1, fa1, a0); } if (DB) { b0 = mfma32(v0, fb0, b0); b0 = mfma32(v1, fb1, b0); } }
        else { if (DA) { a1 = mfma32(v0, fa0, a1); a1 = mfma32(v1, fa1, a1); } if (DB) { b1 = mfma32(v0, fb0, b1); b1 = mfma32(v1, fb1, b1); } } }
    asm volatile("s_waitcnt lgkmcnt(0)" ::: "memory");
}
__device__ __forceinline__ void dil_unit2(const bf16* Qb, const bf16* Kb, const bf16* Vb, const LAS unsigned char* tb, LAS unsigned char* Vw, int troff, int dil, int res, int gi2, int lane, int r32, int hi,
                                          f32x16& a0, f32x16& a1, float& lseA, f32x16& b0, f32x16& b1, float& lseB) {
    u32x4 qr[4], qs[4];
    int lg = lane; asm volatile("" : "+v"(lg));
#pragma unroll
    for (int i4 = 0; i4 < 4; ++i4) { const int idx = lg + 64 * i4, qrow = idx >> 3, ch = idx & 7; const size_t o = (size_t)(dil * (64 * gi2 + qrow) + res) * NQKV + 8 * ch;
        qr[i4] = *(const u32x4*)(Qb + o); qs[i4] = *(const u32x4*)(Qb + o + (size_t)(dil * 32) * NQKV); }
    float la = 0.f, lb = 0.f; a0 = f32x16{}; a1 = f32x16{}; b0 = f32x16{}; b1 = f32x16{};
    const int kt0 = gi2 >= 2 ? 0 : 4 - 2 * gi2;
    const int t0 = 31 - r32 + 8 * hi;
    const LAS unsigned char* cp = tb + (t0 & 3) * (DL_TN * 4) + (t0 & ~3) * 4;
    const int base0 = 64 * gi2 - 128;
    DilTile nx; dil_load(nx, Kb, Vb, dil, res, base0 + 32 * kt0, lg);
    bf16x8 qa[4], qb[4];
#pragma unroll
    for (int i4 = 0; i4 < 4; ++i4) { const int idx = lane + 64 * i4, qrow = idx >> 3, ch = idx & 7; *(LAS u32x4*)(Vw + qrow * DL_KP + ch * 16) = qr[i4]; }
#pragma unroll
    for (int d0 = 0; d0 < 4; ++d0) qa[d0] = *(const LAS bf16x8*)(Vw + r32 * DL_KP + hi * 16 + d0 * 32);
#pragma unroll
    for (int i4 = 0; i4 < 4; ++i4) { const int idx = lane + 64 * i4, qrow = idx >> 3, ch = idx & 7; *(LAS u32x4*)(Vw + qrow * DL_KP + ch * 16) = qs[i4]; }
#pragma unroll
    for (int d0 = 0; d0 < 4; ++d0) qb[d0] = *(const LAS bf16x8*)(Vw + r32 * DL_KP + hi * 16 + d0 * 32);
    int kt = kt0;
    if (kt == 0) { dil_step2<true, false>(nx, Kb, Vb, dil, res, base0 + 32, lg, Vw, troff, cp, 0, lane, r32, hi, qa, qb, a0, a1, la, b0, b1, lb); kt = 1; }
#pragma unroll 1
    for (; kt < 5; ++kt) dil_step2<true, true>(nx, Kb, Vb, dil, res, base0 + 32 * (kt + 1), lg, Vw, troff, cp, kt, lane, r32, hi, qa, qb, a0, a1, la, b0, b1, lb);
    dil_step2<false, true>(nx, Kb, Vb, dil, res, 0, lg, Vw, troff, cp, 5, lane, r32, hi, qa, qb, a0, a1, la, b0, b1, lb);
    const float lta = xhalf_sum(la), ltb = xhalf_sum(lb), ia = 1.f / lta, ib = 1.f / ltb;
#pragma unroll
    for (int r = 0; r < 16; ++r) { a0[r] *= ia; a1[r] *= ia; b0[r] *= ib; b1[r] *= ib; }
    lseA = __builtin_amdgcn_logf(lta); lseB = __builtin_amdgcn_logf(ltb);
}
__device__ __forceinline__ void sb_store(LAS unsigned char* sb, int lt, int hi, const f32x16& o0, const f32x16& o1) {
    LAS unsigned char* p = sb + lt * DL_SBP + 8 * hi;
#pragma unroll
    for (int g4 = 0; g4 < 4; ++g4) { u32x2 a, c2; a.x = cvtpk(o0[4 * g4], o0[4 * g4 + 1]); a.y = cvtpk(o0[4 * g4 + 2], o0[4 * g4 + 3]); c2.x = cvtpk(o1[4 * g4], o1[4 * g4 + 1]); c2.y = cvtpk(o1[4 * g4 + 2], o1[4 * g4 + 3]);
        *(LAS u32x2*)(p + 16 * g4) = a; *(LAS u32x2*)(p + 64 + 16 * g4) = c2; }
}
__device__ __forceinline__ void sb_merge(const LAS unsigned char* sb, int lt, int hi, float wa, float wb, f32x16& o0, f32x16& o1) {
    const LAS unsigned char* p = sb + lt * DL_SBP + 8 * hi;
#pragma unroll
    for (int g4 = 0; g4 < 4; ++g4) { const u32x2 a = *(const LAS u32x2*)(p + 16 * g4), c2 = *(const LAS u32x2*)(p + 64 + 16 * g4);
        o0[4 * g4] = wa * bflo(a.x) + wb * o0[4 * g4]; o0[4 * g4 + 1] = wa * bfhi(a.x) + wb * o0[4 * g4 + 1]; o0[4 * g4 + 2] = wa * bflo(a.y) + wb * o0[4 * g4 + 2]; o0[4 * g4 + 3] = wa * bfhi(a.y) + wb * o0[4 * g4 + 3];
        o1[4 * g4] = wa * bflo(c2.x) + wb * o1[4 * g4]; o1[4 * g4 + 1] = wa * bfhi(c2.x) + wb * o1[4 * g4 + 1]; o1[4 * g4 + 2] = wa * bflo(c2.y) + wb * o1[4 * g4 + 2]; o1[4 * g4 + 3] = wa * bfhi(c2.y) + wb * o1[4 * g4 + 3]; }
}
__device__ __forceinline__ void dil_phase(LAS unsigned char* lds, const bf16* QKV, const float* LUT, bf16* Y, float* SSA, int vcu, int G) {
    const int tid = threadIdx.x, lane = tid & 63, r32 = lane & 31, hi = lane >> 5; const int w = __builtin_amdgcn_readfirstlane(tid >> 6);
    LAS float* dtab = (LAS float*)(lds + DL_LUT);
    LAS unsigned char* Vw = lds + DL_V + w * (32 * DL_VP);
    LAS unsigned char* sb = lds + DL_SB; LAS float* sl = (LAS float*)(lds + DL_SL);
    const int troff = tr_off(lane, DL_VP);
    for (int bh = vcu; bh < BATCH * 8; bh += G) { const int b = bh >> 3, h = bh & 7;
        __syncthreads();
        for (int i = tid; i < 3 * 4 * DL_TN; i += 512) { const int ii = i % DL_TN, sft = (i / DL_TN) & 3, pp = i / (4 * DL_TN); const int dlt = 159 - ii - sft, dist = dlt * (pp == 0 ? 1 : (pp == 1 ? 4 : 16));
            dtab[i] = (dlt >= 0 && dlt <= 128 && dist < 2048) ? LUT[h * 2048 + dist] * LOG2E : -INFINITY; }
        __syncthreads();
        const bf16* Qb = QKV + (size_t)b * SEQ * NQKV + 64 * h; const bf16* Kb = Qb + 512; const bf16* Vb = Qb + 1024;
        const LAS unsigned char* tb0 = lds + DL_LUT;
        for (int sp = 0; sp < 4; ++sp) {
            for (int x = w; x < 16; x += 8) { f32x16 o0, o1; float lse;
                dil_unit(Qb, Kb, Vb, tb0 + 2 * (4 * DL_TN * 4), Vw, troff, 16, x, sp, lane, r32, hi, o0, o1, lse);
                const int lt = 16 * r32 + x; sb_store(sb, lt, hi, o0, o1); if (hi == 0) sl[lt] = lse; }
            __syncthreads();
            { f32x16 oa0, oa1, ob0, ob1; float lsa, lsb;
                dil_unit2(Qb, Kb, Vb, tb0 + 1 * (4 * DL_TN * 4), Vw, troff, 4, w & 3, 2 * sp + (w >> 2), lane, r32, hi, oa0, oa1, lsa, ob0, ob1, lsb);
                { const int lt = 128 * (2 * (w >> 2)) + 4 * r32 + (w & 3); const float ls = sl[lt], mx = fmaxf(ls, lsa);
                  float wa = __builtin_amdgcn_exp2f(ls - mx), wb = __builtin_amdgcn_exp2f(lsa - mx); const float sw = wa + wb, isw = 1.f / sw; wa *= isw; wb *= isw;
                  sb_merge(sb, lt, hi, wa, wb, oa0, oa1); sb_store(sb, lt, hi, oa0, oa1); if (hi == 0) sl[lt] = mx + __builtin_amdgcn_logf(sw); }
                { const int lt = 128 * (2 * (w >> 2) + 1) + 4 * r32 + (w & 3); const float ls = sl[lt], mx = fmaxf(ls, lsb);
                  float wa = __builtin_amdgcn_exp2f(ls - mx), wb = __builtin_amdgcn_exp2f(lsb - mx); const float sw = wa + wb, isw = 1.f / sw; wa *= isw; wb *= isw;
                  sb_merge(sb, lt, hi, wa, wb, ob0, ob1); sb_store(sb, lt, hi, ob0, ob1); if (hi == 0) sl[lt] = mx + __builtin_amdgcn_logf(sw); } }
            __syncthreads();
            { f32x16 oa0, oa1, ob0, ob1; float lsa, lsb;
                dil_unit2(Qb, Kb, Vb, tb0, Vw, troff, 1, 0, 8 * sp + w, lane, r32, hi, oa0, oa1, lsa, ob0, ob1, lsb);
                { const int lt = 32 * (2 * w) + r32; const float ls = sl[lt], mx = fmaxf(ls, lsa);
                  float wa = __builtin_amdgcn_exp2f(ls - mx), wb = __builtin_amdgcn_exp2f(lsa - mx); const float isw = 1.f / (wa + wb); wa *= isw; wb *= isw;
                  sb_merge(sb, lt, hi, wa, wb, oa0, oa1); sb_store(sb, lt, hi, oa0, oa1); }
                { const int lt = 32 * (2 * w + 1) + r32; const float ls = sl[lt], mx = fmaxf(ls, lsb);
                  float wa = __builtin_amdgcn_exp2f(ls - mx), wb = __builtin_amdgcn_exp2f(lsb - mx); const float isw = 1.f / (wa + wb); wa *= isw; wb *= isw;
                  sb_merge(sb, lt, hi, wa, wb, ob0, ob1); sb_store(sb, lt, hi, ob0, ob1); } }
            __syncthreads();
#pragma unroll
            for (int j = 0; j < 8; ++j) { const int idx = tid + 512 * j, row = idx >> 3, ch = idx & 7;
                const LAS unsigned char* p = sb + row * DL_SBP + ch * 16; const u32x2 a = *(const LAS u32x2*)p, c2 = *(const LAS u32x2*)(p + 8);
                u32x4 v; v[0] = a.x; v[1] = a.y; v[2] = c2.x; v[3] = c2.y;
                *(u32x4*)(Y + ((size_t)b * SEQ + 512 * sp + row) * DM + 64 * h + 8 * ch) = v;
                float sq = bflo(a.x) * bflo(a.x) + bfhi(a.x) * bfhi(a.x) + bflo(a.y) * bflo(a.y) + bfhi(a.y) * bfhi(a.y) + bflo(c2.x) * bflo(c2.x) + bfhi(c2.x) * bfhi(c2.x) + bflo(c2.y) * bflo(c2.y) + bfhi(c2.y) * bfhi(c2.y);
                sq += __shfl_xor(sq, 1); sq += __shfl_xor(sq, 2); sq += __shfl_xor(sq, 4);
                if (ch == 0) atomicAdd(SSA + (size_t)b * SEQ + 512 * sp + row, sq); }
            __syncthreads();
        }
    }
}

__device__ __forceinline__ void merge_phase(const bf16* __restrict__ Y, bf16* __restrict__ YN, int gw, int NGW, int lane) {
    for (int m = gw; m < NTOK; m += NGW) {
        const u32x4 ya = *(const u32x4*)(Y + (size_t)m * DM + 8 * lane), yb = *(const u32x4*)(Y + (size_t)m * DM + 512 + 8 * lane);
        float v[8], u[8]; float sa = 0.f, sb = 0.f;
#pragma unroll
        for (int e = 0; e < 4; ++e) { v[2 * e] = bflo(ya[e]); v[2 * e + 1] = bfhi(ya[e]); u[2 * e] = bflo(yb[e]); u[2 * e + 1] = bfhi(yb[e]); }
#pragma unroll
        for (int e = 0; e < 8; ++e) { sa += v[e] * v[e]; sb += u[e] * u[e]; }
        sa = wave_sum(sa); sb = wave_sum(sb);
        const float ra = rsqrtf(sa * (1.f / 512.f) + EPS), rb = rsqrtf(sb * (1.f / 512.f) + EPS);
        u32x4 oa, ob;
#pragma unroll
        for (int e = 0; e < 4; ++e) { oa[e] = cvtpk(v[2 * e] * ra, v[2 * e + 1] * ra); ob[e] = cvtpk(u[2 * e] * rb, u[2 * e + 1] * rb); }
        *(u32x4*)(YN + (size_t)m * DM + 8 * lane) = oa; *(u32x4*)(YN + (size_t)m * DM + 512 + 8 * lane) = ob;
    }
}

constexpr int CR_KP = 272, CR_VP = 320, CR_K = 0, CR_V = 2 * 64 * CR_KP, CR_END = CR_V + 2 * 64 * CR_VP, CR_OP = 272;
static_assert(4 * 32 * CR_OP <= CR_V && CR_END + 4 * 32 * CR_OP <= 139264, "cross LDS map");
typedef __amdgpu_buffer_rsrc_t rsrc_t;
__device__ __forceinline__ rsrc_t mkrsrc(const void* base, unsigned bytes) { return __builtin_amdgcn_make_buffer_rsrc((void*)base, 0, bytes, 0x00020000); }
__device__ __forceinline__ u32x4 bld16(rsrc_t r, unsigned voff, unsigned soff) { return __builtin_bit_cast(u32x4, __builtin_amdgcn_raw_buffer_load_b128(r, voff, soff, 0)); }
__device__ __forceinline__ void cross_phase(LAS unsigned char* lds, const bf16* QM, const bf16* KVM, bf16* OM, int vcu, int G, int pv) {
    const int tid = threadIdx.x, lane = tid & 63, r32 = lane & 31, hi = lane >> 5; const int w = __builtin_amdgcn_readfirstlane(tid >> 6);
    const int troff = tr_off(lane, CR_VP);
    const int kkey = tid >> 3, kch = tid & 7;
    const unsigned soff = (unsigned)kkey * 4096u + (unsigned)kch * 16u;
    const unsigned qoff = (unsigned)(32 * w + r32) * 2048u + (unsigned)hi * 16u;
    const int kl0 = kkey * CR_KP + kch * 16, vl0 = kkey * CR_VP + kch * 16;
    const int kfo = kappa(r32) * CR_KP + hi * 16;
    const rsrc_t rK = mkrsrc(KVM, (unsigned)NMEMTOK * 4096u), rQ = mkrsrc(QM, (unsigned)NTOK * 2048u);
    LAS unsigned char* Tw = lds + (w < 4 ? CR_K + w * (32 * CR_OP) : CR_END + (w - 4) * (32 * CR_OP));
    for (int un = vcu * 4; un < BATCH * 4 * 8; un += G * 4) for (int ui = 0; ui < 4; ++ui) { const int u = un + ui, qblk = u & 7, hm = (u >> 3) & 3, b = u >> 5;
        const unsigned Qs = (unsigned)(((b * SEQ + 256 * qblk) * DM + 256 * hm) * 2);
        unsigned char* Os = (unsigned char*)(OM + ((size_t)b * SEQ + 256 * qblk) * DM + 256 * hm);
        const unsigned Ks = (unsigned)((b * NMEM * 2048 + 256 * hm) * 2), Vs = Ks + 2048u;
        f32x16 sc[8];
#pragma unroll
        for (int kt = 0; kt < 8; ++kt) sc[kt] = f32x16{};
        u32x4 r0, r1;
        __syncthreads();
        r0 = bld16(rK, soff, Ks); r1 = bld16(rK, soff, Ks + 128u);
        *(LAS u32x4*)(lds + CR_K + kl0) = r0; *(LAS u32x4*)(lds + CR_K + kl0 + 128) = r1;
        __syncthreads();
#pragma unroll
        for (int half = 0; half < 2; ++half) {
            bf16x8 qf[8];
#pragma unroll
            for (int d0 = 0; d0 < 8; ++d0) qf[d0] = __builtin_bit_cast(bf16x8, bld16(rQ, qoff, Qs + (unsigned)(256 * half + 32 * d0)));
#pragma unroll
            for (int kp = 0; kp < 4; ++kp) { const int step = half * 4 + kp, buf = step & 1;
                if (!(pv & 2)) { if (step + 1 < 8) { const int nh = (step + 1) >> 2, nk = (step + 1) & 3; const unsigned src = Ks + (unsigned)(nk * (64 * 4096) + 256 * nh); r0 = bld16(rK, soff, src); r1 = bld16(rK, soff, src + 128u); }
                else { r0 = bld16(rK, soff, Vs); r1 = bld16(rK, soff, Vs + 128u); } }
                const LAS unsigned char* Kt = lds + CR_K + buf * (64 * CR_KP) + kfo;
#pragma unroll
                for (int d0 = 0; d0 < 8; ++d0) { sc[2 * kp] = mfma32(*(const LAS bf16x8*)(Kt + d0 * 32), qf[d0], sc[2 * kp]); sc[2 * kp + 1] = mfma32(*(const LAS bf16x8*)(Kt + 32 * CR_KP + d0 * 32), qf[d0], sc[2 * kp + 1]); if (d0 & 1) __builtin_amdgcn_sched_barrier(0); }
                if (step + 1 < 8) { *(LAS u32x4*)(lds + CR_K + (buf ^ 1) * (64 * CR_KP) + kl0) = r0; *(LAS u32x4*)(lds + CR_K + (buf ^ 1) * (64 * CR_KP) + kl0 + 128) = r1; }
                else { *(LAS u32x4*)(lds + CR_V + vl0) = r0; *(LAS u32x4*)(lds + CR_V + vl0 + 128) = r1; }
                LBAR();
            }
        }
        const float c1 = 0.0625f * LOG2E, mo = 0.f; float ls = 0.f;
        bf16x8 pf[8][2];
#pragma unroll
        for (int kt = 0; kt < 8; ++kt) {
#pragma unroll
            for (int r = 0; r < 16; ++r) { sc[kt][r] = __builtin_amdgcn_exp2f(sc[kt][r] * c1 - mo); ls += sc[kt][r]; }
            pf[kt][0] = packp(sc[kt], 0); pf[kt][1] = packp(sc[kt], 1); }
        const float inv = 1.f / xhalf_sum(ls);
#pragma unroll
        for (int hv = 0; hv < 2; ++hv) {
            f32x16 o[4];
#pragma unroll
            for (int c = 0; c < 4; ++c) o[c] = f32x16{};
            if (hv == 1) { if (!(pv & 2)) { r0 = bld16(rK, soff, Vs + 256u); r1 = bld16(rK, soff, Vs + 384u); }
                *(LAS u32x4*)(lds + CR_V + vl0) = r0; *(LAS u32x4*)(lds + CR_V + vl0 + 128) = r1; LBAR(); }
#pragma unroll
            for (int kp = 0; kp < 4; ++kp) { const int buf = kp & 1;
                if (kp + 1 < 4 && !(pv & 2)) { const unsigned src = Vs + (unsigned)((kp + 1) * (64 * 4096) + 256 * hv); r0 = bld16(rK, soff, src); r1 = bld16(rK, soff, src + 128u); }
                const LAS unsigned char* vb = lds + CR_V + buf * (64 * CR_VP) + troff;
#pragma unroll
                for (int t2 = 0; t2 < 2; ++t2) { const unsigned va = (unsigned)(size_t)(vb + t2 * 32 * CR_VP);
                    s16x4 l0, h0, l1, h1, l2, h2, l3, h3, l4, h4, l5, h5, l6, h6, l7, h7;
                    TR_RD(l0, va, 0 * CR_VP); TR_RD(h0, va, 4 * CR_VP); TR_RD(l1, va, 16 * CR_VP); TR_RD(h1, va, 20 * CR_VP); TR_RD(l2, va, 64 + 0 * CR_VP); TR_RD(h2, va, 64 + 4 * CR_VP); TR_RD(l3, va, 64 + 16 * CR_VP); TR_RD(h3, va, 64 + 20 * CR_VP);
                    TR_RD(l4, va, 128 + 0 * CR_VP); TR_RD(h4, va, 128 + 4 * CR_VP); TR_RD(l5, va, 128 + 16 * CR_VP); TR_RD(h5, va, 128 + 20 * CR_VP); TR_RD(l6, va, 192 + 0 * CR_VP); TR_RD(h6, va, 192 + 4 * CR_VP); TR_RD(l7, va, 192 + 16 * CR_VP); TR_RD(h7, va, 192 + 20 * CR_VP);
                    const bf16x8 q0 = pf[2 * kp + t2][0], q1 = pf[2 * kp + t2][1];
                    TR_WAIT(14, l0, h0); o[0] = mfma32(cat8(l0, h0), q0, o[0]); TR_WAIT(12, l1, h1); o[0] = mfma32(cat8(l1, h1), q1, o[0]); TR_WAIT(10, l2, h2); o[1] = mfma32(cat8(l2, h2), q0, o[1]); TR_WAIT(8, l3, h3); o[1] = mfma32(cat8(l3, h3), q1, o[1]);
                    TR_WAIT(6, l4, h4); o[2] = mfma32(cat8(l4, h4), q0, o[2]); TR_WAIT(4, l5, h5); o[2] = mfma32(cat8(l5, h5), q1, o[2]); TR_WAIT(2, l6, h6); o[3] = mfma32(cat8(l6, h6), q0, o[3]); TR_WAIT(0, l7, h7); o[3] = mfma32(cat8(l7, h7), q1, o[3]); }
                if (kp + 1 < 4) { *(LAS u32x4*)(lds + CR_V + (buf ^ 1) * (64 * CR_VP) + vl0) = r0; *(LAS u32x4*)(lds + CR_V + (buf ^ 1) * (64 * CR_VP) + vl0 + 128) = r1; }
                LBAR();
            }
            if (!(pv & 1)) {
#pragma unroll
                for (int c = 0; c < 4; ++c)
#pragma unroll
                    for (int g4 = 0; g4 < 4; ++g4) { u32x2 a; a.x = cvtpk(o[c][4 * g4] * inv, o[c][4 * g4 + 1] * inv); a.y = cvtpk(o[c][4 * g4 + 2] * inv, o[c][4 * g4 + 3] * inv); *(LAS u32x2*)(Tw + r32 * CR_OP + 64 * c + 16 * g4 + 8 * hi) = a; }
                unsigned char* yp = Os + 256 * hv + (lane & 15) * 16 + (size_t)(32 * w + (lane >> 4)) * 2048;
#pragma unroll
                for (int j = 0; j < 8; ++j) { const u32x4 v = *(const LAS u32x4*)(Tw + ((lane >> 4) + 4 * j) * CR_OP + (lane & 15) * 16); *(u32x4*)(yp + (size_t)j * (4 * 2048)) = v; }
            }
        }
    }
}
}


struct Frame {
    LAS unsigned char* lds;
    int tid, lane, wave, vcu, G;
};
__device__ __forceinline__ void p0_titem(const float* __restrict__ W, int Nsrc, int nsrc0, int k0, const float* __restrict__ g, const float* __restrict__ g2, int gsplit,
                                         bf16* __restrict__ WT, int K, int ndst0, LAS float* scr, int lane) {
#pragma unroll 8
    for (int i = 0; i < 32; ++i) { const int kk = 2 * i + (lane >> 5); const int k = k0 + kk;
        float gv = 1.f; if (g) gv = (g2 && k >= gsplit) ? g2[k - gsplit] : g[k];
        scr[kk * 33 + (lane & 31)] = W[(size_t)k * Nsrc + nsrc0 + (lane & 31)] * gv; }
    LDS_WAIT(); asm volatile("" ::: "memory");
    const int c = lane & 7;
#pragma unroll
    for (int j = 0; j < 4; ++j) { const int n = (lane >> 3) + 8 * j; const LAS float* s = scr + (8 * c) * 33 + n;
        v4u o; o.x = pk2(s[0 * 33], s[1 * 33]); o.y = pk2(s[2 * 33], s[3 * 33]); o.z = pk2(s[4 * 33], s[5 * 33]); o.w = pk2(s[6 * 33], s[7 * 33]);
        *(GAS v4u*)(WT + (size_t)(ndst0 + n) * K + k0 + 8 * c) = o; }
    LDS_WAIT(); asm volatile("" ::: "memory");
}
__device__ __forceinline__ void p0_norm_rows2(const float* __restrict__ x0, const float* __restrict__ x1, bf16* __restrict__ o0, bf16* __restrict__ o1, int lane) {
    const GAS f32x4* a = (const GAS f32x4*)x0 + lane; const GAS f32x4* b = (const GAS f32x4*)x1 + lane; f32x4 v[4], u[4]; float s = 0.f, t = 0.f;
#pragma unroll
    for (int j = 0; j < 4; ++j) { v[j] = a[64 * j]; u[j] = b[64 * j]; }
#pragma unroll
    for (int j = 0; j < 4; ++j) { s += (v[j].x * v[j].x + v[j].y * v[j].y) + (v[j].z * v[j].z + v[j].w * v[j].w); t += (u[j].x * u[j].x + u[j].y * u[j].y) + (u[j].z * u[j].z + u[j].w * u[j].w); }
    s = wave_sum(s); t = wave_sum(t);
    const float rs = rsqrtf(s * (1.f / DM) + EPS), rt = rsqrtf(t * (1.f / DM) + EPS);
    GAS unsigned long long* p = (GAS unsigned long long*)o0 + lane; GAS unsigned long long* q = (GAS unsigned long long*)o1 + lane;
#pragma unroll
    for (int j = 0; j < 4; ++j) { p[64 * j] = (unsigned long long)pk2(v[j].x * rs, v[j].y * rs) | ((unsigned long long)pk2(v[j].z * rs, v[j].w * rs) << 32);
        q[64 * j] = (unsigned long long)pk2(u[j].x * rt, u[j].y * rt) | ((unsigned long long)pk2(u[j].z * rt, u[j].w * rt) << 32); }
}

struct Args { const float* in[20]; float* out; unsigned char* ws; int ph_lo, ph_hi, att_mask, ss_dummy, bar_idx, variant; };
enum { PH_PRO = 0, PH_QKV = 1, PH_ATT = 2, PH_MERGE = 3, PH_OUT = 4, PH_QM = 5, PH_CROSS = 6, PH_OM = 7, PH_FFN1 = 8, PH_FIX = 9, PH_DOWN = 10, PH_N = 11 };

__global__ void __launch_bounds__(NWAVES * 64, 2) mega(Args args) {
    extern __shared__ __attribute__((aligned(16))) unsigned char lds_raw[];
    Frame F;
    F.lds = (LAS unsigned char*)lds_raw;
    F.tid = threadIdx.x; F.lane = F.tid & 63; F.wave = __builtin_amdgcn_readfirstlane(F.tid >> 6);
    F.G = gridDim.x; { const int bx = blockIdx.x; F.vcu = (F.G % 8 == 0) ? (bx % 8) * (F.G / 8) + bx / 8 : bx; }
    unsigned char* ws = args.ws;
    volatile LAS unsigned* MISC = (volatile LAS unsigned*)(F.lds + MISC_OFF);
    for (int u = F.tid; u < (LDS_BYTES - MISC_OFF) / 4; u += NWAVES * 64) ((LAS unsigned*)(F.lds + MISC_OFF))[u] = 0u;
    __syncthreads();
    const int lo = args.ph_lo, hi = args.ph_hi;
    unsigned* barw = (unsigned*)(ws + WS_CTL) + CW_BAR + args.bar_idx * XCD_BAR_WORDS;
    XcdBarrier bar; bar.bar = barw; bar.x = 0; bar.st = nullptr;
    if (hi - lo > 1 || (lo <= PH_DOWN && PH_DOWN < hi)) bar = xcd_barrier_post(barw, MISC + 8);
#define IN(k) (lo <= (k) && (k) < hi)
#define SEAM(k) do { if (IN(k) && IN((k) + 1)) xcd_barrier(bar); } while (0)

    const float* x = args.in[0]; const float* mem = args.in[1]; const float* w_in = args.in[2]; const float* g_mix = args.in[3]; const float* g_od = args.in[4];
    const float* g_om = args.in[5]; const float* w_out = args.in[6]; const float* rel_bias = args.in[7]; const float* g_cross = args.in[8]; const float* g_mem = args.in[9];
    const float* w_q = args.in[10]; const float* w_kv = args.in[11]; const float* w_o = args.in[12]; const float* g_ffn = args.in[13]; const float* w_gate = args.in[14];
    const float* w_up = args.in[15]; const float* conv_w = args.in[16]; const float* conv_b = args.in[17]; const float* w_down = args.in[18]; const float* g_final = args.in[19];
    float* RS0 = (float*)(ws + WS_RS0); float* RSM = (float*)(ws + WS_RSM); float* SS1 = (float*)(ws + WS_SS1); float* SS2 = (float*)(ws + WS_SS2); float* SS3 = (float*)(ws + WS_SS3);
    float* SSA = (float*)(ws + WS_SSA); float* SSB = (float*)(ws + WS_SSB);
    float* SA1 = SS1; float* SA2 = SS2; float* SA3 = SS3; float* SAA = SSA; float* SAB = SSB;
    if (0) { SA1 = SA2 = SA3 = SAA = SAB = (float*)(ws + WS_DUMMY); }
    float* LUT = (float*)(ws + WS_LUT); float* KMP = (float*)(ws + WS_KMP); float* HALOG = (float*)(ws + WS_HALOG); float* FIXG = (float*)(ws + WS_FIXG); float* FIXU = (float*)(ws + WS_FIXU); float* PS = (float*)(ws + WS_PS);
    bf16* WIN = (bf16*)(ws + WS_WIN); bf16* WOUT = (bf16*)(ws + WS_WOUT); bf16* WQ = (bf16*)(ws + WS_WQ); bf16* WKV = (bf16*)(ws + WS_WKV);
    bf16* WO = (bf16*)(ws + WS_WO); bf16* WGU = (bf16*)(ws + WS_WGU); bf16* WD = (bf16*)(ws + WS_WD);
    bf16* MEMB = (bf16*)(ws + WS_MEMB); bf16* KVM = (bf16*)(ws + WS_KVM); bf16* XB = (bf16*)(ws + WS_XB); bf16* QKV = (bf16*)(ws + WS_QKV);
    bf16* YN = (bf16*)(ws + WS_YN); bf16* Y = (bf16*)(ws + WS_Y); bf16* OP = (bf16*)(ws + WS_OP); float* LSEP = (float*)(ws + WS_LSEP); bf16* H1 = (bf16*)(ws + WS_H1); bf16* QM = (bf16*)(ws + WS_QM);
    bf16* OM = (bf16*)(ws + WS_OM); bf16* H2 = (bf16*)(ws + WS_H2); bf16* ACT = (bf16*)(ws + WS_ACT); bf16* H3 = (bf16*)(ws + WS_H3);
    const int gw = F.vcu * NWAVES + F.wave, NGW = F.G * NWAVES;
    const int gt = (int)blockIdx.x * (NWAVES * 64) + F.tid, NGT = F.G * NWAVES * 64;

    if (IN(PH_PRO)) {
        LAS float* scr = (LAS float*)(F.lds + RING_OFF + F.wave * 16384);
        constexpr int I_IN = 16 * 96, I_OUT = 16 * 32, I_Q = 16 * 32, I_KV = 16 * 64, I_O = 16 * 32, I_GU = 16 * 176, I_D = 44 * 32;
        constexpr int NITEMS = I_IN + I_OUT + I_Q + I_KV + I_O + I_GU + I_D;
        for (int it = gw; it < NITEMS; it += NGW) {
            int r = it;
            if (r < I_IN) { const int kb = r / 96, nb = r % 96; p0_titem(w_in, 3072, 32 * nb, 64 * kb, g_mix, nullptr, 0, WIN, 1024, 32 * nb, scr, F.lane); continue; } r -= I_IN;
            if (r < I_OUT) { const int kb = r / 32, nb = r % 32; p0_titem(w_out, 1024, 32 * nb, 64 * kb, g_od, g_om, 512, WOUT, 1024, 32 * nb, scr, F.lane); continue; } r -= I_OUT;
            if (r < I_Q) { const int kb = r / 32, nb = r % 32; p0_titem(w_q, 1024, 32 * nb, 64 * kb, g_cross, nullptr, 0, WQ, 1024, 32 * nb, scr, F.lane); continue; } r -= I_Q;
            if (r < I_KV) { const int kb = r / 64, nb = r % 64; p0_titem(w_kv, 2048, 32 * nb, 64 * kb, g_mem, nullptr, 0, WKV, 1024, 32 * nb, scr, F.lane); continue; } r -= I_KV;
            if (r < I_O) { const int kb = r / 32, nb = r % 32; p0_titem(w_o, 1024, 32 * nb, 64 * kb, nullptr, nullptr, 0, WO, 1024, 32 * nb, scr, F.lane); continue; } r -= I_O;
            if (r < I_GU) { const int kb = r / 176, nb = r % 176; const int nd = 32 * nb, j = nd >> 8, rr = nd & 255;
                const float* src = (rr < 128) ? w_gate : w_up; const int sc = 128 * j + (rr & 127);
                p0_titem(src, 2816, sc, 64 * kb, g_ffn, nullptr, 0, WGU, 1024, nd, scr, F.lane); continue; } r -= I_GU;
            { const int kb = r / 32, nb = r % 32; p0_titem(w_down, 1024, 32 * nb, 64 * kb, nullptr, nullptr, 0, WD, 2816, 32 * nb, scr, F.lane); }
        }
        for (int m = 2 * gw; m < NTOK; m += 2 * NGW) p0_norm_rows2(x + (size_t)m * DM, x + (size_t)(m + 1) * DM, XB + (size_t)m * DM, XB + (size_t)(m + 1) * DM, F.lane);
        for (int m = 2 * gw; m < NMEMTOK; m += 2 * NGW) p0_norm_rows2(mem + (size_t)m * DM, mem + (size_t)(m + 1) * DM, MEMB + (size_t)m * DM, MEMB + (size_t)(m + 1) * DM, F.lane);
        for (int i = gt; i < 16 * 2048; i += NGT) { const int h = i >> 11, n = i & 2047; int b;
            if (n < 16) b = n; else { b = 16 + (n >= 22) + (n >= 30) + (n >= 40) + (n >= 54) + (n >= 73) + (n >= 99) + (n >= 134) + (n >= 182) + (n >= 246) + (n >= 332) + (n >= 450) + (n >= 609) + (n >= 825) + (n >= 1117) + (n >= 1513); }
            LUT[i] = rel_bias[h * 32 + b]; }
        for (int i = gt; i < NTOK; i += NGT) { SA1[i] = 0.f; SA2[i] = 0.f; SAA[i] = 0.f; SAB[i] = 0.f; }
    }
    SEAM(PH_PRO);

#define STAGGER(ticks) do { const unsigned long long t0_ = __builtin_amdgcn_s_memrealtime(); const unsigned long long d_ = (unsigned long long)((F.vcu & 3) * (ticks)); \
        while (__builtin_amdgcn_s_memrealtime() - t0_ < d_) __builtin_amdgcn_s_sleep(32); } while (0)
    if (IN(PH_QKV)) {
        { pg8::Gemm g{XB, WIN, NTOK, NQKV, 1024}; pg8::StaticOrder S; S.init(NTOK, NQKV, F.G, (int)blockIdx.x);
          pg8::EpiScale E{(0   & 128) ? (bf16*)(ws + WS_H1) : QKV, RS0, (0   & 128) ? nullptr : KMP, NQKV, ((0   & 32) ? 64 : 0) | ((0   & 64) ? 128 : 0) | ((0   & 128) ? 256 : 0)};
          pg8::gemm_phase<pg8::EpiScale, pg8::StaticOrder, true, true>(F.lds + RING_OFF, g, S, E); }
        { pg8::Gemm g{MEMB, WKV, NMEMTOK, 2048, 1024}; pg8::StaticOrder S; S.init(NMEMTOK, 2048, F.G, (int)blockIdx.x);
          pg8::EpiScale E{KVM, RSM, nullptr, 2048, 0};
          pg8::gemm_phase<pg8::EpiScale, pg8::StaticOrder, true, true>(F.lds + RING_OFF, g, S, E); }
    }
    SEAM(PH_QKV);
        if (IN(PH_ATT)) {
        if (3 & 1) att::moba_phase(F.lds, QKV, KMP, LUT, 0   ? (bf16*)(ws + WS_H1) : Y, 0   ? nullptr : SAB, F.vcu, F.G, 0  );
        __syncthreads();
        if (3 & 2) att::dil_phase(F.lds, QKV, LUT, Y, SAA, F.vcu, F.G);
    }

    SEAM(PH_ATT);

    if (IN(PH_OUT)) {
        pg8::Gemm g{Y, WOUT, NTOK, DM, 1024}; pg8::StaticOrder S; S.init(NTOK, DM, F.G, (int)blockIdx.x);
        pg8::EpiOutProj E{H1, x, SA1, SSA, SSB, DM, 0};
        pg8::gemm_phase<pg8::EpiOutProj, pg8::StaticOrder, true, true>(F.lds + RING_OFF, g, S, E);
    }
    SEAM(PH_OUT);
    if (IN(PH_QM)) {
        pg8::Gemm g{H1, WQ, NTOK, DM, 1024}; pg8::StaticOrder S; S.init(NTOK, DM, F.G, (int)blockIdx.x);
        pg8::EpiScale E{QM, SS1, nullptr, DM, 1};
        pg8::gemm_phase<pg8::EpiScale, pg8::StaticOrder, true, true>(F.lds + RING_OFF, g, S, E);
    }
    SEAM(PH_QM);
        if (IN(PH_CROSS)) att::cross_phase(F.lds, QM, KVM, OM, F.vcu, F.G, (0   >> 12) & 3);

    SEAM(PH_CROSS);
    if (IN(PH_OM)) {
        pg8::Gemm g{OM, WO, NTOK, DM, 1024}; pg8::StaticOrder S; S.init(NTOK, DM, F.G, (int)blockIdx.x);
        pg8::EpiResid E{H2, H1, SA2, DM, 0};
        pg8::gemm_phase<pg8::EpiResid, pg8::StaticOrder, true, true>(F.lds + RING_OFF, g, S, E);
    }
    SEAM(PH_OM);
    if (IN(PH_FFN1)) {
        pg8::Gemm g{H2, WGU, NTOK, 5632, 1024}; pg8::StaticOrder S; S.init(NTOK, 5632, F.G, (int)blockIdx.x);
        pg8::EpiFfn1 E{ACT, SS2, conv_w, conv_b, HALOG, FIXG, FIXU, (LAS float*)(F.lds + LDSX_OFF), (0   >> 8) & 3, 0};
        pg8::gemm_phase<pg8::EpiFfn1, pg8::StaticOrder, true, true>(F.lds + RING_OFF, g, S, E);
    }
    SEAM(PH_FFN1);
    if (IN(PH_FIX)) {
        for (int i = gt; i < 256 * 2816; i += NGT) { const int pm = i / 2816, c = i % 2816;
            const float g0 = FIXG[((size_t)pm * 2 + 0) * 2816 + c], g1 = FIXG[((size_t)pm * 2 + 1) * 2816 + c];
            float hm1 = 0.f, hm2 = 0.f; if (pm & 7) { hm2 = HALOG[((size_t)(pm - 1) * 2 + 0) * 2816 + c]; hm1 = HALOG[((size_t)(pm - 1) * 2 + 1) * 2816 + c]; }
            const float w0 = conv_w[c], w1 = conv_w[2816 + c], w2 = conv_w[2 * 2816 + c], cbv = conv_b[c];
            const float c0 = cbv + w2 * g0 + w1 * hm1 + w0 * hm2, c1 = cbv + w2 * g1 + w1 * g0 + w0 * hm1;
            ACT[((size_t)pm * 256 + 0) * 2816 + c] = (bf16)f2bf(c0 / (1.f + __expf(-c0)) * FIXU[((size_t)pm * 2 + 0) * 2816 + c]);
            ACT[((size_t)pm * 256 + 1) * 2816 + c] = (bf16)f2bf(c1 / (1.f + __expf(-c1)) * FIXU[((size_t)pm * 2 + 1) * 2816 + c]); }
    }
    SEAM(PH_FIX);
    if (IN(PH_DOWN)) {
        pg8::Gemm g{ACT, WD, NTOK, DM, DFF}; pg8::StaticOrder S0; S0.init(NTOK, DM, F.G, (int)blockIdx.x);
        pg8::EpiFinal<XcdBarrier> E{H2, args.out, g_final, PS, &bar};
        { pg8::RoundOrder S{S0, 0}; pg8::gemm_phase<pg8::EpiFinal<XcdBarrier>, pg8::RoundOrder, false, true>(F.lds + RING_OFF, g, S, E); }
        __syncthreads();
        { pg8::RoundOrder S{S0, 1}; pg8::gemm_phase<pg8::EpiFinal<XcdBarrier>, pg8::RoundOrder, false, true>(F.lds + RING_OFF, g, S, E); }
        __syncthreads();
        { pg8::RoundOrder S{S0, 2}; pg8::gemm_phase<pg8::EpiFinal<XcdBarrier>, pg8::RoundOrder, false, true>(F.lds + RING_OFF, g, S, E); }
        __syncthreads();
        { pg8::RoundOrder S{S0, 3}; pg8::gemm_phase<pg8::EpiFinal<XcdBarrier>, pg8::RoundOrder, false, true>(F.lds + RING_OFF, g, S, E); }
    }
#undef IN
#undef SEAM
}


extern "C" void kernel_launch(void* const* d_in, const int* in_sizes, int n_in, void* d_out, int out_size, void* d_ws, size_t ws_size, hipStream_t stream) {
    static int grid = 0;
    if (grid == 0) {
        if (n_in != 20 || in_sizes[0] != NTOK * DM || out_size != NTOK * DM || ws_size < WS_END) { fprintf(stderr, "kernel_launch: unexpected shapes (n_in %d, ws %zu); nothing launched\n", n_in, ws_size); grid = -1; return; }
        int dev = 0, cus = 0, per_cu = 0;
        if (hipGetDevice(&dev) != hipSuccess || hipDeviceGetAttribute(&cus, hipDeviceAttributeMultiprocessorCount, dev) != hipSuccess) { grid = -1; return; }
        if (hipFuncSetAttribute((const void*)mega, hipFuncAttributeMaxDynamicSharedMemorySize, LDS_BYTES) != hipSuccess) { fprintf(stderr, "kernel_launch: hipFuncSetAttribute failed\n"); grid = -1; return; }
        if (hipOccupancyMaxActiveBlocksPerMultiprocessor(&per_cu, (const void*)mega, NWAVES * 64, LDS_BYTES) != hipSuccess || per_cu < 1) fprintf(stderr, "kernel_launch: occupancy query says %d\n", per_cu);
        (void)hipGetLastError();
        grid = cus;
        if (grid != NTOK / 256) { fprintf(stderr, "kernel_launch: this kernel needs exactly %d workgroups (one per CU of a 256-CU device); found %d CUs\n", NTOK / 256, cus); grid = NTOK / 256; }
    }
    if (grid < 0) return;
    unsigned char* ws = (unsigned char*)d_ws;
    (void)hipMemsetAsync(ws + WS_CTL, 0, CTL_ZERO_BYTES, stream);
    Args a{};
    for (int i = 0; i < 20; ++i) a.in[i] = (const float*)d_in[i];
    a.out = (float*)d_out; a.ws = ws; a.att_mask = 3;
    int nbar = 0;
    auto runx = [&](int lo, int hi, int mask, int dummy, int variant = 0) { Args b2 = a; b2.variant = variant; b2.bar_idx = (hi - lo > 1 || (lo <= PH_DOWN && PH_DOWN < hi)) ? nbar++ : 0; b2.ph_lo = lo; b2.ph_hi = hi; b2.att_mask = mask; b2.ss_dummy = dummy; hipLaunchKernelGGL(mega, dim3(grid), dim3(NWAVES * 64), LDS_BYTES, stream, b2); };
    auto run = [&](int lo, int hi) { runx(lo, hi, 3, 0); };
    run(0, PH_N);
}
```

```cpp
#include <hip/hip_runtime.h>
#include <cstdio>
#include <cstdint>

typedef unsigned short bf16;
constexpr int BATCH = 32, SEQ = 2048, DM = 1024, NTOK = BATCH * SEQ;
constexpr int NMEM = 256, NMEMTOK = BATCH * NMEM, DFF = 2816;
constexpr int NQKV = 3072;
constexpr float EPS = 1e-6f;

constexpr size_t MiB = 1u << 20;
constexpr size_t WS_CTL = 0, CTL_ZERO_BYTES = 64 * 1024;
constexpr size_t WS_RS0 = 1 * MiB;
constexpr size_t WS_RSM = WS_RS0 + 256 * 1024;
constexpr size_t WS_SS1 = WS_RSM + 256 * 1024;
constexpr size_t WS_SS2 = WS_SS1 + 256 * 1024;
constexpr size_t WS_SS3 = WS_SS2 + 256 * 1024;
constexpr size_t WS_SSA = 27 * MiB, WS_SSB = WS_SSA + 256 * 1024;
constexpr size_t WS_KMEAN = WS_SS3 + 256 * 1024;
constexpr size_t WS_LUT = WS_KMEAN + 512 * 1024;
constexpr size_t WS_KMP = 3 * MiB;
constexpr size_t WS_HALOG = 4 * MiB;
constexpr size_t WS_FIXG = WS_HALOG + 256 * 2 * 2816 * 4;
constexpr size_t WS_FIXU = WS_FIXG + 256 * 2 * 2816 * 4;
constexpr size_t WS_DUMMY = 21 * MiB;
constexpr size_t WS_PS = 22 * MiB;
constexpr size_t WS_LSEP = 23 * MiB;
constexpr size_t WS_WIN = 28 * MiB;
constexpr size_t WS_WOUT = WS_WIN + 6 * MiB;
constexpr size_t WS_WQ = WS_WOUT + 2 * MiB;
constexpr size_t WS_WKV = WS_WQ + 2 * MiB;
constexpr size_t WS_WO = WS_WKV + 4 * MiB;
constexpr size_t WS_WGU = WS_WO + 2 * MiB;
constexpr size_t WS_WD = WS_WGU + 11 * MiB;
constexpr size_t WS_MEMB = 62 * MiB;
constexpr size_t WS_KVM = 78 * MiB;
constexpr size_t WS_XB = 112 * MiB;
constexpr size_t WS_QKV = 240 * MiB;
constexpr size_t WS_Y = 624 * MiB;
constexpr size_t WS_OP = 752 * MiB;
constexpr size_t WS_YN = 240 * MiB;
constexpr size_t WS_H1 = 880 * MiB;
constexpr size_t WS_QM = 368 * MiB;
constexpr size_t WS_OM = 496 * MiB;
constexpr size_t WS_H2 = 624 * MiB;
constexpr size_t WS_ACT = 112 * MiB;
constexpr size_t WS_GU = 752 * MiB;
constexpr size_t WS_H3 = 464 * MiB;
constexpr size_t WS_END = 1024 * MiB;
static_assert(WS_FIXU + 256 * 2 * 2816 * 4 <= WS_LSEP && WS_LSEP + 5 * MiB <= WS_WIN && WS_WD + 6 * MiB <= WS_MEMB, "ws map");

__device__ __forceinline__ unsigned f2bf(float f) { unsigned u = __builtin_bit_cast(unsigned, f); return (u + 0x7fffu + ((u >> 16) & 1u)) >> 16; }
__device__ __forceinline__ float bf2f(bf16 b) { return __builtin_bit_cast(float, (unsigned)b << 16); }
__device__ __forceinline__ float bflo(unsigned w) { return __builtin_bit_cast(float, w << 16); }
__device__ __forceinline__ float bfhi(unsigned w) { return __builtin_bit_cast(float, w & 0xffff0000u); }
__device__ __forceinline__ float wave_sum(float v) {
#pragma unroll
    for (int o = 1; o < 64; o <<= 1) v += __shfl_xor(v, o);
    return v;
}


namespace pg8 {
#define PG8_LAS __attribute__((address_space(3)))
typedef unsigned short bf16_t;
typedef short bf16x8 __attribute__((ext_vector_type(8)));
typedef float f32x4 __attribute__((ext_vector_type(4)));
typedef unsigned u32x4 __attribute__((ext_vector_type(4)));
constexpr int BM = 256, BK = 64, HALF = 128, HTB = HALF * BK * 2  , STAGE_BYTES = 8 * HTB, NXCD = 8, WGM = 8;

__host__ __device__ __forceinline__ int lds_byte(int r, int c) { const int st = (r >> 4) * 2 + (c >> 5), rr = r & 15, cc = c & 31, ob = rr * 64 + cc * 2; return st * 1024 + (ob ^ (((ob >> 9) & 1) << 5)); }
__host__ __device__ __forceinline__ void stage_rc(int b, int& R, int& C) { const int st = b / 1024, sb = b % 1024, swz = sb ^ (((sb >> 9) & 1) << 5); R = (st >> 1) * 16 + swz / 64; C = (st & 1) * 32 + (swz % 64) / 2; }
__host__ __device__ __forceinline__ int perm32(int rho) { const int n = rho >> 4, i = rho & 15; return 8 * (i >> 2) + 4 * n + (i & 3); }

struct Unit { int pm, pn; };
struct Gemm { const bf16_t* A; const bf16_t* Bt; int M, N, K; };

struct StaticOrder {
    int nM, nN, nwg, G, c;
    __host__ __device__ void init(int M, int N, int G_, int c_) { nM = M / BM; nN = N / BM; nwg = nM * nN; G = G_; c = c_; }
    __host__ __device__ bool next(int i, Unit& u) const {
        const long L = (long)i * G + c; if (L >= nwg) return false;
        int wgid = (int)L; { const int q = nwg / NXCD, r = nwg % NXCD, xcd = wgid % NXCD, off = wgid / NXCD; wgid = (xcd < r ? xcd * (q + 1) : r * (q + 1) + (xcd - r) * q) + off; }
        const int nig = WGM * nN, gid = wgid / nig, fm = gid * WGM, gsz = (nM - fm) < WGM ? (nM - fm) : WGM;
        u.pm = fm + ((wgid % nig) % gsz); u.pn = (wgid % nig) / gsz; return true;
    }
    __device__ __forceinline__ void a_ready(const Unit&) const {}
    __device__ __forceinline__ void done(const Unit&) const {}
};


struct PanelOrder { int pm, nN;
    __device__ __forceinline__ bool next(int i, Unit& u) const { if (i >= nN) return false; int a = pm, b = i; asm volatile("" : "+s"(a), "+s"(b)); u.pm = a; u.pn = b; return true; }
    __device__ __forceinline__ void a_ready(const Unit&) const {}
    __device__ __forceinline__ void done(const Unit&) const {} };
__device__ __forceinline__ unsigned cvt_pk_bf16(float lo, float hi) { unsigned r; asm volatile("v_cvt_pk_bf16_f32 %0, %1, %2" : "=v"(r) : "v"(lo), "v"(hi)); return r; }
__device__ __forceinline__ float lo_f(unsigned w) { return __builtin_bit_cast(float, w << 16); }
__device__ __forceinline__ float hi_f(unsigned w) { return __builtin_bit_cast(float, w & 0xffff0000u); }

struct EpiScale {
    static constexpr bool PERM = true, AFTER_DRAIN = false, KSPLIT = false, PERM_A = false;
    bf16_t* O; const float* rs; float* kmp; int ldc; int mode;
    __device__ __forceinline__ void operator()(const f32x4 (&acc)[2][2][4][2], const Unit& u, int wr, int wc, int fr, int fq) const {
        if (mode & 64) return;
        const int row0 = u.pm * BM + wr * 64 + fr, col0 = u.pn * BM + wc * 32 + 8 * fq;
        const bool dokm = (kmp != nullptr) && (u.pn == 8 || u.pn == 9);
        const float qs = ((kmp != nullptr) && (u.pn < 2 || u.pn == 6 || u.pn == 7)) ? 0.125f * 1.4426950408889634f : 1.f;
        float cs[2][8];
#pragma unroll
        for (int bj = 0; bj < 2; ++bj)
#pragma unroll
            for (int e = 0; e < 8; ++e) cs[bj][e] = 0.f;
#pragma unroll
        for (int ai = 0; ai < 2; ++ai)
#pragma unroll
            for (int m = 0; m < 4; ++m) { const int r = row0 + ai * HALF + m * 16; float s = qs; if (mode == 1) s = rsqrtf(rs[r] * (1.f / 1024.f) + 1e-6f);
                bf16_t* rowp = (mode & 256) ? O + (size_t)(r & 255) * ldc + col0 : O + (size_t)r * ldc + col0;
#pragma unroll
                for (int bj = 0; bj < 2; ++bj) { const f32x4 v0 = acc[ai][bj][m][0] * s, v1 = acc[ai][bj][m][1] * s;
                    u32x4 w; w.x = cvt_pk_bf16(v0[0], v0[1]); w.y = cvt_pk_bf16(v0[2], v0[3]); w.z = cvt_pk_bf16(v1[0], v1[1]); w.w = cvt_pk_bf16(v1[2], v1[3]);
                    if (mode & 128) { asm volatile("" :: "v"(w.x), "v"(w.y), "v"(w.z), "v"(w.w)); } else *(u32x4*)(rowp + bj * HALF) = w;
                    if (dokm) { cs[bj][0] += lo_f(w.x); cs[bj][1] += hi_f(w.x); cs[bj][2] += lo_f(w.y); cs[bj][3] += hi_f(w.y); cs[bj][4] += lo_f(w.z); cs[bj][5] += hi_f(w.z); cs[bj][6] += lo_f(w.w); cs[bj][7] += hi_f(w.w); } } }
        if (dokm) {
#pragma unroll
            for (int bj = 0; bj < 2; ++bj)
#pragma unroll
                for (int e = 0; e < 8; ++e) { float v = cs[bj][e]; v += __shfl_xor(v, 1); v += __shfl_xor(v, 2); v += __shfl_xor(v, 4); v += __shfl_xor(v, 8); cs[bj][e] = v; }
            if (fr == 0) { float* kp = kmp + (size_t)(u.pm * 2 + wr) * 512 + (u.pn - 8) * 256 + wc * 32 + 8 * fq;
#pragma unroll
                for (int bj = 0; bj < 2; ++bj) { *(f32x4*)(kp + bj * HALF) = (f32x4){cs[bj][0], cs[bj][1], cs[bj][2], cs[bj][3]}; *(f32x4*)(kp + bj * HALF + 4) = (f32x4){cs[bj][4], cs[bj][5], cs[bj][6], cs[bj][7]}; } }
        }
    }
};

struct EpiResid {
    static constexpr bool PERM = true, AFTER_DRAIN = false, KSPLIT = false, PERM_A = false;
    bf16_t* O; const bf16_t* R; float* ss; int ldc; int pad;
    __device__ __forceinline__ void operator()(const f32x4 (&acc)[2][2][4][2], const Unit& u, int wr, int wc, int fr, int fq) const {
        const int row0 = u.pm * BM + wr * 64 + fr, col0 = u.pn * BM + wc * 32 + 8 * fq;
#pragma unroll
        for (int ai = 0; ai < 2; ++ai)
#pragma unroll
            for (int m = 0; m < 4; ++m) { const int r = row0 + ai * HALF + m * 16; const size_t off = (size_t)r * ldc + col0; float sq = 0.f;
#pragma unroll
                for (int bj = 0; bj < 2; ++bj) { const u32x4 rv = *(const u32x4*)(R + off + bj * HALF);
                    const f32x4 a0 = acc[ai][bj][m][0], a1 = acc[ai][bj][m][1];
                    u32x4 w; w.x = cvt_pk_bf16(a0[0] + lo_f(rv.x), a0[1] + hi_f(rv.x)); w.y = cvt_pk_bf16(a0[2] + lo_f(rv.y), a0[3] + hi_f(rv.y));
                    w.z = cvt_pk_bf16(a1[0] + lo_f(rv.z), a1[1] + hi_f(rv.z)); w.w = cvt_pk_bf16(a1[2] + lo_f(rv.w), a1[3] + hi_f(rv.w));
                    *(u32x4*)(O + off + bj * HALF) = w;
                    float t;
                    t = lo_f(w.x); sq += t * t; t = hi_f(w.x); sq += t * t; t = lo_f(w.y); sq += t * t; t = hi_f(w.y); sq += t * t;
                    t = lo_f(w.z); sq += t * t; t = hi_f(w.z); sq += t * t; t = lo_f(w.w); sq += t * t; t = hi_f(w.w); sq += t * t; }
                sq += __shfl_xor(sq, 16); sq += __shfl_xor(sq, 32);
                if (fq == 0) atomicAdd(ss + r, sq); }
    }
};


struct EpiResidF32 {
    static constexpr bool PERM = true, AFTER_DRAIN = false, KSPLIT = false, PERM_A = false;
    bf16_t* O; const float* R; float* ss; int ldc; int pad;
    __device__ __forceinline__ void operator()(const f32x4 (&acc)[2][2][4][2], const Unit& u, int wr, int wc, int fr, int fq) const {
        const int row0 = u.pm * BM + wr * 64 + fr, col0 = u.pn * BM + wc * 32 + 8 * fq;
#pragma unroll
        for (int ai = 0; ai < 2; ++ai)
#pragma unroll
            for (int m = 0; m < 4; ++m) { const int r = row0 + ai * HALF + m * 16; const size_t off = (size_t)r * ldc + col0; float sq = 0.f;
#pragma unroll
                for (int bj = 0; bj < 2; ++bj) { const f32x4 r0 = *(const f32x4*)(R + off + bj * HALF), r1 = *(const f32x4*)(R + off + bj * HALF + 4);
                    const f32x4 a0 = acc[ai][bj][m][0] + r0, a1 = acc[ai][bj][m][1] + r1;
                    u32x4 w; w.x = cvt_pk_bf16(a0[0], a0[1]); w.y = cvt_pk_bf16(a0[2], a0[3]); w.z = cvt_pk_bf16(a1[0], a1[1]); w.w = cvt_pk_bf16(a1[2], a1[3]);
                    *(u32x4*)(O + off + bj * HALF) = w;
                    float t;
                    t = lo_f(w.x); sq += t * t; t = hi_f(w.x); sq += t * t; t = lo_f(w.y); sq += t * t; t = hi_f(w.y); sq += t * t;
                    t = lo_f(w.z); sq += t * t; t = hi_f(w.z); sq += t * t; t = lo_f(w.w); sq += t * t; t = hi_f(w.w); sq += t * t; }
                sq += __shfl_xor(sq, 16); sq += __shfl_xor(sq, 32);
                if (fq == 0) atomicAdd(ss + r, sq); }
    }
};


struct EpiOutProj {
    static constexpr bool PERM = true, AFTER_DRAIN = false, KSPLIT = true, PERM_A = false;
    bf16_t* O; const float* R; float* ss; const float* ssa; const float* ssb; int ldc; int pad;
    __device__ __forceinline__ void mid(f32x4 (&acc)[2][2][4][2], const Unit& u, int wr, int fr) const {
        asm volatile("" : "+v"(fr));
#pragma unroll
        for (int ai = 0; ai < 2; ++ai) {
#pragma unroll
            for (int m = 0; m < 4; ++m) { const int r = u.pm * BM + ai * HALF + wr * 64 + m * 16 + fr;
                const float ratio = rsqrtf(ssa[r] * (1.f / 512.f) + 1e-6f) * sqrtf(ssb[r] * (1.f / 512.f) + 1e-6f);
#pragma unroll
                for (int bj = 0; bj < 2; ++bj) { acc[ai][bj][m][0] *= ratio; acc[ai][bj][m][1] *= ratio; } }
            asm volatile("" ::: "memory"); __builtin_amdgcn_sched_barrier(0); }
    }
    __device__ __forceinline__ void operator()(const f32x4 (&acc)[2][2][4][2], const Unit& u, int wr, int wc, int fr, int fq) const {
        const int row0 = u.pm * BM + wr * 64 + fr, col0 = u.pn * BM + wc * 32 + 8 * fq;
#pragma unroll
        for (int ai = 0; ai < 2; ++ai)
#pragma unroll
            for (int m = 0; m < 4; ++m) { const int r = row0 + ai * HALF + m * 16; const size_t off = (size_t)r * ldc + col0; float sq = 0.f;
                const float rsb = rsqrtf(ssb[r] * (1.f / 512.f) + 1e-6f);
#pragma unroll
                for (int bj = 0; bj < 2; ++bj) { const f32x4 r0 = *(const f32x4*)(R + off + bj * HALF), r1 = *(const f32x4*)(R + off + bj * HALF + 4);
                    const f32x4 a0 = acc[ai][bj][m][0] * rsb + r0, a1 = acc[ai][bj][m][1] * rsb + r1;
                    u32x4 w; w.x = cvt_pk_bf16(a0[0], a0[1]); w.y = cvt_pk_bf16(a0[2], a0[3]); w.z = cvt_pk_bf16(a1[0], a1[1]); w.w = cvt_pk_bf16(a1[2], a1[3]);
                    *(u32x4*)(O + off + bj * HALF) = w;
                    float t;
                    t = lo_f(w.x); sq += t * t; t = hi_f(w.x); sq += t * t; t = lo_f(w.y); sq += t * t; t = hi_f(w.y); sq += t * t;
                    t = lo_f(w.z); sq += t * t; t = hi_f(w.z); sq += t * t; t = lo_f(w.w); sq += t * t; t = hi_f(w.w); sq += t * t; }
                sq += __shfl_xor(sq, 16); sq += __shfl_xor(sq, 32);
                if (fq == 0) atomicAdd(ss + r, sq); }
    }
};

struct RoundOrder { StaticOrder S; int r;
    __device__ __forceinline__ bool next(int i, Unit& u) const { return i == 0 && S.next(r, u); }
    __device__ __forceinline__ void a_ready(const Unit&) const {}
    __device__ __forceinline__ void done(const Unit&) const {} };
template <class Bar> struct EpiFinal {
    static constexpr bool PERM = false, AFTER_DRAIN = true, KSPLIT = false, PERM_A = false;
    const bf16_t* R; float* out; const float* g; float* ps; const Bar* bar;
    __device__ __forceinline__ void fused(f32x4 (&acc)[2][2][4][2], const Unit& u, int wr, int wc, int fr, int fq, PG8_LAS unsigned char* lds, int wid, int lane) const {
        typedef unsigned u32x2v __attribute__((ext_vector_type(2)));
        PG8_LAS float* P = (PG8_LAS float*)lds;
        PG8_LAS float* S = (PG8_LAS float*)(lds + 4096);
        const int col0 = u.pn * BM + wc * 32 + 4 * fq, tid = wid * 64 + lane;
#pragma unroll
        for (int ai = 0; ai < 2; ++ai)
#pragma unroll
            for (int m = 0; m < 4; ++m) { const int rl = ai * HALF + wr * 64 + m * 16 + fr; const size_t off = (size_t)(u.pm * BM + rl) * 1024 + col0; float sq = 0.f;
#pragma unroll
                for (int bj = 0; bj < 2; ++bj)
#pragma unroll
                    for (int n = 0; n < 2; ++n) { const u32x2v rv = *(const u32x2v*)(R + off + bj * HALF + n * 16);
                        f32x4 v = acc[ai][bj][m][n]; v[0] += lo_f(rv.x); v[1] += hi_f(rv.x); v[2] += lo_f(rv.y); v[3] += hi_f(rv.y); acc[ai][bj][m][n] = v;
                        sq += (v[0] * v[0] + v[1] * v[1]) + (v[2] * v[2] + v[3] * v[3]); }
                sq += __shfl_xor(sq, 16); sq += __shfl_xor(sq, 32);
                if (fq == 0) P[rl * 4 + wc] = sq; }
        asm volatile("s_waitcnt lgkmcnt(0)" ::: "memory"); __builtin_amdgcn_s_barrier(); asm volatile("" ::: "memory");
        if (tid < 256) { const f32x4 p4 = *(const PG8_LAS f32x4*)(P + tid * 4); ps[(size_t)(u.pm * BM + tid) * 4 + u.pn] = (p4[0] + p4[1]) + (p4[2] + p4[3]); }
        xcd_barrier(*bar);
        if (tid < 256) { const f32x4 q4 = *(const f32x4*)(ps + (size_t)(u.pm * BM + tid) * 4); S[tid] = rsqrtf(((q4[0] + q4[1]) + (q4[2] + q4[3])) * (1.f / 1024.f) + 1e-6f); }
        asm volatile("s_waitcnt vmcnt(0) lgkmcnt(0)" ::: "memory"); __builtin_amdgcn_s_barrier(); asm volatile("" ::: "memory");
        f32x4 gv[2][2];
#pragma unroll
        for (int bj = 0; bj < 2; ++bj)
#pragma unroll
            for (int n = 0; n < 2; ++n) gv[bj][n] = *(const f32x4*)(g + col0 + bj * HALF + n * 16);
#pragma unroll
        for (int ai = 0; ai < 2; ++ai)
#pragma unroll
            for (int m = 0; m < 4; ++m) { const int rl = ai * HALF + wr * 64 + m * 16 + fr; const float rs = S[rl]; const size_t off = (size_t)(u.pm * BM + rl) * 1024 + col0;
#pragma unroll
                for (int bj = 0; bj < 2; ++bj)
#pragma unroll
                    for (int n = 0; n < 2; ++n) *(f32x4*)(out + off + bj * HALF + n * 16) = acc[ai][bj][m][n] * rs * gv[bj][n]; }
        asm volatile("s_waitcnt lgkmcnt(0)" ::: "memory"); __builtin_amdgcn_s_barrier(); asm volatile("" ::: "memory");
    }
};

__device__ __forceinline__ float dpp_shr1(float oldv, float src) { return __builtin_bit_cast(float, __builtin_amdgcn_update_dpp(__builtin_bit_cast(int, oldv), __builtin_bit_cast(int, src), 0x111, 0xf, 0xf, false)); }
__device__ __forceinline__ float dpp_shr2(float oldv, float src) { return __builtin_bit_cast(float, __builtin_amdgcn_update_dpp(__builtin_bit_cast(int, oldv), __builtin_bit_cast(int, src), 0x112, 0xf, 0xf, false)); }
__device__ __forceinline__ float dpp_ror1(float src) { return __builtin_bit_cast(float, __builtin_amdgcn_update_dpp(0, __builtin_bit_cast(int, src), 0x121, 0xf, 0xf, false)); }
__device__ __forceinline__ float dpp_ror2(float src) { return __builtin_bit_cast(float, __builtin_amdgcn_update_dpp(0, __builtin_bit_cast(int, src), 0x122, 0xf, 0xf, false)); }
struct EpiFfn1 {
    static constexpr bool PERM = true, AFTER_DRAIN = false, KSPLIT = false, PERM_A = true;
    bf16_t* ACT; const float* ss2; const float* cw; const float* cb; float* halog; float* fixg; float* fixu; PG8_LAS float* hl; int probe, pad;
    __device__ __forceinline__ void operator()(const f32x4 (&acc)[2][2][4][2], const Unit& u, int wr, int wc, int fr, int fq) const {
        constexpr int FF = 2816;
        if (probe & 1) return;
        const int ch0 = u.pn * HALF + wc * 32 + 8 * fq;
        float rsv[2][4];
#pragma unroll
        for (int ai = 0; ai < 2; ++ai) { const f32x4 s4 = *(const f32x4*)(ss2 + u.pm * BM + ai * HALF + wr * 64 + 4 * fr);
#pragma unroll
            for (int m = 0; m < 4; ++m) rsv[ai][m] = rsqrtf(s4[m] * (1.f / 1024.f) + 1e-6f); }
        if (fr == 15) {
#pragma unroll
            for (int ai = 0; ai < 2; ++ai) { const int G = 2 * ai + wr;
#pragma unroll
                for (int j = 0; j < 2; ++j) { PG8_LAS float* p = hl + (((G * 4 + wc) * 2 + j) * 4 + fq) * 8;
                    *(PG8_LAS f32x4*)p = acc[ai][0][2 + j][0] * rsv[ai][2 + j]; *(PG8_LAS f32x4*)(p + 4) = acc[ai][0][2 + j][1] * rsv[ai][2 + j]; } } }
        constexpr float L2E = 1.4426950408889634f, IL2E = 0.6931471805599453f;
        const f32x4 w0a = *(const f32x4*)(cw + ch0) * L2E, w0b = *(const f32x4*)(cw + ch0 + 4) * L2E, w1a = *(const f32x4*)(cw + FF + ch0) * L2E, w1b = *(const f32x4*)(cw + FF + ch0 + 4) * L2E;
        const f32x4 w2a = *(const f32x4*)(cw + 2 * FF + ch0) * L2E, w2b = *(const f32x4*)(cw + 2 * FF + ch0 + 4) * L2E, cba = *(const f32x4*)(cb + ch0) * L2E, cbb = *(const f32x4*)(cb + ch0 + 4) * L2E;
        asm volatile("s_waitcnt lgkmcnt(0)" ::: "memory"); __builtin_amdgcn_s_barrier(); asm volatile("" ::: "memory");
#pragma unroll
        for (int ai = 0; ai < 2; ++ai) { const int G = 2 * ai + wr; const int rbase = u.pm * BM + ai * HALF + wr * 64 + 4 * fr;
            f32x4 h2a = (f32x4){0.f, 0.f, 0.f, 0.f}, h2b = h2a, h3a = h2a, h3b = h2a;
            if (G > 0 && fr == 0) { const PG8_LAS float* p = hl + ((((G - 1) * 4 + wc) * 2) * 4 + fq) * 8; h2a = *(const PG8_LAS f32x4*)p; h2b = *(const PG8_LAS f32x4*)(p + 4); h3a = *(const PG8_LAS f32x4*)(p + 32); h3b = *(const PG8_LAS f32x4*)(p + 36); }
            f32x4 g[4][2], uu[4][2];
#pragma unroll
            for (int m = 0; m < 4; ++m) { const float s = rsv[ai][m]; g[m][0] = acc[ai][0][m][0] * s; g[m][1] = acc[ai][0][m][1] * s; uu[m][0] = acc[ai][1][m][0] * (s * IL2E); uu[m][1] = acc[ai][1][m][1] * (s * IL2E); }
            f32x4 s2[2], s3[2];
#pragma unroll
            for (int e = 0; e < 4; ++e) { s3[0][e] = dpp_shr1(h3a[e], g[3][0][e]); s3[1][e] = dpp_shr1(h3b[e], g[3][1][e]); s2[0][e] = dpp_shr1(h2a[e], g[2][0][e]); s2[1][e] = dpp_shr1(h2b[e], g[2][1][e]); }
#pragma unroll
            for (int m = 0; m < 4; ++m) {
                f32x4 o[2];
#pragma unroll
                for (int hx = 0; hx < 2; ++hx) { const f32x4 w0 = hx ? w0b : w0a, w1 = hx ? w1b : w1a, w2 = hx ? w2b : w2a, cbx = hx ? cbb : cba;
                    const f32x4 g1 = (m == 0) ? s3[hx] : g[m - 1][hx], g2 = (m == 0) ? s2[hx] : (m == 1 ? s3[hx] : g[m - 2][hx]);
#pragma unroll
                    for (int e = 0; e < 4; ++e) { const float c = __builtin_fmaf(w0[e], g2[e], __builtin_fmaf(w1[e], g1[e], __builtin_fmaf(w2[e], g[m][hx][e], cbx[e])));
                        o[hx][e] = c * __builtin_amdgcn_rcpf(1.f + __builtin_amdgcn_exp2f(-c)) * uu[m][hx][e]; } }
                const bool defer = (G == 0 && fr == 0 && m < 2);
                if (defer) { float* pg = fixg + ((size_t)u.pm * 2 + m) * FF + ch0; float* pu = fixu + ((size_t)u.pm * 2 + m) * FF + ch0;
                    *(f32x4*)pg = g[m][0]; *(f32x4*)(pg + 4) = g[m][1]; *(f32x4*)pu = uu[m][0] * L2E; *(f32x4*)(pu + 4) = uu[m][1] * L2E; }
                else { u32x4 w; w.x = cvt_pk_bf16(o[0][0], o[0][1]); w.y = cvt_pk_bf16(o[0][2], o[0][3]); w.z = cvt_pk_bf16(o[1][0], o[1][1]); w.w = cvt_pk_bf16(o[1][2], o[1][3]);
                    if (probe & 2) { asm volatile("" :: "v"(w.x), "v"(w.y), "v"(w.z), "v"(w.w)); } else *(u32x4*)(ACT + (size_t)(rbase + m) * FF + ch0) = w; }
                if (G == 3 && fr == 15 && m >= 2) { float* ph = halog + ((size_t)u.pm * 2 + (m - 2)) * FF + ch0; *(f32x4*)ph = g[m][0]; *(f32x4*)(ph + 4) = g[m][1]; } } }
    }
};

template <class Epi, class Sched, bool ALIGN_EPI = false, bool SP2 = false>
__device__ __forceinline__ void gemm_phase(PG8_LAS unsigned char* lds, const Gemm g, const Sched& S, const Epi& E) {
    int tid_ = threadIdx.x; asm volatile("" : "+v"(tid_));
    const int tid = tid_, wid = __builtin_amdgcn_readfirstlane(tid >> 6), lane = tid & 63, wr = wid >> 2, wc = wid & 3, fr = lane & 15, fq = lane >> 4;
    const int K = g.K, nt = K / BK;
    unsigned voffA[2], voffB[2];
#pragma unroll
    for (int i = 0; i < 2; ++i) { int R, C; stage_rc(tid * 16 + i * 8192, R, C); const int Rb = Epi::PERM ? ((R & ~31) + perm32(R & 31)) : R;
        const int Ra = Epi::PERM_A ? ((R & ~63) + 4 * (R & 15) + ((R >> 4) & 3)) : R;
        voffA[i] = (unsigned)(Ra * K + C) * 2u; voffB[i] = (unsigned)(Rb * K + C) * 2u; }
    const size_t kstep = (size_t)(BK * 2);
    const size_t hstep = (size_t)HALF * K * 2;
    const size_t tstep = 2 * hstep;
    const unsigned ldsw = (unsigned)wid * 1024u;
    const int aoff = lds_byte(wr * 64 + fr, fq * 8), boff = lds_byte(wc * 32 + fr, fq * 8);
#define PG8_SA(b, h) (((b) * 2 + (h)) * HTB)
#define PG8_SB(b, h) ((4 + (b) * 2 + (h)) * HTB)
#define PG8_STAGE(bufoff, gbase, voff) do { _Pragma("unroll") for (int _i = 0; _i < 2; ++_i) \
        __builtin_amdgcn_global_load_lds((const unsigned*)((const char*)(gbase) + (voff)[_i]), (PG8_LAS unsigned*)(lds + (bufoff) + ldsw + _i * 8192), 16, 0, 0); } while (0)
#define PG8_LDA(dst, b, h) do { _Pragma("unroll") for (int m = 0; m < 4; ++m) _Pragma("unroll") for (int k = 0; k < 2; ++k) dst[m][k] = *(const PG8_LAS bf16x8*)(lds + PG8_SA(b, h) + aoff + m * 2048 + k * 1024); } while (0)
#define PG8_LDB(dst, b, h) do { _Pragma("unroll") for (int n = 0; n < 2; ++n) _Pragma("unroll") for (int k = 0; k < 2; ++k) dst[n][k] = *(const PG8_LAS bf16x8*)(lds + PG8_SB(b, h) + boff + n * 2048 + k * 1024); } while (0)
#define PG8_MMA(ai, bj, At, Bt) do { __builtin_amdgcn_s_setprio(1); _Pragma("unroll") for (int m = 0; m < 4; ++m) _Pragma("unroll") for (int n = 0; n < 2; ++n) _Pragma("unroll") for (int k = 0; k < 2; ++k) \
        acc[ai][bj][m][n] = __builtin_amdgcn_mfma_f32_16x16x32_bf16(Bt[n][k], At[m][k], acc[ai][bj][m][n], 0, 0, 0); __builtin_amdgcn_s_setprio(0); } while (0)
#define PG8_WAIT_V(n) asm volatile("s_waitcnt vmcnt(" #n ")" ::: "memory")
#define PG8_WAIT_L(n) asm volatile("s_waitcnt lgkmcnt(" #n ")" ::: "memory")
#define PG8_BAR __builtin_amdgcn_s_barrier()
#define PG8_SCHED __builtin_amdgcn_sched_barrier(0)
    Unit cur, nxt; int ui = 0;
    if (!S.next(0, cur)) return;
    f32x4 acc[2][2][4][2];
#pragma unroll
    for (int a = 0; a < 2; ++a)
#pragma unroll
        for (int b = 0; b < 2; ++b)
#pragma unroll
            for (int m = 0; m < 4; ++m)
#pragma unroll
                for (int n = 0; n < 2; ++n) acc[a][b][m][n] = (f32x4){0.f, 0.f, 0.f, 0.f};
    bf16x8 At[4][2], B0[2][2], B1[2][2];
    const char* cA = (const char*)g.A + (size_t)cur.pm * tstep; const char* cB = (const char*)g.Bt + (size_t)cur.pn * tstep;
    S.a_ready(cur);
    if constexpr (SP2) {
        PG8_STAGE(PG8_SB(0, 0), cB, voffB); PG8_STAGE(PG8_SB(0, 1), cB + hstep, voffB); PG8_STAGE(PG8_SA(0, 0), cA, voffA); PG8_STAGE(PG8_SA(0, 1), cA + hstep, voffA);
        if (wr == 1) PG8_BAR;
        PG8_WAIT_V(2); PG8_BAR;
        PG8_STAGE(PG8_SB(1, 0), cB + kstep, voffB); PG8_STAGE(PG8_SA(1, 0), cA + kstep, voffA); PG8_STAGE(PG8_SB(1, 1), cB + hstep + kstep, voffB);
        PG8_WAIT_V(6); PG8_BAR;
    } else {
        PG8_STAGE(PG8_SB(0, 0), cB, voffB); PG8_STAGE(PG8_SA(0, 0), cA, voffA); PG8_STAGE(PG8_SB(0, 1), cB + hstep, voffB); PG8_STAGE(PG8_SA(0, 1), cA + hstep, voffA);
        if (wr == 1) PG8_BAR;
        PG8_WAIT_V(4); PG8_BAR;
        PG8_STAGE(PG8_SB(1, 0), cB + kstep, voffB); PG8_STAGE(PG8_SA(1, 0), cA + kstep, voffA); PG8_STAGE(PG8_SB(1, 1), cB + hstep + kstep, voffB);
        PG8_WAIT_V(6); PG8_BAR;
    }
    for (;;) {
        const bool has_next = S.next(ui + 1, nxt);
        const char* nA = has_next ? (const char*)g.A + (size_t)nxt.pm * tstep : cA; const char* nB = has_next ? (const char*)g.Bt + (size_t)nxt.pn * tstep : cB;
        for (int t = 0; t < nt; t += 2) {
            if constexpr (Epi::KSPLIT) { if (t == nt / 2) E.mid(acc, cur, wr, fr); }
            const bool last = (t == nt - 2);
            const char* a1 = cA + (size_t)(t + 1) * kstep;
            const char* a2 = last ? nA : cA + (size_t)(t + 2) * kstep; const char* b2 = last ? nB : cB + (size_t)(t + 2) * kstep;
            const char* a3 = a2 + kstep; const char* b3 = b2 + kstep;
            if (last && has_next) S.a_ready(nxt);
            if constexpr (SP2) {
            PG8_LDB(B0, 0, 0); PG8_LDB(B1, 0, 1); PG8_SCHED; PG8_LDA(At, 0, 0); PG8_STAGE(PG8_SA(1, 1), a1 + hstep, voffA);
            PG8_WAIT_V(8); PG8_WAIT_L(0); PG8_BAR; PG8_MMA(0, 0, At, B0); PG8_MMA(0, 1, At, B1); PG8_BAR; PG8_SCHED;
            PG8_LDA(At, 0, 1); PG8_STAGE(PG8_SB(0, 0), b2, voffB); PG8_STAGE(PG8_SB(0, 1), b2 + hstep, voffB); PG8_STAGE(PG8_SA(0, 0), a2, voffA);
            PG8_WAIT_V(8); PG8_WAIT_L(0); PG8_BAR; PG8_MMA(1, 0, At, B0); PG8_MMA(1, 1, At, B1); PG8_BAR; PG8_SCHED;
            PG8_LDB(B0, 1, 0); PG8_LDB(B1, 1, 1); PG8_SCHED; PG8_LDA(At, 1, 0); PG8_STAGE(PG8_SA(0, 1), a2 + hstep, voffA);
            PG8_WAIT_V(8); PG8_WAIT_L(0); PG8_BAR; PG8_MMA(0, 0, At, B0); PG8_MMA(0, 1, At, B1); PG8_BAR; PG8_SCHED;
            PG8_LDA(At, 1, 1); PG8_STAGE(PG8_SB(1, 0), b3, voffB); PG8_STAGE(PG8_SB(1, 1), b3 + hstep, voffB); PG8_STAGE(PG8_SA(1, 0), a3, voffA);
            PG8_WAIT_V(8); PG8_WAIT_L(0); PG8_BAR; PG8_MMA(1, 0, At, B0); PG8_MMA(1, 1, At, B1); PG8_BAR; PG8_SCHED;
            } else {
            PG8_LDB(B0, 0, 0); PG8_SCHED; PG8_LDA(At, 0, 0); PG8_STAGE(PG8_SA(1, 1), a1 + hstep, voffA);
            PG8_WAIT_L(8); PG8_BAR; PG8_WAIT_L(0); PG8_MMA(0, 0, At, B0); PG8_BAR; PG8_SCHED;
            PG8_LDB(B1, 0, 1); PG8_STAGE(PG8_SB(0, 0), b2, voffB);
            PG8_BAR; PG8_WAIT_L(0); PG8_MMA(0, 1, At, B1); PG8_BAR;
            PG8_LDA(At, 0, 1); PG8_STAGE(PG8_SA(0, 0), a2, voffA);
            PG8_BAR; PG8_WAIT_L(0); PG8_MMA(1, 0, At, B0); PG8_BAR; PG8_SCHED;
            PG8_STAGE(PG8_SB(0, 1), b2 + hstep, voffB);
            PG8_WAIT_V(6); PG8_BAR; PG8_MMA(1, 1, At, B1); PG8_BAR;
            PG8_LDB(B0, 1, 0); PG8_SCHED; PG8_LDA(At, 1, 0); PG8_STAGE(PG8_SA(0, 1), a2 + hstep, voffA);
            PG8_WAIT_L(8); PG8_BAR; PG8_WAIT_L(0); PG8_MMA(0, 0, At, B0); PG8_BAR; PG8_SCHED;
            PG8_LDB(B1, 1, 1); PG8_STAGE(PG8_SB(1, 0), b3, voffB);
            PG8_BAR; PG8_WAIT_L(0); PG8_MMA(0, 1, At, B1); PG8_BAR;
            PG8_LDA(At, 1, 1); PG8_STAGE(PG8_SA(1, 0), a3, voffA);
            PG8_BAR; PG8_WAIT_L(0); PG8_MMA(1, 0, At, B0); PG8_BAR; PG8_SCHED;
            PG8_STAGE(PG8_SB(1, 1), b3 + hstep, voffB);
            PG8_WAIT_V(6); PG8_BAR; PG8_MMA(1, 1, At, B1); PG8_BAR;
            }
        }
        if constexpr (ALIGN_EPI) { if (wr == 0) PG8_BAR; }
        if constexpr (!Epi::AFTER_DRAIN) { E(acc, cur, wr, wc, fr, fq); S.done(cur); }
        if (!has_next) break;
#pragma unroll
        for (int a = 0; a < 2; ++a)
#pragma unroll
            for (int b = 0; b < 2; ++b)
#pragma unroll
                for (int m = 0; m < 4; ++m)
#pragma unroll
                    for (int n = 0; n < 2; ++n) acc[a][b][m][n] = (f32x4){0.f, 0.f, 0.f, 0.f};
        cur = nxt; cA = nA; cB = nB; ++ui;
        if constexpr (ALIGN_EPI) { if (wr == 1) PG8_BAR; }
    }
    PG8_WAIT_V(0);
    if constexpr (!ALIGN_EPI) { if (wr == 0) PG8_BAR; }
    PG8_BAR;
    if constexpr (Epi::AFTER_DRAIN) { E.fused(acc, cur, wr, wc, fr, fq, lds, wid, lane); S.done(cur); }
#undef PG8_SA
#undef PG8_SB
#undef PG8_STAGE
#undef PG8_LDA
#undef PG8_LDB
#undef PG8_MMA
#undef PG8_WAIT_V
#undef PG8_WAIT_L
#undef PG8_BAR
#undef PG8_SCHED
}
}


constexpr int NWAVES = 8;
constexpr int RING_OFF = 0, RING_BYTES = 131072;
constexpr int LDSX_OFF = RING_BYTES;
constexpr int MISC_OFF = RING_BYTES + 8192;
constexpr int LDS_BYTES = 147456;
static_assert(MISC_OFF + 128 <= LDS_BYTES, "LDS map");
constexpr int CW_BAR = 1024;
constexpr int CW_FLAG = 16384;

#define GAS __attribute__((address_space(1)))
#define LAS __attribute__((address_space(3)))
typedef unsigned v4u __attribute__((ext_vector_type(4)));
typedef float f32x4 __attribute__((ext_vector_type(4)));
typedef unsigned u32x2 __attribute__((ext_vector_type(2)));
typedef GAS unsigned gu32;
#define LDS_WAIT() asm volatile("s_waitcnt lgkmcnt(0)" ::: "memory")
#define VM_WAIT() asm volatile("s_waitcnt vmcnt(0)" ::: "memory")
__device__ __forceinline__ unsigned pk2(float lo, float hi) { return f2bf(lo) | (f2bf(hi) << 16); }

#define XB_TMO      128
#define XB_XCNT(j)  (256  + 64 * (j))
#define XB_XSUB(j)  (1280 + 64 * (j))
#define XB_XGEN(j)  (2304 + 64 * (j))
#define XB_TOP      3328
#define XB_TOPGEN   3392
#define XCD_BAR_WORDS 3456
#define XB_SPIN_CAP (1u << 18)

__device__ __forceinline__ unsigned xb_ld(unsigned* p)              { return __hip_atomic_load(p, __ATOMIC_RELAXED, __HIP_MEMORY_SCOPE_AGENT); }
__device__ __forceinline__ unsigned xb_add(unsigned* p, unsigned v) { return __hip_atomic_fetch_add(p, v, __ATOMIC_RELAXED, __HIP_MEMORY_SCOPE_AGENT); }
__device__ __forceinline__ unsigned xb_xcc_id() { return (unsigned)__builtin_amdgcn_s_getreg((3 << 11) | 20) & 0xFu; }
#define XB_SPIN(cond, bar) do { unsigned _sp = 0; while (cond) { __builtin_amdgcn_s_sleep(1); \
    if ((++_sp & 255u) == 0u) { if (xb_ld(&(bar)[XB_TMO])) break; if (_sp > XB_SPIN_CAP) { atomicAdd(&(bar)[XB_TMO], 1u); break; } } } } while (0)

struct XcdBarrier {
    unsigned* bar; unsigned x;
    volatile LAS unsigned* st;
};

__device__ __forceinline__ XcdBarrier xcd_barrier_post(unsigned* bar, volatile LAS unsigned* st) {
    XcdBarrier b; b.bar = bar; b.x = xb_xcc_id(); b.st = st;
    if (threadIdx.x == 0) (void)xb_add(&bar[XB_XCNT(b.x)], 1u);
    return b;
}
__device__ __forceinline__ void xcd_barrier_complete(unsigned* bar, unsigned x, unsigned& nloc, unsigned& nx) {
    const unsigned G = gridDim.x * gridDim.y * gridDim.z;
    unsigned sum, cnt, mine, sp = 0u;
    for (;;) {
        sum = 0u; cnt = 0u; mine = 0u;
#pragma unroll
        for (unsigned j = 0; j < 16; ++j) { const unsigned c = xb_ld(&bar[XB_XCNT(j)]); sum += c; cnt += (c > 0u) ? 1u : 0u; mine = (j == x) ? c : mine; }
        if (sum == G) break;
        __builtin_amdgcn_s_sleep(1);
        if ((++sp & 255u) == 0u) { if (xb_ld(&bar[XB_TMO])) break; if (sp > XB_SPIN_CAP) { atomicAdd(&bar[XB_TMO], 1u); break; } }
    }
    nloc = mine > 0u ? mine : 1u; nx = cnt > 0u ? cnt : 1u;
}

__device__ __forceinline__ void xcd_barrier(const XcdBarrier& b) {
    asm volatile("s_waitcnt vmcnt(0)" ::: "memory");
    __syncthreads();
    if (threadIdx.x == 0) {
        unsigned* bar = b.bar;
        __builtin_amdgcn_s_waitcnt(0);
        unsigned nloc = b.st[0], nx = b.st[1];
        if (nloc == 0u) { xcd_barrier_complete(bar, b.x, nloc, nx); b.st[0] = nloc; b.st[1] = nx; }
        const unsigned old = xb_add(&bar[XB_XSUB(b.x)], 1u);
        const unsigned gen = old / nloc;
        if (old + 1u == (gen + 1u) * nloc) {
            __builtin_amdgcn_fence(__ATOMIC_RELEASE, "agent");
            asm volatile("s_waitcnt vmcnt(0)" ::: "memory");
            const unsigned og = xb_add(&bar[XB_TOP], 1u);
            const unsigned tg = og / nx;
            if (og + 1u == (tg + 1u) * nx) xb_add(&bar[XB_TOPGEN], 1u);
            else XB_SPIN(xb_ld(&bar[XB_TOPGEN]) == tg, bar);
            __builtin_amdgcn_fence(__ATOMIC_ACQUIRE, "agent");
            xb_add(&bar[XB_XGEN(b.x)], 1u);
            asm volatile("s_waitcnt vmcnt(0)" ::: "memory");
        } else {
            XB_SPIN(xb_ld(&bar[XB_XGEN(b.x)]) == gen, bar);
            __builtin_amdgcn_fence(__ATOMIC_ACQUIRE, "agent");
            asm volatile("s_waitcnt vmcnt(0)" ::: "memory");
        }
    }
    __syncthreads();
}


namespace att {
typedef short bf16x8 __attribute__((ext_vector_type(8)));
typedef short s16x4 __attribute__((ext_vector_type(4)));
typedef float f32x16 __attribute__((ext_vector_type(16)));
typedef unsigned u32x4 __attribute__((ext_vector_type(4)));
typedef unsigned u32x2 __attribute__((ext_vector_type(2)));
constexpr float LOG2E = 1.4426950408889634f;
#define LBAR() do { asm volatile("s_waitcnt lgkmcnt(0)" ::: "memory"); __builtin_amdgcn_s_barrier(); asm volatile("" ::: "memory"); } while (0)
__device__ __forceinline__ int kappa(int r) { return (r & ~12) | ((r & 4) << 1) | ((r & 8) >> 1); }
__device__ __forceinline__ f32x16 mfma32(bf16x8 a, bf16x8 b, f32x16 c) { return __builtin_amdgcn_mfma_f32_32x32x16_bf16(a, b, c, 0, 0, 0); }
__device__ __forceinline__ s16x4 vtr(const LAS unsigned char* p) { return __builtin_bit_cast(s16x4, __builtin_amdgcn_ds_read_tr16_b64_v4i16((LAS s16x4*)p)); }
__device__ __forceinline__ bf16x8 cat8(s16x4 a, s16x4 b) { return (bf16x8){a[0], a[1], a[2], a[3], b[0], b[1], b[2], b[3]}; }
typedef float f32x2_t __attribute__((ext_vector_type(2))); typedef __bf16 bf16x2_t __attribute__((ext_vector_type(2)));
__device__ __forceinline__ unsigned cvtpk(float lo, float hi) { const f32x2_t v = {lo, hi}; return __builtin_bit_cast(unsigned, __builtin_convertvector(v, bf16x2_t)); }
__device__ __forceinline__ float xhalf_max(float v) { return fmaxf(v, __shfl_xor(v, 32)); }
__device__ __forceinline__ float xhalf_sum(float v) { return v + __shfl_xor(v, 32); }
__device__ __forceinline__ bf16x8 packp(const f32x16& p, int s) {
    u32x4 w; w.x = cvtpk(p[8 * s + 0], p[8 * s + 1]); w.y = cvtpk(p[8 * s + 2], p[8 * s + 3]); w.z = cvtpk(p[8 * s + 4], p[8 * s + 5]); w.w = cvtpk(p[8 * s + 6], p[8 * s + 7]);
    return __builtin_bit_cast(bf16x8, w);
}
__device__ __forceinline__ int tr_off(int lane, int VP) { const int hi = lane >> 5, blk = (lane >> 4) & 1, q4 = (lane & 15) >> 2, p4 = lane & 3; return (8 * hi + q4) * VP + (16 * blk + 4 * p4) * 2; }


#define TR_RD(DST, ADDR, OFF) asm volatile("ds_read_b64_tr_b16 %0, %1 offset:%2" : "=v"(DST) : "v"(ADDR), "i"(OFF))
#define TR_WAIT(N, A, B) asm volatile("s_waitcnt lgkmcnt(" #N ")" : "+v"(A), "+v"(B))
#define PV_CHAIN2(ACC, ADDR, VP, F0, F1) do { s16x4 l0, h0, l1, h1; const unsigned ad_ = (ADDR); \
    TR_RD(l0, ad_, 0 * (VP)); TR_RD(h0, ad_, 4 * (VP)); TR_RD(l1, ad_, 16 * (VP)); TR_RD(h1, ad_, 20 * (VP)); \
    TR_WAIT(2, l0, h0); ACC = mfma32(cat8(l0, h0), F0, ACC); TR_WAIT(0, l1, h1); ACC = mfma32(cat8(l1, h1), F1, ACC); } while (0)
#define PV_CHAIN8(ACC, ADDR, VP, F0, F1, F2, F3, F4, F5, F6, F7) do { s16x4 l0, h0, l1, h1, l2, h2, l3, h3, l4, h4, l5, h5, l6, h6, l7, h7; const unsigned ad_ = (ADDR); \
    TR_RD(l0, ad_, 0 * (VP)); TR_RD(h0, ad_, 4 * (VP)); TR_RD(l1, ad_, 16 * (VP)); TR_RD(h1, ad_, 20 * (VP)); TR_RD(l2, ad_, 32 * (VP)); TR_RD(h2, ad_, 36 * (VP)); TR_RD(l3, ad_, 48 * (VP)); TR_RD(h3, ad_, 52 * (VP)); \
    TR_RD(l4, ad_, 64 * (VP)); TR_RD(h4, ad_, 68 * (VP)); TR_RD(l5, ad_, 80 * (VP)); TR_RD(h5, ad_, 84 * (VP)); TR_RD(l6, ad_, 96 * (VP)); TR_RD(h6, ad_, 100 * (VP)); TR_RD(l7, ad_, 112 * (VP)); TR_RD(h7, ad_, 116 * (VP)); \
    TR_WAIT(14, l0, h0); ACC = mfma32(cat8(l0, h0), F0, ACC); TR_WAIT(12, l1, h1); ACC = mfma32(cat8(l1, h1), F1, ACC); TR_WAIT(10, l2, h2); ACC = mfma32(cat8(l2, h2), F2, ACC); TR_WAIT(8, l3, h3); ACC = mfma32(cat8(l3, h3), F3, ACC); \
    TR_WAIT(6, l4, h4); ACC = mfma32(cat8(l4, h4), F4, ACC); TR_WAIT(4, l5, h5); ACC = mfma32(cat8(l5, h5), F5, ACC); TR_WAIT(2, l6, h6); ACC = mfma32(cat8(l6, h6), F6, ACC); TR_WAIT(0, l7, h7); ACC = mfma32(cat8(l7, h7), F7, ACC); } while (0)

constexpr int MB_KP = 144, MB_VP = 192, MB_TN = 2256, MB_TK = 128;
constexpr int MB_K = 0, MB_V = 2 * MB_TK * MB_KP, MB_LUT = MB_V + 2 * MB_TK * MB_VP, MB_KM = MB_LUT + 4 * MB_TN * 4, MB_END = MB_KM + 2048;
__device__ __forceinline__ f32x16 ld_c16(const LAS unsigned char* p) {
    const f32x4 a = *(const LAS f32x4*)p, b = *(const LAS f32x4*)(p + 16), c = *(const LAS f32x4*)(p + 64), d = *(const LAS f32x4*)(p + 80);
    return (f32x16){a[0], a[1], a[2], a[3], b[0], b[1], b[2], b[3], c[0], c[1], c[2], c[3], d[0], d[1], d[2], d[3]};
}
__device__ __forceinline__ float max16(const f32x16& p) { return fmaxf(fmaxf(fmaxf(fmaxf(p[0], p[1]), fmaxf(p[2], p[3])), fmaxf(fmaxf(p[4], p[5]), fmaxf(p[6], p[7]))), fmaxf(fmaxf(fmaxf(p[8], p[9]), fmaxf(p[10], p[11])), fmaxf(fmaxf(p[12], p[13]), fmaxf(p[14], p[15])))); }
__device__ __forceinline__ void moba_phase(LAS unsigned char* lds, const bf16* QKV, const float* KMP, const float* LUT, bf16* Y, float* SSB, int vcu, int G, int variant) {
    const int tid = threadIdx.x, lane = tid & 63, r32 = lane & 31, hi = lane >> 5; const int w = __builtin_amdgcn_readfirstlane(tid >> 6);
    LAS float* tab = (LAS float*)(lds + MB_LUT); LAS float* km = (LAS float*)(lds + MB_KM);
    const int troff = tr_off(lane, MB_VP);
    int htab = -1;
    for (int tau = vcu; tau < BATCH * 8 * 4; tau += G) { const int bh = tau >> 2, pr = tau & 3, b = bh >> 3, h = bh & 7;
        __syncthreads();
        if (h != htab) { htab = h; float tv[18];
#pragma unroll
            for (int j = 0; j < 18; ++j) { const int i = tid + 512 * j, sft = i / MB_TN, ii = i - sft * MB_TN, idx = 2047 - ii - sft; tv[j] = (i < 4 * MB_TN && idx >= 0) ? LUT[(8 + h) * 2048 + idx] * LOG2E : -INFINITY; }
#pragma unroll
            for (int j = 0; j < 18; ++j) { const int i = tid + 512 * j; if (i < 4 * MB_TN) tab[i] = tv[j]; } }
        { const int j = tid >> 6, d = tid & 63; km[tid] = (KMP[(size_t)((8 * b + j) * 2 + 0) * 512 + 64 * h + d] + KMP[(size_t)((8 * b + j) * 2 + 1) * 512 + 64 * h + d]) * (1.f / 256.f); }
        __syncthreads();
        const bf16* Qb = QKV + (size_t)b * SEQ * NQKV + 1536 + 64 * h; const bf16* Kb = QKV + (size_t)b * SEQ * NQKV + 2048 + 64 * h; const bf16* Vb = Kb + 512;
        for (int s2 = 0; s2 < 2; ++s2) { const int qb = s2 == 0 ? 7 - pr : pr;
            const int tq = 256 * qb + 32 * w + r32;
            bf16x8 qf[4];
#pragma unroll
            for (int d0 = 0; d0 < 4; ++d0) qf[d0] = *(const bf16x8*)(Qb + (size_t)tq * NQKV + 16 * d0 + 8 * hi);
            unsigned sel = 0;
            { float g[8];
#pragma unroll
              for (int j = 0; j < 8; ++j) g[j] = 0.f;
#pragma unroll
              for (int d0 = 0; d0 < 4; ++d0) { float qv[8];
#pragma unroll
                  for (int e = 0; e < 8; ++e) qv[e] = __builtin_bit_cast(float, (unsigned)(unsigned short)qf[d0][e] << 16);
#pragma unroll
                  for (int j = 0; j < 7; ++j) { const LAS float* kp = km + j * 64 + 16 * d0 + 8 * hi; const f32x4 k0 = *(const LAS f32x4*)kp, k1 = *(const LAS f32x4*)(kp + 4);
                      g[j] += qv[0] * k0[0] + qv[1] * k0[1] + qv[2] * k0[2] + qv[3] * k0[3] + qv[4] * k1[0] + qv[5] * k1[1] + qv[6] * k1[2] + qv[7] * k1[3]; } }
#pragma unroll
              for (int j = 0; j < 7; ++j) g[j] += __shfl_xor(g[j], 32);
              const int nsel = qb < 3 ? qb : 3;
              for (int n = 0; n < nsel; ++n) { float best = -3e38f; int bi = 0;
#pragma unroll
                  for (int j = 0; j < 7; ++j) if (j < qb && !((sel >> j) & 1u) && g[j] > best) { best = g[j]; bi = j; }
                  sel |= 1u << bi; }
              sel |= 1u << qb; }
            float l_run = 0.f; f32x16 o0 = {}, o1 = {};
            const int NT = 2 * (qb + 1);
            const int a0 = 2047 - tq + 8 * hi;
            const LAS unsigned char* cp = (const LAS unsigned char*)tab + (a0 & 3) * (MB_TN * 4) + (a0 & ~3) * 4;
            const int skey = tid >> 3, sch = tid & 7;
            const size_t srow = (size_t)skey * NQKV + 8 * sch;
#define MB_GLD(T_) do { if ((T_) < NT) { const size_t ro_ = srow + (size_t)(T_) * MB_TK * NQKV; k0r = *(const u32x4*)(Kb + ro_); k1r = *(const u32x4*)(Kb + ro_ + (size_t)64 * NQKV); v0r = *(const u32x4*)(Vb + ro_); v1r = *(const u32x4*)(Vb + ro_ + (size_t)64 * NQKV); } } while (0)
#define MB_ST(T_) do { if ((T_) < NT) { LAS unsigned char* kd_ = lds + MB_K + ((T_) & 1) * (MB_TK * MB_KP) + skey * MB_KP + sch * 16; LAS unsigned char* vd_ = lds + MB_V + ((T_) & 1) * (MB_TK * MB_VP) + skey * MB_VP + sch * 16; \
                    *(LAS u32x4*)kd_ = k0r; *(LAS u32x4*)(kd_ + 64 * MB_KP) = k1r; *(LAS u32x4*)vd_ = v0r; *(LAS u32x4*)(vd_ + 64 * MB_VP) = v1r; } } while (0)
#define MB_ACT(T_) (((T_) >> 1) < qb ? (__ballot((sel >> ((T_) >> 1)) & 1u) != 0ull) : ((MB_TK * (T_) - 256 * qb) <= 32 * w + 31))
            u32x4 k0r = {}, k1r = {}, v0r = {}, v1r = {};
            MB_GLD(0); MB_ST(0); MB_GLD(1);
            LBAR();
            for (int T = 0; T < NT; ++T) {
                if (MB_ACT(T)) {
                    const LAS unsigned char* Kt = lds + MB_K + (T & 1) * (MB_TK * MB_KP) + kappa(r32) * MB_KP + hi * 16; const LAS unsigned char* Vt = lds + MB_V + (T & 1) * (MB_TK * MB_VP) + troff;
                    const bool selb = (sel >> (T >> 1)) & 1u;
                    const LAS unsigned char* ct = selb ? cp + 512 * T : (const LAS unsigned char*)tab + 2048 * 4;
                    f32x16 p0 = ld_c16(ct), p1 = ld_c16(ct + 128), p2 = ld_c16(ct + 256), p3 = ld_c16(ct + 384);
                    if (!(variant & 4)) {
#pragma unroll
                        for (int d0 = 0; d0 < 4; ++d0) { const bf16x8 ka = *(const LAS bf16x8*)(Kt + d0 * 32), kb = *(const LAS bf16x8*)(Kt + 32 * MB_KP + d0 * 32), kc = *(const LAS bf16x8*)(Kt + 64 * MB_KP + d0 * 32), kd = *(const LAS bf16x8*)(Kt + 96 * MB_KP + d0 * 32);
                            p0 = mfma32(ka, qf[d0], p0); p1 = mfma32(kb, qf[d0], p1); p2 = mfma32(kc, qf[d0], p2); p3 = mfma32(kd, qf[d0], p3); } }
                    float ls0 = 0.f, ls1 = 0.f;
                    if (!(variant & 1)) {
#pragma unroll
                        for (int r = 0; r < 16; ++r) { p0[r] = __builtin_amdgcn_exp2f(p0[r]); p1[r] = __builtin_amdgcn_exp2f(p1[r]); p2[r] = __builtin_amdgcn_exp2f(p2[r]); p3[r] = __builtin_amdgcn_exp2f(p3[r]); ls0 += p0[r] + p1[r]; ls1 += p2[r] + p3[r]; } }
                    l_run += ls0 + ls1;
                    if (!(variant & 2)) {
                        const bf16x8 f0 = packp(p0, 0), f1 = packp(p0, 1), f2 = packp(p1, 0), f3 = packp(p1, 1), f4 = packp(p2, 0), f5 = packp(p2, 1), f6 = packp(p3, 0), f7 = packp(p3, 1);
                        const unsigned va = (unsigned)(size_t)Vt;
                        PV_CHAIN8(o0, va, MB_VP, f0, f1, f2, f3, f4, f5, f6, f7);
                        PV_CHAIN8(o1, va + 64u, MB_VP, f0, f1, f2, f3, f4, f5, f6, f7); }
                }
                MB_ST(T + 1);
                if (!(variant & 16)) LBAR();
                if (!(variant & 8)) MB_GLD(T + 2);
            }
#undef MB_GLD
#undef MB_ST
#undef MB_ACT
            const float inv = 1.f / xhalf_sum(l_run);
            bf16* yp = Y + ((size_t)b * SEQ + tq) * DM + 512 + 64 * h + 4 * hi; float sq = 0.f;
#pragma unroll
            for (int g4 = 0; g4 < 4; ++g4) { u32x2 a, c2; a.x = cvtpk(o0[4 * g4] * inv, o0[4 * g4 + 1] * inv); a.y = cvtpk(o0[4 * g4 + 2] * inv, o0[4 * g4 + 3] * inv);
                c2.x = cvtpk(o1[4 * g4] * inv, o1[4 * g4 + 1] * inv); c2.y = cvtpk(o1[4 * g4 + 2] * inv, o1[4 * g4 + 3] * inv);
                *(u32x2*)(yp + 8 * g4) = a; *(u32x2*)(yp + 32 + 8 * g4) = c2;
                sq += bflo(a.x) * bflo(a.x) + bfhi(a.x) * bfhi(a.x) + bflo(a.y) * bflo(a.y) + bfhi(a.y) * bfhi(a.y) + bflo(c2.x) * bflo(c2.x) + bfhi(c2.x) * bfhi(c2.x) + bflo(c2.y) * bflo(c2.y) + bfhi(c2.y) * bfhi(c2.y); }
            sq = xhalf_sum(sq); if (hi == 0 && SSB) atomicAdd(SSB + (size_t)b * SEQ + tq, sq);
        }
    }
}

constexpr int M2_TK = 64, M2_K = 0, M2_V = 2 * M2_TK * MB_KP, M2_LUT = M2_V + 2 * M2_TK * MB_VP, M2_KM = M2_LUT + 4 * MB_TN * 4, M2_END = M2_KM + 2048;
static_assert(M2_END <= 139264, "MoBA LDS map");
__device__ __forceinline__ unsigned mb_select(const bf16x8 (&qf)[4], const LAS float* km, int qb, int hi) {
    unsigned sel = 0; float g[8];
#pragma unroll
    for (int j = 0; j < 8; ++j) g[j] = 0.f;
#pragma unroll
    for (int d0 = 0; d0 < 4; ++d0) { float qv[8];
#pragma unroll
        for (int e = 0; e < 8; ++e) qv[e] = __builtin_bit_cast(float, (unsigned)(unsigned short)qf[d0][e] << 16);
#pragma unroll
        for (int j = 0; j < 7; ++j) { const LAS float* kp = km + j * 64 + 16 * d0 + 8 * hi; const f32x4 k0 = *(const LAS f32x4*)kp, k1 = *(const LAS f32x4*)(kp + 4);
            g[j] += qv[0] * k0[0] + qv[1] * k0[1] + qv[2] * k0[2] + qv[3] * k0[3] + qv[4] * k1[0] + qv[5] * k1[1] + qv[6] * k1[2] + qv[7] * k1[3]; } }
#pragma unroll
    for (int j = 0; j < 7; ++j) g[j] += __shfl_xor(g[j], 32);
    const int nsel = qb < 3 ? qb : 3;
    for (int n = 0; n < nsel; ++n) { float best = -3e38f; int bi = 0;
#pragma unroll
        for (int j = 0; j < 7; ++j) if (j < qb && !((sel >> j) & 1u) && g[j] > best) { best = g[j]; bi = j; }
        sel |= 1u << bi; }
    return sel | (1u << qb);
}
template <bool DA, bool DB>
__device__ __forceinline__ void mb_step2(const LAS unsigned char* Kt, unsigned va, const LAS unsigned char* ctA, const LAS unsigned char* ctB, const bf16x8 (&qa)[4], const bf16x8 (&qb)[4],
                                         f32x16& oa0, f32x16& oa1, float& la, f32x16& ob0, f32x16& ob1, float& lb) {
    f32x16 a0 = {}, a1 = {}, b0 = {}, b1 = {};
    if (DA) { a0 = ld_c16(ctA); a1 = ld_c16(ctA + 128); }
    if (DB) { b0 = ld_c16(ctB); b1 = ld_c16(ctB + 128); }
#pragma unroll
    for (int d0 = 0; d0 < 4; ++d0) { const bf16x8 k0 = *(const LAS bf16x8*)(Kt + d0 * 32), k1 = *(const LAS bf16x8*)(Kt + 32 * MB_KP + d0 * 32);
        if (DA) { a0 = mfma32(k0, qa[d0], a0); a1 = mfma32(k1, qa[d0], a1); }
        if (DB) { b0 = mfma32(k0, qb[d0], b0); b1 = mfma32(k1, qb[d0], b1); } }
    float sa = 0.f, sb = 0.f;
#pragma unroll
    for (int r = 0; r < 16; ++r) {
        if (DA) { a0[r] = __builtin_amdgcn_exp2f(a0[r]); a1[r] = __builtin_amdgcn_exp2f(a1[r]); sa += a0[r] + a1[r]; }
        if (DB) { b0[r] = __builtin_amdgcn_exp2f(b0[r]); b1[r] = __builtin_amdgcn_exp2f(b1[r]); sb += b0[r] + b1[r]; } }
    la += sa; lb += sb;
    const bf16x8 fa0 = packp(a0, 0), fa1 = packp(a0, 1), fa2 = packp(a1, 0), fa3 = packp(a1, 1), fb0 = packp(b0, 0), fb1 = packp(b0, 1), fb2 = packp(b1, 0), fb3 = packp(b1, 1);
#pragma unroll
    for (int c = 0; c < 2; ++c) { const unsigned ad = va + 64u * c; s16x4 l0, h0, l1, h1, l2, h2, l3, h3;
        TR_RD(l0, ad, 0 * MB_VP); TR_RD(h0, ad, 4 * MB_VP); TR_RD(l1, ad, 16 * MB_VP); TR_RD(h1, ad, 20 * MB_VP); TR_RD(l2, ad, 32 * MB_VP); TR_RD(h2, ad, 36 * MB_VP); TR_RD(l3, ad, 48 * MB_VP); TR_RD(h3, ad, 52 * MB_VP);
        f32x16& xa = c ? oa1 : oa0; f32x16& xb = c ? ob1 : ob0;
        TR_WAIT(6, l0, h0); { const bf16x8 v = cat8(l0, h0); if (DA) xa = mfma32(v, fa0, xa); if (DB) xb = mfma32(v, fb0, xb); }
        TR_WAIT(4, l1, h1); { const bf16x8 v = cat8(l1, h1); if (DA) xa = mfma32(v, fa1, xa); if (DB) xb = mfma32(v, fb1, xb); }
        TR_WAIT(2, l2, h2); { const bf16x8 v = cat8(l2, h2); if (DA) xa = mfma32(v, fa2, xa); if (DB) xb = mfma32(v, fb2, xb); }
        TR_WAIT(0, l3, h3); { const bf16x8 v = cat8(l3, h3); if (DA) xa = mfma32(v, fa3, xa); if (DB) xb = mfma32(v, fb3, xb); } }
}
__device__ __forceinline__ void moba_phase2(LAS unsigned char* lds, const bf16* QKV, const float* KMP, const float* LUT, bf16* Y, float* SSB, int vcu, int G) {
    const int tid_ = threadIdx.x, tid = tid_, lane = tid & 63, r32_ = lane & 31, hi_ = lane >> 5; const int w = __builtin_amdgcn_readfirstlane(tid >> 6);
    LAS float* tab = (LAS float*)(lds + M2_LUT); LAS float* km = (LAS float*)(lds + M2_KM);
    int htab = -1;
    for (int tau = vcu; tau < BATCH * 8 * 2; tau += G) { const int bh = tau >> 1, half = tau & 1, b = bh >> 3, h = bh & 7;
        __syncthreads();
        int tt = tid_; asm volatile("" : "+v"(tt));
        if (h != htab) { htab = h; float tv[18];
#pragma unroll
            for (int j = 0; j < 18; ++j) { const int i = tt + 512 * j, sft = i / MB_TN, ii = i - sft * MB_TN, idx = 2047 - ii - sft; tv[j] = (i < 4 * MB_TN && idx >= 0) ? LUT[(8 + h) * 2048 + idx] * LOG2E : -INFINITY; }
#pragma unroll
            for (int j = 0; j < 18; ++j) { const int i = tt + 512 * j; if (i < 4 * MB_TN) tab[i] = tv[j]; } }
        { const int j = tt >> 6, d = tt & 63; km[tt] = (KMP[(size_t)((8 * b + j) * 2 + 0) * 512 + 64 * h + d] + KMP[(size_t)((8 * b + j) * 2 + 1) * 512 + 64 * h + d]) * (1.f / 256.f); }
        __syncthreads();
        const bf16* Qb = QKV + (size_t)b * SEQ * NQKV + 1536 + 64 * h; const bf16* Kb = QKV + (size_t)b * SEQ * NQKV + 2048 + 64 * h; const bf16* Vb = Kb + 512;
        for (int s2 = 0; s2 < 2; ++s2) { const int jp = half == 0 ? (s2 == 0 ? 3 : 0) : (s2 == 0 ? 2 : 1); const int qA = 2 * jp, qB = qA + 1;
            int r32 = r32_, hi = hi_, tid = tid_; asm volatile("" : "+v"(r32), "+v"(hi), "+v"(tid));
            const int troff = (8 * hi + ((r32 & 15) >> 2)) * MB_VP + (16 * ((r32 >> 4) & 1) + 4 * (r32 & 3)) * 2;
            const int tqA = 256 * qA + 32 * w + r32, tqB = tqA + 256;
            bf16x8 qa[4], qb[4];
#pragma unroll
            for (int d0 = 0; d0 < 4; ++d0) { qa[d0] = *(const bf16x8*)(Qb + (size_t)tqA * NQKV + 16 * d0 + 8 * hi); qb[d0] = *(const bf16x8*)(Qb + (size_t)tqB * NQKV + 16 * d0 + 8 * hi); }
            const unsigned selA = mb_select(qa, km, qA, hi);
            int ko = 0; asm volatile("" : "+v"(ko) :: "memory");
            const unsigned selB = mb_select(qb, km + ko, qB, hi);
            float la = 0.f, lb = 0.f; f32x16 oa0 = {}, oa1 = {}, ob0 = {}, ob1 = {};
            const int NT = 4 * (qB + 1);
            const int tA = 2047 - tqA + 8 * hi, tB = tA - 256;
            const LAS unsigned char* cpA = (const LAS unsigned char*)tab + (tA & 3) * (MB_TN * 4) + (tA & ~3) * 4;
            const LAS unsigned char* cpB = (const LAS unsigned char*)tab + (tB & 3) * (MB_TN * 4) + (tB & ~3) * 4;
            const LAS unsigned char* minf = (const LAS unsigned char*)tab + 2048 * 4;
            const int skey = tid >> 3, sch = tid & 7;
            const size_t srow = (size_t)skey * NQKV + 8 * sch;
            u32x4 k0r = {}, v0r = {};
#define M2_GLD(T_) do { if ((T_) < NT) { const size_t ro_ = srow + (size_t)(T_) * M2_TK * NQKV; k0r = *(const u32x4*)(Kb + ro_); v0r = *(const u32x4*)(Vb + ro_); } } while (0)
#define M2_ST(T_) do { if ((T_) < NT) { *(LAS u32x4*)(lds + M2_K + ((T_) & 1) * (M2_TK * MB_KP) + skey * MB_KP + sch * 16) = k0r; *(LAS u32x4*)(lds + M2_V + ((T_) & 1) * (M2_TK * MB_VP) + skey * MB_VP + sch * 16) = v0r; } } while (0)
            M2_GLD(0); M2_ST(0); M2_GLD(1);
            LBAR();
            for (int T = 0; T < NT; ++T) { const int kb = T >> 2;
                const bool actA = kb < qA ? (__ballot((selA >> kb) & 1u) != 0ull) : (kb == qA && (M2_TK * T - 256 * qA) <= 32 * w + 31);
                const bool actB = kb < qB ? (__ballot((selB >> kb) & 1u) != 0ull) : ((M2_TK * T - 256 * qB) <= 32 * w + 31);
                const LAS unsigned char* Kt = lds + M2_K + (T & 1) * (M2_TK * MB_KP) + kappa(r32) * MB_KP + hi * 16; const unsigned va = (unsigned)(size_t)(lds + M2_V + (T & 1) * (M2_TK * MB_VP) + troff);
                const LAS unsigned char* ctA = ((selA >> kb) & 1u) ? cpA + 256 * T : minf; const LAS unsigned char* ctB = ((selB >> kb) & 1u) ? cpB + 256 * T : minf;
                if (actA && actB) mb_step2<true, true>(Kt, va, ctA, ctB, qa, qb, oa0, oa1, la, ob0, ob1, lb);
                else if (actB) mb_step2<false, true>(Kt, va, ctA, ctB, qa, qb, oa0, oa1, la, ob0, ob1, lb);
                else if (actA) mb_step2<true, false>(Kt, va, ctA, ctB, qa, qb, oa0, oa1, la, ob0, ob1, lb);
                M2_ST(T + 1);
                LBAR();
                M2_GLD(T + 2);
            }
#undef M2_GLD
#undef M2_ST
#pragma unroll
            for (int gsel = 0; gsel < 2; ++gsel) { const f32x16& o0 = gsel ? ob0 : oa0; const f32x16& o1 = gsel ? ob1 : oa1; const int tq = gsel ? tqB : tqA;
                const float inv = 1.f / xhalf_sum(gsel ? lb : la);
                bf16* yp = Y + ((size_t)b * SEQ + tq) * DM + 512 + 64 * h + 4 * hi; float sq = 0.f;
#pragma unroll
                for (int g4 = 0; g4 < 4; ++g4) { u32x2 a, c2; a.x = cvtpk(o0[4 * g4] * inv, o0[4 * g4 + 1] * inv); a.y = cvtpk(o0[4 * g4 + 2] * inv, o0[4 * g4 + 3] * inv);
                    c2.x = cvtpk(o1[4 * g4] * inv, o1[4 * g4 + 1] * inv); c2.y = cvtpk(o1[4 * g4 + 2] * inv, o1[4 * g4 + 3] * inv);
                    *(u32x2*)(yp + 8 * g4) = a; *(u32x2*)(yp + 32 + 8 * g4) = c2;
                    sq += bflo(a.x) * bflo(a.x) + bfhi(a.x) * bfhi(a.x) + bflo(a.y) * bflo(a.y) + bfhi(a.y) * bfhi(a.y) + bflo(c2.x) * bflo(c2.x) + bfhi(c2.x) * bfhi(c2.x) + bflo(c2.y) * bflo(c2.y) + bfhi(c2.y) * bfhi(c2.y); }
                sq = xhalf_sum(sq); if (hi == 0 && SSB) atomicAdd(SSB + (size_t)b * SEQ + tq, sq); }
        }
    }
}

constexpr int DL_VP = 192, DL_KP = 144, DL_LUT = 0, DL_TN = 208, DL_V = 16384, DL_SB = 65536, DL_SBP = 136, DL_SL = DL_SB + 512 * DL_SBP, DL_END = DL_SL + 2048;
static_assert(DL_END <= 139264, "dilated LDS map");
struct DilTile { u32x4 kr[4]; u32x4 vr[4]; };
__device__ __forceinline__ void dil_load(DilTile& t, const bf16* Kb, const bf16* Vb, int dil, int res, int base, int lane) {
#pragma unroll
    for (int i4 = 0; i4 < 4; ++i4) { const int idx = lane + 64 * i4, key = idx >> 3, ch = idx & 7; const size_t o = (size_t)(dil * (base + key) + res) * NQKV + 8 * ch;
        t.kr[i4] = *(const u32x4*)(Kb + o); t.vr[i4] = *(const u32x4*)(Vb + o); }
}
__device__ __forceinline__ void dil_unit(const bf16* Qb, const bf16* Kb, const bf16* Vb, const LAS unsigned char* tb, LAS unsigned char* Vw, int troff, int dil, int res, int gi, int lane, int r32, int hi,
                                         f32x16& o0, f32x16& o1, float& lse) {
    const int ms = 32 * gi + r32, tq = dil * ms + res;
    u32x4 qr[4];
    int lg = lane; asm volatile("" : "+v"(lg));
#pragma unroll
    for (int i4 = 0; i4 < 4; ++i4) { const int idx = lg + 64 * i4, qrow = idx >> 3, ch = idx & 7; qr[i4] = *(const u32x4*)(Qb + (size_t)(dil * (32 * gi + qrow) + res) * NQKV + 8 * ch); }
    float l_run = 0.f; o0 = f32x16{}; o1 = f32x16{};
    const int kt0 = gi >= 4 ? 0 : 4 - gi;
    const int a0 = 31 - r32 + 8 * hi;
    const LAS unsigned char* cp = tb + (a0 & 3) * (DL_TN * 4) + (a0 & ~3) * 4;
    DilTile nx, nx2; dil_load(nx, Kb, Vb, dil, res, 32 * gi - 128 + 32 * kt0, lg); nx2 = nx;
    if (kt0 < 4) dil_load(nx2, Kb, Vb, dil, res, 32 * gi - 128 + 32 * (kt0 + 1), lg);
    bf16x8 qf[4];
#pragma unroll
    for (int i4 = 0; i4 < 4; ++i4) { const int idx = lane + 64 * i4, qrow = idx >> 3, ch = idx & 7; *(LAS u32x4*)(Vw + qrow * DL_KP + ch * 16) = qr[i4]; }
#pragma unroll
    for (int d0 = 0; d0 < 4; ++d0) qf[d0] = *(const LAS bf16x8*)(Vw + r32 * DL_KP + hi * 16 + d0 * 32);
#pragma unroll 1
    for (int kt = kt0; kt < 5; ++kt) { const int base = 32 * gi - 128 + 32 * kt;
        DilTile cu = nx; nx = nx2;
        if (kt < 3) dil_load(nx2, Kb, Vb, dil, res, base + 64, lg);
        asm volatile("" ::: "memory");
#pragma unroll
        for (int i4 = 0; i4 < 4; ++i4) { const int idx = lane + 64 * i4, key = idx >> 3, ch = idx & 7; *(LAS u32x4*)(Vw + key * DL_KP + ch * 16) = cu.kr[i4]; }
        bf16x8 kf[4];
#pragma unroll
        for (int d0 = 0; d0 < 4; ++d0) kf[d0] = *(const LAS bf16x8*)(Vw + kappa(r32) * DL_KP + hi * 16 + d0 * 32);
#pragma unroll
        for (int i4 = 0; i4 < 4; ++i4) { const int idx = lane + 64 * i4, key = idx >> 3, ch = idx & 7; *(LAS u32x4*)(Vw + key * DL_VP + ch * 16) = cu.vr[i4]; }
        f32x16 p0 = ld_c16(cp + 128 * kt);
#pragma unroll
        for (int d0 = 0; d0 < 4; ++d0) p0 = mfma32(kf[d0], qf[d0], p0);
        float ls = 0.f;
#pragma unroll
        for (int r = 0; r < 16; ++r) { p0[r] = __builtin_amdgcn_exp2f(p0[r]); ls += p0[r]; }
        l_run += ls;
        const bf16x8 pf0 = packp(p0, 0), pf1 = packp(p0, 1);
        asm volatile("s_waitcnt lgkmcnt(0)" ::: "memory");
#pragma unroll
        for (int c = 0; c < 2; ++c) { const LAS unsigned char* vb = Vw + troff + c * 64;
            const bf16x8 v0 = cat8(vtr(vb), vtr(vb + 4 * DL_VP)), v1 = cat8(vtr(vb + 16 * DL_VP), vtr(vb + 20 * DL_VP));
            if (c == 0) { o0 = mfma32(v0, pf0, o0); o0 = mfma32(v1, pf1, o0); } else { o1 = mfma32(v0, pf0, o1); o1 = mfma32(v1, pf1, o1); } }
        asm volatile("s_waitcnt lgkmcnt(0)" ::: "memory");
    }
    const float lt = xhalf_sum(l_run), inv = 1.f / lt;
#pragma unroll
    for (int r = 0; r < 16; ++r) { o0[r] *= inv; o1[r] *= inv; }
    lse = __builtin_amdgcn_logf(lt);
}
template <bool DA, bool DB>
__device__ __forceinline__ void dil_step2(DilTile& cu, const bf16* Kb, const bf16* Vb, int dil, int res, int nbase, int lg, LAS unsigned char* Vw, int troff, const LAS unsigned char* cp, int kt, int lane, int r32, int hi,
                                          const bf16x8 (&qa)[4], const bf16x8 (&qb)[4], f32x16& a0, f32x16& a1, float& la, f32x16& b0, f32x16& b1, float& lb) {
#pragma unroll
    for (int i4 = 0; i4 < 4; ++i4) { const int idx = lane + 64 * i4, key = idx >> 3, ch = idx & 7; *(LAS u32x4*)(Vw + key * DL_KP + ch * 16) = cu.kr[i4]; }
    bf16x8 kf[4];
#pragma unroll
    for (int d0 = 0; d0 < 4; ++d0) kf[d0] = *(const LAS bf16x8*)(Vw + kappa(r32) * DL_KP + hi * 16 + d0 * 32);
#pragma unroll
    for (int i4 = 0; i4 < 4; ++i4) { const int idx = lane + 64 * i4, key = idx >> 3, ch = idx & 7; *(LAS u32x4*)(Vw + key * DL_VP + ch * 16) = cu.vr[i4]; }
    if (DA) dil_load(cu, Kb, Vb, dil, res, nbase, lg);
    asm volatile("" ::: "memory");
    f32x16 pa = {}, pb = {};
    if (DA) pa = ld_c16(cp + 128 * kt);
    if (DB) pb = ld_c16(cp + 128 * (kt - 1));
#pragma unroll
    for (int d0 = 0; d0 < 4; ++d0) { if (DA) pa = mfma32(kf[d0], qa[d0], pa); if (DB) pb = mfma32(kf[d0], qb[d0], pb); }
    float lsa = 0.f, lsb = 0.f;
#pragma unroll
    for (int r = 0; r < 16; ++r) { if (DA) { pa[r] = __builtin_amdgcn_exp2f(pa[r]); lsa += pa[r]; } if (DB) { pb[r] = __builtin_amdgcn_exp2f(pb[r]); lsb += pb[r]; } }
    la += lsa; lb += lsb;
    const bf16x8 fa0 = packp(pa, 0), fa1 = packp(pa, 1), fb0 = packp(pb, 0), fb1 = packp(pb, 1);
    asm volatile("s_waitcnt lgkmcnt(0)" ::: "memory");
#pragma unroll
    for (int c = 0; c < 2; ++c) { const LAS unsigned char* vb = Vw + troff + c * 64;
        const bf16x8 v0 = cat8(vtr(vb), vtr(vb + 4 * DL_VP)), v1 = cat8(vtr(vb + 16 * DL_VP), vtr(vb + 20 * DL_VP));
        if (c == 0) { if (DA) { a0 = mfma32(v0, fa0, a0); a0 = mfma32(v1, fa1, a0); } if (DB) { b0 = mfma32(v0, fb0, b0); b0 = mfma32(v1, fb1, b0); } }
        else { if (DA) { a1 = mfma32(v0, fa0, a1); a1 = mfma32(v1, fa1, a1); } if (DB) { b1 = mfma32(v0, fb0, b1); b1 = mfma32(v1, fb1, b1); } } }
    asm volatile("s_waitcnt lgkmcnt(0)" ::: "memory");
}
__device__ __forceinline__ void dil_unit2(const bf16* Qb, const bf16* Kb, const bf16* Vb, const LAS unsigned char* tb, LAS unsigned char* Vw, int troff, int dil, int res, int gi2, int lane, int r32, int hi,
                                          f32x16& a0, f32x16& a1, float& lseA, f32x16& b0, f32x16& b1, float& lseB) {
    u32x4 qr[4], qs[4];
    int lg = lane; asm volatile("" : "+v"(lg));
#pragma unroll
    for (int i4 = 0; i4 < 4; ++i4) { const int idx = lg + 64 * i4, qrow = idx >> 3, ch = idx & 7; const size_t o = (size_t)(dil * (64 * gi2 + qrow) + res) * NQKV + 8 * ch;
        qr[i4] = *(const u32x4*)(Qb + o); qs[i4] = *(const u32x4*)(Qb + o + (size_t)(dil * 32) * NQKV); }
    float la = 0.f, lb = 0.f; a0 = f32x16{}; a1 = f32x16{}; b0 = f32x16{}; b1 = f32x16{};
    const int kt0 = gi2 >= 2 ? 0 : 4 - 2 * gi2;
    const int t0 = 31 - r32 + 8 * hi;
    const LAS unsigned char* cp = tb + (t0 & 3) * (DL_TN * 4) + (t0 & ~3) * 4;
    const int base0 = 64 * gi2 - 128;
    DilTile nx; dil_load(nx, Kb, Vb, dil, res, base0 + 32 * kt0, lg);
    bf16x8 qa[4], qb[4];
#pragma unroll
    for (int i4 = 0; i4 < 4; ++i4) { const int idx = lane + 64 * i4, qrow = idx >> 3, ch = idx & 7; *(LAS u32x4*)(Vw + qrow * DL_KP + ch * 16) = qr[i4]; }
#pragma unroll
    for (int d0 = 0; d0 < 4; ++d0) qa[d0] = *(const LAS bf16x8*)(Vw + r32 * DL_KP + hi * 16 + d0 * 32);
#pragma unroll
    for (int i4 = 0; i4 < 4; ++i4) { const int idx = lane + 64 * i4, qrow = idx >> 3, ch = idx & 7; *(LAS u32x4*)(Vw + qrow * DL_KP + ch * 16) = qs[i4]; }
#pragma unroll
    for (int d0 = 0; d0 < 4; ++d0) qb[d0] = *(const LAS bf16x8*)(Vw + r32 * DL_KP + hi * 16 + d0 * 32);
    int kt = kt0;
    if (kt == 0) { dil_step2<true, false>(nx, Kb, Vb, dil, res, base0 + 32, lg, Vw, troff, cp, 0, lane, r32, hi, qa, qb, a0, a1, la, b0, b1, lb); kt = 1; }
#pragma unroll 1
    for (; kt < 5; ++kt) dil_step2<true, true>(nx, Kb, Vb, dil, res, base0 + 32 * (kt + 1), lg, Vw, troff, cp, kt, lane, r32, hi, qa, qb, a0, a1, la, b0, b1, lb);
    dil_step2<false, true>(nx, Kb, Vb, dil, res, 0, lg, Vw, troff, cp, 5, lane, r32, hi, qa, qb, a0, a1, la, b0, b1, lb);
    const float lta = xhalf_sum(la), ltb = xhalf_sum(lb), ia = 1.f / lta, ib = 1.f / ltb;
#pragma unroll
    for (int r = 0; r < 16; ++r) { a0[r] *= ia; a1[r] *= ia; b0[r] *= ib; b1[r] *= ib; }
    lseA = __builtin_amdgcn_logf(lta); lseB = __builtin_amdgcn_logf(ltb);
}
__device__ __forceinline__ void sb_store(LAS unsigned char* sb, int lt, int hi, const f32x16& o0, const f32x16& o1) {
    LAS unsigned char* p = sb + lt * DL_SBP + 8 * hi;
#pragma unroll
    for (int g4 = 0; g4 < 4; ++g4) { u32x2 a, c2; a.x = cvtpk(o0[4 * g4], o0[4 * g4 + 1]); a.y = cvtpk(o0[4 * g4 + 2], o0[4 * g4 + 3]); c2.x = cvtpk(o1[4 * g4], o1[4 * g4 + 1]); c2.y = cvtpk(o1[4 * g4 + 2], o1[4 * g4 + 3]);
        *(LAS u32x2*)(p + 16 * g4) = a; *(LAS u32x2*)(p + 64 + 16 * g4) = c2; }
}
__device__ __forceinline__ void sb_merge(const LAS unsigned char* sb, int lt, int hi, float wa, float wb, f32x16& o0, f32x16& o1) {
    const LAS unsigned char* p = sb + lt * DL_SBP + 8 * hi;
#pragma unroll
    for (int g4 = 0; g4 < 4; ++g4) { const u32x2 a = *(const LAS u32x2*)(p + 16 * g4), c2 = *(const LAS u32x2*)(p + 64 + 16 * g4);
        o0[4 * g4] = wa * bflo(a.x) + wb * o0[4 * g4]; o0[4 * g4 + 1] = wa * bfhi(a.x) + wb * o0[4 * g4 + 1]; o0[4 * g4 + 2] = wa * bflo(a.y) + wb * o0[4 * g4 + 2]; o0[4 * g4 + 3] = wa * bfhi(a.y) + wb * o0[4 * g4 + 3];
        o1[4 * g4] = wa * bflo(c2.x) + wb * o1[4 * g4]; o1[4 * g4 + 1] = wa * bfhi(c2.x) + wb * o1[4 * g4 + 1]; o1[4 * g4 + 2] = wa * bflo(c2.y) + wb * o1[4 * g4 + 2]; o1[4 * g4 + 3] = wa * bfhi(c2.y) + wb * o1[4 * g4 + 3]; }
}
__device__ __forceinline__ void dil_phase(LAS unsigned char* lds, const bf16* QKV, const float* LUT, bf16* Y, float* SSA, int vcu, int G) {
    const int tid = threadIdx.x, lane = tid & 63, r32 = lane & 31, hi = lane >> 5; const int w = __builtin_amdgcn_readfirstlane(tid >> 6);
    LAS float* dtab = (LAS float*)(lds + DL_LUT);
    LAS unsigned char* Vw = lds + DL_V + w * (32 * DL_VP);
    LAS unsigned char* sb = lds + DL_SB; LAS float* sl = (LAS float*)(lds + DL_SL);
    const int troff = tr_off(lane, DL_VP);
    for (int bh = vcu; bh < BATCH * 8; bh += G) { const int b = bh >> 3, h = bh & 7;
        __syncthreads();
        for (int i = tid; i < 3 * 4 * DL_TN; i += 512) { const int ii = i % DL_TN, sft = (i / DL_TN) & 3, pp = i / (4 * DL_TN); const int dlt = 159 - ii - sft, dist = dlt * (pp == 0 ? 1 : (pp == 1 ? 4 : 16));
            dtab[i] = (dlt >= 0 && dlt <= 128 && dist < 2048) ? LUT[h * 2048 + dist] * LOG2E : -INFINITY; }
        __syncthreads();
        const bf16* Qb = QKV + (size_t)b * SEQ * NQKV + 64 * h; const bf16* Kb = Qb + 512; const bf16* Vb = Qb + 1024;
        const LAS unsigned char* tb0 = lds + DL_LUT;
        for (int sp = 0; sp < 4; ++sp) {
            for (int x = w; x < 16; x += 8) { f32x16 o0, o1; float lse;
                dil_unit(Qb, Kb, Vb, tb0 + 2 * (4 * DL_TN * 4), Vw, troff, 16, x, sp, lane, r32, hi, o0, o1, lse);
                const int lt = 16 * r32 + x; sb_store(sb, lt, hi, o0, o1); if (hi == 0) sl[lt] = lse; }
            __syncthreads();
            { f32x16 oa0, oa1, ob0, ob1; float lsa, lsb;
                dil_unit2(Qb, Kb, Vb, tb0 + 1 * (4 * DL_TN * 4), Vw, troff, 4, w & 3, 2 * sp + (w >> 2), lane, r32, hi, oa0, oa1, lsa, ob0, ob1, lsb);
                { const int lt = 128 * (2 * (w >> 2)) + 4 * r32 + (w & 3); const float ls = sl[lt], mx = fmaxf(ls, lsa);
                  float wa = __builtin_amdgcn_exp2f(ls - mx), wb = __builtin_amdgcn_exp2f(lsa - mx); const float sw = wa + wb, isw = 1.f / sw; wa *= isw; wb *= isw;
                  sb_merge(sb, lt, hi, wa, wb, oa0, oa1); sb_store(sb, lt, hi, oa0, oa1); if (hi == 0) sl[lt] = mx + __builtin_amdgcn_logf(sw); }
                { const int lt = 128 * (2 * (w >> 2) + 1) + 4 * r32 + (w & 3); const float ls = sl[lt], mx = fmaxf(ls, lsb);
                  float wa = __builtin_amdgcn_exp2f(ls - mx), wb = __builtin_amdgcn_exp2f(lsb - mx); const float sw = wa + wb, isw = 1.f / sw; wa *= isw; wb *= isw;
                  sb_merge(sb, lt, hi, wa, wb, ob0, ob1); sb_store(sb, lt, hi, ob0, ob1); if (hi == 0) sl[lt] = mx + __builtin_amdgcn_logf(sw); } }
            __syncthreads();
            { f32x16 oa0, oa1, ob0, ob1; float lsa, lsb;
                dil_unit2(Qb, Kb, Vb, tb0, Vw, troff, 1, 0, 8 * sp + w, lane, r32, hi, oa0, oa1, lsa, ob0, ob1, lsb);
                { const int lt = 32 * (2 * w) + r32; const float ls = sl[lt], mx = fmaxf(ls, lsa);
                  float wa = __builtin_amdgcn_exp2f(ls - mx), wb = __builtin_amdgcn_exp2f(lsa - mx); const float isw = 1.f / (wa + wb); wa *= isw; wb *= isw;
                  sb_merge(sb, lt, hi, wa, wb, oa0, oa1); sb_store(sb, lt, hi, oa0, oa1); }
                { const int lt = 32 * (2 * w + 1) + r32; const float ls = sl[lt], mx = fmaxf(ls, lsb);
                  float wa = __builtin_amdgcn_exp2f(ls - mx), wb = __builtin_amdgcn_exp2f(lsb - mx); const float isw = 1.f / (wa + wb); wa *= isw; wb *= isw;
                  sb_merge(sb, lt, hi, wa, wb, ob0, ob1); sb_store(sb, lt, hi, ob0, ob1); } }
            __syncthreads();
#pragma unroll
            for (int j = 0; j < 8; ++j) { const int idx = tid + 512 * j, row = idx >> 3, ch = idx & 7;
                const LAS unsigned char* p = sb + row * DL_SBP + ch * 16; const u32x2 a = *(const LAS u32x2*)p, c2 = *(const LAS u32x2*)(p + 8);
                u32x4 v; v[0] = a.x; v[1] = a.y; v[2] = c2.x; v[3] = c2.y;
                *(u32x4*)(Y + ((size_t)b * SEQ + 512 * sp + row) * DM + 64 * h + 8 * ch) = v;
                float sq = bflo(a.x) * bflo(a.x) + bfhi(a.x) * bfhi(a.x) + bflo(a.y) * bflo(a.y) + bfhi(a.y) * bfhi(a.y) + bflo(c2.x) * bflo(c2.x) + bfhi(c2.x) * bfhi(c2.x) + bflo(c2.y) * bflo(c2.y) + bfhi(c2.y) * bfhi(c2.y);
                sq += __shfl_xor(sq, 1); sq += __shfl_xor(sq, 2); sq += __shfl_xor(sq, 4);
                if (ch == 0) atomicAdd(SSA + (size_t)b * SEQ + 512 * sp + row, sq); }
            __syncthreads();
        }
    }
}

__device__ __forceinline__ void merge_phase(const bf16* __restrict__ Y, bf16* __restrict__ YN, int gw, int NGW, int lane) {
    for (int m = gw; m < NTOK; m += NGW) {
        const u32x4 ya = *(const u32x4*)(Y + (size_t)m * DM + 8 * lane), yb = *(const u32x4*)(Y + (size_t)m * DM + 512 + 8 * lane);
        float v[8], u[8]; float sa = 0.f, sb = 0.f;
#pragma unroll
        for (int e = 0; e < 4; ++e) { v[2 * e] = bflo(ya[e]); v[2 * e + 1] = bfhi(ya[e]); u[2 * e] = bflo(yb[e]); u[2 * e + 1] = bfhi(yb[e]); }
#pragma unroll
        for (int e = 0; e < 8; ++e) { sa += v[e] * v[e]; sb += u[e] * u[e]; }
        sa = wave_sum(sa); sb = wave_sum(sb);
        const float ra = rsqrtf(sa * (1.f / 512.f) + EPS), rb = rsqrtf(sb * (1.f / 512.f) + EPS);
        u32x4 oa, ob;
#pragma unroll
        for (int e = 0; e < 4; ++e) { oa[e] = cvtpk(v[2 * e] * ra, v[2 * e + 1] * ra); ob[e] = cvtpk(u[2 * e] * rb, u[2 * e + 1] * rb); }
        *(u32x4*)(YN + (size_t)m * DM + 8 * lane) = oa; *(u32x4*)(YN + (size_t)m * DM + 512 + 8 * lane) = ob;
    }
}

constexpr int CR_KP = 272, CR_VP = 320, CR_K = 0, CR_V = 2 * 64 * CR_KP, CR_END = CR_V + 2 * 64 * CR_VP, CR_OP = 272;
static_assert(4 * 32 * CR_OP <= CR_V && CR_END + 4 * 32 * CR_OP <= 139264, "cross LDS map");
typedef __amdgpu_buffer_rsrc_t rsrc_t;
__device__ __forceinline__ rsrc_t mkrsrc(const void* base, unsigned bytes) { return __builtin_amdgcn_make_buffer_rsrc((void*)base, 0, bytes, 0x00020000); }
__device__ __forceinline__ u32x4 bld16(rsrc_t r, unsigned voff, unsigned soff) { return __builtin_bit_cast(u32x4, __builtin_amdgcn_raw_buffer_load_b128(r, voff, soff, 0)); }
__device__ __forceinline__ void cross_phase(LAS unsigned char* lds, const bf16* QM, const bf16* KVM, bf16* OM, int vcu, int G, int pv) {
    const int tid = threadIdx.x, lane = tid & 63, r32 = lane & 31, hi = lane >> 5; const int w = __builtin_amdgcn_readfirstlane(tid >> 6);
    const int troff = tr_off(lane, CR_VP);
    const int kkey = tid >> 3, kch = tid & 7;
    const unsigned soff = (unsigned)kkey * 4096u + (unsigned)kch * 16u;
    const unsigned qoff = (unsigned)(32 * w + r32) * 2048u + (unsigned)hi * 16u;
    const int kl0 = kkey * CR_KP + kch * 16, vl0 = kkey * CR_VP + kch * 16;
    const int kfo = kappa(r32) * CR_KP + hi * 16;
    const rsrc_t rK = mkrsrc(KVM, (unsigned)NMEMTOK * 4096u), rQ = mkrsrc(QM, (unsigned)NTOK * 2048u);
    LAS unsigned char* Tw = lds + (w < 4 ? CR_K + w * (32 * CR_OP) : CR_END + (w - 4) * (32 * CR_OP));
    for (int un = vcu * 4; un < BATCH * 4 * 8; un += G * 4) for (int ui = 0; ui < 4; ++ui) { const int u = un + ui, qblk = u & 7, hm = (u >> 3) & 3, b = u >> 5;
        const unsigned Qs = (unsigned)(((b * SEQ + 256 * qblk) * DM + 256 * hm) * 2);
        unsigned char* Os = (unsigned char*)(OM + ((size_t)b * SEQ + 256 * qblk) * DM + 256 * hm);
        const unsigned Ks = (unsigned)((b * NMEM * 2048 + 256 * hm) * 2), Vs = Ks + 2048u;
        f32x16 sc[8];
#pragma unroll
        for (int kt = 0; kt < 8; ++kt) sc[kt] = f32x16{};
        u32x4 r0, r1;
        __syncthreads();
        r0 = bld16(rK, soff, Ks); r1 = bld16(rK, soff, Ks + 128u);
        *(LAS u32x4*)(lds + CR_K + kl0) = r0; *(LAS u32x4*)(lds + CR_K + kl0 + 128) = r1;
        __syncthreads();
#pragma unroll
        for (int half = 0; half < 2; ++half) {
            bf16x8 qf[8];
#pragma unroll
            for (int d0 = 0; d0 < 8; ++d0) qf[d0] = __builtin_bit_cast(bf16x8, bld16(rQ, qoff, Qs + (unsigned)(256 * half + 32 * d0)));
#pragma unroll
            for (int kp = 0; kp < 4; ++kp) { const int step = half * 4 + kp, buf = step & 1;
                if (!(pv & 2)) { if (step + 1 < 8) { const int nh = (step + 1) >> 2, nk = (step + 1) & 3; const unsigned src = Ks + (unsigned)(nk * (64 * 4096) + 256 * nh); r0 = bld16(rK, soff, src); r1 = bld16(rK, soff, src + 128u); }
                else { r0 = bld16(rK, soff, Vs); r1 = bld16(rK, soff, Vs + 128u); } }
                const LAS unsigned char* Kt = lds + CR_K + buf * (64 * CR_KP) + kfo;
#pragma unroll
                for (int d0 = 0; d0 < 8; ++d0) { sc[2 * kp] = mfma32(*(const LAS bf16x8*)(Kt + d0 * 32), qf[d0], sc[2 * kp]); sc[2 * kp + 1] = mfma32(*(const LAS bf16x8*)(Kt + 32 * CR_KP + d0 * 32), qf[d0], sc[2 * kp + 1]); if (d0 & 1) __builtin_amdgcn_sched_barrier(0); }
                if (step + 1 < 8) { *(LAS u32x4*)(lds + CR_K + (buf ^ 1) * (64 * CR_KP) + kl0) = r0; *(LAS u32x4*)(lds + CR_K + (buf ^ 1) * (64 * CR_KP) + kl0 + 128) = r1; }
                else { *(LAS u32x4*)(lds + CR_V + vl0) = r0; *(LAS u32x4*)(lds + CR_V + vl0 + 128) = r1; }
                LBAR();
            }
        }
        const float c1 = 0.0625f * LOG2E, mo = 0.f; float ls = 0.f;
        bf16x8 pf[8][2];
#pragma unroll
        for (int kt = 0; kt < 8; ++kt) {
#pragma unroll
            for (int r = 0; r < 16; ++r) { sc[kt][r] = __builtin_amdgcn_exp2f(sc[kt][r] * c1 - mo); ls += sc[kt][r]; }
            pf[kt][0] = packp(sc[kt], 0); pf[kt][1] = packp(sc[kt], 1); }
        const float inv = 1.f / xhalf_sum(ls);
#pragma unroll
        for (int hv = 0; hv < 2; ++hv) {
            f32x16 o[4];
#pragma unroll
            for (int c = 0; c < 4; ++c) o[c] = f32x16{};
            if (hv == 1) { if (!(pv & 2)) { r0 = bld16(rK, soff, Vs + 256u); r1 = bld16(rK, soff, Vs + 384u); }
                *(LAS u32x4*)(lds + CR_V + vl0) = r0; *(LAS u32x4*)(lds + CR_V + vl0 + 128) = r1; LBAR(); }
#pragma unroll
            for (int kp = 0; kp < 4; ++kp) { const int buf = kp & 1;
                if (kp + 1 < 4 && !(pv & 2)) { const unsigned src = Vs + (unsigned)((kp + 1) * (64 * 4096) + 256 * hv); r0 = bld16(rK, soff, src); r1 = bld16(rK, soff, src + 128u); }
                const LAS unsigned char* vb = lds + CR_V + buf * (64 * CR_VP) + troff;
#pragma unroll
                for (int t2 = 0; t2 < 2; ++t2) { const unsigned va = (unsigned)(size_t)(vb + t2 * 32 * CR_VP);
                    s16x4 l0, h0, l1, h1, l2, h2, l3, h3, l4, h4, l5, h5, l6, h6, l7, h7;
                    TR_RD(l0, va, 0 * CR_VP); TR_RD(h0, va, 4 * CR_VP); TR_RD(l1, va, 16 * CR_VP); TR_RD(h1, va, 20 * CR_VP); TR_RD(l2, va, 64 + 0 * CR_VP); TR_RD(h2, va, 64 + 4 * CR_VP); TR_RD(l3, va, 64 + 16 * CR_VP); TR_RD(h3, va, 64 + 20 * CR_VP);
                    TR_RD(l4, va, 128 + 0 * CR_VP); TR_RD(h4, va, 128 + 4 * CR_VP); TR_RD(l5, va, 128 + 16 * CR_VP); TR_RD(h5, va, 128 + 20 * CR_VP); TR_RD(l6, va, 192 + 0 * CR_VP); TR_RD(h6, va, 192 + 4 * CR_VP); TR_RD(l7, va, 192 + 16 * CR_VP); TR_RD(h7, va, 192 + 20 * CR_VP);
                    const bf16x8 q0 = pf[2 * kp + t2][0], q1 = pf[2 * kp + t2][1];
                    TR_WAIT(14, l0, h0); o[0] = mfma32(cat8(l0, h0), q0, o[0]); TR_WAIT(12, l1, h1); o[0] = mfma32(cat8(l1, h1), q1, o[0]); TR_WAIT(10, l2, h2); o[1] = mfma32(cat8(l2, h2), q0, o[1]); TR_WAIT(8, l3, h3); o[1] = mfma32(cat8(l3, h3), q1, o[1]);
                    TR_WAIT(6, l4, h4); o[2] = mfma32(cat8(l4, h4), q0, o[2]); TR_WAIT(4, l5, h5); o[2] = mfma32(cat8(l5, h5), q1, o[2]); TR_WAIT(2, l6, h6); o[3] = mfma32(cat8(l6, h6), q0, o[3]); TR_WAIT(0, l7, h7); o[3] = mfma32(cat8(l7, h7), q1, o[3]); }
                if (kp + 1 < 4) { *(LAS u32x4*)(lds + CR_V + (buf ^ 1) * (64 * CR_VP) + vl0) = r0; *(LAS u32x4*)(lds + CR_V + (buf ^ 1) * (64 * CR_VP) + vl0 + 128) = r1; }
                LBAR();
            }
            if (!(pv & 1)) {
#pragma unroll
                for (int c = 0; c < 4; ++c)
#pragma unroll
                    for (int g4 = 0; g4 < 4; ++g4) { u32x2 a; a.x = cvtpk(o[c][4 * g4] * inv, o[c][4 * g4 + 1] * inv); a.y = cvtpk(o[c][4 * g4 + 2] * inv, o[c][4 * g4 + 3] * inv); *(LAS u32x2*)(Tw + r32 * CR_OP + 64 * c + 16 * g4 + 8 * hi) = a; }
                unsigned char* yp = Os + 256 * hv + (lane & 15) * 16 + (size_t)(32 * w + (lane >> 4)) * 2048;
#pragma unroll
                for (int j = 0; j < 8; ++j) { const u32x4 v = *(const LAS u32x4*)(Tw + ((lane >> 4) + 4 * j) * CR_OP + (lane & 15) * 16); *(u32x4*)(yp + (size_t)j * (4 * 2048)) = v; }
            }
        }
    }
}
}


struct Frame {
    LAS unsigned char* lds;
    int tid, lane, wave, vcu, G;
};
__device__ __forceinline__ void p0_titem(const float* __restrict__ W, int Nsrc, int nsrc0, int k0, const float* __restrict__ g, const float* __restrict__ g2, int gsplit,
                                         bf16* __restrict__ WT, int K, int ndst0, LAS float* scr, int lane) {
#pragma unroll 8
    for (int i = 0; i < 32; ++i) { const int kk = 2 * i + (lane >> 5); const int k = k0 + kk;
        float gv = 1.f; if (g) gv = (g2 && k >= gsplit) ? g2[k - gsplit] : g[k];
        scr[kk * 33 + (lane & 31)] = W[(size_t)k * Nsrc + nsrc0 + (lane & 31)] * gv; }
    LDS_WAIT(); asm volatile("" ::: "memory");
    const int c = lane & 7;
#pragma unroll
    for (int j = 0; j < 4; ++j) { const int n = (lane >> 3) + 8 * j; const LAS float* s = scr + (8 * c) * 33 + n;
        v4u o; o.x = pk2(s[0 * 33], s[1 * 33]); o.y = pk2(s[2 * 33], s[3 * 33]); o.z = pk2(s[4 * 33], s[5 * 33]); o.w = pk2(s[6 * 33], s[7 * 33]);
        *(GAS v4u*)(WT + (size_t)(ndst0 + n) * K + k0 + 8 * c) = o; }
    LDS_WAIT(); asm volatile("" ::: "memory");
}
__device__ __forceinline__ void p0_norm_rows2(const float* __restrict__ x0, const float* __restrict__ x1, bf16* __restrict__ o0, bf16* __restrict__ o1, int lane) {
    const GAS f32x4* a = (const GAS f32x4*)x0 + lane; const GAS f32x4* b = (const GAS f32x4*)x1 + lane; f32x4 v[4], u[4]; float s = 0.f, t = 0.f;
#pragma unroll
    for (int j = 0; j < 4; ++j) { v[j] = a[64 * j]; u[j] = b[64 * j]; }
#pragma unroll
    for (int j = 0; j < 4; ++j) { s += (v[j].x * v[j].x + v[j].y * v[j].y) + (v[j].z * v[j].z + v[j].w * v[j].w); t += (u[j].x * u[j].x + u[j].y * u[j].y) + (u[j].z * u[j].z + u[j].w * u[j].w); }
    s = wave_sum(s); t = wave_sum(t);
    const float rs = rsqrtf(s * (1.f / DM) + EPS), rt = rsqrtf(t * (1.f / DM) + EPS);
    GAS unsigned long long* p = (GAS unsigned long long*)o0 + lane; GAS unsigned long long* q = (GAS unsigned long long*)o1 + lane;
#pragma unroll
    for (int j = 0; j < 4; ++j) { p[64 * j] = (unsigned long long)pk2(v[j].x * rs, v[j].y * rs) | ((unsigned long long)pk2(v[j].z * rs, v[j].w * rs) << 32);
        q[64 * j] = (unsigned long long)pk2(u[j].x * rt, u[j].y * rt) | ((unsigned long long)pk2(u[j].z * rt, u[j].w * rt) << 32); }
}

struct Args { const float* in[20]; float* out; unsigned char* ws; int ph_lo, ph_hi, att_mask, ss_dummy, bar_idx, variant; };
enum { PH_PRO = 0, PH_QKV = 1, PH_ATT = 2, PH_MERGE = 3, PH_OUT = 4, PH_QM = 5, PH_CROSS = 6, PH_OM = 7, PH_FFN1 = 8, PH_FIX = 9, PH_DOWN = 10, PH_N = 11 };

__global__ void __launch_bounds__(NWAVES * 64, 2) mega(Args args) {
    extern __shared__ __attribute__((aligned(16))) unsigned char lds_raw[];
    Frame F;
    F.lds = (LAS unsigned char*)lds_raw;
    F.tid = threadIdx.x; F.lane = F.tid & 63; F.wave = __builtin_amdgcn_readfirstlane(F.tid >> 6);
    F.G = gridDim.x; { const int bx = blockIdx.x; F.vcu = (F.G % 8 == 0) ? (bx % 8) * (F.G / 8) + bx / 8 : bx; }
    unsigned char* ws = args.ws;
    volatile LAS unsigned* MISC = (volatile LAS unsigned*)(F.lds + MISC_OFF);
    for (int u = F.tid; u < (LDS_BYTES - MISC_OFF) / 4; u += NWAVES * 64) ((LAS unsigned*)(F.lds + MISC_OFF))[u] = 0u;
    __syncthreads();
    const int lo = args.ph_lo, hi = args.ph_hi;
    unsigned* barw = (unsigned*)(ws + WS_CTL) + CW_BAR + args.bar_idx * XCD_BAR_WORDS;
    XcdBarrier bar; bar.bar = barw; bar.x = 0; bar.st = nullptr;
    if (hi - lo > 1 || (lo <= PH_DOWN && PH_DOWN < hi)) bar = xcd_barrier_post(barw, MISC + 8);
#define IN(k) (lo <= (k) && (k) < hi)
#define SEAM(k) do { if (IN(k) && IN((k) + 1)) xcd_barrier(bar); } while (0)

    const float* x = args.in[0]; const float* mem = args.in[1]; const float* w_in = args.in[2]; const float* g_mix = args.in[3]; const float* g_od = args.in[4];
    const float* g_om = args.in[5]; const float* w_out = args.in[6]; const float* rel_bias = args.in[7]; const float* g_cross = args.in[8]; const float* g_mem = args.in[9];
    const float* w_q = args.in[10]; const float* w_kv = args.in[11]; const float* w_o = args.in[12]; const float* g_ffn = args.in[13]; const float* w_gate = args.in[14];
    const float* w_up = args.in[15]; const float* conv_w = args.in[16]; const float* conv_b = args.in[17]; const float* w_down = args.in[18]; const float* g_final = args.in[19];
    float* RS0 = (float*)(ws + WS_RS0); float* RSM = (float*)(ws + WS_RSM); float* SS1 = (float*)(ws + WS_SS1); float* SS2 = (float*)(ws + WS_SS2); float* SS3 = (float*)(ws + WS_SS3);
    float* SSA = (float*)(ws + WS_SSA); float* SSB = (float*)(ws + WS_SSB);
    float* SA1 = SS1; float* SA2 = SS2; float* SA3 = SS3; float* SAA = SSA; float* SAB = SSB;
    if (0) { SA1 = SA2 = SA3 = SAA = SAB = (float*)(ws + WS_DUMMY); }
    float* LUT = (float*)(ws + WS_LUT); float* KMP = (float*)(ws + WS_KMP); float* HALOG = (float*)(ws + WS_HALOG); float* FIXG = (float*)(ws + WS_FIXG); float* FIXU = (float*)(ws + WS_FIXU); float* PS = (float*)(ws + WS_PS);
    bf16* WIN = (bf16*)(ws + WS_WIN); bf16* WOUT = (bf16*)(ws + WS_WOUT); bf16* WQ = (bf16*)(ws + WS_WQ); bf16* WKV = (bf16*)(ws + WS_WKV);
    bf16* WO = (bf16*)(ws + WS_WO); bf16* WGU = (bf16*)(ws + WS_WGU); bf16* WD = (bf16*)(ws + WS_WD);
    bf16* MEMB = (bf16*)(ws + WS_MEMB); bf16* KVM = (bf16*)(ws + WS_KVM); bf16* XB = (bf16*)(ws + WS_XB); bf16* QKV = (bf16*)(ws + WS_QKV);
    bf16* YN = (bf16*)(ws + WS_YN); bf16* Y = (bf16*)(ws + WS_Y); bf16* OP = (bf16*)(ws + WS_OP); float* LSEP = (float*)(ws + WS_LSEP); bf16* H1 = (bf16*)(ws + WS_H1); bf16* QM = (bf16*)(ws + WS_QM);
    bf16* OM = (bf16*)(ws + WS_OM); bf16* H2 = (bf16*)(ws + WS_H2); bf16* ACT = (bf16*)(ws + WS_ACT); bf16* H3 = (bf16*)(ws + WS_H3);
    const int gw = F.vcu * NWAVES + F.wave, NGW = F.G * NWAVES;
    const int gt = (int)blockIdx.x * (NWAVES * 64) + F.tid, NGT = F.G * NWAVES * 64;

    if (IN(PH_PRO)) {
        LAS float* scr = (LAS float*)(F.lds + RING_OFF + F.wave * 16384);
        constexpr int I_IN = 16 * 96, I_OUT = 16 * 32, I_Q = 16 * 32, I_KV = 16 * 64, I_O = 16 * 32, I_GU = 16 * 176, I_D = 44 * 32;
        constexpr int NITEMS = I_IN + I_OUT + I_Q + I_KV + I_O + I_GU + I_D;
        for (int it = gw; it < NITEMS; it += NGW) {
            int r = it;
            if (r < I_IN) { const int kb = r / 96, nb = r % 96; p0_titem(w_in, 3072, 32 * nb, 64 * kb, g_mix, nullptr, 0, WIN, 1024, 32 * nb, scr, F.lane); continue; } r -= I_IN;
            if (r < I_OUT) { const int kb = r / 32, nb = r % 32; p0_titem(w_out, 1024, 32 * nb, 64 * kb, g_od, g_om, 512, WOUT, 1024, 32 * nb, scr, F.lane); continue; } r -= I_OUT;
            if (r < I_Q) { const int kb = r / 32, nb = r % 32; p0_titem(w_q, 1024, 32 * nb, 64 * kb, g_cross, nullptr, 0, WQ, 1024, 32 * nb, scr, F.lane); continue; } r -= I_Q;
            if (r < I_KV) { const int kb = r / 64, nb = r % 64; p0_titem(w_kv, 2048, 32 * nb, 64 * kb, g_mem, nullptr, 0, WKV, 1024, 32 * nb, scr, F.lane); continue; } r -= I_KV;
            if (r < I_O) { const int kb = r / 32, nb = r % 32; p0_titem(w_o, 1024, 32 * nb, 64 * kb, nullptr, nullptr, 0, WO, 1024, 32 * nb, scr, F.lane); continue; } r -= I_O;
            if (r < I_GU) { const int kb = r / 176, nb = r % 176; const int nd = 32 * nb, j = nd >> 8, rr = nd & 255;
                const float* src = (rr < 128) ? w_gate : w_up; const int sc = 128 * j + (rr & 127);
                p0_titem(src, 2816, sc, 64 * kb, g_ffn, nullptr, 0, WGU, 1024, nd, scr, F.lane); continue; } r -= I_GU;
            { const int kb = r / 32, nb = r % 32; p0_titem(w_down, 1024, 32 * nb, 64 * kb, nullptr, nullptr, 0, WD, 2816, 32 * nb, scr, F.lane); }
        }
        for (int m = 2 * gw; m < NTOK; m += 2 * NGW) p0_norm_rows2(x + (size_t)m * DM, x + (size_t)(m + 1) * DM, XB + (size_t)m * DM, XB + (size_t)(m + 1) * DM, F.lane);
        for (int m = 2 * gw; m < NMEMTOK; m += 2 * NGW) p0_norm_rows2(mem + (size_t)m * DM, mem + (size_t)(m + 1) * DM, MEMB + (size_t)m * DM, MEMB + (size_t)(m + 1) * DM, F.lane);
        for (int i = gt; i < 16 * 2048; i += NGT) { const int h = i >> 11, n = i & 2047; int b;
            if (n < 16) b = n; else { b = 16 + (n >= 22) + (n >= 30) + (n >= 40) + (n >= 54) + (n >= 73) + (n >= 99) + (n >= 134) + (n >= 182) + (n >= 246) + (n >= 332) + (n >= 450) + (n >= 609) + (n >= 825) + (n >= 1117) + (n >= 1513); }
            LUT[i] = rel_bias[h * 32 + b]; }
        for (int i = gt; i < NTOK; i += NGT) { SA1[i] = 0.f; SA2[i] = 0.f; SAA[i] = 0.f; SAB[i] = 0.f; }
    }
    SEAM(PH_PRO);

#define STAGGER(ticks) do { const unsigned long long t0_ = __builtin_amdgcn_s_memrealtime(); const unsigned long long d_ = (unsigned long long)((F.vcu & 3) * (ticks)); \
        while (__builtin_amdgcn_s_memrealtime() - t0_ < d_) __builtin_amdgcn_s_sleep(32); } while (0)
    if (IN(PH_QKV)) {
        { pg8::Gemm g{XB, WIN, NTOK, NQKV, 1024}; pg8::StaticOrder S; S.init(NTOK, NQKV, F.G, (int)blockIdx.x);
          pg8::EpiScale E{(0   & 128) ? (bf16*)(ws + WS_H1) : QKV, RS0, (0   & 128) ? nullptr : KMP, NQKV, ((0   & 32) ? 64 : 0) | ((0   & 64) ? 128 : 0) | ((0   & 128) ? 256 : 0)};
          pg8::gemm_phase<pg8::EpiScale, pg8::StaticOrder, true, true>(F.lds + RING_OFF, g, S, E); }
        { pg8::Gemm g{MEMB, WKV, NMEMTOK, 2048, 1024}; pg8::StaticOrder S; S.init(NMEMTOK, 2048, F.G, (int)blockIdx.x);
          pg8::EpiScale E{KVM, RSM, nullptr, 2048, 0};
          pg8::gemm_phase<pg8::EpiScale, pg8::StaticOrder, true, true>(F.lds + RING_OFF, g, S, E); }
    }
    SEAM(PH_QKV);
        if (IN(PH_ATT)) {
        if (3 & 1) att::moba_phase2(F.lds, QKV, KMP, LUT, 0   ? (bf16*)(ws + WS_H1) : Y, 0   ? nullptr : SAB, F.vcu, F.G);
        __syncthreads();
        if (3 & 2) att::dil_phase(F.lds, QKV, LUT, Y, SAA, F.vcu, F.G);
    }

    SEAM(PH_ATT);

    if (IN(PH_OUT)) {
        pg8::Gemm g{Y, WOUT, NTOK, DM, 1024}; pg8::StaticOrder S; S.init(NTOK, DM, F.G, (int)blockIdx.x);
        pg8::EpiOutProj E{H1, x, SA1, SSA, SSB, DM, 0};
        pg8::gemm_phase<pg8::EpiOutProj, pg8::StaticOrder, true, true>(F.lds + RING_OFF, g, S, E);
    }
    SEAM(PH_OUT);
    if (IN(PH_QM)) {
        pg8::Gemm g{H1, WQ, NTOK, DM, 1024}; pg8::StaticOrder S; S.init(NTOK, DM, F.G, (int)blockIdx.x);
        pg8::EpiScale E{QM, SS1, nullptr, DM, 1};
        pg8::gemm_phase<pg8::EpiScale, pg8::StaticOrder, true, true>(F.lds + RING_OFF, g, S, E);
    }
    SEAM(PH_QM);
        if (IN(PH_CROSS)) att::cross_phase(F.lds, QM, KVM, OM, F.vcu, F.G, (0   >> 12) & 3);

    SEAM(PH_CROSS);
    if (IN(PH_OM)) {
        pg8::Gemm g{OM, WO, NTOK, DM, 1024}; pg8::StaticOrder S; S.init(NTOK, DM, F.G, (int)blockIdx.x);
        pg8::EpiResid E{H2, H1, SA2, DM, 0};
        pg8::gemm_phase<pg8::EpiResid, pg8::StaticOrder, true, true>(F.lds + RING_OFF, g, S, E);
    }
    SEAM(PH_OM);
    if (IN(PH_FFN1)) {
        pg8::Gemm g{H2, WGU, NTOK, 5632, 1024}; pg8::StaticOrder S; S.init(NTOK, 5632, F.G, (int)blockIdx.x);
        pg8::EpiFfn1 E{ACT, SS2, conv_w, conv_b, HALOG, FIXG, FIXU, (LAS float*)(F.lds + LDSX_OFF), (0   >> 8) & 3, 0};
        pg8::gemm_phase<pg8::EpiFfn1, pg8::StaticOrder, true, true>(F.lds + RING_OFF, g, S, E);
    }
    SEAM(PH_FFN1);
    if (IN(PH_FIX)) {
        for (int i = gt; i < 256 * 2816; i += NGT) { const int pm = i / 2816, c = i % 2816;
            const float g0 = FIXG[((size_t)pm * 2 + 0) * 2816 + c], g1 = FIXG[((size_t)pm * 2 + 1) * 2816 + c];
            float hm1 = 0.f, hm2 = 0.f; if (pm & 7) { hm2 = HALOG[((size_t)(pm - 1) * 2 + 0) * 2816 + c]; hm1 = HALOG[((size_t)(pm - 1) * 2 + 1) * 2816 + c]; }
            const float w0 = conv_w[c], w1 = conv_w[2816 + c], w2 = conv_w[2 * 2816 + c], cbv = conv_b[c];
            const float c0 = cbv + w2 * g0 + w1 * hm1 + w0 * hm2, c1 = cbv + w2 * g1 + w1 * g0 + w0 * hm1;
            ACT[((size_t)pm * 256 + 0) * 2816 + c] = (bf16)f2bf(c0 / (1.f + __expf(-c0)) * FIXU[((size_t)pm * 2 + 0) * 2816 + c]);
            ACT[((size_t)pm * 256 + 1) * 2816 + c] = (bf16)f2bf(c1 / (1.f + __expf(-c1)) * FIXU[((size_t)pm * 2 + 1) * 2816 + c]); }
    }
    SEAM(PH_FIX);
    if (IN(PH_DOWN)) {
        pg8::Gemm g{ACT, WD, NTOK, DM, DFF}; pg8::StaticOrder S0; S0.init(NTOK, DM, F.G, (int)blockIdx.x);
        pg8::EpiFinal<XcdBarrier> E{H2, args.out, g_final, PS, &bar};
        { pg8::RoundOrder S{S0, 0}; pg8::gemm_phase<pg8::EpiFinal<XcdBarrier>, pg8::RoundOrder, false, true>(F.lds + RING_OFF, g, S, E); }
        __syncthreads();
        { pg8::RoundOrder S{S0, 1}; pg8::gemm_phase<pg8::EpiFinal<XcdBarrier>, pg8::RoundOrder, false, true>(F.lds + RING_OFF, g, S, E); }
        __syncthreads();
        { pg8::RoundOrder S{S0, 2}; pg8::gemm_phase<pg8::EpiFinal<XcdBarrier>, pg8::RoundOrder, false, true>(F.lds + RING_OFF, g, S, E); }
        __syncthreads();
        { pg8::RoundOrder S{S0, 3}; pg8::gemm_phase<pg8::EpiFinal<XcdBarrier>, pg8::RoundOrder, false, true>(F.lds + RING_OFF, g, S, E); }
    }
#undef IN
#undef SEAM
}


extern "C" void kernel_launch(void* const* d_in, const int* in_sizes, int n_in, void* d_out, int out_size, void* d_ws, size_t ws_size, hipStream_t stream) {
    static int grid = 0;
    if (grid == 0) {
        if (n_in != 20 || in_sizes[0] != NTOK * DM || out_size != NTOK * DM || ws_size < WS_END) { fprintf(stderr, "kernel_launch: unexpected shapes (n_in %d, ws %zu); nothing launched\n", n_in, ws_size); grid = -1; return; }
        int dev = 0, cus = 0, per_cu = 0;
        if (hipGetDevice(&dev) != hipSuccess || hipDeviceGetAttribute(&cus, hipDeviceAttributeMultiprocessorCount, dev) != hipSuccess) { grid = -1; return; }
        if (hipFuncSetAttribute((const void*)mega, hipFuncAttributeMaxDynamicSharedMemorySize, LDS_BYTES) != hipSuccess) { fprintf(stderr, "kernel_launch: hipFuncSetAttribute failed\n"); grid = -1; return; }
        if (hipOccupancyMaxActiveBlocksPerMultiprocessor(&per_cu, (const void*)mega, NWAVES * 64, LDS_BYTES) != hipSuccess || per_cu < 1) fprintf(stderr, "kernel_launch: occupancy query says %d\n", per_cu);
        (void)hipGetLastError();
        grid = cus;
        if (grid != NTOK / 256) { fprintf(stderr, "kernel_launch: this kernel needs exactly %d workgroups (one per CU of a 256-CU device); found %d CUs\n", NTOK / 256, cus); grid = NTOK / 256; }
    }
    if (grid < 0) return;
    unsigned char* ws = (unsigned char*)d_ws;
    (void)hipMemsetAsync(ws + WS_CTL, 0, CTL_ZERO_BYTES, stream);
    Args a{};
    for (int i = 0; i < 20; ++i) a.in[i] = (const float*)d_in[i];
    a.out = (float*)d_out; a.ws = ws; a.att_mask = 3;
    int nbar = 0;
    auto runx = [&](int lo, int hi, int mask, int dummy, int variant = 0) { Args b2 = a; b2.variant = variant; b2.bar_idx = (hi - lo > 1 || (lo <= PH_DOWN && PH_DOWN < hi)) ? nbar++ : 0; b2.ph_lo = lo; b2.ph_hi = hi; b2.att_mask = mask; b2.ss_dummy = dummy; hipLaunchKernelGGL(mega, dim3(grid), dim3(NWAVES * 64), LDS_BYTES, stream, b2); };
    auto run = [&](int lo, int hi) { runx(lo, hi, 3, 0); };
    run(0, PH_N);
}
```

```cpp
#include <hip/hip_runtime.h>
#include <cstdio>
#include <cstdint>

typedef unsigned short bf16;
constexpr int BATCH = 32, SEQ = 2048, DM = 1024, NTOK = BATCH * SEQ;
constexpr int NMEM = 256, NMEMTOK = BATCH * NMEM, DFF = 2816;
constexpr int NQKV = 3072;
constexpr float EPS = 1e-6f;

constexpr size_t MiB = 1u << 20;
constexpr size_t WS_CTL = 0, CTL_ZERO_BYTES = 64 * 1024;
constexpr size_t WS_RS0 = 1 * MiB;
constexpr size_t WS_RSM = WS_RS0 + 256 * 1024;
constexpr size_t WS_SS1 = WS_RSM + 256 * 1024;
constexpr size_t WS_SS2 = WS_SS1 + 256 * 1024;
constexpr size_t WS_SS3 = WS_SS2 + 256 * 1024;
constexpr size_t WS_SSA = 27 * MiB, WS_SSB = WS_SSA + 256 * 1024;
constexpr size_t WS_KMEAN = WS_SS3 + 256 * 1024;
constexpr size_t WS_LUT = WS_KMEAN + 512 * 1024;
constexpr size_t WS_KMP = 3 * MiB;
constexpr size_t WS_HALOG = 4 * MiB;
constexpr size_t WS_FIXG = WS_HALOG + 256 * 2 * 2816 * 4;
constexpr size_t WS_FIXU = WS_FIXG + 256 * 2 * 2816 * 4;
constexpr size_t WS_DUMMY = 21 * MiB;
constexpr size_t WS_PS = 22 * MiB;
constexpr size_t WS_LSEP = 23 * MiB;
constexpr size_t WS_WIN = 28 * MiB;
constexpr size_t WS_WOUT = WS_WIN + 6 * MiB;
constexpr size_t WS_WQ = WS_WOUT + 2 * MiB;
constexpr size_t WS_WKV = WS_WQ + 2 * MiB;
constexpr size_t WS_WO = WS_WKV + 4 * MiB;
constexpr size_t WS_WGU = WS_WO + 2 * MiB;
constexpr size_t WS_WD = WS_WGU + 11 * MiB;
constexpr size_t WS_MEMB = 62 * MiB;
constexpr size_t WS_KVM = 78 * MiB;
constexpr size_t WS_XB = 112 * MiB;
constexpr size_t WS_QKV = 240 * MiB;
constexpr size_t WS_Y = 624 * MiB;
constexpr size_t WS_OP = 752 * MiB;
constexpr size_t WS_YN = 240 * MiB;
constexpr size_t WS_H1 = 880 * MiB;
constexpr size_t WS_QM = 368 * MiB;
constexpr size_t WS_OM = 496 * MiB;
constexpr size_t WS_H2 = 624 * MiB;
constexpr size_t WS_ACT = 112 * MiB;
constexpr size_t WS_GU = 752 * MiB;
constexpr size_t WS_H3 = 464 * MiB;
constexpr size_t WS_END = 1024 * MiB;
static_assert(WS_FIXU + 256 * 2 * 2816 * 4 <= WS_LSEP && WS_LSEP + 5 * MiB <= WS_WIN && WS_WD + 6 * MiB <= WS_MEMB, "ws map");

__device__ __forceinline__ unsigned f2bf(float f) { unsigned u = __builtin_bit_cast(unsigned, f); return (u + 0x7fffu + ((u >> 16) & 1u)) >> 16; }
__device__ __forceinline__ float bf2f(bf16 b) { return __builtin_bit_cast(float, (unsigned)b << 16); }
__device__ __forceinline__ float bflo(unsigned w) { return __builtin_bit_cast(float, w << 16); }
__device__ __forceinline__ float bfhi(unsigned w) { return __builtin_bit_cast(float, w & 0xffff0000u); }
__device__ __forceinline__ float wave_sum(float v) {
#pragma unroll
    for (int o = 1; o < 64; o <<= 1) v += __shfl_xor(v, o);
    return v;
}


namespace pg8 {
#define PG8_LAS __attribute__((address_space(3)))
typedef unsigned short bf16_t;
typedef short bf16x8 __attribute__((ext_vector_type(8)));
typedef float f32x4 __attribute__((ext_vector_type(4)));
typedef unsigned u32x4 __attribute__((ext_vector_type(4)));
constexpr int BM = 256, BK = 64, HALF = 128, HTB = HALF * BK * 2  , STAGE_BYTES = 8 * HTB, NXCD = 8, WGM = 8;

__host__ __device__ __forceinline__ int lds_byte(int r, int c) { const int st = (r >> 4) * 2 + (c >> 5), rr = r & 15, cc = c & 31, ob = rr * 64 + cc * 2; return st * 1024 + (ob ^ (((ob >> 9) & 1) << 5)); }
__host__ __device__ __forceinline__ void stage_rc(int b, int& R, int& C) { const int st = b / 1024, sb = b % 1024, swz = sb ^ (((sb >> 9) & 1) << 5); R = (st >> 1) * 16 + swz / 64; C = (st & 1) * 32 + (swz % 64) / 2; }
__host__ __device__ __forceinline__ int perm32(int rho) { const int n = rho >> 4, i = rho & 15; return 8 * (i >> 2) + 4 * n + (i & 3); }

struct Unit { int pm, pn; };
struct Gemm { const bf16_t* A; const bf16_t* Bt; int M, N, K; };

struct StaticOrder {
    int nM, nN, nwg, G, c;
    __host__ __device__ void init(int M, int N, int G_, int c_) { nM = M / BM; nN = N / BM; nwg = nM * nN; G = G_; c = c_; }
    __host__ __device__ bool next(int i, Unit& u) const {
        const long L = (long)i * G + c; if (L >= nwg) return false;
        int wgid = (int)L; { const int q = nwg / NXCD, r = nwg % NXCD, xcd = wgid % NXCD, off = wgid / NXCD; wgid = (xcd < r ? xcd * (q + 1) : r * (q + 1) + (xcd - r) * q) + off; }
        const int nig = WGM * nN, gid = wgid / nig, fm = gid * WGM, gsz = (nM - fm) < WGM ? (nM - fm) : WGM;
        u.pm = fm + ((wgid % nig) % gsz); u.pn = (wgid % nig) / gsz; return true;
    }
    __device__ __forceinline__ void a_ready(const Unit&) const {}
    __device__ __forceinline__ void done(const Unit&) const {}
};


struct PanelOrder { int pm, nN;
    __device__ __forceinline__ bool next(int i, Unit& u) const { if (i >= nN) return false; int a = pm, b = i; asm volatile("" : "+s"(a), "+s"(b)); u.pm = a; u.pn = b; return true; }
    __device__ __forceinline__ void a_ready(const Unit&) const {}
    __device__ __forceinline__ void done(const Unit&) const {} };
__device__ __forceinline__ unsigned cvt_pk_bf16(float lo, float hi) { unsigned r; asm volatile("v_cvt_pk_bf16_f32 %0, %1, %2" : "=v"(r) : "v"(lo), "v"(hi)); return r; }
__device__ __forceinline__ float lo_f(unsigned w) { return __builtin_bit_cast(float, w << 16); }
__device__ __forceinline__ float hi_f(unsigned w) { return __builtin_bit_cast(float, w & 0xffff0000u); }

struct EpiScale {
    static constexpr bool PERM = true, AFTER_DRAIN = false, KSPLIT = false, PERM_A = false;
    bf16_t* O; const float* rs; float* kmp; int ldc; int mode;
    __device__ __forceinline__ void operator()(const f32x4 (&acc)[2][2][4][2], const Unit& u, int wr, int wc, int fr, int fq) const {
        if (mode & 64) return;
        const int row0 = u.pm * BM + wr * 64 + fr, col0 = u.pn * BM + wc * 32 + 8 * fq;
        const bool dokm = (kmp != nullptr) && (u.pn == 8 || u.pn == 9);
        const float qs = ((kmp != nullptr) && (u.pn < 2 || u.pn == 6 || u.pn == 7)) ? 0.125f * 1.4426950408889634f : 1.f;
        float cs[2][8];
#pragma unroll
        for (int bj = 0; bj < 2; ++bj)
#pragma unroll
            for (int e = 0; e < 8; ++e) cs[bj][e] = 0.f;
#pragma unroll
        for (int ai = 0; ai < 2; ++ai)
#pragma unroll
            for (int m = 0; m < 4; ++m) { const int r = row0 + ai * HALF + m * 16; float s = qs; if (mode == 1) s = rsqrtf(rs[r] * (1.f / 1024.f) + 1e-6f);
                bf16_t* rowp = (mode & 256) ? O + (size_t)(r & 255) * ldc + col0 : O + (size_t)r * ldc + col0;
#pragma unroll
                for (int bj = 0; bj < 2; ++bj) { const f32x4 v0 = acc[ai][bj][m][0] * s, v1 = acc[ai][bj][m][1] * s;
                    u32x4 w; w.x = cvt_pk_bf16(v0[0], v0[1]); w.y = cvt_pk_bf16(v0[2], v0[3]); w.z = cvt_pk_bf16(v1[0], v1[1]); w.w = cvt_pk_bf16(v1[2], v1[3]);
                    if (mode & 128) { asm volatile("" :: "v"(w.x), "v"(w.y), "v"(w.z), "v"(w.w)); } else *(u32x4*)(rowp + bj * HALF) = w;
                    if (dokm) { cs[bj][0] += lo_f(w.x); cs[bj][1] += hi_f(w.x); cs[bj][2] += lo_f(w.y); cs[bj][3] += hi_f(w.y); cs[bj][4] += lo_f(w.z); cs[bj][5] += hi_f(w.z); cs[bj][6] += lo_f(w.w); cs[bj][7] += hi_f(w.w); } } }
        if (dokm) {
#pragma unroll
            for (int bj = 0; bj < 2; ++bj)
#pragma unroll
                for (int e = 0; e < 8; ++e) { float v = cs[bj][e]; v += __shfl_xor(v, 1); v += __shfl_xor(v, 2); v += __shfl_xor(v, 4); v += __shfl_xor(v, 8); cs[bj][e] = v; }
            if (fr == 0) { float* kp = kmp + (size_t)(u.pm * 2 + wr) * 512 + (u.pn - 8) * 256 + wc * 32 + 8 * fq;
#pragma unroll
                for (int bj = 0; bj < 2; ++bj) { *(f32x4*)(kp + bj * HALF) = (f32x4){cs[bj][0], cs[bj][1], cs[bj][2], cs[bj][3]}; *(f32x4*)(kp + bj * HALF + 4) = (f32x4){cs[bj][4], cs[bj][5], cs[bj][6], cs[bj][7]}; } }
        }
    }
};

struct EpiResid {
    static constexpr bool PERM = true, AFTER_DRAIN = false, KSPLIT = false, PERM_A = false;
    bf16_t* O; const bf16_t* R; float* ss; int ldc; int pad;
    __device__ __forceinline__ void operator()(const f32x4 (&acc)[2][2][4][2], const Unit& u, int wr, int wc, int fr, int fq) const {
        const int row0 = u.pm * BM + wr * 64 + fr, col0 = u.pn * BM + wc * 32 + 8 * fq;
#pragma unroll
        for (int ai = 0; ai < 2; ++ai)
#pragma unroll
            for (int m = 0; m < 4; ++m) { const int r = row0 + ai * HALF + m * 16; const size_t off = (size_t)r * ldc + col0; float sq = 0.f;
#pragma unroll
                for (int bj = 0; bj < 2; ++bj) { const u32x4 rv = *(const u32x4*)(R + off + bj * HALF);
                    const f32x4 a0 = acc[ai][bj][m][0], a1 = acc[ai][bj][m][1];
                    u32x4 w; w.x = cvt_pk_bf16(a0[0] + lo_f(rv.x), a0[1] + hi_f(rv.x)); w.y = cvt_pk_bf16(a0[2] + lo_f(rv.y), a0[3] + hi_f(rv.y));
                    w.z = cvt_pk_bf16(a1[0] + lo_f(rv.z), a1[1] + hi_f(rv.z)); w.w = cvt_pk_bf16(a1[2] + lo_f(rv.w), a1[3] + hi_f(rv.w));
                    *(u32x4*)(O + off + bj * HALF) = w;
                    float t;
                    t = lo_f(w.x); sq += t * t; t = hi_f(w.x); sq += t * t; t = lo_f(w.y); sq += t * t; t = hi_f(w.y); sq += t * t;
                    t = lo_f(w.z); sq += t * t; t = hi_f(w.z); sq += t * t; t = lo_f(w.w); sq += t * t; t = hi_f(w.w); sq += t * t; }
                sq += __shfl_xor(sq, 16); sq += __shfl_xor(sq, 32);
                if (fq == 0) atomicAdd(ss + r, sq); }
    }
};


struct EpiResidF32 {
    static constexpr bool PERM = true, AFTER_DRAIN = false, KSPLIT = false, PERM_A = false;
    bf16_t* O; const float* R; float* ss; int ldc; int pad;
    __device__ __forceinline__ void operator()(const f32x4 (&acc)[2][2][4][2], const Unit& u, int wr, int wc, int fr, int fq) const {
        const int row0 = u.pm * BM + wr * 64 + fr, col0 = u.pn * BM + wc * 32 + 8 * fq;
#pragma unroll
        for (int ai = 0; ai < 2; ++ai)
#pragma unroll
            for (int m = 0; m < 4; ++m) { const int r = row0 + ai * HALF + m * 16; const size_t off = (size_t)r * ldc + col0; float sq = 0.f;
#pragma unroll
                for (int bj = 0; bj < 2; ++bj) { const f32x4 r0 = *(const f32x4*)(R + off + bj * HALF), r1 = *(const f32x4*)(R + off + bj * HALF + 4);
                    const f32x4 a0 = acc[ai][bj][m][0] + r0, a1 = acc[ai][bj][m][1] + r1;
                    u32x4 w; w.x = cvt_pk_bf16(a0[0], a0[1]); w.y = cvt_pk_bf16(a0[2], a0[3]); w.z = cvt_pk_bf16(a1[0], a1[1]); w.w = cvt_pk_bf16(a1[2], a1[3]);
                    *(u32x4*)(O + off + bj * HALF) = w;
                    float t;
                    t = lo_f(w.x); sq += t * t; t = hi_f(w.x); sq += t * t; t = lo_f(w.y); sq += t * t; t = hi_f(w.y); sq += t * t;
                    t = lo_f(w.z); sq += t * t; t = hi_f(w.z); sq += t * t; t = lo_f(w.w); sq += t * t; t = hi_f(w.w); sq += t * t; }
                sq += __shfl_xor(sq, 16); sq += __shfl_xor(sq, 32);
                if (fq == 0) atomicAdd(ss + r, sq); }
    }
};


struct EpiOutProj {
    static constexpr bool PERM = true, AFTER_DRAIN = false, KSPLIT = true, PERM_A = false;
    bf16_t* O; const float* R; float* ss; const float* ssa; const float* ssb; int ldc; int pad;
    __device__ __forceinline__ void mid(f32x4 (&acc)[2][2][4][2], const Unit& u, int wr, int fr) const {
        asm volatile("" : "+v"(fr));
#pragma unroll
        for (int ai = 0; ai < 2; ++ai) {
#pragma unroll
            for (int m = 0; m < 4; ++m) { const int r = u.pm * BM + ai * HALF + wr * 64 + m * 16 + fr;
                const float ratio = rsqrtf(ssa[r] * (1.f / 512.f) + 1e-6f) * sqrtf(ssb[r] * (1.f / 512.f) + 1e-6f);
#pragma unroll
                for (int bj = 0; bj < 2; ++bj) { acc[ai][bj][m][0] *= ratio; acc[ai][bj][m][1] *= ratio; } }
            asm volatile("" ::: "memory"); __builtin_amdgcn_sched_barrier(0); }
    }
    __device__ __forceinline__ void operator()(const f32x4 (&acc)[2][2][4][2], const Unit& u, int wr, int wc, int fr, int fq) const {
        const int row0 = u.pm * BM + wr * 64 + fr, col0 = u.pn * BM + wc * 32 + 8 * fq;
#pragma unroll
        for (int ai = 0; ai < 2; ++ai)
#pragma unroll
            for (int m = 0; m < 4; ++m) { const int r = row0 + ai * HALF + m * 16; const size_t off = (size_t)r * ldc + col0; float sq = 0.f;
                const float rsb = rsqrtf(ssb[r] * (1.f / 512.f) + 1e-6f);
#pragma unroll
                for (int bj = 0; bj < 2; ++bj) { const f32x4 r0 = *(const f32x4*)(R + off + bj * HALF), r1 = *(const f32x4*)(R + off + bj * HALF + 4);
                    const f32x4 a0 = acc[ai][bj][m][0] * rsb + r0, a1 = acc[ai][bj][m][1] * rsb + r1;
                    u32x4 w; w.x = cvt_pk_bf16(a0[0], a0[1]); w.y = cvt_pk_bf16(a0[2], a0[3]); w.z = cvt_pk_bf16(a1[0], a1[1]); w.w = cvt_pk_bf16(a1[2], a1[3]);
                    *(u32x4*)(O + off + bj * HALF) = w;
                    float t;
                    t = lo_f(w.x); sq += t * t; t = hi_f(w.x); sq += t * t; t = lo_f(w.y); sq += t * t; t = hi_f(w.y); sq += t * t;
                    t = lo_f(w.z); sq += t * t; t = hi_f(w.z); sq += t * t; t = lo_f(w.w); sq += t * t; t = hi_f(w.w); sq += t * t; }
                sq += __shfl_xor(sq, 16); sq += __shfl_xor(sq, 32);
                if (fq == 0) atomicAdd(ss + r, sq); }
    }
};

struct RoundOrder { StaticOrder S; int r;
    __device__ __forceinline__ bool next(int i, Unit& u) const { return i == 0 && S.next(r, u); }
    __device__ __forceinline__ void a_ready(const Unit&) const {}
    __device__ __forceinline__ void done(const Unit&) const {} };
template <class Bar> struct EpiFinal {
    static constexpr bool PERM = false, AFTER_DRAIN = true, KSPLIT = false, PERM_A = false;
    const bf16_t* R; float* out; const float* g; float* ps; unsigned* pcnt;
    __device__ __forceinline__ void fused(f32x4 (&acc)[2][2][4][2], const Unit& u, int wr, int wc, int fr, int fq, PG8_LAS unsigned char* lds, int wid, int lane) const {
        typedef unsigned u32x2v __attribute__((ext_vector_type(2)));
        PG8_LAS float* P = (PG8_LAS float*)lds;
        PG8_LAS float* S = (PG8_LAS float*)(lds + 4096);
        const int col0 = u.pn * BM + wc * 32 + 4 * fq, tid = wid * 64 + lane;
#pragma unroll
        for (int ai = 0; ai < 2; ++ai)
#pragma unroll
            for (int m = 0; m < 4; ++m) { const int rl = ai * HALF + wr * 64 + m * 16 + fr; const size_t off = (size_t)(u.pm * BM + rl) * 1024 + col0; float sq = 0.f;
#pragma unroll
                for (int bj = 0; bj < 2; ++bj)
#pragma unroll
                    for (int n = 0; n < 2; ++n) { const u32x2v rv = *(const u32x2v*)(R + off + bj * HALF + n * 16);
                        f32x4 v = acc[ai][bj][m][n]; v[0] += lo_f(rv.x); v[1] += hi_f(rv.x); v[2] += lo_f(rv.y); v[3] += hi_f(rv.y); acc[ai][bj][m][n] = v;
                        sq += (v[0] * v[0] + v[1] * v[1]) + (v[2] * v[2] + v[3] * v[3]); }
                sq += __shfl_xor(sq, 16); sq += __shfl_xor(sq, 32);
                if (fq == 0) P[rl * 4 + wc] = sq; }
        asm volatile("s_waitcnt lgkmcnt(0)" ::: "memory"); __builtin_amdgcn_s_barrier(); asm volatile("" ::: "memory");
        if (tid < 256) { const f32x4 p4 = *(const PG8_LAS f32x4*)(P + tid * 4); (void)__hip_atomic_fetch_add(ps + (size_t)u.pm * BM + tid, (p4[0] + p4[1]) + (p4[2] + p4[3]), __ATOMIC_RELAXED, __HIP_MEMORY_SCOPE_AGENT); }
        asm volatile("s_waitcnt vmcnt(0)" ::: "memory"); __syncthreads();
        if (tid == 0) { (void)__hip_atomic_fetch_add(pcnt + u.pm, 1u, __ATOMIC_RELAXED, __HIP_MEMORY_SCOPE_AGENT);
            unsigned sp = 0u; while (__hip_atomic_load(pcnt + u.pm, __ATOMIC_RELAXED, __HIP_MEMORY_SCOPE_AGENT) < 4u) { __builtin_amdgcn_s_sleep(1); if (++sp > (1u << 22)) break; } }
        __syncthreads();
        if (tid < 256) { const float q = __hip_atomic_load(ps + (size_t)u.pm * BM + tid, __ATOMIC_RELAXED, __HIP_MEMORY_SCOPE_AGENT); S[tid] = rsqrtf(q * (1.f / 1024.f) + 1e-6f); }
        asm volatile("s_waitcnt vmcnt(0) lgkmcnt(0)" ::: "memory"); __builtin_amdgcn_s_barrier(); asm volatile("" ::: "memory");
        f32x4 gv[2][2];
#pragma unroll
        for (int bj = 0; bj < 2; ++bj)
#pragma unroll
            for (int n = 0; n < 2; ++n) gv[bj][n] = *(const f32x4*)(g + col0 + bj * HALF + n * 16);
#pragma unroll
        for (int ai = 0; ai < 2; ++ai)
#pragma unroll
            for (int m = 0; m < 4; ++m) { const int rl = ai * HALF + wr * 64 + m * 16 + fr; const float rs = S[rl]; const size_t off = (size_t)(u.pm * BM + rl) * 1024 + col0;
#pragma unroll
                for (int bj = 0; bj < 2; ++bj)
#pragma unroll
                    for (int n = 0; n < 2; ++n) *(f32x4*)(out + off + bj * HALF + n * 16) = acc[ai][bj][m][n] * rs * gv[bj][n]; }
        asm volatile("s_waitcnt lgkmcnt(0)" ::: "memory"); __builtin_amdgcn_s_barrier(); asm volatile("" ::: "memory");
    }
};

__device__ __forceinline__ float dpp_shr1(float oldv, float src) { return __builtin_bit_cast(float, __builtin_amdgcn_update_dpp(__builtin_bit_cast(int, oldv), __builtin_bit_cast(int, src), 0x111, 0xf, 0xf, false)); }
__device__ __forceinline__ float dpp_shr2(float oldv, float src) { return __builtin_bit_cast(float, __builtin_amdgcn_update_dpp(__builtin_bit_cast(int, oldv), __builtin_bit_cast(int, src), 0x112, 0xf, 0xf, false)); }
__device__ __forceinline__ float dpp_ror1(float src) { return __builtin_bit_cast(float, __builtin_amdgcn_update_dpp(0, __builtin_bit_cast(int, src), 0x121, 0xf, 0xf, false)); }
__device__ __forceinline__ float dpp_ror2(float src) { return __builtin_bit_cast(float, __builtin_amdgcn_update_dpp(0, __builtin_bit_cast(int, src), 0x122, 0xf, 0xf, false)); }
struct EpiFfn1 {
    static constexpr bool PERM = true, AFTER_DRAIN = false, KSPLIT = false, PERM_A = true;
    bf16_t* ACT; const float* ss2; const float* cw; const float* cb; float* halog; float* fixg; float* fixu; PG8_LAS float* hl; int probe, pad;
    __device__ __forceinline__ void operator()(const f32x4 (&acc)[2][2][4][2], const Unit& u, int wr, int wc, int fr, int fq) const {
        constexpr int FF = 2816;
        if (probe & 1) return;
        const int ch0 = u.pn * HALF + wc * 32 + 8 * fq;
        float rsv[2][4];
#pragma unroll
        for (int ai = 0; ai < 2; ++ai) { const f32x4 s4 = *(const f32x4*)(ss2 + u.pm * BM + ai * HALF + wr * 64 + 4 * fr);
#pragma unroll
            for (int m = 0; m < 4; ++m) rsv[ai][m] = rsqrtf(s4[m] * (1.f / 1024.f) + 1e-6f); }
        if (fr == 15) {
#pragma unroll
            for (int ai = 0; ai < 2; ++ai) { const int G = 2 * ai + wr;
#pragma unroll
                for (int j = 0; j < 2; ++j) { PG8_LAS float* p = hl + (((G * 4 + wc) * 2 + j) * 4 + fq) * 8;
                    *(PG8_LAS f32x4*)p = acc[ai][0][2 + j][0] * rsv[ai][2 + j]; *(PG8_LAS f32x4*)(p + 4) = acc[ai][0][2 + j][1] * rsv[ai][2 + j]; } } }
        constexpr float L2E = 1.4426950408889634f, IL2E = 0.6931471805599453f;
        const f32x4 w0a = *(const f32x4*)(cw + ch0) * L2E, w0b = *(const f32x4*)(cw + ch0 + 4) * L2E, w1a = *(const f32x4*)(cw + FF + ch0) * L2E, w1b = *(const f32x4*)(cw + FF + ch0 + 4) * L2E;
        const f32x4 w2a = *(const f32x4*)(cw + 2 * FF + ch0) * L2E, w2b = *(const f32x4*)(cw + 2 * FF + ch0 + 4) * L2E, cba = *(const f32x4*)(cb + ch0) * L2E, cbb = *(const f32x4*)(cb + ch0 + 4) * L2E;
        asm volatile("s_waitcnt lgkmcnt(0)" ::: "memory"); __builtin_amdgcn_s_barrier(); asm volatile("" ::: "memory");
#pragma unroll
        for (int ai = 0; ai < 2; ++ai) { const int G = 2 * ai + wr; const int rbase = u.pm * BM + ai * HALF + wr * 64 + 4 * fr;
            f32x4 h2a = (f32x4){0.f, 0.f, 0.f, 0.f}, h2b = h2a, h3a = h2a, h3b = h2a;
            if (G > 0 && fr == 0) { const PG8_LAS float* p = hl + ((((G - 1) * 4 + wc) * 2) * 4 + fq) * 8; h2a = *(const PG8_LAS f32x4*)p; h2b = *(const PG8_LAS f32x4*)(p + 4); h3a = *(const PG8_LAS f32x4*)(p + 32); h3b = *(const PG8_LAS f32x4*)(p + 36); }
            f32x4 g[4][2], uu[4][2];
#pragma unroll
            for (int m = 0; m < 4; ++m) { const float s = rsv[ai][m]; g[m][0] = acc[ai][0][m][0] * s; g[m][1] = acc[ai][0][m][1] * s; uu[m][0] = acc[ai][1][m][0] * (s * IL2E); uu[m][1] = acc[ai][1][m][1] * (s * IL2E); }
            f32x4 s2[2], s3[2];
#pragma unroll
            for (int e = 0; e < 4; ++e) { s3[0][e] = dpp_shr1(h3a[e], g[3][0][e]); s3[1][e] = dpp_shr1(h3b[e], g[3][1][e]); s2[0][e] = dpp_shr1(h2a[e], g[2][0][e]); s2[1][e] = dpp_shr1(h2b[e], g[2][1][e]); }
#pragma unroll
            for (int m = 0; m < 4; ++m) {
                f32x4 o[2];
#pragma unroll
                for (int hx = 0; hx < 2; ++hx) { const f32x4 w0 = hx ? w0b : w0a, w1 = hx ? w1b : w1a, w2 = hx ? w2b : w2a, cbx = hx ? cbb : cba;
                    const f32x4 g1 = (m == 0) ? s3[hx] : g[m - 1][hx], g2 = (m == 0) ? s2[hx] : (m == 1 ? s3[hx] : g[m - 2][hx]);
#pragma unroll
                    for (int e = 0; e < 4; ++e) { const float c = __builtin_fmaf(w0[e], g2[e], __builtin_fmaf(w1[e], g1[e], __builtin_fmaf(w2[e], g[m][hx][e], cbx[e])));
                        o[hx][e] = c * __builtin_amdgcn_rcpf(1.f + __builtin_amdgcn_exp2f(-c)) * uu[m][hx][e]; } }
                const bool defer = (G == 0 && fr == 0 && m < 2);
                if (defer) { float* pg = fixg + ((size_t)u.pm * 2 + m) * FF + ch0; float* pu = fixu + ((size_t)u.pm * 2 + m) * FF + ch0;
                    *(f32x4*)pg = g[m][0]; *(f32x4*)(pg + 4) = g[m][1]; *(f32x4*)pu = uu[m][0] * L2E; *(f32x4*)(pu + 4) = uu[m][1] * L2E; }
                else { u32x4 w; w.x = cvt_pk_bf16(o[0][0], o[0][1]); w.y = cvt_pk_bf16(o[0][2], o[0][3]); w.z = cvt_pk_bf16(o[1][0], o[1][1]); w.w = cvt_pk_bf16(o[1][2], o[1][3]);
                    if (probe & 2) { asm volatile("" :: "v"(w.x), "v"(w.y), "v"(w.z), "v"(w.w)); } else *(u32x4*)(ACT + (size_t)(rbase + m) * FF + ch0) = w; }
                if (G == 3 && fr == 15 && m >= 2) { float* ph = halog + ((size_t)u.pm * 2 + (m - 2)) * FF + ch0; *(f32x4*)ph = g[m][0]; *(f32x4*)(ph + 4) = g[m][1]; } } }
    }
};

template <class Epi, class Sched, bool ALIGN_EPI = false, bool SP2 = false>
__device__ __forceinline__ void gemm_phase(PG8_LAS unsigned char* lds, const Gemm g, const Sched& S, const Epi& E) {
    int tid_ = threadIdx.x; asm volatile("" : "+v"(tid_));
    const int tid = tid_, wid = __builtin_amdgcn_readfirstlane(tid >> 6), lane = tid & 63, wr = wid >> 2, wc = wid & 3, fr = lane & 15, fq = lane >> 4;
    const int K = g.K, nt = K / BK;
    unsigned voffA[2], voffB[2];
#pragma unroll
    for (int i = 0; i < 2; ++i) { int R, C; stage_rc(tid * 16 + i * 8192, R, C); const int Rb = Epi::PERM ? ((R & ~31) + perm32(R & 31)) : R;
        const int Ra = Epi::PERM_A ? ((R & ~63) + 4 * (R & 15) + ((R >> 4) & 3)) : R;
        voffA[i] = (unsigned)(Ra * K + C) * 2u; voffB[i] = (unsigned)(Rb * K + C) * 2u; }
    const size_t kstep = (size_t)(BK * 2);
    const size_t hstep = (size_t)HALF * K * 2;
    const size_t tstep = 2 * hstep;
    const unsigned ldsw = (unsigned)wid * 1024u;
    const int aoff = lds_byte(wr * 64 + fr, fq * 8), boff = lds_byte(wc * 32 + fr, fq * 8);
#define PG8_SA(b, h) (((b) * 2 + (h)) * HTB)
#define PG8_SB(b, h) ((4 + (b) * 2 + (h)) * HTB)
#define PG8_STAGE(bufoff, gbase, voff) do { _Pragma("unroll") for (int _i = 0; _i < 2; ++_i) \
        __builtin_amdgcn_global_load_lds((const unsigned*)((const char*)(gbase) + (voff)[_i]), (PG8_LAS unsigned*)(lds + (bufoff) + ldsw + _i * 8192), 16, 0, 0); } while (0)
#define PG8_LDA(dst, b, h) do { _Pragma("unroll") for (int m = 0; m < 4; ++m) _Pragma("unroll") for (int k = 0; k < 2; ++k) dst[m][k] = *(const PG8_LAS bf16x8*)(lds + PG8_SA(b, h) + aoff + m * 2048 + k * 1024); } while (0)
#define PG8_LDB(dst, b, h) do { _Pragma("unroll") for (int n = 0; n < 2; ++n) _Pragma("unroll") for (int k = 0; k < 2; ++k) dst[n][k] = *(const PG8_LAS bf16x8*)(lds + PG8_SB(b, h) + boff + n * 2048 + k * 1024); } while (0)
#define PG8_MMA(ai, bj, At, Bt) do { __builtin_amdgcn_s_setprio(1); _Pragma("unroll") for (int m = 0; m < 4; ++m) _Pragma("unroll") for (int n = 0; n < 2; ++n) _Pragma("unroll") for (int k = 0; k < 2; ++k) \
        acc[ai][bj][m][n] = __builtin_amdgcn_mfma_f32_16x16x32_bf16(Bt[n][k], At[m][k], acc[ai][bj][m][n], 0, 0, 0); __builtin_amdgcn_s_setprio(0); } while (0)
#define PG8_WAIT_V(n) asm volatile("s_waitcnt vmcnt(" #n ")" ::: "memory")
#define PG8_WAIT_L(n) asm volatile("s_waitcnt lgkmcnt(" #n ")" ::: "memory")
#define PG8_BAR __builtin_amdgcn_s_barrier()
#define PG8_SCHED __builtin_amdgcn_sched_barrier(0)
    Unit cur, nxt; int ui = 0;
    if (!S.next(0, cur)) return;
    f32x4 acc[2][2][4][2];
#pragma unroll
    for (int a = 0; a < 2; ++a)
#pragma unroll
        for (int b = 0; b < 2; ++b)
#pragma unroll
            for (int m = 0; m < 4; ++m)
#pragma unroll
                for (int n = 0; n < 2; ++n) acc[a][b][m][n] = (f32x4){0.f, 0.f, 0.f, 0.f};
    bf16x8 At[4][2], B0[2][2], B1[2][2];
    const char* cA = (const char*)g.A + (size_t)cur.pm * tstep; const char* cB = (const char*)g.Bt + (size_t)cur.pn * tstep;
    S.a_ready(cur);
    if constexpr (SP2) {
        PG8_STAGE(PG8_SB(0, 0), cB, voffB); PG8_STAGE(PG8_SB(0, 1), cB + hstep, voffB); PG8_STAGE(PG8_SA(0, 0), cA, voffA); PG8_STAGE(PG8_SA(0, 1), cA + hstep, voffA);
        if (wr == 1) PG8_BAR;
        PG8_WAIT_V(2); PG8_BAR;
        PG8_STAGE(PG8_SB(1, 0), cB + kstep, voffB); PG8_STAGE(PG8_SA(1, 0), cA + kstep, voffA); PG8_STAGE(PG8_SB(1, 1), cB + hstep + kstep, voffB);
        PG8_WAIT_V(6); PG8_BAR;
    } else {
        PG8_STAGE(PG8_SB(0, 0), cB, voffB); PG8_STAGE(PG8_SA(0, 0), cA, voffA); PG8_STAGE(PG8_SB(0, 1), cB + hstep, voffB); PG8_STAGE(PG8_SA(0, 1), cA + hstep, voffA);
        if (wr == 1) PG8_BAR;
        PG8_WAIT_V(4); PG8_BAR;
        PG8_STAGE(PG8_SB(1, 0), cB + kstep, voffB); PG8_STAGE(PG8_SA(1, 0), cA + kstep, voffA); PG8_STAGE(PG8_SB(1, 1), cB + hstep + kstep, voffB);
        PG8_WAIT_V(6); PG8_BAR;
    }
    for (;;) {
        const bool has_next = S.next(ui + 1, nxt);
        const char* nA = has_next ? (const char*)g.A + (size_t)nxt.pm * tstep : cA; const char* nB = has_next ? (const char*)g.Bt + (size_t)nxt.pn * tstep : cB;
        for (int t = 0; t < nt; t += 2) {
            if constexpr (Epi::KSPLIT) { if (t == nt / 2) E.mid(acc, cur, wr, fr); }
            const bool last = (t == nt - 2);
            const char* a1 = cA + (size_t)(t + 1) * kstep;
            const char* a2 = last ? nA : cA + (size_t)(t + 2) * kstep; const char* b2 = last ? nB : cB + (size_t)(t + 2) * kstep;
            const char* a3 = a2 + kstep; const char* b3 = b2 + kstep;
            if (last && has_next) S.a_ready(nxt);
            if constexpr (SP2) {
            PG8_LDB(B0, 0, 0); PG8_LDB(B1, 0, 1); PG8_SCHED; PG8_LDA(At, 0, 0); PG8_STAGE(PG8_SA(1, 1), a1 + hstep, voffA);
            PG8_WAIT_V(8); PG8_WAIT_L(0); PG8_BAR; PG8_MMA(0, 0, At, B0); PG8_MMA(0, 1, At, B1); PG8_BAR; PG8_SCHED;
            PG8_LDA(At, 0, 1); PG8_STAGE(PG8_SB(0, 0), b2, voffB); PG8_STAGE(PG8_SB(0, 1), b2 + hstep, voffB); PG8_STAGE(PG8_SA(0, 0), a2, voffA);
            PG8_WAIT_V(8); PG8_WAIT_L(0); PG8_BAR; PG8_MMA(1, 0, At, B0); PG8_MMA(1, 1, At, B1); PG8_BAR; PG8_SCHED;
            PG8_LDB(B0, 1, 0); PG8_LDB(B1, 1, 1); PG8_SCHED; PG8_LDA(At, 1, 0); PG8_STAGE(PG8_SA(0, 1), a2 + hstep, voffA);
            PG8_WAIT_V(8); PG8_WAIT_L(0); PG8_BAR; PG8_MMA(0, 0, At, B0); PG8_MMA(0, 1, At, B1); PG8_BAR; PG8_SCHED;
            PG8_LDA(At, 1, 1); PG8_STAGE(PG8_SB(1, 0), b3, voffB); PG8_STAGE(PG8_SB(1, 1), b3 + hstep, voffB); PG8_STAGE(PG8_SA(1, 0), a3, voffA);
            PG8_WAIT_V(8); PG8_WAIT_L(0); PG8_BAR; PG8_MMA(1, 0, At, B0); PG8_MMA(1, 1, At, B1); PG8_BAR; PG8_SCHED;
            } else {
            PG8_LDB(B0, 0, 0); PG8_SCHED; PG8_LDA(At, 0, 0); PG8_STAGE(PG8_SA(1, 1), a1 + hstep, voffA);
            PG8_WAIT_L(8); PG8_BAR; PG8_WAIT_L(0); PG8_MMA(0, 0, At, B0); PG8_BAR; PG8_SCHED;
            PG8_LDB(B1, 0, 1); PG8_STAGE(PG8_SB(0, 0), b2, voffB);
            PG8_BAR; PG8_WAIT_L(0); PG8_MMA(0, 1, At, B1); PG8_BAR;
            PG8_LDA(At, 0, 1); PG8_STAGE(PG8_SA(0, 0), a2, voffA);
            PG8_BAR; PG8_WAIT_L(0); PG8_MMA(1, 0, At, B0); PG8_BAR; PG8_SCHED;
            PG8_STAGE(PG8_SB(0, 1), b2 + hstep, voffB);
            PG8_WAIT_V(6); PG8_BAR; PG8_MMA(1, 1, At, B1); PG8_BAR;
            PG8_LDB(B0, 1, 0); PG8_SCHED; PG8_LDA(At, 1, 0); PG8_STAGE(PG8_SA(0, 1), a2 + hstep, voffA);
            PG8_WAIT_L(8); PG8_BAR; PG8_WAIT_L(0); PG8_MMA(0, 0, At, B0); PG8_BAR; PG8_SCHED;
            PG8_LDB(B1, 1, 1); PG8_STAGE(PG8_SB(1, 0), b3, voffB);
            PG8_BAR; PG8_WAIT_L(0); PG8_MMA(0, 1, At, B1); PG8_BAR;
            PG8_LDA(At, 1, 1); PG8_STAGE(PG8_SA(1, 0), a3, voffA);
            PG8_BAR; PG8_WAIT_L(0); PG8_MMA(1, 0, At, B0); PG8_BAR; PG8_SCHED;
            PG8_STAGE(PG8_SB(1, 1), b3 + hstep, voffB);
            PG8_WAIT_V(6); PG8_BAR; PG8_MMA(1, 1, At, B1); PG8_BAR;
            }
        }
        if constexpr (ALIGN_EPI) { if (wr == 0) PG8_BAR; }
        if constexpr (!Epi::AFTER_DRAIN) { E(acc, cur, wr, wc, fr, fq); S.done(cur); }
        if (!has_next) break;
#pragma unroll
        for (int a = 0; a < 2; ++a)
#pragma unroll
            for (int b = 0; b < 2; ++b)
#pragma unroll
                for (int m = 0; m < 4; ++m)
#pragma unroll
                    for (int n = 0; n < 2; ++n) acc[a][b][m][n] = (f32x4){0.f, 0.f, 0.f, 0.f};
        cur = nxt; cA = nA; cB = nB; ++ui;
        if constexpr (ALIGN_EPI) { if (wr == 1) PG8_BAR; }
    }
    PG8_WAIT_V(0);
    if constexpr (!ALIGN_EPI) { if (wr == 0) PG8_BAR; }
    PG8_BAR;
    if constexpr (Epi::AFTER_DRAIN) { E.fused(acc, cur, wr, wc, fr, fq, lds, wid, lane); S.done(cur); }
#undef PG8_SA
#undef PG8_SB
#undef PG8_STAGE
#undef PG8_LDA
#undef PG8_LDB
#undef PG8_MMA
#undef PG8_WAIT_V
#undef PG8_WAIT_L
#undef PG8_BAR
#undef PG8_SCHED
}
}


constexpr int NWAVES = 8;
constexpr int RING_OFF = 0, RING_BYTES = 131072;
constexpr int LDSX_OFF = RING_BYTES;
constexpr int MISC_OFF = RING_BYTES + 8192;
constexpr int LDS_BYTES = 147456;
static_assert(MISC_OFF + 128 <= LDS_BYTES, "LDS map");
constexpr int CW_BAR = 1024;
constexpr int CW_FLAG = 16384;

#define GAS __attribute__((address_space(1)))
#define LAS __attribute__((address_space(3)))
typedef unsigned v4u __attribute__((ext_vector_type(4)));
typedef float f32x4 __attribute__((ext_vector_type(4)));
typedef unsigned u32x2 __attribute__((ext_vector_type(2)));
typedef GAS unsigned gu32;
#define LDS_WAIT() asm volatile("s_waitcnt lgkmcnt(0)" ::: "memory")
#define VM_WAIT() asm volatile("s_waitcnt vmcnt(0)" ::: "memory")
__device__ __forceinline__ unsigned pk2(float lo, float hi) { return f2bf(lo) | (f2bf(hi) << 16); }

#define XB_TMO      128
#define XB_XCNT(j)  (256  + 64 * (j))
#define XB_XSUB(j)  (1280 + 64 * (j))
#define XB_XGEN(j)  (2304 + 64 * (j))
#define XB_TOP      3328
#define XB_TOPGEN   3392
#define XCD_BAR_WORDS 3456
#define XB_SPIN_CAP (1u << 18)

__device__ __forceinline__ unsigned xb_ld(unsigned* p)              { return __hip_atomic_load(p, __ATOMIC_RELAXED, __HIP_MEMORY_SCOPE_AGENT); }
__device__ __forceinline__ unsigned xb_add(unsigned* p, unsigned v) { return __hip_atomic_fetch_add(p, v, __ATOMIC_RELAXED, __HIP_MEMORY_SCOPE_AGENT); }
__device__ __forceinline__ unsigned xb_xcc_id() { return (unsigned)__builtin_amdgcn_s_getreg((3 << 11) | 20) & 0xFu; }
#define XB_SPIN(cond, bar) do { unsigned _sp = 0; while (cond) { __builtin_amdgcn_s_sleep(1); \
    if ((++_sp & 255u) == 0u) { if (xb_ld(&(bar)[XB_TMO])) break; if (_sp > XB_SPIN_CAP) { atomicAdd(&(bar)[XB_TMO], 1u); break; } } } } while (0)

struct XcdBarrier {
    unsigned* bar; unsigned x;
    volatile LAS unsigned* st;
};

__device__ __forceinline__ XcdBarrier xcd_barrier_post(unsigned* bar, volatile LAS unsigned* st) {
    XcdBarrier b; b.bar = bar; b.x = xb_xcc_id(); b.st = st;
    if (threadIdx.x == 0) (void)xb_add(&bar[XB_XCNT(b.x)], 1u);
    return b;
}
__device__ __forceinline__ void xcd_barrier_complete(unsigned* bar, unsigned x, unsigned& nloc, unsigned& nx) {
    const unsigned G = gridDim.x * gridDim.y * gridDim.z;
    unsigned sum, cnt, mine, sp = 0u;
    for (;;) {
        sum = 0u; cnt = 0u; mine = 0u;
#pragma unroll
        for (unsigned j = 0; j < 16; ++j) { const unsigned c = xb_ld(&bar[XB_XCNT(j)]); sum += c; cnt += (c > 0u) ? 1u : 0u; mine = (j == x) ? c : mine; }
        if (sum == G) break;
        __builtin_amdgcn_s_sleep(1);
        if ((++sp & 255u) == 0u) { if (xb_ld(&bar[XB_TMO])) break; if (sp > XB_SPIN_CAP) { atomicAdd(&bar[XB_TMO], 1u); break; } }
    }
    nloc = mine > 0u ? mine : 1u; nx = cnt > 0u ? cnt : 1u;
}

__device__ __forceinline__ void xcd_barrier(const XcdBarrier& b) {
    asm volatile("s_waitcnt vmcnt(0)" ::: "memory");
    __syncthreads();
    if (threadIdx.x == 0) {
        unsigned* bar = b.bar;
        __builtin_amdgcn_s_waitcnt(0);
        unsigned nloc = b.st[0], nx = b.st[1];
        if (nloc == 0u) { xcd_barrier_complete(bar, b.x, nloc, nx); b.st[0] = nloc; b.st[1] = nx; }
        const unsigned old = xb_add(&bar[XB_XSUB(b.x)], 1u);
        const unsigned gen = old / nloc;
        if (old + 1u == (gen + 1u) * nloc) {
            __builtin_amdgcn_fence(__ATOMIC_RELEASE, "agent");
            asm volatile("s_waitcnt vmcnt(0)" ::: "memory");
            const unsigned og = xb_add(&bar[XB_TOP], 1u);
            const unsigned tg = og / nx;
            if (og + 1u == (tg + 1u) * nx) xb_add(&bar[XB_TOPGEN], 1u);
            else XB_SPIN(xb_ld(&bar[XB_TOPGEN]) == tg, bar);
            __builtin_amdgcn_fence(__ATOMIC_ACQUIRE, "agent");
            xb_add(&bar[XB_XGEN(b.x)], 1u);
            asm volatile("s_waitcnt vmcnt(0)" ::: "memory");
        } else {
            XB_SPIN(xb_ld(&bar[XB_XGEN(b.x)]) == gen, bar);
            __builtin_amdgcn_fence(__ATOMIC_ACQUIRE, "agent");
            asm volatile("s_waitcnt vmcnt(0)" ::: "memory");
        }
    }
    __syncthreads();
}


namespace att {
typedef short bf16x8 __attribute__((ext_vector_type(8)));
typedef short s16x4 __attribute__((ext_vector_type(4)));
typedef float f32x16 __attribute__((ext_vector_type(16)));
typedef unsigned u32x4 __attribute__((ext_vector_type(4)));
typedef unsigned u32x2 __attribute__((ext_vector_type(2)));
constexpr float LOG2E = 1.4426950408889634f;
#define LBAR() do { asm volatile("s_waitcnt lgkmcnt(0)" ::: "memory"); __builtin_amdgcn_s_barrier(); asm volatile("" ::: "memory"); } while (0)
__device__ __forceinline__ int kappa(int r) { return (r & ~12) | ((r & 4) << 1) | ((r & 8) >> 1); }
__device__ __forceinline__ f32x16 mfma32(bf16x8 a, bf16x8 b, f32x16 c) { return __builtin_amdgcn_mfma_f32_32x32x16_bf16(a, b, c, 0, 0, 0); }
__device__ __forceinline__ s16x4 vtr(const LAS unsigned char* p) { return __builtin_bit_cast(s16x4, __builtin_amdgcn_ds_read_tr16_b64_v4i16((LAS s16x4*)p)); }
__device__ __forceinline__ bf16x8 cat8(s16x4 a, s16x4 b) { return (bf16x8){a[0], a[1], a[2], a[3], b[0], b[1], b[2], b[3]}; }
typedef float f32x2_t __attribute__((ext_vector_type(2))); typedef __bf16 bf16x2_t __attribute__((ext_vector_type(2)));
__device__ __forceinline__ unsigned cvtpk(float lo, float hi) { const f32x2_t v = {lo, hi}; return __builtin_bit_cast(unsigned, __builtin_convertvector(v, bf16x2_t)); }
__device__ __forceinline__ float xhalf_max(float v) { return fmaxf(v, __shfl_xor(v, 32)); }
__device__ __forceinline__ float xhalf_sum(float v) { return v + __shfl_xor(v, 32); }
__device__ __forceinline__ bf16x8 packp(const f32x16& p, int s) {
    u32x4 w; w.x = cvtpk(p[8 * s + 0], p[8 * s + 1]); w.y = cvtpk(p[8 * s + 2], p[8 * s + 3]); w.z = cvtpk(p[8 * s + 4], p[8 * s + 5]); w.w = cvtpk(p[8 * s + 6], p[8 * s + 7]);
    return __builtin_bit_cast(bf16x8, w);
}
__device__ __forceinline__ int tr_off(int lane, int VP) { const int hi = lane >> 5, blk = (lane >> 4) & 1, q4 = (lane & 15) >> 2, p4 = lane & 3; return (8 * hi + q4) * VP + (16 * blk + 4 * p4) * 2; }


#define TR_RD(DST, ADDR, OFF) asm volatile("ds_read_b64_tr_b16 %0, %1 offset:%2" : "=v"(DST) : "v"(ADDR), "i"(OFF))
#define TR_WAIT(N, A, B) asm volatile("s_waitcnt lgkmcnt(" #N ")" : "+v"(A), "+v"(B))
#define PV_CHAIN2(ACC, ADDR, VP, F0, F1) do { s16x4 l0, h0, l1, h1; const unsigned ad_ = (ADDR); \
    TR_RD(l0, ad_, 0 * (VP)); TR_RD(h0, ad_, 4 * (VP)); TR_RD(l1, ad_, 16 * (VP)); TR_RD(h1, ad_, 20 * (VP)); \
    TR_WAIT(2, l0, h0); ACC = mfma32(cat8(l0, h0), F0, ACC); TR_WAIT(0, l1, h1); ACC = mfma32(cat8(l1, h1), F1, ACC); } while (0)
#define PV_CHAIN8(ACC, ADDR, VP, F0, F1, F2, F3, F4, F5, F6, F7) do { s16x4 l0, h0, l1, h1, l2, h2, l3, h3, l4, h4, l5, h5, l6, h6, l7, h7; const unsigned ad_ = (ADDR); \
    TR_RD(l0, ad_, 0 * (VP)); TR_RD(h0, ad_, 4 * (VP)); TR_RD(l1, ad_, 16 * (VP)); TR_RD(h1, ad_, 20 * (VP)); TR_RD(l2, ad_, 32 * (VP)); TR_RD(h2, ad_, 36 * (VP)); TR_RD(l3, ad_, 48 * (VP)); TR_RD(h3, ad_, 52 * (VP)); \
    TR_RD(l4, ad_, 64 * (VP)); TR_RD(h4, ad_, 68 * (VP)); TR_RD(l5, ad_, 80 * (VP)); TR_RD(h5, ad_, 84 * (VP)); TR_RD(l6, ad_, 96 * (VP)); TR_RD(h6, ad_, 100 * (VP)); TR_RD(l7, ad_, 112 * (VP)); TR_RD(h7, ad_, 116 * (VP)); \
    TR_WAIT(14, l0, h0); ACC = mfma32(cat8(l0, h0), F0, ACC); TR_WAIT(12, l1, h1); ACC = mfma32(cat8(l1, h1), F1, ACC); TR_WAIT(10, l2, h2); ACC = mfma32(cat8(l2, h2), F2, ACC); TR_WAIT(8, l3, h3); ACC = mfma32(cat8(l3, h3), F3, ACC); \
    TR_WAIT(6, l4, h4); ACC = mfma32(cat8(l4, h4), F4, ACC); TR_WAIT(4, l5, h5); ACC = mfma32(cat8(l5, h5), F5, ACC); TR_WAIT(2, l6, h6); ACC = mfma32(cat8(l6, h6), F6, ACC); TR_WAIT(0, l7, h7); ACC = mfma32(cat8(l7, h7), F7, ACC); } while (0)

constexpr int MB_KP = 144, MB_VP = 192, MB_TN = 2256, MB_TK = 128;
constexpr int MB_K = 0, MB_V = 2 * MB_TK * MB_KP, MB_LUT = MB_V + 2 * MB_TK * MB_VP, MB_KM = MB_LUT + 4 * MB_TN * 4, MB_END = MB_KM + 2048;
__device__ __forceinline__ f32x16 ld_c16(const LAS unsigned char* p) {
    const f32x4 a = *(const LAS f32x4*)p, b = *(const LAS f32x4*)(p + 16), c = *(const LAS f32x4*)(p + 64), d = *(const LAS f32x4*)(p + 80);
    return (f32x16){a[0], a[1], a[2], a[3], b[0], b[1], b[2], b[3], c[0], c[1], c[2], c[3], d[0], d[1], d[2], d[3]};
}
__device__ __forceinline__ float max16(const f32x16& p) { return fmaxf(fmaxf(fmaxf(fmaxf(p[0], p[1]), fmaxf(p[2], p[3])), fmaxf(fmaxf(p[4], p[5]), fmaxf(p[6], p[7]))), fmaxf(fmaxf(fmaxf(p[8], p[9]), fmaxf(p[10], p[11])), fmaxf(fmaxf(p[12], p[13]), fmaxf(p[14], p[15])))); }
__device__ __forceinline__ void moba_phase(LAS unsigned char* lds, const bf16* QKV, const float* KMP, const float* LUT, bf16* Y, float* SSB, int vcu, int G, int variant) {
    const int tid = threadIdx.x, lane = tid & 63, r32 = lane & 31, hi = lane >> 5; const int w = __builtin_amdgcn_readfirstlane(tid >> 6);
    LAS float* tab = (LAS float*)(lds + MB_LUT); LAS float* km = (LAS float*)(lds + MB_KM);
    const int troff = tr_off(lane, MB_VP);
    int htab = -1;
    for (int tau = vcu; tau < BATCH * 8 * 4; tau += G) { const int bh = tau >> 2, pr = tau & 3, b = bh >> 3, h = bh & 7;
        __syncthreads();
        if (h != htab) { htab = h; float tv[18];
#pragma unroll
            for (int j = 0; j < 18; ++j) { const int i = tid + 512 * j, sft = i / MB_TN, ii = i - sft * MB_TN, idx = 2047 - ii - sft; tv[j] = (i < 4 * MB_TN && idx >= 0) ? LUT[(8 + h) * 2048 + idx] * LOG2E : -INFINITY; }
#pragma unroll
            for (int j = 0; j < 18; ++j) { const int i = tid + 512 * j; if (i < 4 * MB_TN) tab[i] = tv[j]; } }
        { const int j = tid >> 6, d = tid & 63; km[tid] = (KMP[(size_t)((8 * b + j) * 2 + 0) * 512 + 64 * h + d] + KMP[(size_t)((8 * b + j) * 2 + 1) * 512 + 64 * h + d]) * (1.f / 256.f); }
        __syncthreads();
        const bf16* Qb = QKV + (size_t)b * SEQ * NQKV + 1536 + 64 * h; const bf16* Kb = QKV + (size_t)b * SEQ * NQKV + 2048 + 64 * h; const bf16* Vb = Kb + 512;
        for (int s2 = 0; s2 < 2; ++s2) { const int qb = s2 == 0 ? 7 - pr : pr;
            const int tq = 256 * qb + 32 * w + r32;
            bf16x8 qf[4];
#pragma unroll
            for (int d0 = 0; d0 < 4; ++d0) qf[d0] = *(const bf16x8*)(Qb + (size_t)tq * NQKV + 16 * d0 + 8 * hi);
            unsigned sel = 0;
            { float g[8];
#pragma unroll
              for (int j = 0; j < 8; ++j) g[j] = 0.f;
#pragma unroll
              for (int d0 = 0; d0 < 4; ++d0) { float qv[8];
#pragma unroll
                  for (int e = 0; e < 8; ++e) qv[e] = __builtin_bit_cast(float, (unsigned)(unsigned short)qf[d0][e] << 16);
#pragma unroll
                  for (int j = 0; j < 7; ++j) { const LAS float* kp = km + j * 64 + 16 * d0 + 8 * hi; const f32x4 k0 = *(const LAS f32x4*)kp, k1 = *(const LAS f32x4*)(kp + 4);
                      g[j] += qv[0] * k0[0] + qv[1] * k0[1] + qv[2] * k0[2] + qv[3] * k0[3] + qv[4] * k1[0] + qv[5] * k1[1] + qv[6] * k1[2] + qv[7] * k1[3]; } }
#pragma unroll
              for (int j = 0; j < 7; ++j) g[j] += __shfl_xor(g[j], 32);
              const int nsel = qb < 3 ? qb : 3;
              for (int n = 0; n < nsel; ++n) { float best = -3e38f; int bi = 0;
#pragma unroll
                  for (int j = 0; j < 7; ++j) if (j < qb && !((sel >> j) & 1u) && g[j] > best) { best = g[j]; bi = j; }
                  sel |= 1u << bi; }
              sel |= 1u << qb; }
            float l_run = 0.f; f32x16 o0 = {}, o1 = {};
            const int NT = 2 * (qb + 1);
            const int a0 = 2047 - tq + 8 * hi;
            const LAS unsigned char* cp = (const LAS unsigned char*)tab + (a0 & 3) * (MB_TN * 4) + (a0 & ~3) * 4;
            const int skey = tid >> 3, sch = tid & 7;
            const size_t srow = (size_t)skey * NQKV + 8 * sch;
#define MB_GLD(T_) do { if ((T_) < NT) { const size_t ro_ = srow + (size_t)(T_) * MB_TK * NQKV; k0r = *(const u32x4*)(Kb + ro_); k1r = *(const u32x4*)(Kb + ro_ + (size_t)64 * NQKV); v0r = *(const u32x4*)(Vb + ro_); v1r = *(const u32x4*)(Vb + ro_ + (size_t)64 * NQKV); } } while (0)
#define MB_ST(T_) do { if ((T_) < NT) { LAS unsigned char* kd_ = lds + MB_K + ((T_) & 1) * (MB_TK * MB_KP) + skey * MB_KP + sch * 16; LAS unsigned char* vd_ = lds + MB_V + ((T_) & 1) * (MB_TK * MB_VP) + skey * MB_VP + sch * 16; \
                    *(LAS u32x4*)kd_ = k0r; *(LAS u32x4*)(kd_ + 64 * MB_KP) = k1r; *(LAS u32x4*)vd_ = v0r; *(LAS u32x4*)(vd_ + 64 * MB_VP) = v1r; } } while (0)
#define MB_ACT(T_) (((T_) >> 1) < qb ? (__ballot((sel >> ((T_) >> 1)) & 1u) != 0ull) : ((MB_TK * (T_) - 256 * qb) <= 32 * w + 31))
            u32x4 k0r = {}, k1r = {}, v0r = {}, v1r = {};
            MB_GLD(0); MB_ST(0); MB_GLD(1);
            LBAR();
            for (int T = 0; T < NT; ++T) {
                if (MB_ACT(T)) {
                    const LAS unsigned char* Kt = lds + MB_K + (T & 1) * (MB_TK * MB_KP) + kappa(r32) * MB_KP + hi * 16; const LAS unsigned char* Vt = lds + MB_V + (T & 1) * (MB_TK * MB_VP) + troff;
                    const bool selb = (sel >> (T >> 1)) & 1u;
                    const LAS unsigned char* ct = selb ? cp + 512 * T : (const LAS unsigned char*)tab + 2048 * 4;
                    f32x16 p0 = ld_c16(ct), p1 = ld_c16(ct + 128), p2 = ld_c16(ct + 256), p3 = ld_c16(ct + 384);
                    if (!(variant & 4)) {
#pragma unroll
                        for (int d0 = 0; d0 < 4; ++d0) { const bf16x8 ka = *(const LAS bf16x8*)(Kt + d0 * 32), kb = *(const LAS bf16x8*)(Kt + 32 * MB_KP + d0 * 32), kc = *(const LAS bf16x8*)(Kt + 64 * MB_KP + d0 * 32), kd = *(const LAS bf16x8*)(Kt + 96 * MB_KP + d0 * 32);
                            p0 = mfma32(ka, qf[d0], p0); p1 = mfma32(kb, qf[d0], p1); p2 = mfma32(kc, qf[d0], p2); p3 = mfma32(kd, qf[d0], p3); } }
                    float ls0 = 0.f, ls1 = 0.f;
                    if (!(variant & 1)) {
#pragma unroll
                        for (int r = 0; r < 16; ++r) { p0[r] = __builtin_amdgcn_exp2f(p0[r]); p1[r] = __builtin_amdgcn_exp2f(p1[r]); p2[r] = __builtin_amdgcn_exp2f(p2[r]); p3[r] = __builtin_amdgcn_exp2f(p3[r]); ls0 += p0[r] + p1[r]; ls1 += p2[r] + p3[r]; } }
                    l_run += ls0 + ls1;
                    if (!(variant & 2)) {
                        const bf16x8 f0 = packp(p0, 0), f1 = packp(p0, 1), f2 = packp(p1, 0), f3 = packp(p1, 1), f4 = packp(p2, 0), f5 = packp(p2, 1), f6 = packp(p3, 0), f7 = packp(p3, 1);
                        const unsigned va = (unsigned)(size_t)Vt;
                        PV_CHAIN8(o0, va, MB_VP, f0, f1, f2, f3, f4, f5, f6, f7);
                        PV_CHAIN8(o1, va + 64u, MB_VP, f0, f1, f2, f3, f4, f5, f6, f7); }
                }
                MB_ST(T + 1);
                if (!(variant & 16)) LBAR();
                if (!(variant & 8)) MB_GLD(T + 2);
            }
#undef MB_GLD
#undef MB_ST
#undef MB_ACT
            const float inv = 1.f / xhalf_sum(l_run);
            bf16* yp = Y + ((size_t)b * SEQ + tq) * DM + 512 + 64 * h + 4 * hi; float sq = 0.f;
#pragma unroll
            for (int g4 = 0; g4 < 4; ++g4) { u32x2 a, c2; a.x = cvtpk(o0[4 * g4] * inv, o0[4 * g4 + 1] * inv); a.y = cvtpk(o0[4 * g4 + 2] * inv, o0[4 * g4 + 3] * inv);
                c2.x = cvtpk(o1[4 * g4] * inv, o1[4 * g4 + 1] * inv); c2.y = cvtpk(o1[4 * g4 + 2] * inv, o1[4 * g4 + 3] * inv);
                *(u32x2*)(yp + 8 * g4) = a; *(u32x2*)(yp + 32 + 8 * g4) = c2;
                sq += bflo(a.x) * bflo(a.x) + bfhi(a.x) * bfhi(a.x) + bflo(a.y) * bflo(a.y) + bfhi(a.y) * bfhi(a.y) + bflo(c2.x) * bflo(c2.x) + bfhi(c2.x) * bfhi(c2.x) + bflo(c2.y) * bflo(c2.y) + bfhi(c2.y) * bfhi(c2.y); }
            sq = xhalf_sum(sq); if (hi == 0 && SSB) atomicAdd(SSB + (size_t)b * SEQ + tq, sq);
        }
    }
}

constexpr int M2_TK = 64, M2_K = 0, M2_V = 2 * M2_TK * MB_KP, M2_LUT = M2_V + 2 * M2_TK * MB_VP, M2_KM = M2_LUT + 4 * MB_TN * 4, M2_END = M2_KM + 2048;
static_assert(M2_END <= 139264, "MoBA LDS map");
__device__ __forceinline__ unsigned mb_select(const bf16x8 (&qf)[4], const LAS float* km, int qb, int hi) {
    unsigned sel = 0; float g[8];
#pragma unroll
    for (int j = 0; j < 8; ++j) g[j] = 0.f;
#pragma unroll
    for (int d0 = 0; d0 < 4; ++d0) { float qv[8];
#pragma unroll
        for (int e = 0; e < 8; ++e) qv[e] = __builtin_bit_cast(float, (unsigned)(unsigned short)qf[d0][e] << 16);
#pragma unroll
        for (int j = 0; j < 7; ++j) { const LAS float* kp = km + j * 64 + 16 * d0 + 8 * hi; const f32x4 k0 = *(const LAS f32x4*)kp, k1 = *(const LAS f32x4*)(kp + 4);
            g[j] += qv[0] * k0[0] + qv[1] * k0[1] + qv[2] * k0[2] + qv[3] * k0[3] + qv[4] * k1[0] + qv[5] * k1[1] + qv[6] * k1[2] + qv[7] * k1[3]; } }
#pragma unroll
    for (int j = 0; j < 7; ++j) g[j] += __shfl_xor(g[j], 32);
    const int nsel = qb < 3 ? qb : 3;
    for (int n = 0; n < nsel; ++n) { float best = -3e38f; int bi = 0;
#pragma unroll
        for (int j = 0; j < 7; ++j) if (j < qb && !((sel >> j) & 1u) && g[j] > best) { best = g[j]; bi = j; }
        sel |= 1u << bi; }
    return sel | (1u << qb);
}
template <bool DA, bool DB>
__device__ __forceinline__ void mb_step2(const LAS unsigned char* Kt, unsigned va, const LAS unsigned char* ctA, const LAS unsigned char* ctB, const bf16x8 (&qa)[4], const bf16x8 (&qb)[4],
                                         f32x16& oa0, f32x16& oa1, float& la, f32x16& ob0, f32x16& ob1, float& lb) {
    f32x16 a0 = {}, a1 = {}, b0 = {}, b1 = {};
    if (DA) { a0 = ld_c16(ctA); a1 = ld_c16(ctA + 128); }
    if (DB) { b0 = ld_c16(ctB); b1 = ld_c16(ctB + 128); }
#pragma unroll
    for (int d0 = 0; d0 < 4; ++d0) { const bf16x8 k0 = *(const LAS bf16x8*)(Kt + d0 * 32), k1 = *(const LAS bf16x8*)(Kt + 32 * MB_KP + d0 * 32);
        if (DA) { a0 = mfma32(k0, qa[d0], a0); a1 = mfma32(k1, qa[d0], a1); }
        if (DB) { b0 = mfma32(k0, qb[d0], b0); b1 = mfma32(k1, qb[d0], b1); } }
    float sa = 0.f, sb = 0.f;
#pragma unroll
    for (int r = 0; r < 16; ++r) {
        if (DA) { a0[r] = __builtin_amdgcn_exp2f(a0[r]); a1[r] = __builtin_amdgcn_exp2f(a1[r]); sa += a0[r] + a1[r]; }
        if (DB) { b0[r] = __builtin_amdgcn_exp2f(b0[r]); b1[r] = __builtin_amdgcn_exp2f(b1[r]); sb += b0[r] + b1[r]; } }
    la += sa; lb += sb;
    const bf16x8 fa0 = packp(a0, 0), fa1 = packp(a0, 1), fa2 = packp(a1, 0), fa3 = packp(a1, 1), fb0 = packp(b0, 0), fb1 = packp(b0, 1), fb2 = packp(b1, 0), fb3 = packp(b1, 1);
#pragma unroll
    for (int c = 0; c < 2; ++c) { const unsigned ad = va + 64u * c; s16x4 l0, h0, l1, h1, l2, h2, l3, h3;
        TR_RD(l0, ad, 0 * MB_VP); TR_RD(h0, ad, 4 * MB_VP); TR_RD(l1, ad, 16 * MB_VP); TR_RD(h1, ad, 20 * MB_VP); TR_RD(l2, ad, 32 * MB_VP); TR_RD(h2, ad, 36 * MB_VP); TR_RD(l3, ad, 48 * MB_VP); TR_RD(h3, ad, 52 * MB_VP);
        f32x16& xa = c ? oa1 : oa0; f32x16& xb = c ? ob1 : ob0;
        TR_WAIT(6, l0, h0); { const bf16x8 v = cat8(l0, h0); if (DA) xa = mfma32(v, fa0, xa); if (DB) xb = mfma32(v, fb0, xb); }
        TR_WAIT(4, l1, h1); { const bf16x8 v = cat8(l1, h1); if (DA) xa = mfma32(v, fa1, xa); if (DB) xb = mfma32(v, fb1, xb); }
        TR_WAIT(2, l2, h2); { const bf16x8 v = cat8(l2, h2); if (DA) xa = mfma32(v, fa2, xa); if (DB) xb = mfma32(v, fb2, xb); }
        TR_WAIT(0, l3, h3); { const bf16x8 v = cat8(l3, h3); if (DA) xa = mfma32(v, fa3, xa); if (DB) xb = mfma32(v, fb3, xb); } }
}
__device__ __forceinline__ void moba_phase2(LAS unsigned char* lds, const bf16* QKV, const float* KMP, const float* LUT, bf16* Y, float* SSB, int vcu, int G) {
    const int tid_ = threadIdx.x, tid = tid_, lane = tid & 63, r32_ = lane & 31, hi_ = lane >> 5; const int w = __builtin_amdgcn_readfirstlane(tid >> 6);
    LAS float* tab = (LAS float*)(lds + M2_LUT); LAS float* km = (LAS float*)(lds + M2_KM);
    int htab = -1;
    for (int tau = vcu; tau < BATCH * 8 * 2; tau += G) { const int bh = tau >> 1, half = tau & 1, b = bh >> 3, h = bh & 7;
        __syncthreads();
        int tt = tid_; asm volatile("" : "+v"(tt));
        if (h != htab) { htab = h; float tv[18];
#pragma unroll
            for (int j = 0; j < 18; ++j) { const int i = tt + 512 * j, sft = i / MB_TN, ii = i - sft * MB_TN, idx = 2047 - ii - sft; tv[j] = (i < 4 * MB_TN && idx >= 0) ? LUT[(8 + h) * 2048 + idx] * LOG2E : -INFINITY; }
#pragma unroll
            for (int j = 0; j < 18; ++j) { const int i = tt + 512 * j; if (i < 4 * MB_TN) tab[i] = tv[j]; } }
        { const int j = tt >> 6, d = tt & 63; km[tt] = (KMP[(size_t)((8 * b + j) * 2 + 0) * 512 + 64 * h + d] + KMP[(size_t)((8 * b + j) * 2 + 1) * 512 + 64 * h + d]) * (1.f / 256.f); }
        __syncthreads();
        const bf16* Qb = QKV + (size_t)b * SEQ * NQKV + 1536 + 64 * h; const bf16* Kb = QKV + (size_t)b * SEQ * NQKV + 2048 + 64 * h; const bf16* Vb = Kb + 512;
        for (int s2 = 0; s2 < 2; ++s2) { const int jp = half == 0 ? (s2 == 0 ? 3 : 0) : (s2 == 0 ? 2 : 1); const int qA = 2 * jp, qB = qA + 1;
            int r32 = r32_, hi = hi_, tid = tid_; asm volatile("" : "+v"(r32), "+v"(hi), "+v"(tid));
            const int troff = (8 * hi + ((r32 & 15) >> 2)) * MB_VP + (16 * ((r32 >> 4) & 1) + 4 * (r32 & 3)) * 2;
            const int tqA = 256 * qA + 32 * w + r32, tqB = tqA + 256;
            bf16x8 qa[4], qb[4];
#pragma unroll
            for (int d0 = 0; d0 < 4; ++d0) { qa[d0] = *(const bf16x8*)(Qb + (size_t)tqA * NQKV + 16 * d0 + 8 * hi); qb[d0] = *(const bf16x8*)(Qb + (size_t)tqB * NQKV + 16 * d0 + 8 * hi); }
            const unsigned selA = mb_select(qa, km, qA, hi);
            int ko = 0; asm volatile("" : "+v"(ko) :: "memory");
            const unsigned selB = mb_select(qb, km + ko, qB, hi);
            float la = 0.f, lb = 0.f; f32x16 oa0 = {}, oa1 = {}, ob0 = {}, ob1 = {};
            const int NT = 4 * (qB + 1);
            const int tA = 2047 - tqA + 8 * hi, tB = tA - 256;
            const LAS unsigned char* cpA = (const LAS unsigned char*)tab + (tA & 3) * (MB_TN * 4) + (tA & ~3) * 4;
            const LAS unsigned char* cpB = (const LAS unsigned char*)tab + (tB & 3) * (MB_TN * 4) + (tB & ~3) * 4;
            const LAS unsigned char* minf = (const LAS unsigned char*)tab + 2048 * 4;
            const int skey = tid >> 3, sch = tid & 7;
            const size_t srow = (size_t)skey * NQKV + 8 * sch;
            u32x4 k0r = {}, v0r = {};
#define M2_GLD(T_) do { if ((T_) < NT) { const size_t ro_ = srow + (size_t)(T_) * M2_TK * NQKV; k0r = *(const u32x4*)(Kb + ro_); v0r = *(const u32x4*)(Vb + ro_); } } while (0)
#define M2_ST(T_) do { if ((T_) < NT) { *(LAS u32x4*)(lds + M2_K + ((T_) & 1) * (M2_TK * MB_KP) + skey * MB_KP + sch * 16) = k0r; *(LAS u32x4*)(lds + M2_V + ((T_) & 1) * (M2_TK * MB_VP) + skey * MB_VP + sch * 16) = v0r; } } while (0)
            M2_GLD(0); M2_ST(0); M2_GLD(1);
            LBAR();
            for (int T = 0; T < NT; ++T) { const int kb = T >> 2;
                const bool actA = kb < qA ? (__ballot((selA >> kb) & 1u) != 0ull) : (kb == qA && (M2_TK * T - 256 * qA) <= 32 * w + 31);
                const bool actB = kb < qB ? (__ballot((selB >> kb) & 1u) != 0ull) : ((M2_TK * T - 256 * qB) <= 32 * w + 31);
                const LAS unsigned char* Kt = lds + M2_K + (T & 1) * (M2_TK * MB_KP) + kappa(r32) * MB_KP + hi * 16; const unsigned va = (unsigned)(size_t)(lds + M2_V + (T & 1) * (M2_TK * MB_VP) + troff);
                const LAS unsigned char* ctA = ((selA >> kb) & 1u) ? cpA + 256 * T : minf; const LAS unsigned char* ctB = ((selB >> kb) & 1u) ? cpB + 256 * T : minf;
                if (actA && actB) mb_step2<true, true>(Kt, va, ctA, ctB, qa, qb, oa0, oa1, la, ob0, ob1, lb);
                else if (actB) mb_step2<false, true>(Kt, va, ctA, ctB, qa, qb, oa0, oa1, la, ob0, ob1, lb);
                else if (actA) mb_step2<true, false>(Kt, va, ctA, ctB, qa, qb, oa0, oa1, la, ob0, ob1, lb);
                M2_ST(T + 1);
                LBAR();
                M2_GLD(T + 2);
            }
#undef M2_GLD
#undef M2_ST
#pragma unroll
            for (int gsel = 0; gsel < 2; ++gsel) { const f32x16& o0 = gsel ? ob0 : oa0; const f32x16& o1 = gsel ? ob1 : oa1; const int tq = gsel ? tqB : tqA;
                const float inv = 1.f / xhalf_sum(gsel ? lb : la);
                bf16* yp = Y + ((size_t)b * SEQ + tq) * DM + 512 + 64 * h + 4 * hi; float sq = 0.f;
#pragma unroll
                for (int g4 = 0; g4 < 4; ++g4) { u32x2 a, c2; a.x = cvtpk(o0[4 * g4] * inv, o0[4 * g4 + 1] * inv); a.y = cvtpk(o0[4 * g4 + 2] * inv, o0[4 * g4 + 3] * inv);
                    c2.x = cvtpk(o1[4 * g4] * inv, o1[4 * g4 + 1] * inv); c2.y = cvtpk(o1[4 * g4 + 2] * inv, o1[4 * g4 + 3] * inv);
                    *(u32x2*)(yp + 8 * g4) = a; *(u32x2*)(yp + 32 + 8 * g4) = c2;
                    sq += bflo(a.x) * bflo(a.x) + bfhi(a.x) * bfhi(a.x) + bflo(a.y) * bflo(a.y) + bfhi(a.y) * bfhi(a.y) + bflo(c2.x) * bflo(c2.x) + bfhi(c2.x) * bfhi(c2.x) + bflo(c2.y) * bflo(c2.y) + bfhi(c2.y) * bfhi(c2.y); }
                sq = xhalf_sum(sq); if (hi == 0 && SSB) atomicAdd(SSB + (size_t)b * SEQ + tq, sq); }
        }
    }
}

constexpr int DL_VP = 192, DL_KP = 144, DL_LUT = 0, DL_TN = 208, DL_V = 16384, DL_SB = 65536, DL_SBP = 136, DL_SL = DL_SB + 512 * DL_SBP, DL_END = DL_SL + 2048;
static_assert(DL_END <= 139264, "dilated LDS map");
struct DilTile { u32x4 kr[4]; u32x4 vr[4]; };
__device__ __forceinline__ void dil_load(DilTile& t, const bf16* Kb, const bf16* Vb, int dil, int res, int base, int lane) {
#pragma unroll
    for (int i4 = 0; i4 < 4; ++i4) { const int idx = lane + 64 * i4, key = idx >> 3, ch = idx & 7; const size_t o = (size_t)(dil * (base + key) + res) * NQKV + 8 * ch;
        t.kr[i4] = *(const u32x4*)(Kb + o); t.vr[i4] = *(const u32x4*)(Vb + o); }
}
__device__ __forceinline__ void dil_unit(const bf16* Qb, const bf16* Kb, const bf16* Vb, const LAS unsigned char* tb, LAS unsigned char* Vw, int troff, int dil, int res, int gi, int lane, int r32, int hi,
                                         f32x16& o0, f32x16& o1, float& lse) {
    const int ms = 32 * gi + r32, tq = dil * ms + res;
    u32x4 qr[4];
    int lg = lane; asm volatile("" : "+v"(lg));
#pragma unroll
    for (int i4 = 0; i4 < 4; ++i4) { const int idx = lg + 64 * i4, qrow = idx >> 3, ch = idx & 7; qr[i4] = *(const u32x4*)(Qb + (size_t)(dil * (32 * gi + qrow) + res) * NQKV + 8 * ch); }
    float l_run = 0.f; o0 = f32x16{}; o1 = f32x16{};
    const int kt0 = gi >= 4 ? 0 : 4 - gi;
    const int a0 = 31 - r32 + 8 * hi;
    const LAS unsigned char* cp = tb + (a0 & 3) * (DL_TN * 4) + (a0 & ~3) * 4;
    DilTile nx, nx2; dil_load(nx, Kb, Vb, dil, res, 32 * gi - 128 + 32 * kt0, lg); nx2 = nx;
    if (kt0 < 4) dil_load(nx2, Kb, Vb, dil, res, 32 * gi - 128 + 32 * (kt0 + 1), lg);
    bf16x8 qf[4];
#pragma unroll
    for (int i4 = 0; i4 < 4; ++i4) { const int idx = lane + 64 * i4, qrow = idx >> 3, ch = idx & 7; *(LAS u32x4*)(Vw + qrow * DL_KP + ch * 16) = qr[i4]; }
#pragma unroll
    for (int d0 = 0; d0 < 4; ++d0) qf[d0] = *(const LAS bf16x8*)(Vw + r32 * DL_KP + hi * 16 + d0 * 32);
#pragma unroll 1
    for (int kt = kt0; kt < 5; ++kt) { const int base = 32 * gi - 128 + 32 * kt;
        DilTile cu = nx; nx = nx2;
        if (kt < 3) dil_load(nx2, Kb, Vb, dil, res, base + 64, lg);
        asm volatile("" ::: "memory");
#pragma unroll
        for (int i4 = 0; i4 < 4; ++i4) { const int idx = lane + 64 * i4, key = idx >> 3, ch = idx & 7; *(LAS u32x4*)(Vw + key * DL_KP + ch * 16) = cu.kr[i4]; }
        bf16x8 kf[4];
#pragma unroll
        for (int d0 = 0; d0 < 4; ++d0) kf[d0] = *(const LAS bf16x8*)(Vw + kappa(r32) * DL_KP + hi * 16 + d0 * 32);
#pragma unroll
        for (int i4 = 0; i4 < 4; ++i4) { const int idx = lane + 64 * i4, key = idx >> 3, ch = idx & 7; *(LAS u32x4*)(Vw + key * DL_VP + ch * 16) = cu.vr[i4]; }
        f32x16 p0 = ld_c16(cp + 128 * kt);
#pragma unroll
        for (int d0 = 0; d0 < 4; ++d0) p0 = mfma32(kf[d0], qf[d0], p0);
        float ls = 0.f;
#pragma unroll
        for (int r = 0; r < 16; ++r) { p0[r] = __builtin_amdgcn_exp2f(p0[r]); ls += p0[r]; }
        l_run += ls;
        const bf16x8 pf0 = packp(p0, 0), pf1 = packp(p0, 1);
        asm volatile("s_waitcnt lgkmcnt(0)" ::: "memory");
#pragma unroll
        for (int c = 0; c < 2; ++c) { const LAS unsigned char* vb = Vw + troff + c * 64;
            const bf16x8 v0 = cat8(vtr(vb), vtr(vb + 4 * DL_VP)), v1 = cat8(vtr(vb + 16 * DL_VP), vtr(vb + 20 * DL_VP));
            if (c == 0) { o0 = mfma32(v0, pf0, o0); o0 = mfma32(v1, pf1, o0); } else { o1 = mfma32(v0, pf0, o1); o1 = mfma32(v1, pf1, o1); } }
        asm volatile("s_waitcnt lgkmcnt(0)" ::: "memory");
    }
    const float lt = xhalf_sum(l_run), inv = 1.f / lt;
#pragma unroll
    for (int r = 0; r < 16; ++r) { o0[r] *= inv; o1[r] *= inv; }
    lse = __builtin_amdgcn_logf(lt);
}
template <bool DA, bool DB>
__device__ __forceinline__ void dil_step2(DilTile& cu, const bf16* Kb, const bf16* Vb, int dil, int res, int nbase, int lg, LAS unsigned char* Vw, int troff, const LAS unsigned char* cp, int kt, int lane, int r32, int hi,
                                          const bf16x8 (&qa)[4], const bf16x8 (&qb)[4], f32x16& a0, f32x16& a1, float& la, f32x16& b0, f32x16& b1, float& lb) {
#pragma unroll
    for (int i4 = 0; i4 < 4; ++i4) { const int idx = lane + 64 * i4, key = idx >> 3, ch = idx & 7; *(LAS u32x4*)(Vw + key * DL_KP + ch * 16) = cu.kr[i4]; }
    bf16x8 kf[4];
#pragma unroll
    for (int d0 = 0; d0 < 4; ++d0) kf[d0] = *(const LAS bf16x8*)(Vw + kappa(r32) * DL_KP + hi * 16 + d0 * 32);
#pragma unroll
    for (int i4 = 0; i4 < 4; ++i4) { const int idx = lane + 64 * i4, key = idx >> 3, ch = idx & 7; *(LAS u32x4*)(Vw + key * DL_VP + ch * 16) = cu.vr[i4]; }
    if (DA) dil_load(cu, Kb, Vb, dil, res, nbase, lg);
    asm volatile("" ::: "memory");
    f32x16 pa = {}, pb = {};
    if (DA) pa = ld_c16(cp + 128 * kt);
    if (DB) pb = ld_c16(cp + 128 * (kt - 1));
#pragma unroll
    for (int d0 = 0; d0 < 4; ++d0) { if (DA) pa = mfma32(kf[d0], qa[d0], pa); if (DB) pb = mfma32(kf[d0], qb[d0], pb); }
    float lsa = 0.f, lsb = 0.f;
#pragma unroll
    for (int r = 0; r < 16; ++r) { if (DA) { pa[r] = __builtin_amdgcn_exp2f(pa[r]); lsa += pa[r]; } if (DB) { pb[r] = __builtin_amdgcn_exp2f(pb[r]); lsb += pb[r]; } }
    la += lsa; lb += lsb;
    const bf16x8 fa0 = packp(pa, 0), fa1 = packp(pa, 1), fb0 = packp(pb, 0), fb1 = packp(pb, 1);
    asm volatile("s_waitcnt lgkmcnt(0)" ::: "memory");
#pragma unroll
    for (int c = 0; c < 2; ++c) { const LAS unsigned char* vb = Vw + troff + c * 64;
        const bf16x8 v0 = cat8(vtr(vb), vtr(vb + 4 * DL_VP)), v1 = cat8(vtr(vb + 16 * DL_VP), vtr(vb + 20 * DL_VP));
        if (c == 0) { if (DA) { a0 = mfma32(v0, fa0, a0); a0 = mfma32(v1, fa1, a0); } if (DB) { b0 = mfma32(v0, fb0, b0); b0 = mfma32(v1, fb1, b0); } }
        else { if (DA) { a1 = mfma32(v0, fa0, a1); a1 = mfma32(v1, fa1, a1); } if (DB) { b1 = mfma32(v0, fb0, b1); b1 = mfma32(v1, fb1, b1); } } }
    asm volatile("s_waitcnt lgkmcnt(0)" ::: "memory");
}
__device__ __forceinline__ void dil_unit2(const bf16* Qb, const bf16* Kb, const bf16* Vb, const LAS unsigned char* tb, LAS unsigned char* Vw, int troff, int dil, int res, int gi2, int lane, int r32, int hi,
                                          f32x16& a0, f32x16& a1, float& lseA, f32x16& b0, f32x16& b1, float& lseB) {
    u32x4 qr[4], qs[4];
    int lg = lane; asm volatile("" : "+v"(lg));
#pragma unroll
    for (int i4 = 0; i4 < 4; ++i4) { const int idx = lg + 64 * i4, qrow = idx >> 3, ch = idx & 7; const size_t o = (size_t)(dil * (64 * gi2 + qrow) + res) * NQKV + 8 * ch;
        qr[i4] = *(const u32x4*)(Qb + o); qs[i4] = *(const u32x4*)(Qb + o + (size_t)(dil * 32) * NQKV); }
    float la = 0.f, lb = 0.f; a0 = f32x16{}; a1 = f32x16{}; b0 = f32x16{}; b1 = f32x16{};
    const int kt0 = gi2 >= 2 ? 0 : 4 - 2 * gi2;
    const int t0 = 31 - r32 + 8 * hi;
    const LAS unsigned char* cp = tb + (t0 & 3) * (DL_TN * 4) + (t0 & ~3) * 4;
    const int base0 = 64 * gi2 - 128;
    DilTile nx; dil_load(nx, Kb, Vb, dil, res, base0 + 32 * kt0, lg);
    bf16x8 qa[4], qb[4];
#pragma unroll
    for (int i4 = 0; i4 < 4; ++i4) { const int idx = lane + 64 * i4, qrow = idx >> 3, ch = idx & 7; *(LAS u32x4*)(Vw + qrow * DL_KP + ch * 16) = qr[i4]; }
#pragma unroll
    for (int d0 = 0; d0 < 4; ++d0) qa[d0] = *(const LAS bf16x8*)(Vw + r32 * DL_KP + hi * 16 + d0 * 32);
#pragma unroll
    for (int i4 = 0; i4 < 4; ++i4) { const int idx = lane + 64 * i4, qrow = idx >> 3, ch = idx & 7; *(LAS u32x4*)(Vw + qrow * DL_KP + ch * 16) = qs[i4]; }
#pragma unroll
    for (int d0 = 0; d0 < 4; ++d0) qb[d0] = *(const LAS bf16x8*)(Vw + r32 * DL_KP + hi * 16 + d0 * 32);
    int kt = kt0;
    if (kt == 0) { dil_step2<true, false>(nx, Kb, Vb, dil, res, base0 + 32, lg, Vw, troff, cp, 0, lane, r32, hi, qa, qb, a0, a1, la, b0, b1, lb); kt = 1; }
#pragma unroll 1
    for (; kt < 5; ++kt) dil_step2<true, true>(nx, Kb, Vb, dil, res, base0 + 32 * (kt + 1), lg, Vw, troff, cp, kt, lane, r32, hi, qa, qb, a0, a1, la, b0, b1, lb);
    dil_step2<false, true>(nx, Kb, Vb, dil, res, 0, lg, Vw, troff, cp, 5, lane, r32, hi, qa, qb, a0, a1, la, b0, b1, lb);
    const float lta = xhalf_sum(la), ltb = xhalf_sum(lb), ia = 1.f / lta, ib = 1.f / ltb;
#pragma unroll
    for (int r = 0; r < 16; ++r) { a0[r] *= ia; a1[r] *= ia; b0[r] *= ib; b1[r] *= ib; }
    lseA = __builtin_amdgcn_logf(lta); lseB = __builtin_amdgcn_logf(ltb);
}
__device__ __forceinline__ void sb_store(LAS unsigned char* sb, int lt, int hi, const f32x16& o0, const f32x16& o1) {
    LAS unsigned char* p = sb + lt * DL_SBP + 8 * hi;
#pragma unroll
    for (int g4 = 0; g4 < 4; ++g4) { u32x2 a, c2; a.x = cvtpk(o0[4 * g4], o0[4 * g4 + 1]); a.y = cvtpk(o0[4 * g4 + 2], o0[4 * g4 + 3]); c2.x = cvtpk(o1[4 * g4], o1[4 * g4 + 1]); c2.y = cvtpk(o1[4 * g4 + 2], o1[4 * g4 + 3]);
        *(LAS u32x2*)(p + 16 * g4) = a; *(LAS u32x2*)(p + 64 + 16 * g4) = c2; }
}
__device__ __forceinline__ void sb_merge(const LAS unsigned char* sb, int lt, int hi, float wa, float wb, f32x16& o0, f32x16& o1) {
    const LAS unsigned char* p = sb + lt * DL_SBP + 8 * hi;
#pragma unroll
    for (int g4 = 0; g4 < 4; ++g4) { const u32x2 a = *(const LAS u32x2*)(p + 16 * g4), c2 = *(const LAS u32x2*)(p + 64 + 16 * g4);
        o0[4 * g4] = wa * bflo(a.x) + wb * o0[4 * g4]; o0[4 * g4 + 1] = wa * bfhi(a.x) + wb * o0[4 * g4 + 1]; o0[4 * g4 + 2] = wa * bflo(a.y) + wb * o0[4 * g4 + 2]; o0[4 * g4 + 3] = wa * bfhi(a.y) + wb * o0[4 * g4 + 3];
        o1[4 * g4] = wa * bflo(c2.x) + wb * o1[4 * g4]; o1[4 * g4 + 1] = wa * bfhi(c2.x) + wb * o1[4 * g4 + 1]; o1[4 * g4 + 2] = wa * bflo(c2.y) + wb * o1[4 * g4 + 2]; o1[4 * g4 + 3] = wa * bfhi(c2.y) + wb * o1[4 * g4 + 3]; }
}
__device__ __forceinline__ void dil_phase(LAS unsigned char* lds, const bf16* QKV, const float* LUT, bf16* Y, float* SSA, int vcu, int G) {
    const int tid = threadIdx.x, lane = tid & 63, r32 = lane & 31, hi = lane >> 5; const int w = __builtin_amdgcn_readfirstlane(tid >> 6);
    LAS float* dtab = (LAS float*)(lds + DL_LUT);
    LAS unsigned char* Vw = lds + DL_V + w * (32 * DL_VP);
    LAS unsigned char* sb = lds + DL_SB; LAS float* sl = (LAS float*)(lds + DL_SL);
    const int troff = tr_off(lane, DL_VP);
    for (int bh = vcu; bh < BATCH * 8; bh += G) { const int b = bh >> 3, h = bh & 7;
        __syncthreads();
        for (int i = tid; i < 3 * 4 * DL_TN; i += 512) { const int ii = i % DL_TN, sft = (i / DL_TN) & 3, pp = i / (4 * DL_TN); const int dlt = 159 - ii - sft, dist = dlt * (pp == 0 ? 1 : (pp == 1 ? 4 : 16));
            dtab[i] = (dlt >= 0 && dlt <= 128 && dist < 2048) ? LUT[h * 2048 + dist] * LOG2E : -INFINITY; }
        __syncthreads();
        const bf16* Qb = QKV + (size_t)b * SEQ * NQKV + 64 * h; const bf16* Kb = Qb + 512; const bf16* Vb = Qb + 1024;
        const LAS unsigned char* tb0 = lds + DL_LUT;
        for (int sp = 0; sp < 4; ++sp) {
            for (int x = w; x < 16; x += 8) { f32x16 o0, o1; float lse;
                dil_unit(Qb, Kb, Vb, tb0 + 2 * (4 * DL_TN * 4), Vw, troff, 16, x, sp, lane, r32, hi, o0, o1, lse);
                const int lt = 16 * r32 + x; sb_store(sb, lt, hi, o0, o1); if (hi == 0) sl[lt] = lse; }
            __syncthreads();
            { f32x16 oa0, oa1, ob0, ob1; float lsa, lsb;
                dil_unit2(Qb, Kb, Vb, tb0 + 1 * (4 * DL_TN * 4), Vw, troff, 4, w & 3, 2 * sp + (w >> 2), lane, r32, hi, oa0, oa1, lsa, ob0, ob1, lsb);
                { const int lt = 128 * (2 * (w >> 2)) + 4 * r32 + (w & 3); const float ls = sl[lt], mx = fmaxf(ls, lsa);
                  float wa = __builtin_amdgcn_exp2f(ls - mx), wb = __builtin_amdgcn_exp2f(lsa - mx); const float sw = wa + wb, isw = 1.f / sw; wa *= isw; wb *= isw;
                  sb_merge(sb, lt, hi, wa, wb, oa0, oa1); sb_store(sb, lt, hi, oa0, oa1); if (hi == 0) sl[lt] = mx + __builtin_amdgcn_logf(sw); }
                { const int lt = 128 * (2 * (w >> 2) + 1) + 4 * r32 + (w & 3); const float ls = sl[lt], mx = fmaxf(ls, lsb);
                  float wa = __builtin_amdgcn_exp2f(ls - mx), wb = __builtin_amdgcn_exp2f(lsb - mx); const float sw = wa + wb, isw = 1.f / sw; wa *= isw; wb *= isw;
                  sb_merge(sb, lt, hi, wa, wb, ob0, ob1); sb_store(sb, lt, hi, ob0, ob1); if (hi == 0) sl[lt] = mx + __builtin_amdgcn_logf(sw); } }
            __syncthreads();
            { f32x16 oa0, oa1, ob0, ob1; float lsa, lsb;
                dil_unit2(Qb, Kb, Vb, tb0, Vw, troff, 1, 0, 8 * sp + w, lane, r32, hi, oa0, oa1, lsa, ob0, ob1, lsb);
                { const int lt = 32 * (2 * w) + r32; const float ls = sl[lt], mx = fmaxf(ls, lsa);
                  float wa = __builtin_amdgcn_exp2f(ls - mx), wb = __builtin_amdgcn_exp2f(lsa - mx); const float isw = 1.f / (wa + wb); wa *= isw; wb *= isw;
                  sb_merge(sb, lt, hi, wa, wb, oa0, oa1); sb_store(sb, lt, hi, oa0, oa1); }
                { const int lt = 32 * (2 * w + 1) + r32; const float ls = sl[lt], mx = fmaxf(ls, lsb);
                  float wa = __builtin_amdgcn_exp2f(ls - mx), wb = __builtin_amdgcn_exp2f(lsb - mx); const float isw = 1.f / (wa + wb); wa *= isw; wb *= isw;
                  sb_merge(sb, lt, hi, wa, wb, ob0, ob1); sb_store(sb, lt, hi, ob0, ob1); } }
            __syncthreads();
#pragma unroll
            for (int j = 0; j < 8; ++j) { const int idx = tid + 512 * j, row = idx >> 3, ch = idx & 7;
                const LAS unsigned char* p = sb + row * DL_SBP + ch * 16; const u32x2 a = *(const LAS u32x2*)p, c2 = *(const LAS u32x2*)(p + 8);
                u32x4 v; v[0] = a.x; v[1] = a.y; v[2] = c2.x; v[3] = c2.y;
                *(u32x4*)(Y + ((size_t)b * SEQ + 512 * sp + row) * DM + 64 * h + 8 * ch) = v;
                float sq = bflo(a.x) * bflo(a.x) + bfhi(a.x) * bfhi(a.x) + bflo(a.y) * bflo(a.y) + bfhi(a.y) * bfhi(a.y) + bflo(c2.x) * bflo(c2.x) + bfhi(c2.x) * bfhi(c2.x) + bflo(c2.y) * bflo(c2.y) + bfhi(c2.y) * bfhi(c2.y);
                sq += __shfl_xor(sq, 1); sq += __shfl_xor(sq, 2); sq += __shfl_xor(sq, 4);
                if (ch == 0) atomicAdd(SSA + (size_t)b * SEQ + 512 * sp + row, sq); }
            __syncthreads();
        }
    }
}

__device__ __forceinline__ void merge_phase(const bf16* __restrict__ Y, bf16* __restrict__ YN, int gw, int NGW, int lane) {
    for (int m = gw; m < NTOK; m += NGW) {
        const u32x4 ya = *(const u32x4*)(Y + (size_t)m * DM + 8 * lane), yb = *(const u32x4*)(Y + (size_t)m * DM + 512 + 8 * lane);
        float v[8], u[8]; float sa = 0.f, sb = 0.f;
#pragma unroll
        for (int e = 0; e < 4; ++e) { v[2 * e] = bflo(ya[e]); v[2 * e + 1] = bfhi(ya[e]); u[2 * e] = bflo(yb[e]); u[2 * e + 1] = bfhi(yb[e]); }
#pragma unroll
        for (int e = 0; e < 8; ++e) { sa += v[e] * v[e]; sb += u[e] * u[e]; }
        sa = wave_sum(sa); sb = wave_sum(sb);
        const float ra = rsqrtf(sa * (1.f / 512.f) + EPS), rb = rsqrtf(sb * (1.f / 512.f) + EPS);
        u32x4 oa, ob;
#pragma unroll
        for (int e = 0; e < 4; ++e) { oa[e] = cvtpk(v[2 * e] * ra, v[2 * e + 1] * ra); ob[e] = cvtpk(u[2 * e] * rb, u[2 * e + 1] * rb); }
        *(u32x4*)(YN + (size_t)m * DM + 8 * lane) = oa; *(u32x4*)(YN + (size_t)m * DM + 512 + 8 * lane) = ob;
    }
}

constexpr int CR_KP = 272, CR_VP = 320, CR_K = 0, CR_V = 2 * 64 * CR_KP, CR_END = CR_V + 2 * 64 * CR_VP, CR_OP = 272;
static_assert(4 * 32 * CR_OP <= CR_V && CR_END + 4 * 32 * CR_OP <= 139264, "cross LDS map");
typedef __amdgpu_buffer_rsrc_t rsrc_t;
__device__ __forceinline__ rsrc_t mkrsrc(const void* base, unsigned bytes) { return __builtin_amdgcn_make_buffer_rsrc((void*)base, 0, bytes, 0x00020000); }
__device__ __forceinline__ u32x4 bld16(rsrc_t r, unsigned voff, unsigned soff) { return __builtin_bit_cast(u32x4, __builtin_amdgcn_raw_buffer_load_b128(r, voff, soff, 0)); }
__device__ __forceinline__ void cross_phase(LAS unsigned char* lds, const bf16* QM, const bf16* KVM, bf16* OM, int vcu, int G, int pv) {
    const int tid = threadIdx.x, lane = tid & 63, r32 = lane & 31, hi = lane >> 5; const int w = __builtin_amdgcn_readfirstlane(tid >> 6);
    const int troff = tr_off(lane, CR_VP);
    const int kkey = tid >> 3, kch = tid & 7;
    const unsigned soff = (unsigned)kkey * 4096u + (unsigned)kch * 16u;
    const unsigned qoff = (unsigned)(32 * w + r32) * 2048u + (unsigned)hi * 16u;
    const int kl0 = kkey * CR_KP + kch * 16, vl0 = kkey * CR_VP + kch * 16;
    const int kfo = kappa(r32) * CR_KP + hi * 16;
    const rsrc_t rK = mkrsrc(KVM, (unsigned)NMEMTOK * 4096u), rQ = mkrsrc(QM, (unsigned)NTOK * 2048u);
    LAS unsigned char* Tw = lds + (w < 4 ? CR_K + w * (32 * CR_OP) : CR_END + (w - 4) * (32 * CR_OP));
    for (int un = vcu * 4; un < BATCH * 4 * 8; un += G * 4) for (int ui = 0; ui < 4; ++ui) { const int u = un + ui, qblk = u & 7, hm = (u >> 3) & 3, b = u >> 5;
        const unsigned Qs = (unsigned)(((b * SEQ + 256 * qblk) * DM + 256 * hm) * 2);
        unsigned char* Os = (unsigned char*)(OM + ((size_t)b * SEQ + 256 * qblk) * DM + 256 * hm);
        const unsigned Ks = (unsigned)((b * NMEM * 2048 + 256 * hm) * 2), Vs = Ks + 2048u;
        f32x16 sc[8];
#pragma unroll
        for (int kt = 0; kt < 8; ++kt) sc[kt] = f32x16{};
        u32x4 r0, r1;
        __syncthreads();
        r0 = bld16(rK, soff, Ks); r1 = bld16(rK, soff, Ks + 128u);
        *(LAS u32x4*)(lds + CR_K + kl0) = r0; *(LAS u32x4*)(lds + CR_K + kl0 + 128) = r1;
        __syncthreads();
#pragma unroll
        for (int half = 0; half < 2; ++half) {
            bf16x8 qf[8];
#pragma unroll
            for (int d0 = 0; d0 < 8; ++d0) qf[d0] = __builtin_bit_cast(bf16x8, bld16(rQ, qoff, Qs + (unsigned)(256 * half + 32 * d0)));
#pragma unroll
            for (int kp = 0; kp < 4; ++kp) { const int step = half * 4 + kp, buf = step & 1;
                if (!(pv & 2)) { if (step + 1 < 8) { const int nh = (step + 1) >> 2, nk = (step + 1) & 3; const unsigned src = Ks + (unsigned)(nk * (64 * 4096) + 256 * nh); r0 = bld16(rK, soff, src); r1 = bld16(rK, soff, src + 128u); }
                else { r0 = bld16(rK, soff, Vs); r1 = bld16(rK, soff, Vs + 128u); } }
                const LAS unsigned char* Kt = lds + CR_K + buf * (64 * CR_KP) + kfo;
#pragma unroll
                for (int d0 = 0; d0 < 8; ++d0) { sc[2 * kp] = mfma32(*(const LAS bf16x8*)(Kt + d0 * 32), qf[d0], sc[2 * kp]); sc[2 * kp + 1] = mfma32(*(const LAS bf16x8*)(Kt + 32 * CR_KP + d0 * 32), qf[d0], sc[2 * kp + 1]); if (d0 & 1) __builtin_amdgcn_sched_barrier(0); }
                if (step + 1 < 8) { *(LAS u32x4*)(lds + CR_K + (buf ^ 1) * (64 * CR_KP) + kl0) = r0; *(LAS u32x4*)(lds + CR_K + (buf ^ 1) * (64 * CR_KP) + kl0 + 128) = r1; }
                else { *(LAS u32x4*)(lds + CR_V + vl0) = r0; *(LAS u32x4*)(lds + CR_V + vl0 + 128) = r1; }
                LBAR();
            }
        }
        const float c1 = 0.0625f * LOG2E, mo = 0.f; float ls = 0.f;
        bf16x8 pf[8][2];
#pragma unroll
        for (int kt = 0; kt < 8; ++kt) {
#pragma unroll
            for (int r = 0; r < 16; ++r) { sc[kt][r] = __builtin_amdgcn_exp2f(sc[kt][r] * c1 - mo); ls += sc[kt][r]; }
            pf[kt][0] = packp(sc[kt], 0); pf[kt][1] = packp(sc[kt], 1); }
        const float inv = 1.f / xhalf_sum(ls);
#pragma unroll
        for (int hv = 0; hv < 2; ++hv) {
            f32x16 o[4];
#pragma unroll
            for (int c = 0; c < 4; ++c) o[c] = f32x16{};
            if (hv == 1) { if (!(pv & 2)) { r0 = bld16(rK, soff, Vs + 256u); r1 = bld16(rK, soff, Vs + 384u); }
                *(LAS u32x4*)(lds + CR_V + vl0) = r0; *(LAS u32x4*)(lds + CR_V + vl0 + 128) = r1; LBAR(); }
#pragma unroll
            for (int kp = 0; kp < 4; ++kp) { const int buf = kp & 1;
                if (kp + 1 < 4 && !(pv & 2)) { const unsigned src = Vs + (unsigned)((kp + 1) * (64 * 4096) + 256 * hv); r0 = bld16(rK, soff, src); r1 = bld16(rK, soff, src + 128u); }
                const LAS unsigned char* vb = lds + CR_V + buf * (64 * CR_VP) + troff;
#pragma unroll
                for (int t2 = 0; t2 < 2; ++t2) { const unsigned va = (unsigned)(size_t)(vb + t2 * 32 * CR_VP);
                    s16x4 l0, h0, l1, h1, l2, h2, l3, h3, l4, h4, l5, h5, l6, h6, l7, h7;
                    TR_RD(l0, va, 0 * CR_VP); TR_RD(h0, va, 4 * CR_VP); TR_RD(l1, va, 16 * CR_VP); TR_RD(h1, va, 20 * CR_VP); TR_RD(l2, va, 64 + 0 * CR_VP); TR_RD(h2, va, 64 + 4 * CR_VP); TR_RD(l3, va, 64 + 16 * CR_VP); TR_RD(h3, va, 64 + 20 * CR_VP);
                    TR_RD(l4, va, 128 + 0 * CR_VP); TR_RD(h4, va, 128 + 4 * CR_VP); TR_RD(l5, va, 128 + 16 * CR_VP); TR_RD(h5, va, 128 + 20 * CR_VP); TR_RD(l6, va, 192 + 0 * CR_VP); TR_RD(h6, va, 192 + 4 * CR_VP); TR_RD(l7, va, 192 + 16 * CR_VP); TR_RD(h7, va, 192 + 20 * CR_VP);
                    const bf16x8 q0 = pf[2 * kp + t2][0], q1 = pf[2 * kp + t2][1];
                    TR_WAIT(14, l0, h0); o[0] = mfma32(cat8(l0, h0), q0, o[0]); TR_WAIT(12, l1, h1); o[0] = mfma32(cat8(l1, h1), q1, o[0]); TR_WAIT(10, l2, h2); o[1] = mfma32(cat8(l2, h2), q0, o[1]); TR_WAIT(8, l3, h3); o[1] = mfma32(cat8(l3, h3), q1, o[1]);
                    TR_WAIT(6, l4, h4); o[2] = mfma32(cat8(l4, h4), q0, o[2]); TR_WAIT(4, l5, h5); o[2] = mfma32(cat8(l5, h5), q1, o[2]); TR_WAIT(2, l6, h6); o[3] = mfma32(cat8(l6, h6), q0, o[3]); TR_WAIT(0, l7, h7); o[3] = mfma32(cat8(l7, h7), q1, o[3]); }
                if (kp + 1 < 4) { *(LAS u32x4*)(lds + CR_V + (buf ^ 1) * (64 * CR_VP) + vl0) = r0; *(LAS u32x4*)(lds + CR_V + (buf ^ 1) * (64 * CR_VP) + vl0 + 128) = r1; }
                LBAR();
            }
            if (!(pv & 1)) {
#pragma unroll
                for (int c = 0; c < 4; ++c)
#pragma unroll
                    for (int g4 = 0; g4 < 4; ++g4) { u32x2 a; a.x = cvtpk(o[c][4 * g4] * inv, o[c][4 * g4 + 1] * inv); a.y = cvtpk(o[c][4 * g4 + 2] * inv, o[c][4 * g4 + 3] * inv); *(LAS u32x2*)(Tw + r32 * CR_OP + 64 * c + 16 * g4 + 8 * hi) = a; }
                unsigned char* yp = Os + 256 * hv + (lane & 15) * 16 + (size_t)(32 * w + (lane >> 4)) * 2048;
#pragma unroll
                for (int j = 0; j < 8; ++j) { const u32x4 v = *(const LAS u32x4*)(Tw + ((lane >> 4) + 4 * j) * CR_OP + (lane & 15) * 16); *(u32x4*)(yp + (size_t)j * (4 * 2048)) = v; }
            }
        }
    }
}
}


struct Frame {
    LAS unsigned char* lds;
    int tid, lane, wave, vcu, G;
};
__device__ __forceinline__ void p0_titem(const float* __restrict__ W, int Nsrc, int nsrc0, int k0, const float* __restrict__ g, const float* __restrict__ g2, int gsplit,
                                         bf16* __restrict__ WT, int K, int ndst0, LAS float* scr, int lane) {
#pragma unroll 8
    for (int i = 0; i < 32; ++i) { const int kk = 2 * i + (lane >> 5); const int k = k0 + kk;
        float gv = 1.f; if (g) gv = (g2 && k >= gsplit) ? g2[k - gsplit] : g[k];
        scr[kk * 33 + (lane & 31)] = W[(size_t)k * Nsrc + nsrc0 + (lane & 31)] * gv; }
    LDS_WAIT(); asm volatile("" ::: "memory");
    const int c = lane & 7;
#pragma unroll
    for (int j = 0; j < 4; ++j) { const int n = (lane >> 3) + 8 * j; const LAS float* s = scr + (8 * c) * 33 + n;
        v4u o; o.x = pk2(s[0 * 33], s[1 * 33]); o.y = pk2(s[2 * 33], s[3 * 33]); o.z = pk2(s[4 * 33], s[5 * 33]); o.w = pk2(s[6 * 33], s[7 * 33]);
        *(GAS v4u*)(WT + (size_t)(ndst0 + n) * K + k0 + 8 * c) = o; }
    LDS_WAIT(); asm volatile("" ::: "memory");
}
__device__ __forceinline__ void p0_norm_rows2(const float* __restrict__ x0, const float* __restrict__ x1, bf16* __restrict__ o0, bf16* __restrict__ o1, int lane) {
    const GAS f32x4* a = (const GAS f32x4*)x0 + lane; const GAS f32x4* b = (const GAS f32x4*)x1 + lane; f32x4 v[4], u[4]; float s = 0.f, t = 0.f;
#pragma unroll
    for (int j = 0; j < 4; ++j) { v[j] = a[64 * j]; u[j] = b[64 * j]; }
#pragma unroll
    for (int j = 0; j < 4; ++j) { s += (v[j].x * v[j].x + v[j].y * v[j].y) + (v[j].z * v[j].z + v[j].w * v[j].w); t += (u[j].x * u[j].x + u[j].y * u[j].y) + (u[j].z * u[j].z + u[j].w * u[j].w); }
    s = wave_sum(s); t = wave_sum(t);
    const float rs = rsqrtf(s * (1.f / DM) + EPS), rt = rsqrtf(t * (1.f / DM) + EPS);
    GAS unsigned long long* p = (GAS unsigned long long*)o0 + lane; GAS unsigned long long* q = (GAS unsigned long long*)o1 + lane;
#pragma unroll
    for (int j = 0; j < 4; ++j) { p[64 * j] = (unsigned long long)pk2(v[j].x * rs, v[j].y * rs) | ((unsigned long long)pk2(v[j].z * rs, v[j].w * rs) << 32);
        q[64 * j] = (unsigned long long)pk2(u[j].x * rt, u[j].y * rt) | ((unsigned long long)pk2(u[j].z * rt, u[j].w * rt) << 32); }
}

struct Args { const float* in[20]; float* out; unsigned char* ws; int ph_lo, ph_hi, att_mask, ss_dummy, bar_idx, variant; };
enum { PH_PRO = 0, PH_QKV = 1, PH_ATT = 2, PH_MERGE = 3, PH_OUT = 4, PH_QM = 5, PH_CROSS = 6, PH_OM = 7, PH_FFN1 = 8, PH_FIX = 9, PH_DOWN = 10, PH_N = 11 };

__global__ void __launch_bounds__(NWAVES * 64, 2) mega(Args args) {
    extern __shared__ __attribute__((aligned(16))) unsigned char lds_raw[];
    Frame F;
    F.lds = (LAS unsigned char*)lds_raw;
    F.tid = threadIdx.x; F.lane = F.tid & 63; F.wave = __builtin_amdgcn_readfirstlane(F.tid >> 6);
    F.G = gridDim.x; { const int bx = blockIdx.x; F.vcu = (F.G % 8 == 0) ? (bx % 8) * (F.G / 8) + bx / 8 : bx; }
    unsigned char* ws = args.ws;
    volatile LAS unsigned* MISC = (volatile LAS unsigned*)(F.lds + MISC_OFF);
    for (int u = F.tid; u < (LDS_BYTES - MISC_OFF) / 4; u += NWAVES * 64) ((LAS unsigned*)(F.lds + MISC_OFF))[u] = 0u;
    __syncthreads();
    const int lo = args.ph_lo, hi = args.ph_hi;
    unsigned* barw = (unsigned*)(ws + WS_CTL) + CW_BAR + args.bar_idx * XCD_BAR_WORDS;
    XcdBarrier bar; bar.bar = barw; bar.x = 0; bar.st = nullptr;
    if (hi - lo > 1 || (lo <= PH_DOWN && PH_DOWN < hi)) bar = xcd_barrier_post(barw, MISC + 8);
#define IN(k) (lo <= (k) && (k) < hi)
#define SEAM(k) do { if (IN(k) && IN((k) + 1)) xcd_barrier(bar); } while (0)

    const float* x = args.in[0]; const float* mem = args.in[1]; const float* w_in = args.in[2]; const float* g_mix = args.in[3]; const float* g_od = args.in[4];
    const float* g_om = args.in[5]; const float* w_out = args.in[6]; const float* rel_bias = args.in[7]; const float* g_cross = args.in[8]; const float* g_mem = args.in[9];
    const float* w_q = args.in[10]; const float* w_kv = args.in[11]; const float* w_o = args.in[12]; const float* g_ffn = args.in[13]; const float* w_gate = args.in[14];
    const float* w_up = args.in[15]; const float* conv_w = args.in[16]; const float* conv_b = args.in[17]; const float* w_down = args.in[18]; const float* g_final = args.in[19];
    float* RS0 = (float*)(ws + WS_RS0); float* RSM = (float*)(ws + WS_RSM); float* SS1 = (float*)(ws + WS_SS1); float* SS2 = (float*)(ws + WS_SS2); float* SS3 = (float*)(ws + WS_SS3);
    float* SSA = (float*)(ws + WS_SSA); float* SSB = (float*)(ws + WS_SSB);
    float* SA1 = SS1; float* SA2 = SS2; float* SA3 = SS3; float* SAA = SSA; float* SAB = SSB;
    if (0) { SA1 = SA2 = SA3 = SAA = SAB = (float*)(ws + WS_DUMMY); }
    float* LUT = (float*)(ws + WS_LUT); float* KMP = (float*)(ws + WS_KMP); float* HALOG = (float*)(ws + WS_HALOG); float* FIXG = (float*)(ws + WS_FIXG); float* FIXU = (float*)(ws + WS_FIXU); float* PS = (float*)(ws + WS_PS);
    bf16* WIN = (bf16*)(ws + WS_WIN); bf16* WOUT = (bf16*)(ws + WS_WOUT); bf16* WQ = (bf16*)(ws + WS_WQ); bf16* WKV = (bf16*)(ws + WS_WKV);
    bf16* WO = (bf16*)(ws + WS_WO); bf16* WGU = (bf16*)(ws + WS_WGU); bf16* WD = (bf16*)(ws + WS_WD);
    bf16* MEMB = (bf16*)(ws + WS_MEMB); bf16* KVM = (bf16*)(ws + WS_KVM); bf16* XB = (bf16*)(ws + WS_XB); bf16* QKV = (bf16*)(ws + WS_QKV);
    bf16* YN = (bf16*)(ws + WS_YN); bf16* Y = (bf16*)(ws + WS_Y); bf16* OP = (bf16*)(ws + WS_OP); float* LSEP = (float*)(ws + WS_LSEP); bf16* H1 = (bf16*)(ws + WS_H1); bf16* QM = (bf16*)(ws + WS_QM);
    bf16* OM = (bf16*)(ws + WS_OM); bf16* H2 = (bf16*)(ws + WS_H2); bf16* ACT = (bf16*)(ws + WS_ACT); bf16* H3 = (bf16*)(ws + WS_H3);
    const int gw = F.vcu * NWAVES + F.wave, NGW = F.G * NWAVES;
    const int gt = (int)blockIdx.x * (NWAVES * 64) + F.tid, NGT = F.G * NWAVES * 64;

    if (IN(PH_PRO)) {
        LAS float* scr = (LAS float*)(F.lds + RING_OFF + F.wave * 16384);
        constexpr int I_IN = 16 * 96, I_OUT = 16 * 32, I_Q = 16 * 32, I_KV = 16 * 64, I_O = 16 * 32, I_GU = 16 * 176, I_D = 44 * 32;
        constexpr int NITEMS = I_IN + I_OUT + I_Q + I_KV + I_O + I_GU + I_D;
        for (int it = gw; it < NITEMS; it += NGW) {
            int r = it;
            if (r < I_IN) { const int kb = r / 96, nb = r % 96; p0_titem(w_in, 3072, 32 * nb, 64 * kb, g_mix, nullptr, 0, WIN, 1024, 32 * nb, scr, F.lane); continue; } r -= I_IN;
            if (r < I_OUT) { const int kb = r / 32, nb = r % 32; p0_titem(w_out, 1024, 32 * nb, 64 * kb, g_od, g_om, 512, WOUT, 1024, 32 * nb, scr, F.lane); continue; } r -= I_OUT;
            if (r < I_Q) { const int kb = r / 32, nb = r % 32; p0_titem(w_q, 1024, 32 * nb, 64 * kb, g_cross, nullptr, 0, WQ, 1024, 32 * nb, scr, F.lane); continue; } r -= I_Q;
            if (r < I_KV) { const int kb = r / 64, nb = r % 64; p0_titem(w_kv, 2048, 32 * nb, 64 * kb, g_mem, nullptr, 0, WKV, 1024, 32 * nb, scr, F.lane); continue; } r -= I_KV;
            if (r < I_O) { const int kb = r / 32, nb = r % 32; p0_titem(w_o, 1024, 32 * nb, 64 * kb, nullptr, nullptr, 0, WO, 1024, 32 * nb, scr, F.lane); continue; } r -= I_O;
            if (r < I_GU) { const int kb = r / 176, nb = r % 176; const int nd = 32 * nb, j = nd >> 8, rr = nd & 255;
                const float* src = (rr < 128) ? w_gate : w_up; const int sc = 128 * j + (rr & 127);
                p0_titem(src, 2816, sc, 64 * kb, g_ffn, nullptr, 0, WGU, 1024, nd, scr, F.lane); continue; } r -= I_GU;
            { const int kb = r / 32, nb = r % 32; p0_titem(w_down, 1024, 32 * nb, 64 * kb, nullptr, nullptr, 0, WD, 2816, 32 * nb, scr, F.lane); }
        }
        for (int m = 2 * gw; m < NTOK; m += 2 * NGW) p0_norm_rows2(x + (size_t)m * DM, x + (size_t)(m + 1) * DM, XB + (size_t)m * DM, XB + (size_t)(m + 1) * DM, F.lane);
        for (int m = 2 * gw; m < NMEMTOK; m += 2 * NGW) p0_norm_rows2(mem + (size_t)m * DM, mem + (size_t)(m + 1) * DM, MEMB + (size_t)m * DM, MEMB + (size_t)(m + 1) * DM, F.lane);
        for (int i = gt; i < 16 * 2048; i += NGT) { const int h = i >> 11, n = i & 2047; int b;
            if (n < 16) b = n; else { b = 16 + (n >= 22) + (n >= 30) + (n >= 40) + (n >= 54) + (n >= 73) + (n >= 99) + (n >= 134) + (n >= 182) + (n >= 246) + (n >= 332) + (n >= 450) + (n >= 609) + (n >= 825) + (n >= 1117) + (n >= 1513); }
            LUT[i] = rel_bias[h * 32 + b]; }
        for (int i = gt; i < NTOK; i += NGT) { SA1[i] = 0.f; SA2[i] = 0.f; SAA[i] = 0.f; SAB[i] = 0.f; }
        for (int i = gt; i < NTOK + 256; i += NGT) ((unsigned*)PS)[i] = 0u;
    }
    SEAM(PH_PRO);

#define STAGGER(ticks) do { const unsigned long long t0_ = __builtin_amdgcn_s_memrealtime(); const unsigned long long d_ = (unsigned long long)((F.vcu & 3) * (ticks)); \
        while (__builtin_amdgcn_s_memrealtime() - t0_ < d_) __builtin_amdgcn_s_sleep(32); } while (0)
    if (IN(PH_QKV)) {
        { pg8::Gemm g{XB, WIN, NTOK, NQKV, 1024}; pg8::StaticOrder S; S.init(NTOK, NQKV, F.G, (int)blockIdx.x);
          pg8::EpiScale E{(0   & 128) ? (bf16*)(ws + WS_H1) : QKV, RS0, (0   & 128) ? nullptr : KMP, NQKV, ((0   & 32) ? 64 : 0) | ((0   & 64) ? 128 : 0) | ((0   & 128) ? 256 : 0)};
          pg8::gemm_phase<pg8::EpiScale, pg8::StaticOrder, true, true>(F.lds + RING_OFF, g, S, E); }
        { pg8::Gemm g{MEMB, WKV, NMEMTOK, 2048, 1024}; pg8::StaticOrder S; S.init(NMEMTOK, 2048, F.G, (int)blockIdx.x);
          pg8::EpiScale E{KVM, RSM, nullptr, 2048, 0};
          pg8::gemm_phase<pg8::EpiScale, pg8::StaticOrder, true, true>(F.lds + RING_OFF, g, S, E); }
    }
    SEAM(PH_QKV);
        if (IN(PH_ATT)) {
        if (3 & 1) att::moba_phase2(F.lds, QKV, KMP, LUT, 0   ? (bf16*)(ws + WS_H1) : Y, 0   ? nullptr : SAB, F.vcu, F.G);
        __syncthreads();
        if (3 & 2) att::dil_phase(F.lds, QKV, LUT, Y, SAA, F.vcu, F.G);
    }

    SEAM(PH_ATT);

    if (IN(PH_OUT)) {
        pg8::Gemm g{Y, WOUT, NTOK, DM, 1024}; pg8::StaticOrder S; S.init(NTOK, DM, F.G, (int)blockIdx.x);
        pg8::EpiOutProj E{H1, x, SA1, SSA, SSB, DM, 0};
        pg8::gemm_phase<pg8::EpiOutProj, pg8::StaticOrder, true, true>(F.lds + RING_OFF, g, S, E);
    }
    SEAM(PH_OUT);
    if (IN(PH_QM)) {
        pg8::Gemm g{H1, WQ, NTOK, DM, 1024}; pg8::StaticOrder S; S.init(NTOK, DM, F.G, (int)blockIdx.x);
        pg8::EpiScale E{QM, SS1, nullptr, DM, 1};
        pg8::gemm_phase<pg8::EpiScale, pg8::StaticOrder, true, true>(F.lds + RING_OFF, g, S, E);
    }
    SEAM(PH_QM);
        if (IN(PH_CROSS)) att::cross_phase(F.lds, QM, KVM, OM, F.vcu, F.G, (0   >> 12) & 3);

    SEAM(PH_CROSS);
    if (IN(PH_OM)) {
        pg8::Gemm g{OM, WO, NTOK, DM, 1024}; pg8::StaticOrder S; S.init(NTOK, DM, F.G, (int)blockIdx.x);
        pg8::EpiResid E{H2, H1, SA2, DM, 0};
        pg8::gemm_phase<pg8::EpiResid, pg8::StaticOrder, true, true>(F.lds + RING_OFF, g, S, E);
    }
    SEAM(PH_OM);
    if (IN(PH_FFN1)) {
        pg8::Gemm g{H2, WGU, NTOK, 5632, 1024}; pg8::StaticOrder S; S.init(NTOK, 5632, F.G, (int)blockIdx.x);
        pg8::EpiFfn1 E{ACT, SS2, conv_w, conv_b, HALOG, FIXG, FIXU, (LAS float*)(F.lds + LDSX_OFF), (0   >> 8) & 3, 0};
        pg8::gemm_phase<pg8::EpiFfn1, pg8::StaticOrder, true, true>(F.lds + RING_OFF, g, S, E);
    }
    SEAM(PH_FFN1);
    if (IN(PH_FIX)) {
        for (int i = gt; i < 256 * 2816; i += NGT) { const int pm = i / 2816, c = i % 2816;
            const float g0 = FIXG[((size_t)pm * 2 + 0) * 2816 + c], g1 = FIXG[((size_t)pm * 2 + 1) * 2816 + c];
            float hm1 = 0.f, hm2 = 0.f; if (pm & 7) { hm2 = HALOG[((size_t)(pm - 1) * 2 + 0) * 2816 + c]; hm1 = HALOG[((size_t)(pm - 1) * 2 + 1) * 2816 + c]; }
            const float w0 = conv_w[c], w1 = conv_w[2816 + c], w2 = conv_w[2 * 2816 + c], cbv = conv_b[c];
            const float c0 = cbv + w2 * g0 + w1 * hm1 + w0 * hm2, c1 = cbv + w2 * g1 + w1 * g0 + w0 * hm1;
            ACT[((size_t)pm * 256 + 0) * 2816 + c] = (bf16)f2bf(c0 / (1.f + __expf(-c0)) * FIXU[((size_t)pm * 2 + 0) * 2816 + c]);
            ACT[((size_t)pm * 256 + 1) * 2816 + c] = (bf16)f2bf(c1 / (1.f + __expf(-c1)) * FIXU[((size_t)pm * 2 + 1) * 2816 + c]); }
    }
    SEAM(PH_FIX);
    if (IN(PH_DOWN)) {
        pg8::Gemm g{ACT, WD, NTOK, DM, DFF}; pg8::StaticOrder S0; S0.init(NTOK, DM, F.G, (int)blockIdx.x);
        pg8::EpiFinal<XcdBarrier> E{H2, args.out, g_final, PS, (unsigned*)(PS + NTOK)};
        { pg8::RoundOrder S{S0, 0}; pg8::gemm_phase<pg8::EpiFinal<XcdBarrier>, pg8::RoundOrder, false, true>(F.lds + RING_OFF, g, S, E); }
        __syncthreads();
        { pg8::RoundOrder S{S0, 1}; pg8::gemm_phase<pg8::EpiFinal<XcdBarrier>, pg8::RoundOrder, false, true>(F.lds + RING_OFF, g, S, E); }
        __syncthreads();
        { pg8::RoundOrder S{S0, 2}; pg8::gemm_phase<pg8::EpiFinal<XcdBarrier>, pg8::RoundOrder, false, true>(F.lds + RING_OFF, g, S, E); }
        __syncthreads();
        { pg8::RoundOrder S{S0, 3}; pg8::gemm_phase<pg8::EpiFinal<XcdBarrier>, pg8::RoundOrder, false, true>(F.lds + RING_OFF, g, S, E); }
    }
#undef IN
#undef SEAM
}


extern "C" void kernel_launch(void* const* d_in, const int* in_sizes, int n_in, void* d_out, int out_size, void* d_ws, size_t ws_size, hipStream_t stream) {
    static int grid = 0;
    if (grid == 0) {
        if (n_in != 20 || in_sizes[0] != NTOK * DM || out_size != NTOK * DM || ws_size < WS_END) { fprintf(stderr, "kernel_launch: unexpected shapes (n_in %d, ws %zu); nothing launched\n", n_in, ws_size); grid = -1; return; }
        int dev = 0, cus = 0, per_cu = 0;
        if (hipGetDevice(&dev) != hipSuccess || hipDeviceGetAttribute(&cus, hipDeviceAttributeMultiprocessorCount, dev) != hipSuccess) { grid = -1; return; }
        if (hipFuncSetAttribute((const void*)mega, hipFuncAttributeMaxDynamicSharedMemorySize, LDS_BYTES) != hipSuccess) { fprintf(stderr, "kernel_launch: hipFuncSetAttribute failed\n"); grid = -1; return; }
        if (hipOccupancyMaxActiveBlocksPerMultiprocessor(&per_cu, (const void*)mega, NWAVES * 64, LDS_BYTES) != hipSuccess || per_cu < 1) fprintf(stderr, "kernel_launch: occupancy query says %d\n", per_cu);
        (void)hipGetLastError();
        grid = cus;
        if (grid != NTOK / 256) { fprintf(stderr, "kernel_launch: this kernel needs exactly %d workgroups (one per CU of a 256-CU device); found %d CUs\n", NTOK / 256, cus); grid = NTOK / 256; }
    }
    if (grid < 0) return;
    unsigned char* ws = (unsigned char*)d_ws;
    (void)hipMemsetAsync(ws + WS_CTL, 0, CTL_ZERO_BYTES, stream);
    Args a{};
    for (int i = 0; i < 20; ++i) a.in[i] = (const float*)d_in[i];
    a.out = (float*)d_out; a.ws = ws; a.att_mask = 3;
    int nbar = 0;
    auto runx = [&](int lo, int hi, int mask, int dummy, int variant = 0) { Args b2 = a; b2.variant = variant; b2.bar_idx = (hi - lo > 1 || (lo <= PH_DOWN && PH_DOWN < hi)) ? nbar++ : 0; b2.ph_lo = lo; b2.ph_hi = hi; b2.att_mask = mask; b2.ss_dummy = dummy; hipLaunchKernelGGL(mega, dim3(grid), dim3(NWAVES * 64), LDS_BYTES, stream, b2); };
    auto run = [&](int lo, int hi) { runx(lo, hi, 3, 0); };
    run(0, PH_N);
}
```

```cpp
#include <hip/hip_runtime.h>
#include <cstdio>
#include <cstdint>

typedef unsigned short bf16;
constexpr int BATCH = 32, SEQ = 2048, DM = 1024, NTOK = BATCH * SEQ;
constexpr int NMEM = 256, NMEMTOK = BATCH * NMEM, DFF = 2816;
constexpr int NQKV = 3072;
constexpr float EPS = 1e-6f;

constexpr size_t MiB = 1u << 20;
constexpr size_t WS_CTL = 0, CTL_ZERO_BYTES = 64 * 1024;
constexpr size_t WS_RS0 = 1 * MiB;
constexpr size_t WS_RSM = WS_RS0 + 256 * 1024;
constexpr size_t WS_SS1 = WS_RSM + 256 * 1024;
constexpr size_t WS_SS2 = WS_SS1 + 256 * 1024;
constexpr size_t WS_SS3 = WS_SS2 + 256 * 1024;
constexpr size_t WS_SSA = 27 * MiB, WS_SSB = WS_SSA + 256 * 1024;
constexpr size_t WS_KMEAN = WS_SS3 + 256 * 1024;
constexpr size_t WS_LUT = WS_KMEAN + 512 * 1024;
constexpr size_t WS_KMP = 3 * MiB;
constexpr size_t WS_HALOG = 4 * MiB;
constexpr size_t WS_FIXG = WS_HALOG + 256 * 2 * 2816 * 4;
constexpr size_t WS_FIXU = WS_FIXG + 256 * 2 * 2816 * 4;
constexpr size_t WS_DUMMY = 21 * MiB;
constexpr size_t WS_PS = 22 * MiB;
constexpr size_t WS_RN0 = 24 * MiB;
constexpr size_t WS_LSEP = 23 * MiB;
constexpr size_t WS_WIN = 28 * MiB;
constexpr size_t WS_WOUT = WS_WIN + 6 * MiB;
constexpr size_t WS_WQ = WS_WOUT + 2 * MiB;
constexpr size_t WS_WKV = WS_WQ + 2 * MiB;
constexpr size_t WS_WO = WS_WKV + 4 * MiB;
constexpr size_t WS_WGU = WS_WO + 2 * MiB;
constexpr size_t WS_WD = WS_WGU + 11 * MiB;
constexpr size_t WS_MEMB = 62 * MiB;
constexpr size_t WS_KVM = 78 * MiB;
constexpr size_t WS_XB = 112 * MiB;
constexpr size_t WS_QKV = 240 * MiB;
constexpr size_t WS_Y = 624 * MiB;
constexpr size_t WS_OP = 752 * MiB;
constexpr size_t WS_YN = 240 * MiB;
constexpr size_t WS_H1 = 880 * MiB;
constexpr size_t WS_QM = 368 * MiB;
constexpr size_t WS_OM = 496 * MiB;
constexpr size_t WS_H2 = 624 * MiB;
constexpr size_t WS_ACT = 112 * MiB;
constexpr size_t WS_GU = 752 * MiB;
constexpr size_t WS_H3 = 464 * MiB;
constexpr size_t WS_END = 1024 * MiB;
static_assert(WS_FIXU + 256 * 2 * 2816 * 4 <= WS_LSEP && WS_LSEP + 5 * MiB <= WS_WIN && WS_WD + 6 * MiB <= WS_MEMB, "ws map");

__device__ __forceinline__ unsigned f2bf(float f) { unsigned u = __builtin_bit_cast(unsigned, f); return (u + 0x7fffu + ((u >> 16) & 1u)) >> 16; }
__device__ __forceinline__ float bf2f(bf16 b) { return __builtin_bit_cast(float, (unsigned)b << 16); }
__device__ __forceinline__ float bflo(unsigned w) { return __builtin_bit_cast(float, w << 16); }
__device__ __forceinline__ float bfhi(unsigned w) { return __builtin_bit_cast(float, w & 0xffff0000u); }
__device__ __forceinline__ float wave_sum(float v) {
#pragma unroll
    for (int o = 1; o < 64; o <<= 1) v += __shfl_xor(v, o);
    return v;
}


namespace pg8 {
#define PG8_LAS __attribute__((address_space(3)))
typedef unsigned short bf16_t;
typedef short bf16x8 __attribute__((ext_vector_type(8)));
typedef float f32x4 __attribute__((ext_vector_type(4)));
typedef unsigned u32x4 __attribute__((ext_vector_type(4)));
constexpr int BM = 256, BK = 64, HALF = 128, HTB = HALF * BK * 2  , STAGE_BYTES = 8 * HTB, NXCD = 8, WGM = 8;

__host__ __device__ __forceinline__ int lds_byte(int r, int c) { const int st = (r >> 4) * 2 + (c >> 5), rr = r & 15, cc = c & 31, ob = rr * 64 + cc * 2; return st * 1024 + (ob ^ (((ob >> 9) & 1) << 5)); }
__host__ __device__ __forceinline__ void stage_rc(int b, int& R, int& C) { const int st = b / 1024, sb = b % 1024, swz = sb ^ (((sb >> 9) & 1) << 5); R = (st >> 1) * 16 + swz / 64; C = (st & 1) * 32 + (swz % 64) / 2; }
__host__ __device__ __forceinline__ int perm32(int rho) { const int n = rho >> 4, i = rho & 15; return 8 * (i >> 2) + 4 * n + (i & 3); }

struct Unit { int pm, pn; };
struct Gemm { const bf16_t* A; const bf16_t* Bt; int M, N, K; };

struct StaticOrder {
    int nM, nN, nwg, G, c;
    __host__ __device__ void init(int M, int N, int G_, int c_) { nM = M / BM; nN = N / BM; nwg = nM * nN; G = G_; c = c_; }
    __host__ __device__ bool next(int i, Unit& u) const {
        const long L = (long)i * G + c; if (L >= nwg) return false;
        int wgid = (int)L; { const int q = nwg / NXCD, r = nwg % NXCD, xcd = wgid % NXCD, off = wgid / NXCD; wgid = (xcd < r ? xcd * (q + 1) : r * (q + 1) + (xcd - r) * q) + off; }
        const int nig = WGM * nN, gid = wgid / nig, fm = gid * WGM, gsz = (nM - fm) < WGM ? (nM - fm) : WGM;
        u.pm = fm + ((wgid % nig) % gsz); u.pn = (wgid % nig) / gsz; return true;
    }
    __device__ __forceinline__ void a_ready(const Unit&) const {}
    __device__ __forceinline__ void done(const Unit&) const {}
};


struct PanelOrder { int pm, nN;
    __device__ __forceinline__ bool next(int i, Unit& u) const { if (i >= nN) return false; int a = pm, b = i; asm volatile("" : "+s"(a), "+s"(b)); u.pm = a; u.pn = b; return true; }
    __device__ __forceinline__ void a_ready(const Unit&) const {}
    __device__ __forceinline__ void done(const Unit&) const {} };
__device__ __forceinline__ unsigned cvt_pk_bf16(float lo, float hi) { unsigned r; asm volatile("v_cvt_pk_bf16_f32 %0, %1, %2" : "=v"(r) : "v"(lo), "v"(hi)); return r; }
__device__ __forceinline__ float lo_f(unsigned w) { return __builtin_bit_cast(float, w << 16); }
__device__ __forceinline__ float hi_f(unsigned w) { return __builtin_bit_cast(float, w & 0xffff0000u); }

struct EpiScale {
    static constexpr bool PERM = true, AFTER_DRAIN = false, KSPLIT = false, PERM_A = false;
    bf16_t* O; const float* rs; float* kmp; int ldc; int mode;
    __device__ __forceinline__ void operator()(const f32x4 (&acc)[2][2][4][2], const Unit& u, int wr, int wc, int fr, int fq) const {
        if (mode & 64) return;
        const int row0 = u.pm * BM + wr * 64 + fr, col0 = u.pn * BM + wc * 32 + 8 * fq;
        const bool dokm = (kmp != nullptr) && (u.pn == 8 || u.pn == 9);
        const float qs = ((kmp != nullptr) && (u.pn < 2 || u.pn == 6 || u.pn == 7)) ? 0.125f * 1.4426950408889634f : 1.f;
        float cs[2][8];
#pragma unroll
        for (int bj = 0; bj < 2; ++bj)
#pragma unroll
            for (int e = 0; e < 8; ++e) cs[bj][e] = 0.f;
#pragma unroll
        for (int ai = 0; ai < 2; ++ai)
#pragma unroll
            for (int m = 0; m < 4; ++m) { const int r = row0 + ai * HALF + m * 16; float s = qs; if (mode == 1) s = rsqrtf(rs[r] * (1.f / 1024.f) + 1e-6f);
                bf16_t* rowp = (mode & 256) ? O + (size_t)(r & 255) * ldc + col0 : O + (size_t)r * ldc + col0;
#pragma unroll
                for (int bj = 0; bj < 2; ++bj) { const f32x4 v0 = acc[ai][bj][m][0] * s, v1 = acc[ai][bj][m][1] * s;
                    u32x4 w; w.x = cvt_pk_bf16(v0[0], v0[1]); w.y = cvt_pk_bf16(v0[2], v0[3]); w.z = cvt_pk_bf16(v1[0], v1[1]); w.w = cvt_pk_bf16(v1[2], v1[3]);
                    if (mode & 128) { asm volatile("" :: "v"(w.x), "v"(w.y), "v"(w.z), "v"(w.w)); } else *(u32x4*)(rowp + bj * HALF) = w;
                    if (dokm) { cs[bj][0] += lo_f(w.x); cs[bj][1] += hi_f(w.x); cs[bj][2] += lo_f(w.y); cs[bj][3] += hi_f(w.y); cs[bj][4] += lo_f(w.z); cs[bj][5] += hi_f(w.z); cs[bj][6] += lo_f(w.w); cs[bj][7] += hi_f(w.w); } } }
        if (dokm) {
#pragma unroll
            for (int bj = 0; bj < 2; ++bj)
#pragma unroll
                for (int e = 0; e < 8; ++e) { float v = cs[bj][e]; v += __shfl_xor(v, 1); v += __shfl_xor(v, 2); v += __shfl_xor(v, 4); v += __shfl_xor(v, 8); cs[bj][e] = v; }
            if (fr == 0) { float* kp = kmp + (size_t)(u.pm * 2 + wr) * 512 + (u.pn - 8) * 256 + wc * 32 + 8 * fq;
#pragma unroll
                for (int bj = 0; bj < 2; ++bj) { *(f32x4*)(kp + bj * HALF) = (f32x4){cs[bj][0], cs[bj][1], cs[bj][2], cs[bj][3]}; *(f32x4*)(kp + bj * HALF + 4) = (f32x4){cs[bj][4], cs[bj][5], cs[bj][6], cs[bj][7]}; } }
        }
    }
};

struct EpiResid {
    static constexpr bool PERM = true, AFTER_DRAIN = false, KSPLIT = false, PERM_A = false;
    bf16_t* O; const bf16_t* R; float* ss; int ldc; int pad;
    __device__ __forceinline__ void operator()(const f32x4 (&acc)[2][2][4][2], const Unit& u, int wr, int wc, int fr, int fq) const {
        const int row0 = u.pm * BM + wr * 64 + fr, col0 = u.pn * BM + wc * 32 + 8 * fq;
#pragma unroll
        for (int ai = 0; ai < 2; ++ai)
#pragma unroll
            for (int m = 0; m < 4; ++m) { const int r = row0 + ai * HALF + m * 16; const size_t off = (size_t)r * ldc + col0; float sq = 0.f;
#pragma unroll
                for (int bj = 0; bj < 2; ++bj) { const u32x4 rv = *(const u32x4*)(R + off + bj * HALF);
                    const f32x4 a0 = acc[ai][bj][m][0], a1 = acc[ai][bj][m][1];
                    u32x4 w; w.x = cvt_pk_bf16(a0[0] + lo_f(rv.x), a0[1] + hi_f(rv.x)); w.y = cvt_pk_bf16(a0[2] + lo_f(rv.y), a0[3] + hi_f(rv.y));
                    w.z = cvt_pk_bf16(a1[0] + lo_f(rv.z), a1[1] + hi_f(rv.z)); w.w = cvt_pk_bf16(a1[2] + lo_f(rv.w), a1[3] + hi_f(rv.w));
                    *(u32x4*)(O + off + bj * HALF) = w;
                    float t;
                    t = lo_f(w.x); sq += t * t; t = hi_f(w.x); sq += t * t; t = lo_f(w.y); sq += t * t; t = hi_f(w.y); sq += t * t;
                    t = lo_f(w.z); sq += t * t; t = hi_f(w.z); sq += t * t; t = lo_f(w.w); sq += t * t; t = hi_f(w.w); sq += t * t; }
                sq += __shfl_xor(sq, 16); sq += __shfl_xor(sq, 32);
                if (fq == 0) atomicAdd(ss + r, sq); }
    }
};


struct EpiResidF32 {
    static constexpr bool PERM = true, AFTER_DRAIN = false, KSPLIT = false, PERM_A = false;
    bf16_t* O; const float* R; float* ss; int ldc; int pad;
    __device__ __forceinline__ void operator()(const f32x4 (&acc)[2][2][4][2], const Unit& u, int wr, int wc, int fr, int fq) const {
        const int row0 = u.pm * BM + wr * 64 + fr, col0 = u.pn * BM + wc * 32 + 8 * fq;
#pragma unroll
        for (int ai = 0; ai < 2; ++ai)
#pragma unroll
            for (int m = 0; m < 4; ++m) { const int r = row0 + ai * HALF + m * 16; const size_t off = (size_t)r * ldc + col0; float sq = 0.f;
#pragma unroll
                for (int bj = 0; bj < 2; ++bj) { const f32x4 r0 = *(const f32x4*)(R + off + bj * HALF), r1 = *(const f32x4*)(R + off + bj * HALF + 4);
                    const f32x4 a0 = acc[ai][bj][m][0] + r0, a1 = acc[ai][bj][m][1] + r1;
                    u32x4 w; w.x = cvt_pk_bf16(a0[0], a0[1]); w.y = cvt_pk_bf16(a0[2], a0[3]); w.z = cvt_pk_bf16(a1[0], a1[1]); w.w = cvt_pk_bf16(a1[2], a1[3]);
                    *(u32x4*)(O + off + bj * HALF) = w;
                    float t;
                    t = lo_f(w.x); sq += t * t; t = hi_f(w.x); sq += t * t; t = lo_f(w.y); sq += t * t; t = hi_f(w.y); sq += t * t;
                    t = lo_f(w.z); sq += t * t; t = hi_f(w.z); sq += t * t; t = lo_f(w.w); sq += t * t; t = hi_f(w.w); sq += t * t; }
                sq += __shfl_xor(sq, 16); sq += __shfl_xor(sq, 32);
                if (fq == 0) atomicAdd(ss + r, sq); }
    }
};


struct EpiOutProj {
    static constexpr bool PERM = true, AFTER_DRAIN = false, KSPLIT = true, PERM_A = false;
    bf16_t* O; const bf16_t* R; const float* rn; float* ss; const float* ssa; const float* ssb; int ldc; int pad;
    __device__ __forceinline__ void mid(f32x4 (&acc)[2][2][4][2], const Unit& u, int wr, int fr) const {
        asm volatile("" : "+v"(fr));
#pragma unroll
        for (int ai = 0; ai < 2; ++ai) {
#pragma unroll
            for (int m = 0; m < 4; ++m) { const int r = u.pm * BM + ai * HALF + wr * 64 + m * 16 + fr;
                const float ratio = rsqrtf(ssa[r] * (1.f / 512.f) + 1e-6f) * sqrtf(ssb[r] * (1.f / 512.f) + 1e-6f);
#pragma unroll
                for (int bj = 0; bj < 2; ++bj) { acc[ai][bj][m][0] *= ratio; acc[ai][bj][m][1] *= ratio; } }
            asm volatile("" ::: "memory"); __builtin_amdgcn_sched_barrier(0); }
    }
    __device__ __forceinline__ void operator()(const f32x4 (&acc)[2][2][4][2], const Unit& u, int wr, int wc, int fr, int fq) const {
        const int row0 = u.pm * BM + wr * 64 + fr, col0 = u.pn * BM + wc * 32 + 8 * fq;
#pragma unroll
        for (int ai = 0; ai < 2; ++ai)
#pragma unroll
            for (int m = 0; m < 4; ++m) { const int r = row0 + ai * HALF + m * 16; const size_t off = (size_t)r * ldc + col0; float sq = 0.f;
                const float rsb = rsqrtf(ssb[r] * (1.f / 512.f) + 1e-6f), xs = rn[r];
#pragma unroll
                for (int bj = 0; bj < 2; ++bj) { const u32x4 rv = *(const u32x4*)(R + off + bj * HALF);
                    const f32x4 r0 = (f32x4){lo_f(rv.x), hi_f(rv.x), lo_f(rv.y), hi_f(rv.y)} * xs, r1 = (f32x4){lo_f(rv.z), hi_f(rv.z), lo_f(rv.w), hi_f(rv.w)} * xs;
                    const f32x4 a0 = acc[ai][bj][m][0] * rsb + r0, a1 = acc[ai][bj][m][1] * rsb + r1;
                    u32x4 w; w.x = cvt_pk_bf16(a0[0], a0[1]); w.y = cvt_pk_bf16(a0[2], a0[3]); w.z = cvt_pk_bf16(a1[0], a1[1]); w.w = cvt_pk_bf16(a1[2], a1[3]);
                    *(u32x4*)(O + off + bj * HALF) = w;
                    float t;
                    t = lo_f(w.x); sq += t * t; t = hi_f(w.x); sq += t * t; t = lo_f(w.y); sq += t * t; t = hi_f(w.y); sq += t * t;
                    t = lo_f(w.z); sq += t * t; t = hi_f(w.z); sq += t * t; t = lo_f(w.w); sq += t * t; t = hi_f(w.w); sq += t * t; }
                sq += __shfl_xor(sq, 16); sq += __shfl_xor(sq, 32);
                if (fq == 0) atomicAdd(ss + r, sq); }
    }
};

struct RoundOrder { StaticOrder S; int r;
    __device__ __forceinline__ bool next(int i, Unit& u) const { return i == 0 && S.next(r, u); }
    __device__ __forceinline__ void a_ready(const Unit&) const {}
    __device__ __forceinline__ void done(const Unit&) const {} };
template <class Bar> struct EpiFinal {
    static constexpr bool PERM = false, AFTER_DRAIN = true, KSPLIT = false, PERM_A = false;
    const bf16_t* R; float* out; const float* g; float* ps; unsigned* pcnt;
    __device__ __forceinline__ void fused(f32x4 (&acc)[2][2][4][2], const Unit& u, int wr, int wc, int fr, int fq, PG8_LAS unsigned char* lds, int wid, int lane) const {
        typedef unsigned u32x2v __attribute__((ext_vector_type(2)));
        PG8_LAS float* P = (PG8_LAS float*)lds;
        PG8_LAS float* S = (PG8_LAS float*)(lds + 4096);
        const int col0 = u.pn * BM + wc * 32 + 4 * fq, tid = wid * 64 + lane;
#pragma unroll
        for (int ai = 0; ai < 2; ++ai)
#pragma unroll
            for (int m = 0; m < 4; ++m) { const int rl = ai * HALF + wr * 64 + m * 16 + fr; const size_t off = (size_t)(u.pm * BM + rl) * 1024 + col0; float sq = 0.f;
#pragma unroll
                for (int bj = 0; bj < 2; ++bj)
#pragma unroll
                    for (int n = 0; n < 2; ++n) { const u32x2v rv = *(const u32x2v*)(R + off + bj * HALF + n * 16);
                        f32x4 v = acc[ai][bj][m][n]; v[0] += lo_f(rv.x); v[1] += hi_f(rv.x); v[2] += lo_f(rv.y); v[3] += hi_f(rv.y); acc[ai][bj][m][n] = v;
                        sq += (v[0] * v[0] + v[1] * v[1]) + (v[2] * v[2] + v[3] * v[3]); }
                sq += __shfl_xor(sq, 16); sq += __shfl_xor(sq, 32);
                if (fq == 0) P[rl * 4 + wc] = sq; }
        asm volatile("s_waitcnt lgkmcnt(0)" ::: "memory"); __builtin_amdgcn_s_barrier(); asm volatile("" ::: "memory");
        if (tid < 256) { const f32x4 p4 = *(const PG8_LAS f32x4*)(P + tid * 4); (void)__hip_atomic_fetch_add(ps + (size_t)u.pm * BM + tid, (p4[0] + p4[1]) + (p4[2] + p4[3]), __ATOMIC_RELAXED, __HIP_MEMORY_SCOPE_AGENT); }
        asm volatile("s_waitcnt vmcnt(0)" ::: "memory"); __syncthreads();
        if (tid == 0) { (void)__hip_atomic_fetch_add(pcnt + u.pm, 1u, __ATOMIC_RELAXED, __HIP_MEMORY_SCOPE_AGENT);
            unsigned sp = 0u; while (__hip_atomic_load(pcnt + u.pm, __ATOMIC_RELAXED, __HIP_MEMORY_SCOPE_AGENT) < 4u) { __builtin_amdgcn_s_sleep(1); if (++sp > (1u << 22)) break; } }
        __syncthreads();
        if (tid < 256) { const float q = __hip_atomic_load(ps + (size_t)u.pm * BM + tid, __ATOMIC_RELAXED, __HIP_MEMORY_SCOPE_AGENT); S[tid] = rsqrtf(q * (1.f / 1024.f) + 1e-6f); }
        asm volatile("s_waitcnt vmcnt(0) lgkmcnt(0)" ::: "memory"); __builtin_amdgcn_s_barrier(); asm volatile("" ::: "memory");
        f32x4 gv[2][2];
#pragma unroll
        for (int bj = 0; bj < 2; ++bj)
#pragma unroll
            for (int n = 0; n < 2; ++n) gv[bj][n] = *(const f32x4*)(g + col0 + bj * HALF + n * 16);
#pragma unroll
        for (int ai = 0; ai < 2; ++ai)
#pragma unroll
            for (int m = 0; m < 4; ++m) { const int rl = ai * HALF + wr * 64 + m * 16 + fr; const float rs = S[rl]; const size_t off = (size_t)(u.pm * BM + rl) * 1024 + col0;
#pragma unroll
                for (int bj = 0; bj < 2; ++bj)
#pragma unroll
                    for (int n = 0; n < 2; ++n) *(f32x4*)(out + off + bj * HALF + n * 16) = acc[ai][bj][m][n] * rs * gv[bj][n]; }
        asm volatile("s_waitcnt lgkmcnt(0)" ::: "memory"); __builtin_amdgcn_s_barrier(); asm volatile("" ::: "memory");
    }
};

__device__ __forceinline__ float dpp_shr1(float oldv, float src) { return __builtin_bit_cast(float, __builtin_amdgcn_update_dpp(__builtin_bit_cast(int, oldv), __builtin_bit_cast(int, src), 0x111, 0xf, 0xf, false)); }
__device__ __forceinline__ float dpp_shr2(float oldv, float src) { return __builtin_bit_cast(float, __builtin_amdgcn_update_dpp(__builtin_bit_cast(int, oldv), __builtin_bit_cast(int, src), 0x112, 0xf, 0xf, false)); }
__device__ __forceinline__ float dpp_ror1(float src) { return __builtin_bit_cast(float, __builtin_amdgcn_update_dpp(0, __builtin_bit_cast(int, src), 0x121, 0xf, 0xf, false)); }
__device__ __forceinline__ float dpp_ror2(float src) { return __builtin_bit_cast(float, __builtin_amdgcn_update_dpp(0, __builtin_bit_cast(int, src), 0x122, 0xf, 0xf, false)); }
struct EpiFfn1 {
    static constexpr bool PERM = true, AFTER_DRAIN = false, KSPLIT = false, PERM_A = true;
    bf16_t* ACT; const float* ss2; const float* cw; const float* cb; float* halog; float* fixg; float* fixu; PG8_LAS float* hl; int probe, pad;
    __device__ __forceinline__ void operator()(const f32x4 (&acc)[2][2][4][2], const Unit& u, int wr, int wc, int fr, int fq) const {
        constexpr int FF = 2816;
        if (probe & 1) return;
        const int ch0 = u.pn * HALF + wc * 32 + 8 * fq;
        float rsv[2][4];
#pragma unroll
        for (int ai = 0; ai < 2; ++ai) { const f32x4 s4 = *(const f32x4*)(ss2 + u.pm * BM + ai * HALF + wr * 64 + 4 * fr);
#pragma unroll
            for (int m = 0; m < 4; ++m) rsv[ai][m] = rsqrtf(s4[m] * (1.f / 1024.f) + 1e-6f); }
        if (fr == 15) {
#pragma unroll
            for (int ai = 0; ai < 2; ++ai) { const int G = 2 * ai + wr;
#pragma unroll
                for (int j = 0; j < 2; ++j) { PG8_LAS float* p = hl + (((G * 4 + wc) * 2 + j) * 4 + fq) * 8;
                    *(PG8_LAS f32x4*)p = acc[ai][0][2 + j][0] * rsv[ai][2 + j]; *(PG8_LAS f32x4*)(p + 4) = acc[ai][0][2 + j][1] * rsv[ai][2 + j]; } } }
        constexpr float L2E = 1.4426950408889634f, IL2E = 0.6931471805599453f;
        const f32x4 w0a = *(const f32x4*)(cw + ch0) * L2E, w0b = *(const f32x4*)(cw + ch0 + 4) * L2E, w1a = *(const f32x4*)(cw + FF + ch0) * L2E, w1b = *(const f32x4*)(cw + FF + ch0 + 4) * L2E;
        const f32x4 w2a = *(const f32x4*)(cw + 2 * FF + ch0) * L2E, w2b = *(const f32x4*)(cw + 2 * FF + ch0 + 4) * L2E, cba = *(const f32x4*)(cb + ch0) * L2E, cbb = *(const f32x4*)(cb + ch0 + 4) * L2E;
        asm volatile("s_waitcnt lgkmcnt(0)" ::: "memory"); __builtin_amdgcn_s_barrier(); asm volatile("" ::: "memory");
#pragma unroll
        for (int ai = 0; ai < 2; ++ai) { const int G = 2 * ai + wr; const int rbase = u.pm * BM + ai * HALF + wr * 64 + 4 * fr;
            f32x4 h2a = (f32x4){0.f, 0.f, 0.f, 0.f}, h2b = h2a, h3a = h2a, h3b = h2a;
            if (G > 0 && fr == 0) { const PG8_LAS float* p = hl + ((((G - 1) * 4 + wc) * 2) * 4 + fq) * 8; h2a = *(const PG8_LAS f32x4*)p; h2b = *(const PG8_LAS f32x4*)(p + 4); h3a = *(const PG8_LAS f32x4*)(p + 32); h3b = *(const PG8_LAS f32x4*)(p + 36); }
            f32x4 g[4][2], uu[4][2];
#pragma unroll
            for (int m = 0; m < 4; ++m) { const float s = rsv[ai][m]; g[m][0] = acc[ai][0][m][0] * s; g[m][1] = acc[ai][0][m][1] * s; uu[m][0] = acc[ai][1][m][0] * (s * IL2E); uu[m][1] = acc[ai][1][m][1] * (s * IL2E); }
            f32x4 s2[2], s3[2];
#pragma unroll
            for (int e = 0; e < 4; ++e) { s3[0][e] = dpp_shr1(h3a[e], g[3][0][e]); s3[1][e] = dpp_shr1(h3b[e], g[3][1][e]); s2[0][e] = dpp_shr1(h2a[e], g[2][0][e]); s2[1][e] = dpp_shr1(h2b[e], g[2][1][e]); }
#pragma unroll
            for (int m = 0; m < 4; ++m) {
                f32x4 o[2];
#pragma unroll
                for (int hx = 0; hx < 2; ++hx) { const f32x4 w0 = hx ? w0b : w0a, w1 = hx ? w1b : w1a, w2 = hx ? w2b : w2a, cbx = hx ? cbb : cba;
                    const f32x4 g1 = (m == 0) ? s3[hx] : g[m - 1][hx], g2 = (m == 0) ? s2[hx] : (m == 1 ? s3[hx] : g[m - 2][hx]);
#pragma unroll
                    for (int e = 0; e < 4; ++e) { const float c = __builtin_fmaf(w0[e], g2[e], __builtin_fmaf(w1[e], g1[e], __builtin_fmaf(w2[e], g[m][hx][e], cbx[e])));
                        o[hx][e] = c * __builtin_amdgcn_rcpf(1.f + __builtin_amdgcn_exp2f(-c)) * uu[m][hx][e]; } }
                const bool defer = (G == 0 && fr == 0 && m < 2);
                if (defer) { float* pg = fixg + ((size_t)u.pm * 2 + m) * FF + ch0; float* pu = fixu + ((size_t)u.pm * 2 + m) * FF + ch0;
                    *(f32x4*)pg = g[m][0]; *(f32x4*)(pg + 4) = g[m][1]; *(f32x4*)pu = uu[m][0] * L2E; *(f32x4*)(pu + 4) = uu[m][1] * L2E; }
                else { u32x4 w; w.x = cvt_pk_bf16(o[0][0], o[0][1]); w.y = cvt_pk_bf16(o[0][2], o[0][3]); w.z = cvt_pk_bf16(o[1][0], o[1][1]); w.w = cvt_pk_bf16(o[1][2], o[1][3]);
                    if (probe & 2) { asm volatile("" :: "v"(w.x), "v"(w.y), "v"(w.z), "v"(w.w)); } else *(u32x4*)(ACT + (size_t)(rbase + m) * FF + ch0) = w; }
                if (G == 3 && fr == 15 && m >= 2) { float* ph = halog + ((size_t)u.pm * 2 + (m - 2)) * FF + ch0; *(f32x4*)ph = g[m][0]; *(f32x4*)(ph + 4) = g[m][1]; } } }
    }
};

template <class Epi, class Sched, bool ALIGN_EPI = false, bool SP2 = false>
__device__ __forceinline__ void gemm_phase(PG8_LAS unsigned char* lds, const Gemm g, const Sched& S, const Epi& E) {
    int tid_ = threadIdx.x; asm volatile("" : "+v"(tid_));
    const int tid = tid_, wid = __builtin_amdgcn_readfirstlane(tid >> 6), lane = tid & 63, wr = wid >> 2, wc = wid & 3, fr = lane & 15, fq = lane >> 4;
    const int K = g.K, nt = K / BK;
    unsigned voffA[2], voffB[2];
#pragma unroll
    for (int i = 0; i < 2; ++i) { int R, C; stage_rc(tid * 16 + i * 8192, R, C); const int Rb = Epi::PERM ? ((R & ~31) + perm32(R & 31)) : R;
        const int Ra = Epi::PERM_A ? ((R & ~63) + 4 * (R & 15) + ((R >> 4) & 3)) : R;
        voffA[i] = (unsigned)(Ra * K + C) * 2u; voffB[i] = (unsigned)(Rb * K + C) * 2u; }
    const size_t kstep = (size_t)(BK * 2);
    const size_t hstep = (size_t)HALF * K * 2;
    const size_t tstep = 2 * hstep;
    const unsigned ldsw = (unsigned)wid * 1024u;
    const int aoff = lds_byte(wr * 64 + fr, fq * 8), boff = lds_byte(wc * 32 + fr, fq * 8);
#define PG8_SA(b, h) (((b) * 2 + (h)) * HTB)
#define PG8_SB(b, h) ((4 + (b) * 2 + (h)) * HTB)
#define PG8_STAGE(bufoff, gbase, voff) do { _Pragma("unroll") for (int _i = 0; _i < 2; ++_i) \
        __builtin_amdgcn_global_load_lds((const unsigned*)((const char*)(gbase) + (voff)[_i]), (PG8_LAS unsigned*)(lds + (bufoff) + ldsw + _i * 8192), 16, 0, 0); } while (0)
#define PG8_LDA(dst, b, h) do { _Pragma("unroll") for (int m = 0; m < 4; ++m) _Pragma("unroll") for (int k = 0; k < 2; ++k) dst[m][k] = *(const PG8_LAS bf16x8*)(lds + PG8_SA(b, h) + aoff + m * 2048 + k * 1024); } while (0)
#define PG8_LDB(dst, b, h) do { _Pragma("unroll") for (int n = 0; n < 2; ++n) _Pragma("unroll") for (int k = 0; k < 2; ++k) dst[n][k] = *(const PG8_LAS bf16x8*)(lds + PG8_SB(b, h) + boff + n * 2048 + k * 1024); } while (0)
#define PG8_MMA(ai, bj, At, Bt) do { __builtin_amdgcn_s_setprio(1); _Pragma("unroll") for (int m = 0; m < 4; ++m) _Pragma("unroll") for (int n = 0; n < 2; ++n) _Pragma("unroll") for (int k = 0; k < 2; ++k) \
        acc[ai][bj][m][n] = __builtin_amdgcn_mfma_f32_16x16x32_bf16(Bt[n][k], At[m][k], acc[ai][bj][m][n], 0, 0, 0); __builtin_amdgcn_s_setprio(0); } while (0)
#define PG8_WAIT_V(n) asm volatile("s_waitcnt vmcnt(" #n ")" ::: "memory")
#define PG8_WAIT_L(n) asm volatile("s_waitcnt lgkmcnt(" #n ")" ::: "memory")
#define PG8_BAR __builtin_amdgcn_s_barrier()
#define PG8_SCHED __builtin_amdgcn_sched_barrier(0)
    Unit cur, nxt; int ui = 0;
    if (!S.next(0, cur)) return;
    f32x4 acc[2][2][4][2];
#pragma unroll
    for (int a = 0; a < 2; ++a)
#pragma unroll
        for (int b = 0; b < 2; ++b)
#pragma unroll
            for (int m = 0; m < 4; ++m)
#pragma unroll
                for (int n = 0; n < 2; ++n) acc[a][b][m][n] = (f32x4){0.f, 0.f, 0.f, 0.f};
    bf16x8 At[4][2], B0[2][2], B1[2][2];
    const char* cA = (const char*)g.A + (size_t)cur.pm * tstep; const char* cB = (const char*)g.Bt + (size_t)cur.pn * tstep;
    S.a_ready(cur);
    if constexpr (SP2) {
        PG8_STAGE(PG8_SB(0, 0), cB, voffB); PG8_STAGE(PG8_SB(0, 1), cB + hstep, voffB); PG8_STAGE(PG8_SA(0, 0), cA, voffA); PG8_STAGE(PG8_SA(0, 1), cA + hstep, voffA);
        if (wr == 1) PG8_BAR;
        PG8_WAIT_V(2); PG8_BAR;
        PG8_STAGE(PG8_SB(1, 0), cB + kstep, voffB); PG8_STAGE(PG8_SA(1, 0), cA + kstep, voffA); PG8_STAGE(PG8_SB(1, 1), cB + hstep + kstep, voffB);
        PG8_WAIT_V(6); PG8_BAR;
    } else {
        PG8_STAGE(PG8_SB(0, 0), cB, voffB); PG8_STAGE(PG8_SA(0, 0), cA, voffA); PG8_STAGE(PG8_SB(0, 1), cB + hstep, voffB); PG8_STAGE(PG8_SA(0, 1), cA + hstep, voffA);
        if (wr == 1) PG8_BAR;
        PG8_WAIT_V(4); PG8_BAR;
        PG8_STAGE(PG8_SB(1, 0), cB + kstep, voffB); PG8_STAGE(PG8_SA(1, 0), cA + kstep, voffA); PG8_STAGE(PG8_SB(1, 1), cB + hstep + kstep, voffB);
        PG8_WAIT_V(6); PG8_BAR;
    }
    for (;;) {
        const bool has_next = S.next(ui + 1, nxt);
        const char* nA = has_next ? (const char*)g.A + (size_t)nxt.pm * tstep : cA; const char* nB = has_next ? (const char*)g.Bt + (size_t)nxt.pn * tstep : cB;
        for (int t = 0; t < nt; t += 2) {
            if constexpr (Epi::KSPLIT) { if (t == nt / 2) E.mid(acc, cur, wr, fr); }
            const bool last = (t == nt - 2);
            const char* a1 = cA + (size_t)(t + 1) * kstep;
            const char* a2 = last ? nA : cA + (size_t)(t + 2) * kstep; const char* b2 = last ? nB : cB + (size_t)(t + 2) * kstep;
            const char* a3 = a2 + kstep; const char* b3 = b2 + kstep;
            if (last && has_next) S.a_ready(nxt);
            if constexpr (SP2) {
            PG8_LDB(B0, 0, 0); PG8_LDB(B1, 0, 1); PG8_SCHED; PG8_LDA(At, 0, 0); PG8_STAGE(PG8_SA(1, 1), a1 + hstep, voffA);
            PG8_WAIT_V(8); PG8_WAIT_L(0); PG8_BAR; PG8_MMA(0, 0, At, B0); PG8_MMA(0, 1, At, B1); PG8_BAR; PG8_SCHED;
            PG8_LDA(At, 0, 1); PG8_STAGE(PG8_SB(0, 0), b2, voffB); PG8_STAGE(PG8_SB(0, 1), b2 + hstep, voffB); PG8_STAGE(PG8_SA(0, 0), a2, voffA);
            PG8_WAIT_V(8); PG8_WAIT_L(0); PG8_BAR; PG8_MMA(1, 0, At, B0); PG8_MMA(1, 1, At, B1); PG8_BAR; PG8_SCHED;
            PG8_LDB(B0, 1, 0); PG8_LDB(B1, 1, 1); PG8_SCHED; PG8_LDA(At, 1, 0); PG8_STAGE(PG8_SA(0, 1), a2 + hstep, voffA);
            PG8_WAIT_V(8); PG8_WAIT_L(0); PG8_BAR; PG8_MMA(0, 0, At, B0); PG8_MMA(0, 1, At, B1); PG8_BAR; PG8_SCHED;
            PG8_LDA(At, 1, 1); PG8_STAGE(PG8_SB(1, 0), b3, voffB); PG8_STAGE(PG8_SB(1, 1), b3 + hstep, voffB); PG8_STAGE(PG8_SA(1, 0), a3, voffA);
            PG8_WAIT_V(8); PG8_WAIT_L(0); PG8_BAR; PG8_MMA(1, 0, At, B0); PG8_MMA(1, 1, At, B1); PG8_BAR; PG8_SCHED;
            } else {
            PG8_LDB(B0, 0, 0); PG8_SCHED; PG8_LDA(At, 0, 0); PG8_STAGE(PG8_SA(1, 1), a1 + hstep, voffA);
            PG8_WAIT_L(8); PG8_BAR; PG8_WAIT_L(0); PG8_MMA(0, 0, At, B0); PG8_BAR; PG8_SCHED;
            PG8_LDB(B1, 0, 1); PG8_STAGE(PG8_SB(0, 0), b2, voffB);
            PG8_BAR; PG8_WAIT_L(0); PG8_MMA(0, 1, At, B1); PG8_BAR;
            PG8_LDA(At, 0, 1); PG8_STAGE(PG8_SA(0, 0), a2, voffA);
            PG8_BAR; PG8_WAIT_L(0); PG8_MMA(1, 0, At, B0); PG8_BAR; PG8_SCHED;
            PG8_STAGE(PG8_SB(0, 1), b2 + hstep, voffB);
            PG8_WAIT_V(6); PG8_BAR; PG8_MMA(1, 1, At, B1); PG8_BAR;
            PG8_LDB(B0, 1, 0); PG8_SCHED; PG8_LDA(At, 1, 0); PG8_STAGE(PG8_SA(0, 1), a2 + hstep, voffA);
            PG8_WAIT_L(8); PG8_BAR; PG8_WAIT_L(0); PG8_MMA(0, 0, At, B0); PG8_BAR; PG8_SCHED;
            PG8_LDB(B1, 1, 1); PG8_STAGE(PG8_SB(1, 0), b3, voffB);
            PG8_BAR; PG8_WAIT_L(0); PG8_MMA(0, 1, At, B1); PG8_BAR;
            PG8_LDA(At, 1, 1); PG8_STAGE(PG8_SA(1, 0), a3, voffA);
            PG8_BAR; PG8_WAIT_L(0); PG8_MMA(1, 0, At, B0); PG8_BAR; PG8_SCHED;
            PG8_STAGE(PG8_SB(1, 1), b3 + hstep, voffB);
            PG8_WAIT_V(6); PG8_BAR; PG8_MMA(1, 1, At, B1); PG8_BAR;
            }
        }
        if constexpr (ALIGN_EPI) { if (wr == 0) PG8_BAR; }
        if constexpr (!Epi::AFTER_DRAIN) { E(acc, cur, wr, wc, fr, fq); S.done(cur); }
        if (!has_next) break;
#pragma unroll
        for (int a = 0; a < 2; ++a)
#pragma unroll
            for (int b = 0; b < 2; ++b)
#pragma unroll
                for (int m = 0; m < 4; ++m)
#pragma unroll
                    for (int n = 0; n < 2; ++n) acc[a][b][m][n] = (f32x4){0.f, 0.f, 0.f, 0.f};
        cur = nxt; cA = nA; cB = nB; ++ui;
        if constexpr (ALIGN_EPI) { if (wr == 1) PG8_BAR; }
    }
    PG8_WAIT_V(0);
    if constexpr (!ALIGN_EPI) { if (wr == 0) PG8_BAR; }
    PG8_BAR;
    if constexpr (Epi::AFTER_DRAIN) { E.fused(acc, cur, wr, wc, fr, fq, lds, wid, lane); S.done(cur); }
#undef PG8_SA
#undef PG8_SB
#undef PG8_STAGE
#undef PG8_LDA
#undef PG8_LDB
#undef PG8_MMA
#undef PG8_WAIT_V
#undef PG8_WAIT_L
#undef PG8_BAR
#undef PG8_SCHED
}
}


constexpr int NWAVES = 8;
constexpr int RING_OFF = 0, RING_BYTES = 131072;
constexpr int LDSX_OFF = RING_BYTES;
constexpr int MISC_OFF = RING_BYTES + 8192;
constexpr int LDS_BYTES = 147456;
static_assert(MISC_OFF + 128 <= LDS_BYTES, "LDS map");
constexpr int CW_BAR = 1024;
constexpr int CW_FLAG = 16384;

#define GAS __attribute__((address_space(1)))
#define LAS __attribute__((address_space(3)))
typedef unsigned v4u __attribute__((ext_vector_type(4)));
typedef float f32x4 __attribute__((ext_vector_type(4)));
typedef unsigned u32x2 __attribute__((ext_vector_type(2)));
typedef GAS unsigned gu32;
#define LDS_WAIT() asm volatile("s_waitcnt lgkmcnt(0)" ::: "memory")
#define VM_WAIT() asm volatile("s_waitcnt vmcnt(0)" ::: "memory")
__device__ __forceinline__ unsigned pk2(float lo, float hi) { return f2bf(lo) | (f2bf(hi) << 16); }

#define XB_TMO      128
#define XB_XCNT(j)  (256  + 64 * (j))
#define XB_XSUB(j)  (1280 + 64 * (j))
#define XB_XGEN(j)  (2304 + 64 * (j))
#define XB_TOP      3328
#define XB_TOPGEN   3392
#define XCD_BAR_WORDS 3456
#define XB_SPIN_CAP (1u << 18)

__device__ __forceinline__ unsigned xb_ld(unsigned* p)              { return __hip_atomic_load(p, __ATOMIC_RELAXED, __HIP_MEMORY_SCOPE_AGENT); }
__device__ __forceinline__ unsigned xb_add(unsigned* p, unsigned v) { return __hip_atomic_fetch_add(p, v, __ATOMIC_RELAXED, __HIP_MEMORY_SCOPE_AGENT); }
__device__ __forceinline__ unsigned xb_xcc_id() { return (unsigned)__builtin_amdgcn_s_getreg((3 << 11) | 20) & 0xFu; }
#define XB_SPIN(cond, bar) do { unsigned _sp = 0; while (cond) { __builtin_amdgcn_s_sleep(1); \
    if ((++_sp & 255u) == 0u) { if (xb_ld(&(bar)[XB_TMO])) break; if (_sp > XB_SPIN_CAP) { atomicAdd(&(bar)[XB_TMO], 1u); break; } } } } while (0)

struct XcdBarrier {
    unsigned* bar; unsigned x;
    volatile LAS unsigned* st;
};

__device__ __forceinline__ XcdBarrier xcd_barrier_post(unsigned* bar, volatile LAS unsigned* st) {
    XcdBarrier b; b.bar = bar; b.x = xb_xcc_id(); b.st = st;
    if (threadIdx.x == 0) (void)xb_add(&bar[XB_XCNT(b.x)], 1u);
    return b;
}
__device__ __forceinline__ void xcd_barrier_complete(unsigned* bar, unsigned x, unsigned& nloc, unsigned& nx) {
    const unsigned G = gridDim.x * gridDim.y * gridDim.z;
    unsigned sum, cnt, mine, sp = 0u;
    for (;;) {
        sum = 0u; cnt = 0u; mine = 0u;
#pragma unroll
        for (unsigned j = 0; j < 16; ++j) { const unsigned c = xb_ld(&bar[XB_XCNT(j)]); sum += c; cnt += (c > 0u) ? 1u : 0u; mine = (j == x) ? c : mine; }
        if (sum == G) break;
        __builtin_amdgcn_s_sleep(1);
        if ((++sp & 255u) == 0u) { if (xb_ld(&bar[XB_TMO])) break; if (sp > XB_SPIN_CAP) { atomicAdd(&bar[XB_TMO], 1u); break; } }
    }
    nloc = mine > 0u ? mine : 1u; nx = cnt > 0u ? cnt : 1u;
}

__device__ __forceinline__ void xcd_barrier(const XcdBarrier& b) {
    asm volatile("s_waitcnt vmcnt(0)" ::: "memory");
    __syncthreads();
    if (threadIdx.x == 0) {
        unsigned* bar = b.bar;
        __builtin_amdgcn_s_waitcnt(0);
        unsigned nloc = b.st[0], nx = b.st[1];
        if (nloc == 0u) { xcd_barrier_complete(bar, b.x, nloc, nx); b.st[0] = nloc; b.st[1] = nx; }
        const unsigned old = xb_add(&bar[XB_XSUB(b.x)], 1u);
        const unsigned gen = old / nloc;
        if (old + 1u == (gen + 1u) * nloc) {
            __builtin_amdgcn_fence(__ATOMIC_RELEASE, "agent");
            asm volatile("s_waitcnt vmcnt(0)" ::: "memory");
            const unsigned og = xb_add(&bar[XB_TOP], 1u);
            const unsigned tg = og / nx;
            if (og + 1u == (tg + 1u) * nx) xb_add(&bar[XB_TOPGEN], 1u);
            else XB_SPIN(xb_ld(&bar[XB_TOPGEN]) == tg, bar);
            __builtin_amdgcn_fence(__ATOMIC_ACQUIRE, "agent");
            xb_add(&bar[XB_XGEN(b.x)], 1u);
            asm volatile("s_waitcnt vmcnt(0)" ::: "memory");
        } else {
            XB_SPIN(xb_ld(&bar[XB_XGEN(b.x)]) == gen, bar);
            __builtin_amdgcn_fence(__ATOMIC_ACQUIRE, "agent");
            asm volatile("s_waitcnt vmcnt(0)" ::: "memory");
        }
    }
    __syncthreads();
}


namespace att {
typedef short bf16x8 __attribute__((ext_vector_type(8)));
typedef short s16x4 __attribute__((ext_vector_type(4)));
typedef float f32x16 __attribute__((ext_vector_type(16)));
typedef unsigned u32x4 __attribute__((ext_vector_type(4)));
typedef unsigned u32x2 __attribute__((ext_vector_type(2)));
constexpr float LOG2E = 1.4426950408889634f;
#define LBAR() do { asm volatile("s_waitcnt lgkmcnt(0)" ::: "memory"); __builtin_amdgcn_s_barrier(); asm volatile("" ::: "memory"); } while (0)
__device__ __forceinline__ int kappa(int r) { return (r & ~12) | ((r & 4) << 1) | ((r & 8) >> 1); }
__device__ __forceinline__ f32x16 mfma32(bf16x8 a, bf16x8 b, f32x16 c) { return __builtin_amdgcn_mfma_f32_32x32x16_bf16(a, b, c, 0, 0, 0); }
__device__ __forceinline__ s16x4 vtr(const LAS unsigned char* p) { return __builtin_bit_cast(s16x4, __builtin_amdgcn_ds_read_tr16_b64_v4i16((LAS s16x4*)p)); }
__device__ __forceinline__ bf16x8 cat8(s16x4 a, s16x4 b) { return (bf16x8){a[0], a[1], a[2], a[3], b[0], b[1], b[2], b[3]}; }
typedef float f32x2_t __attribute__((ext_vector_type(2))); typedef __bf16 bf16x2_t __attribute__((ext_vector_type(2)));
__device__ __forceinline__ unsigned cvtpk(float lo, float hi) { const f32x2_t v = {lo, hi}; return __builtin_bit_cast(unsigned, __builtin_convertvector(v, bf16x2_t)); }
__device__ __forceinline__ float xhalf_max(float v) { return fmaxf(v, __shfl_xor(v, 32)); }
__device__ __forceinline__ float xhalf_sum(float v) { return v + __shfl_xor(v, 32); }
__device__ __forceinline__ bf16x8 packp(const f32x16& p, int s) {
    u32x4 w; w.x = cvtpk(p[8 * s + 0], p[8 * s + 1]); w.y = cvtpk(p[8 * s + 2], p[8 * s + 3]); w.z = cvtpk(p[8 * s + 4], p[8 * s + 5]); w.w = cvtpk(p[8 * s + 6], p[8 * s + 7]);
    return __builtin_bit_cast(bf16x8, w);
}
__device__ __forceinline__ int tr_off(int lane, int VP) { const int hi = lane >> 5, blk = (lane >> 4) & 1, q4 = (lane & 15) >> 2, p4 = lane & 3; return (8 * hi + q4) * VP + (16 * blk + 4 * p4) * 2; }


#define TR_RD(DST, ADDR, OFF) asm volatile("ds_read_b64_tr_b16 %0, %1 offset:%2" : "=v"(DST) : "v"(ADDR), "i"(OFF))
#define TR_WAIT(N, A, B) asm volatile("s_waitcnt lgkmcnt(" #N ")" : "+v"(A), "+v"(B))
#define PV_CHAIN2(ACC, ADDR, VP, F0, F1) do { s16x4 l0, h0, l1, h1; const unsigned ad_ = (ADDR); \
    TR_RD(l0, ad_, 0 * (VP)); TR_RD(h0, ad_, 4 * (VP)); TR_RD(l1, ad_, 16 * (VP)); TR_RD(h1, ad_, 20 * (VP)); \
    TR_WAIT(2, l0, h0); ACC = mfma32(cat8(l0, h0), F0, ACC); TR_WAIT(0, l1, h1); ACC = mfma32(cat8(l1, h1), F1, ACC); } while (0)
#define PV_CHAIN8(ACC, ADDR, VP, F0, F1, F2, F3, F4, F5, F6, F7) do { s16x4 l0, h0, l1, h1, l2, h2, l3, h3, l4, h4, l5, h5, l6, h6, l7, h7; const unsigned ad_ = (ADDR); \
    TR_RD(l0, ad_, 0 * (VP)); TR_RD(h0, ad_, 4 * (VP)); TR_RD(l1, ad_, 16 * (VP)); TR_RD(h1, ad_, 20 * (VP)); TR_RD(l2, ad_, 32 * (VP)); TR_RD(h2, ad_, 36 * (VP)); TR_RD(l3, ad_, 48 * (VP)); TR_RD(h3, ad_, 52 * (VP)); \
    TR_RD(l4, ad_, 64 * (VP)); TR_RD(h4, ad_, 68 * (VP)); TR_RD(l5, ad_, 80 * (VP)); TR_RD(h5, ad_, 84 * (VP)); TR_RD(l6, ad_, 96 * (VP)); TR_RD(h6, ad_, 100 * (VP)); TR_RD(l7, ad_, 112 * (VP)); TR_RD(h7, ad_, 116 * (VP)); \
    TR_WAIT(14, l0, h0); ACC = mfma32(cat8(l0, h0), F0, ACC); TR_WAIT(12, l1, h1); ACC = mfma32(cat8(l1, h1), F1, ACC); TR_WAIT(10, l2, h2); ACC = mfma32(cat8(l2, h2), F2, ACC); TR_WAIT(8, l3, h3); ACC = mfma32(cat8(l3, h3), F3, ACC); \
    TR_WAIT(6, l4, h4); ACC = mfma32(cat8(l4, h4), F4, ACC); TR_WAIT(4, l5, h5); ACC = mfma32(cat8(l5, h5), F5, ACC); TR_WAIT(2, l6, h6); ACC = mfma32(cat8(l6, h6), F6, ACC); TR_WAIT(0, l7, h7); ACC = mfma32(cat8(l7, h7), F7, ACC); } while (0)

constexpr int MB_KP = 144, MB_VP = 192, MB_TN = 2256, MB_TK = 128;
constexpr int MB_K = 0, MB_V = 2 * MB_TK * MB_KP, MB_LUT = MB_V + 2 * MB_TK * MB_VP, MB_KM = MB_LUT + 4 * MB_TN * 4, MB_END = MB_KM + 2048;
__device__ __forceinline__ f32x16 ld_c16(const LAS unsigned char* p) {
    const f32x4 a = *(const LAS f32x4*)p, b = *(const LAS f32x4*)(p + 16), c = *(const LAS f32x4*)(p + 64), d = *(const LAS f32x4*)(p + 80);
    return (f32x16){a[0], a[1], a[2], a[3], b[0], b[1], b[2], b[3], c[0], c[1], c[2], c[3], d[0], d[1], d[2], d[3]};
}
__device__ __forceinline__ float max16(const f32x16& p) { return fmaxf(fmaxf(fmaxf(fmaxf(p[0], p[1]), fmaxf(p[2], p[3])), fmaxf(fmaxf(p[4], p[5]), fmaxf(p[6], p[7]))), fmaxf(fmaxf(fmaxf(p[8], p[9]), fmaxf(p[10], p[11])), fmaxf(fmaxf(p[12], p[13]), fmaxf(p[14], p[15])))); }
__device__ __forceinline__ void moba_phase(LAS unsigned char* lds, const bf16* QKV, const float* KMP, const float* LUT, bf16* Y, float* SSB, int vcu, int G, int variant) {
    const int tid = threadIdx.x, lane = tid & 63, r32 = lane & 31, hi = lane >> 5; const int w = __builtin_amdgcn_readfirstlane(tid >> 6);
    LAS float* tab = (LAS float*)(lds + MB_LUT); LAS float* km = (LAS float*)(lds + MB_KM);
    const int troff = tr_off(lane, MB_VP);
    int htab = -1;
    for (int tau = vcu; tau < BATCH * 8 * 4; tau += G) { const int bh = tau >> 2, pr = tau & 3, b = bh >> 3, h = bh & 7;
        __syncthreads();
        if (h != htab) { htab = h; float tv[18];
#pragma unroll
            for (int j = 0; j < 18; ++j) { const int i = tid + 512 * j, sft = i / MB_TN, ii = i - sft * MB_TN, idx = 2047 - ii - sft; tv[j] = (i < 4 * MB_TN && idx >= 0) ? LUT[(8 + h) * 2048 + idx] * LOG2E : -INFINITY; }
#pragma unroll
            for (int j = 0; j < 18; ++j) { const int i = tid + 512 * j; if (i < 4 * MB_TN) tab[i] = tv[j]; } }
        { const int j = tid >> 6, d = tid & 63; km[tid] = (KMP[(size_t)((8 * b + j) * 2 + 0) * 512 + 64 * h + d] + KMP[(size_t)((8 * b + j) * 2 + 1) * 512 + 64 * h + d]) * (1.f / 256.f); }
        __syncthreads();
        const bf16* Qb = QKV + (size_t)b * SEQ * NQKV + 1536 + 64 * h; const bf16* Kb = QKV + (size_t)b * SEQ * NQKV + 2048 + 64 * h; const bf16* Vb = Kb + 512;
        for (int s2 = 0; s2 < 2; ++s2) { const int qb = s2 == 0 ? 7 - pr : pr;
            const int tq = 256 * qb + 32 * w + r32;
            bf16x8 qf[4];
#pragma unroll
            for (int d0 = 0; d0 < 4; ++d0) qf[d0] = *(const bf16x8*)(Qb + (size_t)tq * NQKV + 16 * d0 + 8 * hi);
            unsigned sel = 0;
            { float g[8];
#pragma unroll
              for (int j = 0; j < 8; ++j) g[j] = 0.f;
#pragma unroll
              for (int d0 = 0; d0 < 4; ++d0) { float qv[8];
#pragma unroll
                  for (int e = 0; e < 8; ++e) qv[e] = __builtin_bit_cast(float, (unsigned)(unsigned short)qf[d0][e] << 16);
#pragma unroll
                  for (int j = 0; j < 7; ++j) { const LAS float* kp = km + j * 64 + 16 * d0 + 8 * hi; const f32x4 k0 = *(const LAS f32x4*)kp, k1 = *(const LAS f32x4*)(kp + 4);
                      g[j] += qv[0] * k0[0] + qv[1] * k0[1] + qv[2] * k0[2] + qv[3] * k0[3] + qv[4] * k1[0] + qv[5] * k1[1] + qv[6] * k1[2] + qv[7] * k1[3]; } }
#pragma unroll
              for (int j = 0; j < 7; ++j) g[j] += __shfl_xor(g[j], 32);
              const int nsel = qb < 3 ? qb : 3;
              for (int n = 0; n < nsel; ++n) { float best = -3e38f; int bi = 0;
#pragma unroll
                  for (int j = 0; j < 7; ++j) if (j < qb && !((sel >> j) & 1u) && g[j] > best) { best = g[j]; bi = j; }
                  sel |= 1u << bi; }
              sel |= 1u << qb; }
            float l_run = 0.f; f32x16 o0 = {}, o1 = {};
            const int NT = 2 * (qb + 1);
            const int a0 = 2047 - tq + 8 * hi;
            const LAS unsigned char* cp = (const LAS unsigned char*)tab + (a0 & 3) * (MB_TN * 4) + (a0 & ~3) * 4;
            const int skey = tid >> 3, sch = tid & 7;
            const size_t srow = (size_t)skey * NQKV + 8 * sch;
#define MB_GLD(T_) do { if ((T_) < NT) { const size_t ro_ = srow + (size_t)(T_) * MB_TK * NQKV; k0r = *(const u32x4*)(Kb + ro_); k1r = *(const u32x4*)(Kb + ro_ + (size_t)64 * NQKV); v0r = *(const u32x4*)(Vb + ro_); v1r = *(const u32x4*)(Vb + ro_ + (size_t)64 * NQKV); } } while (0)
#define MB_ST(T_) do { if ((T_) < NT) { LAS unsigned char* kd_ = lds + MB_K + ((T_) & 1) * (MB_TK * MB_KP) + skey * MB_KP + sch * 16; LAS unsigned char* vd_ = lds + MB_V + ((T_) & 1) * (MB_TK * MB_VP) + skey * MB_VP + sch * 16; \
                    *(LAS u32x4*)kd_ = k0r; *(LAS u32x4*)(kd_ + 64 * MB_KP) = k1r; *(LAS u32x4*)vd_ = v0r; *(LAS u32x4*)(vd_ + 64 * MB_VP) = v1r; } } while (0)
#define MB_ACT(T_) (((T_) >> 1) < qb ? (__ballot((sel >> ((T_) >> 1)) & 1u) != 0ull) : ((MB_TK * (T_) - 256 * qb) <= 32 * w + 31))
            u32x4 k0r = {}, k1r = {}, v0r = {}, v1r = {};
            MB_GLD(0); MB_ST(0); MB_GLD(1);
            LBAR();
            for (int T = 0; T < NT; ++T) {
                if (MB_ACT(T)) {
                    const LAS unsigned char* Kt = lds + MB_K + (T & 1) * (MB_TK * MB_KP) + kappa(r32) * MB_KP + hi * 16; const LAS unsigned char* Vt = lds + MB_V + (T & 1) * (MB_TK * MB_VP) + troff;
                    const bool selb = (sel >> (T >> 1)) & 1u;
                    const LAS unsigned char* ct = selb ? cp + 512 * T : (const LAS unsigned char*)tab + 2048 * 4;
                    f32x16 p0 = ld_c16(ct), p1 = ld_c16(ct + 128), p2 = ld_c16(ct + 256), p3 = ld_c16(ct + 384);
                    if (!(variant & 4)) {
#pragma unroll
                        for (int d0 = 0; d0 < 4; ++d0) { const bf16x8 ka = *(const LAS bf16x8*)(Kt + d0 * 32), kb = *(const LAS bf16x8*)(Kt + 32 * MB_KP + d0 * 32), kc = *(const LAS bf16x8*)(Kt + 64 * MB_KP + d0 * 32), kd = *(const LAS bf16x8*)(Kt + 96 * MB_KP + d0 * 32);
                            p0 = mfma32(ka, qf[d0], p0); p1 = mfma32(kb, qf[d0], p1); p2 = mfma32(kc, qf[d0], p2); p3 = mfma32(kd, qf[d0], p3); } }
                    float ls0 = 0.f, ls1 = 0.f;
                    if (!(variant & 1)) {
#pragma unroll
                        for (int r = 0; r < 16; ++r) { p0[r] = __builtin_amdgcn_exp2f(p0[r]); p1[r] = __builtin_amdgcn_exp2f(p1[r]); p2[r] = __builtin_amdgcn_exp2f(p2[r]); p3[r] = __builtin_amdgcn_exp2f(p3[r]); ls0 += p0[r] + p1[r]; ls1 += p2[r] + p3[r]; } }
                    l_run += ls0 + ls1;
                    if (!(variant & 2)) {
                        const bf16x8 f0 = packp(p0, 0), f1 = packp(p0, 1), f2 = packp(p1, 0), f3 = packp(p1, 1), f4 = packp(p2, 0), f5 = packp(p2, 1), f6 = packp(p3, 0), f7 = packp(p3, 1);
                        const unsigned va = (unsigned)(size_t)Vt;
                        PV_CHAIN8(o0, va, MB_VP, f0, f1, f2, f3, f4, f5, f6, f7);
                        PV_CHAIN8(o1, va + 64u, MB_VP, f0, f1, f2, f3, f4, f5, f6, f7); }
                }
                MB_ST(T + 1);
                if (!(variant & 16)) LBAR();
                if (!(variant & 8)) MB_GLD(T + 2);
            }
#undef MB_GLD
#undef MB_ST
#undef MB_ACT
            const float inv = 1.f / xhalf_sum(l_run);
            bf16* yp = Y + ((size_t)b * SEQ + tq) * DM + 512 + 64 * h + 4 * hi; float sq = 0.f;
#pragma unroll
            for (int g4 = 0; g4 < 4; ++g4) { u32x2 a, c2; a.x = cvtpk(o0[4 * g4] * inv, o0[4 * g4 + 1] * inv); a.y = cvtpk(o0[4 * g4 + 2] * inv, o0[4 * g4 + 3] * inv);
                c2.x = cvtpk(o1[4 * g4] * inv, o1[4 * g4 + 1] * inv); c2.y = cvtpk(o1[4 * g4 + 2] * inv, o1[4 * g4 + 3] * inv);
                *(u32x2*)(yp + 8 * g4) = a; *(u32x2*)(yp + 32 + 8 * g4) = c2;
                sq += bflo(a.x) * bflo(a.x) + bfhi(a.x) * bfhi(a.x) + bflo(a.y) * bflo(a.y) + bfhi(a.y) * bfhi(a.y) + bflo(c2.x) * bflo(c2.x) + bfhi(c2.x) * bfhi(c2.x) + bflo(c2.y) * bflo(c2.y) + bfhi(c2.y) * bfhi(c2.y); }
            sq = xhalf_sum(sq); if (hi == 0 && SSB) atomicAdd(SSB + (size_t)b * SEQ + tq, sq);
        }
    }
}

constexpr int M2_TK = 64, M2_K = 0, M2_V = 2 * M2_TK * MB_KP, M2_LUT = M2_V + 2 * M2_TK * MB_VP, M2_KM = M2_LUT + 4 * MB_TN * 4, M2_END = M2_KM + 2048;
static_assert(M2_END <= 139264, "MoBA LDS map");
__device__ __forceinline__ unsigned mb_select(const bf16x8 (&qf)[4], const LAS float* km, int qb, int hi) {
    unsigned sel = 0; float g[8];
#pragma unroll
    for (int j = 0; j < 8; ++j) g[j] = 0.f;
#pragma unroll
    for (int d0 = 0; d0 < 4; ++d0) { float qv[8];
#pragma unroll
        for (int e = 0; e < 8; ++e) qv[e] = __builtin_bit_cast(float, (unsigned)(unsigned short)qf[d0][e] << 16);
#pragma unroll
        for (int j = 0; j < 7; ++j) { const LAS float* kp = km + j * 64 + 16 * d0 + 8 * hi; const f32x4 k0 = *(const LAS f32x4*)kp, k1 = *(const LAS f32x4*)(kp + 4);
            g[j] += qv[0] * k0[0] + qv[1] * k0[1] + qv[2] * k0[2] + qv[3] * k0[3] + qv[4] * k1[0] + qv[5] * k1[1] + qv[6] * k1[2] + qv[7] * k1[3]; } }
#pragma unroll
    for (int j = 0; j < 7; ++j) g[j] += __shfl_xor(g[j], 32);
    const int nsel = qb < 3 ? qb : 3;
    for (int n = 0; n < nsel; ++n) { float best = -3e38f; int bi = 0;
#pragma unroll
        for (int j = 0; j < 7; ++j) if (j < qb && !((sel >> j) & 1u) && g[j] > best) { best = g[j]; bi = j; }
        sel |= 1u << bi; }
    return sel | (1u << qb);
}
template <bool DA, bool DB>
__device__ __forceinline__ void mb_step2(const LAS unsigned char* Kt, unsigned va, const LAS unsigned char* ctA, const LAS unsigned char* ctB, const bf16x8 (&qa)[4], const bf16x8 (&qb)[4],
                                         f32x16& oa0, f32x16& oa1, float& la, f32x16& ob0, f32x16& ob1, float& lb) {
    f32x16 a0 = {}, a1 = {}, b0 = {}, b1 = {};
    if (DA) { a0 = ld_c16(ctA); a1 = ld_c16(ctA + 128); }
    if (DB) { b0 = ld_c16(ctB); b1 = ld_c16(ctB + 128); }
#pragma unroll
    for (int d0 = 0; d0 < 4; ++d0) { const bf16x8 k0 = *(const LAS bf16x8*)(Kt + d0 * 32), k1 = *(const LAS bf16x8*)(Kt + 32 * MB_KP + d0 * 32);
        if (DA) { a0 = mfma32(k0, qa[d0], a0); a1 = mfma32(k1, qa[d0], a1); }
        if (DB) { b0 = mfma32(k0, qb[d0], b0); b1 = mfma32(k1, qb[d0], b1); } }
    float sa = 0.f, sb = 0.f;
#pragma unroll
    for (int r = 0; r < 16; ++r) {
        if (DA) { a0[r] = __builtin_amdgcn_exp2f(a0[r]); a1[r] = __builtin_amdgcn_exp2f(a1[r]); sa += a0[r] + a1[r]; }
        if (DB) { b0[r] = __builtin_amdgcn_exp2f(b0[r]); b1[r] = __builtin_amdgcn_exp2f(b1[r]); sb += b0[r] + b1[r]; } }
    la += sa; lb += sb;
    const bf16x8 fa0 = packp(a0, 0), fa1 = packp(a0, 1), fa2 = packp(a1, 0), fa3 = packp(a1, 1), fb0 = packp(b0, 0), fb1 = packp(b0, 1), fb2 = packp(b1, 0), fb3 = packp(b1, 1);
#pragma unroll
    for (int c = 0; c < 2; ++c) { const unsigned ad = va + 64u * c; s16x4 l0, h0, l1, h1, l2, h2, l3, h3;
        TR_RD(l0, ad, 0 * MB_VP); TR_RD(h0, ad, 4 * MB_VP); TR_RD(l1, ad, 16 * MB_VP); TR_RD(h1, ad, 20 * MB_VP); TR_RD(l2, ad, 32 * MB_VP); TR_RD(h2, ad, 36 * MB_VP); TR_RD(l3, ad, 48 * MB_VP); TR_RD(h3, ad, 52 * MB_VP);
        f32x16& xa = c ? oa1 : oa0; f32x16& xb = c ? ob1 : ob0;
        TR_WAIT(6, l0, h0); { const bf16x8 v = cat8(l0, h0); if (DA) xa = mfma32(v, fa0, xa); if (DB) xb = mfma32(v, fb0, xb); }
        TR_WAIT(4, l1, h1); { const bf16x8 v = cat8(l1, h1); if (DA) xa = mfma32(v, fa1, xa); if (DB) xb = mfma32(v, fb1, xb); }
        TR_WAIT(2, l2, h2); { const bf16x8 v = cat8(l2, h2); if (DA) xa = mfma32(v, fa2, xa); if (DB) xb = mfma32(v, fb2, xb); }
        TR_WAIT(0, l3, h3); { const bf16x8 v = cat8(l3, h3); if (DA) xa = mfma32(v, fa3, xa); if (DB) xb = mfma32(v, fb3, xb); } }
}
__device__ __forceinline__ void moba_phase2(LAS unsigned char* lds, const bf16* QKV, const float* KMP, const float* LUT, bf16* Y, float* SSB, int vcu, int G) {
    const int tid_ = threadIdx.x, tid = tid_, lane = tid & 63, r32_ = lane & 31, hi_ = lane >> 5; const int w = __builtin_amdgcn_readfirstlane(tid >> 6);
    LAS float* tab = (LAS float*)(lds + M2_LUT); LAS float* km = (LAS float*)(lds + M2_KM);
    int htab = -1;
    for (int tau = vcu; tau < BATCH * 8 * 2; tau += G) { const int bh = tau >> 1, half = tau & 1, b = bh >> 3, h = bh & 7;
        __syncthreads();
        int tt = tid_; asm volatile("" : "+v"(tt));
        if (h != htab) { htab = h; float tv[18];
#pragma unroll
            for (int j = 0; j < 18; ++j) { const int i = tt + 512 * j, sft = i / MB_TN, ii = i - sft * MB_TN, idx = 2047 - ii - sft; tv[j] = (i < 4 * MB_TN && idx >= 0) ? LUT[(8 + h) * 2048 + idx] * LOG2E : -INFINITY; }
#pragma unroll
            for (int j = 0; j < 18; ++j) { const int i = tt + 512 * j; if (i < 4 * MB_TN) tab[i] = tv[j]; } }
        { const int j = tt >> 6, d = tt & 63; km[tt] = (KMP[(size_t)((8 * b + j) * 2 + 0) * 512 + 64 * h + d] + KMP[(size_t)((8 * b + j) * 2 + 1) * 512 + 64 * h + d]) * (1.f / 256.f); }
        __syncthreads();
        const bf16* Qb = QKV + (size_t)b * SEQ * NQKV + 1536 + 64 * h; const bf16* Kb = QKV + (size_t)b * SEQ * NQKV + 2048 + 64 * h; const bf16* Vb = Kb + 512;
        for (int s2 = 0; s2 < 2; ++s2) { const int jp = half == 0 ? (s2 == 0 ? 3 : 0) : (s2 == 0 ? 2 : 1); const int qA = 2 * jp, qB = qA + 1;
            int r32 = r32_, hi = hi_, tid = tid_; asm volatile("" : "+v"(r32), "+v"(hi), "+v"(tid));
            const int troff = (8 * hi + ((r32 & 15) >> 2)) * MB_VP + (16 * ((r32 >> 4) & 1) + 4 * (r32 & 3)) * 2;
            const int tqA = 256 * qA + 32 * w + r32, tqB = tqA + 256;
            bf16x8 qa[4], qb[4];
#pragma unroll
            for (int d0 = 0; d0 < 4; ++d0) { qa[d0] = *(const bf16x8*)(Qb + (size_t)tqA * NQKV + 16 * d0 + 8 * hi); qb[d0] = *(const bf16x8*)(Qb + (size_t)tqB * NQKV + 16 * d0 + 8 * hi); }
            const unsigned selA = mb_select(qa, km, qA, hi);
            int ko = 0; asm volatile("" : "+v"(ko) :: "memory");
            const unsigned selB = mb_select(qb, km + ko, qB, hi);
            float la = 0.f, lb = 0.f; f32x16 oa0 = {}, oa1 = {}, ob0 = {}, ob1 = {};
            const int NT = 4 * (qB + 1);
            const int tA = 2047 - tqA + 8 * hi, tB = tA - 256;
            const LAS unsigned char* cpA = (const LAS unsigned char*)tab + (tA & 3) * (MB_TN * 4) + (tA & ~3) * 4;
            const LAS unsigned char* cpB = (const LAS unsigned char*)tab + (tB & 3) * (MB_TN * 4) + (tB & ~3) * 4;
            const LAS unsigned char* minf = (const LAS unsigned char*)tab + 2048 * 4;
            const int skey = tid >> 3, sch = tid & 7;
            const size_t srow = (size_t)skey * NQKV + 8 * sch;
            u32x4 k0r = {}, v0r = {};
#define M2_GLD(T_) do { if ((T_) < NT) { const size_t ro_ = srow + (size_t)(T_) * M2_TK * NQKV; k0r = *(const u32x4*)(Kb + ro_); v0r = *(const u32x4*)(Vb + ro_); } } while (0)
#define M2_ST(T_) do { if ((T_) < NT) { *(LAS u32x4*)(lds + M2_K + ((T_) & 1) * (M2_TK * MB_KP) + skey * MB_KP + sch * 16) = k0r; *(LAS u32x4*)(lds + M2_V + ((T_) & 1) * (M2_TK * MB_VP) + skey * MB_VP + sch * 16) = v0r; } } while (0)
            M2_GLD(0); M2_ST(0); M2_GLD(1);
            LBAR();
            for (int T = 0; T < NT; ++T) { const int kb = T >> 2;
                const bool actA = kb < qA ? (__ballot((selA >> kb) & 1u) != 0ull) : (kb == qA && (M2_TK * T - 256 * qA) <= 32 * w + 31);
                const bool actB = kb < qB ? (__ballot((selB >> kb) & 1u) != 0ull) : ((M2_TK * T - 256 * qB) <= 32 * w + 31);
                const LAS unsigned char* Kt = lds + M2_K + (T & 1) * (M2_TK * MB_KP) + kappa(r32) * MB_KP + hi * 16; const unsigned va = (unsigned)(size_t)(lds + M2_V + (T & 1) * (M2_TK * MB_VP) + troff);
                const LAS unsigned char* ctA = ((selA >> kb) & 1u) ? cpA + 256 * T : minf; const LAS unsigned char* ctB = ((selB >> kb) & 1u) ? cpB + 256 * T : minf;
                if (actA && actB) mb_step2<true, true>(Kt, va, ctA, ctB, qa, qb, oa0, oa1, la, ob0, ob1, lb);
                else if (actB) mb_step2<false, true>(Kt, va, ctA, ctB, qa, qb, oa0, oa1, la, ob0, ob1, lb);
                else if (actA) mb_step2<true, false>(Kt, va, ctA, ctB, qa, qb, oa0, oa1, la, ob0, ob1, lb);
                M2_ST(T + 1);
                LBAR();
                M2_GLD(T + 2);
            }
#undef M2_GLD
#undef M2_ST
#pragma unroll
            for (int gsel = 0; gsel < 2; ++gsel) { const f32x16& o0 = gsel ? ob0 : oa0; const f32x16& o1 = gsel ? ob1 : oa1; const int tq = gsel ? tqB : tqA;
                const float inv = 1.f / xhalf_sum(gsel ? lb : la);
                bf16* yp = Y + ((size_t)b * SEQ + tq) * DM + 512 + 64 * h + 4 * hi; float sq = 0.f;
#pragma unroll
                for (int g4 = 0; g4 < 4; ++g4) { u32x2 a, c2; a.x = cvtpk(o0[4 * g4] * inv, o0[4 * g4 + 1] * inv); a.y = cvtpk(o0[4 * g4 + 2] * inv, o0[4 * g4 + 3] * inv);
                    c2.x = cvtpk(o1[4 * g4] * inv, o1[4 * g4 + 1] * inv); c2.y = cvtpk(o1[4 * g4 + 2] * inv, o1[4 * g4 + 3] * inv);
                    *(u32x2*)(yp + 8 * g4) = a; *(u32x2*)(yp + 32 + 8 * g4) = c2;
                    sq += bflo(a.x) * bflo(a.x) + bfhi(a.x) * bfhi(a.x) + bflo(a.y) * bflo(a.y) + bfhi(a.y) * bfhi(a.y) + bflo(c2.x) * bflo(c2.x) + bfhi(c2.x) * bfhi(c2.x) + bflo(c2.y) * bflo(c2.y) + bfhi(c2.y) * bfhi(c2.y); }
                sq = xhalf_sum(sq); if (hi == 0 && SSB) atomicAdd(SSB + (size_t)b * SEQ + tq, sq); }
        }
    }
}

constexpr int DL_VP = 192, DL_KP = 144, DL_LUT = 0, DL_TN = 208, DL_V = 16384, DL_SB = 65536, DL_SBP = 136, DL_SL = DL_SB + 512 * DL_SBP, DL_END = DL_SL + 2048;
static_assert(DL_END <= 139264, "dilated LDS map");
struct DilTile { u32x4 kr[4]; u32x4 vr[4]; };
__device__ __forceinline__ void dil_load(DilTile& t, const bf16* Kb, const bf16* Vb, int dil, int res, int base, int lane) {
#pragma unroll
    for (int i4 = 0; i4 < 4; ++i4) { const int idx = lane + 64 * i4, key = idx >> 3, ch = idx & 7; const size_t o = (size_t)(dil * (base + key) + res) * NQKV + 8 * ch;
        t.kr[i4] = *(const u32x4*)(Kb + o); t.vr[i4] = *(const u32x4*)(Vb + o); }
}
__device__ __forceinline__ void dil_unit(const bf16* Qb, const bf16* Kb, const bf16* Vb, const LAS unsigned char* tb, LAS unsigned char* Vw, int troff, int dil, int res, int gi, int lane, int r32, int hi,
                                         f32x16& o0, f32x16& o1, float& lse) {
    const int ms = 32 * gi + r32, tq = dil * ms + res;
    u32x4 qr[4];
    int lg = lane; asm volatile("" : "+v"(lg));
#pragma unroll
    for (int i4 = 0; i4 < 4; ++i4) { const int idx = lg + 64 * i4, qrow = idx >> 3, ch = idx & 7; qr[i4] = *(const u32x4*)(Qb + (size_t)(dil * (32 * gi + qrow) + res) * NQKV + 8 * ch); }
    float l_run = 0.f; o0 = f32x16{}; o1 = f32x16{};
    const int kt0 = gi >= 4 ? 0 : 4 - gi;
    const int a0 = 31 - r32 + 8 * hi;
    const LAS unsigned char* cp = tb + (a0 & 3) * (DL_TN * 4) + (a0 & ~3) * 4;
    DilTile nx, nx2; dil_load(nx, Kb, Vb, dil, res, 32 * gi - 128 + 32 * kt0, lg); nx2 = nx;
    if (kt0 < 4) dil_load(nx2, Kb, Vb, dil, res, 32 * gi - 128 + 32 * (kt0 + 1), lg);
    bf16x8 qf[4];
#pragma unroll
    for (int i4 = 0; i4 < 4; ++i4) { const int idx = lane + 64 * i4, qrow = idx >> 3, ch = idx & 7; *(LAS u32x4*)(Vw + qrow * DL_KP + ch * 16) = qr[i4]; }
#pragma unroll
    for (int d0 = 0; d0 < 4; ++d0) qf[d0] = *(const LAS bf16x8*)(Vw + r32 * DL_KP + hi * 16 + d0 * 32);
#pragma unroll 1
    for (int kt = kt0; kt < 5; ++kt) { const int base = 32 * gi - 128 + 32 * kt;
        DilTile cu = nx; nx = nx2;
        if (kt < 3) dil_load(nx2, Kb, Vb, dil, res, base + 64, lg);
        asm volatile("" ::: "memory");
#pragma unroll
        for (int i4 = 0; i4 < 4; ++i4) { const int idx = lane + 64 * i4, key = idx >> 3, ch = idx & 7; *(LAS u32x4*)(Vw + key * DL_KP + ch * 16) = cu.kr[i4]; }
        bf16x8 kf[4];
#pragma unroll
        for (int d0 = 0; d0 < 4; ++d0) kf[d0] = *(const LAS bf16x8*)(Vw + kappa(r32) * DL_KP + hi * 16 + d0 * 32);
#pragma unroll
        for (int i4 = 0; i4 < 4; ++i4) { const int idx = lane + 64 * i4, key = idx >> 3, ch = idx & 7; *(LAS u32x4*)(Vw + key * DL_VP + ch * 16) = cu.vr[i4]; }
        f32x16 p0 = ld_c16(cp + 128 * kt);
#pragma unroll
        for (int d0 = 0; d0 < 4; ++d0) p0 = mfma32(kf[d0], qf[d0], p0);
        float ls = 0.f;
#pragma unroll
        for (int r = 0; r < 16; ++r) { p0[r] = __builtin_amdgcn_exp2f(p0[r]); ls += p0[r]; }
        l_run += ls;
        const bf16x8 pf0 = packp(p0, 0), pf1 = packp(p0, 1);
        asm volatile("s_waitcnt lgkmcnt(0)" ::: "memory");
#pragma unroll
        for (int c = 0; c < 2; ++c) { const LAS unsigned char* vb = Vw + troff + c * 64;
            const bf16x8 v0 = cat8(vtr(vb), vtr(vb + 4 * DL_VP)), v1 = cat8(vtr(vb + 16 * DL_VP), vtr(vb + 20 * DL_VP));
            if (c == 0) { o0 = mfma32(v0, pf0, o0); o0 = mfma32(v1, pf1, o0); } else { o1 = mfma32(v0, pf0, o1); o1 = mfma32(v1, pf1, o1); } }
        asm volatile("s_waitcnt lgkmcnt(0)" ::: "memory");
    }
    const float lt = xhalf_sum(l_run), inv = 1.f / lt;
#pragma unroll
    for (int r = 0; r < 16; ++r) { o0[r] *= inv; o1[r] *= inv; }
    lse = __builtin_amdgcn_logf(lt);
}
template <bool DA, bool DB>
__device__ __forceinline__ void dil_step2(DilTile& cu, const bf16* Kb, const bf16* Vb, int dil, int res, int nbase, int lg, LAS unsigned char* Vw, int troff, const LAS unsigned char* cp, int kt, int lane, int r32, int hi,
                                          const bf16x8 (&qa)[4], const bf16x8 (&qb)[4], f32x16& a0, f32x16& a1, float& la, f32x16& b0, f32x16& b1, float& lb) {
#pragma unroll
    for (int i4 = 0; i4 < 4; ++i4) { const int idx = lane + 64 * i4, key = idx >> 3, ch = idx & 7; *(LAS u32x4*)(Vw + key * DL_KP + ch * 16) = cu.kr[i4]; }
    bf16x8 kf[4];
#pragma unroll
    for (int d0 = 0; d0 < 4; ++d0) kf[d0] = *(const LAS bf16x8*)(Vw + kappa(r32) * DL_KP + hi * 16 + d0 * 32);
#pragma unroll
    for (int i4 = 0; i4 < 4; ++i4) { const int idx = lane + 64 * i4, key = idx >> 3, ch = idx & 7; *(LAS u32x4*)(Vw + key * DL_VP + ch * 16) = cu.vr[i4]; }
    if (DA) dil_load(cu, Kb, Vb, dil, res, nbase, lg);
    asm volatile("" ::: "memory");
    f32x16 pa = {}, pb = {};
    if (DA) pa = ld_c16(cp + 128 * kt);
    if (DB) pb = ld_c16(cp + 128 * (kt - 1));
#pragma unroll
    for (int d0 = 0; d0 < 4; ++d0) { if (DA) pa = mfma32(kf[d0], qa[d0], pa); if (DB) pb = mfma32(kf[d0], qb[d0], pb); }
    float lsa = 0.f, lsb = 0.f;
#pragma unroll
    for (int r = 0; r < 16; ++r) { if (DA) { pa[r] = __builtin_amdgcn_exp2f(pa[r]); lsa += pa[r]; } if (DB) { pb[r] = __builtin_amdgcn_exp2f(pb[r]); lsb += pb[r]; } }
    la += lsa; lb += lsb;
    const bf16x8 fa0 = packp(pa, 0), fa1 = packp(pa, 1), fb0 = packp(pb, 0), fb1 = packp(pb, 1);
    asm volatile("s_waitcnt lgkmcnt(0)" ::: "memory");
#pragma unroll
    for (int c = 0; c < 2; ++c) { const LAS unsigned char* vb = Vw + troff + c * 64;
        const bf16x8 v0 = cat8(vtr(vb), vtr(vb + 4 * DL_VP)), v1 = cat8(vtr(vb + 16 * DL_VP), vtr(vb + 20 * DL_VP));
        if (c == 0) { if (DA) { a0 = mfma32(v0, fa0, a0); a0 = mfma32(v1, fa1, a0); } if (DB) { b0 = mfma32(v0, fb0, b0); b0 = mfma32(v1, fb1, b0); } }
        else { if (DA) { a1 = mfma32(v0, fa0, a1); a1 = mfma32(v1, fa1, a1); } if (DB) { b1 = mfma32(v0, fb0, b1); b1 = mfma32(v1, fb1, b1); } } }
    asm volatile("s_waitcnt lgkmcnt(0)" ::: "memory");
}
__device__ __forceinline__ void dil_unit2(const bf16* Qb, const bf16* Kb, const bf16* Vb, const LAS unsigned char* tb, LAS unsigned char* Vw, int troff, int dil, int res, int gi2, int lane, int r32, int hi,
                                          f32x16& a0, f32x16& a1, float& lseA, f32x16& b0, f32x16& b1, float& lseB) {
    u32x4 qr[4], qs[4];
    int lg = lane; asm volatile("" : "+v"(lg));
#pragma unroll
    for (int i4 = 0; i4 < 4; ++i4) { const int idx = lg + 64 * i4, qrow = idx >> 3, ch = idx & 7; const size_t o = (size_t)(dil * (64 * gi2 + qrow) + res) * NQKV + 8 * ch;
        qr[i4] = *(const u32x4*)(Qb + o); qs[i4] = *(const u32x4*)(Qb + o + (size_t)(dil * 32) * NQKV); }
    float la = 0.f, lb = 0.f; a0 = f32x16{}; a1 = f32x16{}; b0 = f32x16{}; b1 = f32x16{};
    const int kt0 = gi2 >= 2 ? 0 : 4 - 2 * gi2;
    const int t0 = 31 - r32 + 8 * hi;
    const LAS unsigned char* cp = tb + (t0 & 3) * (DL_TN * 4) + (t0 & ~3) * 4;
    const int base0 = 64 * gi2 - 128;
    DilTile nx; dil_load(nx, Kb, Vb, dil, res, base0 + 32 * kt0, lg);
    bf16x8 qa[4], qb[4];
#pragma unroll
    for (int i4 = 0; i4 < 4; ++i4) { const int idx = lane + 64 * i4, qrow = idx >> 3, ch = idx & 7; *(LAS u32x4*)(Vw + qrow * DL_KP + ch * 16) = qr[i4]; }
#pragma unroll
    for (int d0 = 0; d0 < 4; ++d0) qa[d0] = *(const LAS bf16x8*)(Vw + r32 * DL_KP + hi * 16 + d0 * 32);
#pragma unroll
    for (int i4 = 0; i4 < 4; ++i4) { const int idx = lane + 64 * i4, qrow = idx >> 3, ch = idx & 7; *(LAS u32x4*)(Vw + qrow * DL_KP + ch * 16) = qs[i4]; }
#pragma unroll
    for (int d0 = 0; d0 < 4; ++d0) qb[d0] = *(const LAS bf16x8*)(Vw + r32 * DL_KP + hi * 16 + d0 * 32);
    int kt = kt0;
    if (kt == 0) { dil_step2<true, false>(nx, Kb, Vb, dil, res, base0 + 32, lg, Vw, troff, cp, 0, lane, r32, hi, qa, qb, a0, a1, la, b0, b1, lb); kt = 1; }
#pragma unroll 1
    for (; kt < 5; ++kt) dil_step2<true, true>(nx, Kb, Vb, dil, res, base0 + 32 * (kt + 1), lg, Vw, troff, cp, kt, lane, r32, hi, qa, qb, a0, a1, la, b0, b1, lb);
    dil_step2<false, true>(nx, Kb, Vb, dil, res, 0, lg, Vw, troff, cp, 5, lane, r32, hi, qa, qb, a0, a1, la, b0, b1, lb);
    const float lta = xhalf_sum(la), ltb = xhalf_sum(lb), ia = 1.f / lta, ib = 1.f / ltb;
#pragma unroll
    for (int r = 0; r < 16; ++r) { a0[r] *= ia; a1[r] *= ia; b0[r] *= ib; b1[r] *= ib; }
    lseA = __builtin_amdgcn_logf(lta); lseB = __builtin_amdgcn_logf(ltb);
}
__device__ __forceinline__ void sb_store(LAS unsigned char* sb, int lt, int hi, const f32x16& o0, const f32x16& o1) {
    LAS unsigned char* p = sb + lt * DL_SBP + 8 * hi;
#pragma unroll
    for (int g4 = 0; g4 < 4; ++g4) { u32x2 a, c2; a.x = cvtpk(o0[4 * g4], o0[4 * g4 + 1]); a.y = cvtpk(o0[4 * g4 + 2], o0[4 * g4 + 3]); c2.x = cvtpk(o1[4 * g4], o1[4 * g4 + 1]); c2.y = cvtpk(o1[4 * g4 + 2], o1[4 * g4 + 3]);
        *(LAS u32x2*)(p + 16 * g4) = a; *(LAS u32x2*)(p + 64 + 16 * g4) = c2; }
}
__device__ __forceinline__ void sb_merge(const LAS unsigned char* sb, int lt, int hi, float wa, float wb, f32x16& o0, f32x16& o1) {
    const LAS unsigned char* p = sb + lt * DL_SBP + 8 * hi;
#pragma unroll
    for (int g4 = 0; g4 < 4; ++g4) { const u32x2 a = *(const LAS u32x2*)(p + 16 * g4), c2 = *(const LAS u32x2*)(p + 64 + 16 * g4);
        o0[4 * g4] = wa * bflo(a.x) + wb * o0[4 * g4]; o0[4 * g4 + 1] = wa * bfhi(a.x) + wb * o0[4 * g4 + 1]; o0[4 * g4 + 2] = wa * bflo(a.y) + wb * o0[4 * g4 + 2]; o0[4 * g4 + 3] = wa * bfhi(a.y) + wb * o0[4 * g4 + 3];
        o1[4 * g4] = wa * bflo(c2.x) + wb * o1[4 * g4]; o1[4 * g4 + 1] = wa * bfhi(c2.x) + wb * o1[4 * g4 + 1]; o1[4 * g4 + 2] = wa * bflo(c2.y) + wb * o1[4 * g4 + 2]; o1[4 * g4 + 3] = wa * bfhi(c2.y) + wb * o1[4 * g4 + 3]; }
}
__device__ __forceinline__ void dil_phase(LAS unsigned char* lds, const bf16* QKV, const float* LUT, bf16* Y, float* SSA, int vcu, int G) {
    const int tid = threadIdx.x, lane = tid & 63, r32 = lane & 31, hi = lane >> 5; const int w = __builtin_amdgcn_readfirstlane(tid >> 6);
    LAS float* dtab = (LAS float*)(lds + DL_LUT);
    LAS unsigned char* Vw = lds + DL_V + w * (32 * DL_VP);
    LAS unsigned char* sb = lds + DL_SB; LAS float* sl = (LAS float*)(lds + DL_SL);
    const int troff = tr_off(lane, DL_VP);
    for (int bh = vcu; bh < BATCH * 8; bh += G) { const int b = bh >> 3, h = bh & 7;
        __syncthreads();
        for (int i = tid; i < 3 * 4 * DL_TN; i += 512) { const int ii = i % DL_TN, sft = (i / DL_TN) & 3, pp = i / (4 * DL_TN); const int dlt = 159 - ii - sft, dist = dlt * (pp == 0 ? 1 : (pp == 1 ? 4 : 16));
            dtab[i] = (dlt >= 0 && dlt <= 128 && dist < 2048) ? LUT[h * 2048 + dist] * LOG2E : -INFINITY; }
        __syncthreads();
        const bf16* Qb = QKV + (size_t)b * SEQ * NQKV + 64 * h; const bf16* Kb = Qb + 512; const bf16* Vb = Qb + 1024;
        const LAS unsigned char* tb0 = lds + DL_LUT;
        for (int sp = 0; sp < 4; ++sp) {
            for (int x = w; x < 16; x += 8) { f32x16 o0, o1; float lse;
                dil_unit(Qb, Kb, Vb, tb0 + 2 * (4 * DL_TN * 4), Vw, troff, 16, x, sp, lane, r32, hi, o0, o1, lse);
                const int lt = 16 * r32 + x; sb_store(sb, lt, hi, o0, o1); if (hi == 0) sl[lt] = lse; }
            __syncthreads();
            { f32x16 oa0, oa1, ob0, ob1; float lsa, lsb;
                dil_unit2(Qb, Kb, Vb, tb0 + 1 * (4 * DL_TN * 4), Vw, troff, 4, w & 3, 2 * sp + (w >> 2), lane, r32, hi, oa0, oa1, lsa, ob0, ob1, lsb);
                { const int lt = 128 * (2 * (w >> 2)) + 4 * r32 + (w & 3); const float ls = sl[lt], mx = fmaxf(ls, lsa);
                  float wa = __builtin_amdgcn_exp2f(ls - mx), wb = __builtin_amdgcn_exp2f(lsa - mx); const float sw = wa + wb, isw = 1.f / sw; wa *= isw; wb *= isw;
                  sb_merge(sb, lt, hi, wa, wb, oa0, oa1); sb_store(sb, lt, hi, oa0, oa1); if (hi == 0) sl[lt] = mx + __builtin_amdgcn_logf(sw); }
                { const int lt = 128 * (2 * (w >> 2) + 1) + 4 * r32 + (w & 3); const float ls = sl[lt], mx = fmaxf(ls, lsb);
                  float wa = __builtin_amdgcn_exp2f(ls - mx), wb = __builtin_amdgcn_exp2f(lsb - mx); const float sw = wa + wb, isw = 1.f / sw; wa *= isw; wb *= isw;
                  sb_merge(sb, lt, hi, wa, wb, ob0, ob1); sb_store(sb, lt, hi, ob0, ob1); if (hi == 0) sl[lt] = mx + __builtin_amdgcn_logf(sw); } }
            __syncthreads();
            { f32x16 oa0, oa1, ob0, ob1; float lsa, lsb;
                dil_unit2(Qb, Kb, Vb, tb0, Vw, troff, 1, 0, 8 * sp + w, lane, r32, hi, oa0, oa1, lsa, ob0, ob1, lsb);
                { const int lt = 32 * (2 * w) + r32; const float ls = sl[lt], mx = fmaxf(ls, lsa);
                  float wa = __builtin_amdgcn_exp2f(ls - mx), wb = __builtin_amdgcn_exp2f(lsa - mx); const float isw = 1.f / (wa + wb); wa *= isw; wb *= isw;
                  sb_merge(sb, lt, hi, wa, wb, oa0, oa1); sb_store(sb, lt, hi, oa0, oa1); }
                { const int lt = 32 * (2 * w + 1) + r32; const float ls = sl[lt], mx = fmaxf(ls, lsb);
                  float wa = __builtin_amdgcn_exp2f(ls - mx), wb = __builtin_amdgcn_exp2f(lsb - mx); const float isw = 1.f / (wa + wb); wa *= isw; wb *= isw;
                  sb_merge(sb, lt, hi, wa, wb, ob0, ob1); sb_store(sb, lt, hi, ob0, ob1); } }
            __syncthreads();
#pragma unroll
            for (int j = 0; j < 8; ++j) { const int idx = tid + 512 * j, row = idx >> 3, ch = idx & 7;
                const LAS unsigned char* p = sb + row * DL_SBP + ch * 16; const u32x2 a = *(const LAS u32x2*)p, c2 = *(const LAS u32x2*)(p + 8);
                u32x4 v; v[0] = a.x; v[1] = a.y; v[2] = c2.x; v[3] = c2.y;
                *(u32x4*)(Y + ((size_t)b * SEQ + 512 * sp + row) * DM + 64 * h + 8 * ch) = v;
                float sq = bflo(a.x) * bflo(a.x) + bfhi(a.x) * bfhi(a.x) + bflo(a.y) * bflo(a.y) + bfhi(a.y) * bfhi(a.y) + bflo(c2.x) * bflo(c2.x) + bfhi(c2.x) * bfhi(c2.x) + bflo(c2.y) * bflo(c2.y) + bfhi(c2.y) * bfhi(c2.y);
                sq += __shfl_xor(sq, 1); sq += __shfl_xor(sq, 2); sq += __shfl_xor(sq, 4);
                if (ch == 0) atomicAdd(SSA + (size_t)b * SEQ + 512 * sp + row, sq); }
            __syncthreads();
        }
    }
}

__device__ __forceinline__ void merge_phase(const bf16* __restrict__ Y, bf16* __restrict__ YN, int gw, int NGW, int lane) {
    for (int m = gw; m < NTOK; m += NGW) {
        const u32x4 ya = *(const u32x4*)(Y + (size_t)m * DM + 8 * lane), yb = *(const u32x4*)(Y + (size_t)m * DM + 512 + 8 * lane);
        float v[8], u[8]; float sa = 0.f, sb = 0.f;
#pragma unroll
        for (int e = 0; e < 4; ++e) { v[2 * e] = bflo(ya[e]); v[2 * e + 1] = bfhi(ya[e]); u[2 * e] = bflo(yb[e]); u[2 * e + 1] = bfhi(yb[e]); }
#pragma unroll
        for (int e = 0; e < 8; ++e) { sa += v[e] * v[e]; sb += u[e] * u[e]; }
        sa = wave_sum(sa); sb = wave_sum(sb);
        const float ra = rsqrtf(sa * (1.f / 512.f) + EPS), rb = rsqrtf(sb * (1.f / 512.f) + EPS);
        u32x4 oa, ob;
#pragma unroll
        for (int e = 0; e < 4; ++e) { oa[e] = cvtpk(v[2 * e] * ra, v[2 * e + 1] * ra); ob[e] = cvtpk(u[2 * e] * rb, u[2 * e + 1] * rb); }
        *(u32x4*)(YN + (size_t)m * DM + 8 * lane) = oa; *(u32x4*)(YN + (size_t)m * DM + 512 + 8 * lane) = ob;
    }
}

constexpr int CR_KP = 272, CR_VP = 320, CR_K = 0, CR_V = 2 * 64 * CR_KP, CR_END = CR_V + 2 * 64 * CR_VP, CR_OP = 272;
static_assert(4 * 32 * CR_OP <= CR_V && CR_END + 4 * 32 * CR_OP <= 139264, "cross LDS map");
typedef __amdgpu_buffer_rsrc_t rsrc_t;
__device__ __forceinline__ rsrc_t mkrsrc(const void* base, unsigned bytes) { return __builtin_amdgcn_make_buffer_rsrc((void*)base, 0, bytes, 0x00020000); }
__device__ __forceinline__ u32x4 bld16(rsrc_t r, unsigned voff, unsigned soff) { return __builtin_bit_cast(u32x4, __builtin_amdgcn_raw_buffer_load_b128(r, voff, soff, 0)); }
__device__ __forceinline__ void cross_phase(LAS unsigned char* lds, const bf16* QM, const bf16* KVM, bf16* OM, int vcu, int G, int pv) {
    const int tid = threadIdx.x, lane = tid & 63, r32 = lane & 31, hi = lane >> 5; const int w = __builtin_amdgcn_readfirstlane(tid >> 6);
    const int troff = tr_off(lane, CR_VP);
    const int kkey = tid >> 3, kch = tid & 7;
    const unsigned soff = (unsigned)kkey * 4096u + (unsigned)kch * 16u;
    const unsigned qoff = (unsigned)(32 * w + r32) * 2048u + (unsigned)hi * 16u;
    const int kl0 = kkey * CR_KP + kch * 16, vl0 = kkey * CR_VP + kch * 16;
    const int kfo = kappa(r32) * CR_KP + hi * 16;
    const rsrc_t rK = mkrsrc(KVM, (unsigned)NMEMTOK * 4096u), rQ = mkrsrc(QM, (unsigned)NTOK * 2048u);
    LAS unsigned char* Tw = lds + (w < 4 ? CR_K + w * (32 * CR_OP) : CR_END + (w - 4) * (32 * CR_OP));
    for (int un = vcu * 4; un < BATCH * 4 * 8; un += G * 4) for (int ui = 0; ui < 4; ++ui) { const int u = un + ui, qblk = u & 7, hm = (u >> 3) & 3, b = u >> 5;
        const unsigned Qs = (unsigned)(((b * SEQ + 256 * qblk) * DM + 256 * hm) * 2);
        unsigned char* Os = (unsigned char*)(OM + ((size_t)b * SEQ + 256 * qblk) * DM + 256 * hm);
        const unsigned Ks = (unsigned)((b * NMEM * 2048 + 256 * hm) * 2), Vs = Ks + 2048u;
        f32x16 sc[8];
#pragma unroll
        for (int kt = 0; kt < 8; ++kt) sc[kt] = f32x16{};
        u32x4 r0, r1;
        __syncthreads();
        r0 = bld16(rK, soff, Ks); r1 = bld16(rK, soff, Ks + 128u);
        *(LAS u32x4*)(lds + CR_K + kl0) = r0; *(LAS u32x4*)(lds + CR_K + kl0 + 128) = r1;
        __syncthreads();
#pragma unroll
        for (int half = 0; half < 2; ++half) {
            bf16x8 qf[8];
#pragma unroll
            for (int d0 = 0; d0 < 8; ++d0) qf[d0] = __builtin_bit_cast(bf16x8, bld16(rQ, qoff, Qs + (unsigned)(256 * half + 32 * d0)));
#pragma unroll
            for (int kp = 0; kp < 4; ++kp) { const int step = half * 4 + kp, buf = step & 1;
                if (!(pv & 2)) { if (step + 1 < 8) { const int nh = (step + 1) >> 2, nk = (step + 1) & 3; const unsigned src = Ks + (unsigned)(nk * (64 * 4096) + 256 * nh); r0 = bld16(rK, soff, src); r1 = bld16(rK, soff, src + 128u); }
                else { r0 = bld16(rK, soff, Vs); r1 = bld16(rK, soff, Vs + 128u); } }
                const LAS unsigned char* Kt = lds + CR_K + buf * (64 * CR_KP) + kfo;
#pragma unroll
                for (int d0 = 0; d0 < 8; ++d0) { sc[2 * kp] = mfma32(*(const LAS bf16x8*)(Kt + d0 * 32), qf[d0], sc[2 * kp]); sc[2 * kp + 1] = mfma32(*(const LAS bf16x8*)(Kt + 32 * CR_KP + d0 * 32), qf[d0], sc[2 * kp + 1]); if (d0 & 1) __builtin_amdgcn_sched_barrier(0); }
                if (step + 1 < 8) { *(LAS u32x4*)(lds + CR_K + (buf ^ 1) * (64 * CR_KP) + kl0) = r0; *(LAS u32x4*)(lds + CR_K + (buf ^ 1) * (64 * CR_KP) + kl0 + 128) = r1; }
                else { *(LAS u32x4*)(lds + CR_V + vl0) = r0; *(LAS u32x4*)(lds + CR_V + vl0 + 128) = r1; }
                LBAR();
            }
        }
        const float c1 = 0.0625f * LOG2E, mo = 0.f; float ls = 0.f;
        bf16x8 pf[8][2];
#pragma unroll
        for (int kt = 0; kt < 8; ++kt) {
#pragma unroll
            for (int r = 0; r < 16; ++r) { sc[kt][r] = __builtin_amdgcn_exp2f(sc[kt][r] * c1 - mo); ls += sc[kt][r]; }
            pf[kt][0] = packp(sc[kt], 0); pf[kt][1] = packp(sc[kt], 1); }
        const float inv = 1.f / xhalf_sum(ls);
#pragma unroll
        for (int hv = 0; hv < 2; ++hv) {
            f32x16 o[4];
#pragma unroll
            for (int c = 0; c < 4; ++c) o[c] = f32x16{};
            if (hv == 1) { if (!(pv & 2)) { r0 = bld16(rK, soff, Vs + 256u); r1 = bld16(rK, soff, Vs + 384u); }
                *(LAS u32x4*)(lds + CR_V + vl0) = r0; *(LAS u32x4*)(lds + CR_V + vl0 + 128) = r1; LBAR(); }
#pragma unroll
            for (int kp = 0; kp < 4; ++kp) { const int buf = kp & 1;
                if (kp + 1 < 4 && !(pv & 2)) { const unsigned src = Vs + (unsigned)((kp + 1) * (64 * 4096) + 256 * hv); r0 = bld16(rK, soff, src); r1 = bld16(rK, soff, src + 128u); }
                const LAS unsigned char* vb = lds + CR_V + buf * (64 * CR_VP) + troff;
#pragma unroll
                for (int t2 = 0; t2 < 2; ++t2) { const unsigned va = (unsigned)(size_t)(vb + t2 * 32 * CR_VP);
                    s16x4 l0, h0, l1, h1, l2, h2, l3, h3, l4, h4, l5, h5, l6, h6, l7, h7;
                    TR_RD(l0, va, 0 * CR_VP); TR_RD(h0, va, 4 * CR_VP); TR_RD(l1, va, 16 * CR_VP); TR_RD(h1, va, 20 * CR_VP); TR_RD(l2, va, 64 + 0 * CR_VP); TR_RD(h2, va, 64 + 4 * CR_VP); TR_RD(l3, va, 64 + 16 * CR_VP); TR_RD(h3, va, 64 + 20 * CR_VP);
                    TR_RD(l4, va, 128 + 0 * CR_VP); TR_RD(h4, va, 128 + 4 * CR_VP); TR_RD(l5, va, 128 + 16 * CR_VP); TR_RD(h5, va, 128 + 20 * CR_VP); TR_RD(l6, va, 192 + 0 * CR_VP); TR_RD(h6, va, 192 + 4 * CR_VP); TR_RD(l7, va, 192 + 16 * CR_VP); TR_RD(h7, va, 192 + 20 * CR_VP);
                    const bf16x8 q0 = pf[2 * kp + t2][0], q1 = pf[2 * kp + t2][1];
                    TR_WAIT(14, l0, h0); o[0] = mfma32(cat8(l0, h0), q0, o[0]); TR_WAIT(12, l1, h1); o[0] = mfma32(cat8(l1, h1), q1, o[0]); TR_WAIT(10, l2, h2); o[1] = mfma32(cat8(l2, h2), q0, o[1]); TR_WAIT(8, l3, h3); o[1] = mfma32(cat8(l3, h3), q1, o[1]);
                    TR_WAIT(6, l4, h4); o[2] = mfma32(cat8(l4, h4), q0, o[2]); TR_WAIT(4, l5, h5); o[2] = mfma32(cat8(l5, h5), q1, o[2]); TR_WAIT(2, l6, h6); o[3] = mfma32(cat8(l6, h6), q0, o[3]); TR_WAIT(0, l7, h7); o[3] = mfma32(cat8(l7, h7), q1, o[3]); }
                if (kp + 1 < 4) { *(LAS u32x4*)(lds + CR_V + (buf ^ 1) * (64 * CR_VP) + vl0) = r0; *(LAS u32x4*)(lds + CR_V + (buf ^ 1) * (64 * CR_VP) + vl0 + 128) = r1; }
                LBAR();
            }
            if (!(pv & 1)) {
#pragma unroll
                for (int c = 0; c < 4; ++c)
#pragma unroll
                    for (int g4 = 0; g4 < 4; ++g4) { u32x2 a; a.x = cvtpk(o[c][4 * g4] * inv, o[c][4 * g4 + 1] * inv); a.y = cvtpk(o[c][4 * g4 + 2] * inv, o[c][4 * g4 + 3] * inv); *(LAS u32x2*)(Tw + r32 * CR_OP + 64 * c + 16 * g4 + 8 * hi) = a; }
                unsigned char* yp = Os + 256 * hv + (lane & 15) * 16 + (size_t)(32 * w + (lane >> 4)) * 2048;
#pragma unroll
                for (int j = 0; j < 8; ++j) { const u32x4 v = *(const LAS u32x4*)(Tw + ((lane >> 4) + 4 * j) * CR_OP + (lane & 15) * 16); *(u32x4*)(yp + (size_t)j * (4 * 2048)) = v; }
            }
        }
    }
}
}


struct Frame {
    LAS unsigned char* lds;
    int tid, lane, wave, vcu, G;
};
__device__ __forceinline__ void p0_titem(const float* __restrict__ W, int Nsrc, int nsrc0, int k0, const float* __restrict__ g, const float* __restrict__ g2, int gsplit,
                                         bf16* __restrict__ WT, int K, int ndst0, LAS float* scr, int lane) {
#pragma unroll 8
    for (int i = 0; i < 32; ++i) { const int kk = 2 * i + (lane >> 5); const int k = k0 + kk;
        float gv = 1.f; if (g) gv = (g2 && k >= gsplit) ? g2[k - gsplit] : g[k];
        scr[kk * 33 + (lane & 31)] = W[(size_t)k * Nsrc + nsrc0 + (lane & 31)] * gv; }
    LDS_WAIT(); asm volatile("" ::: "memory");
    const int c = lane & 7;
#pragma unroll
    for (int j = 0; j < 4; ++j) { const int n = (lane >> 3) + 8 * j; const LAS float* s = scr + (8 * c) * 33 + n;
        v4u o; o.x = pk2(s[0 * 33], s[1 * 33]); o.y = pk2(s[2 * 33], s[3 * 33]); o.z = pk2(s[4 * 33], s[5 * 33]); o.w = pk2(s[6 * 33], s[7 * 33]);
        *(GAS v4u*)(WT + (size_t)(ndst0 + n) * K + k0 + 8 * c) = o; }
    LDS_WAIT(); asm volatile("" ::: "memory");
}
__device__ __forceinline__ void p0_norm_rows2(const float* __restrict__ x0, const float* __restrict__ x1, bf16* __restrict__ o0, bf16* __restrict__ o1, int lane, float* rn = nullptr) {
    const GAS f32x4* a = (const GAS f32x4*)x0 + lane; const GAS f32x4* b = (const GAS f32x4*)x1 + lane; f32x4 v[4], u[4]; float s = 0.f, t = 0.f;
#pragma unroll
    for (int j = 0; j < 4; ++j) { v[j] = a[64 * j]; u[j] = b[64 * j]; }
#pragma unroll
    for (int j = 0; j < 4; ++j) { s += (v[j].x * v[j].x + v[j].y * v[j].y) + (v[j].z * v[j].z + v[j].w * v[j].w); t += (u[j].x * u[j].x + u[j].y * u[j].y) + (u[j].z * u[j].z + u[j].w * u[j].w); }
    s = wave_sum(s); t = wave_sum(t);
    const float rs = rsqrtf(s * (1.f / DM) + EPS), rt = rsqrtf(t * (1.f / DM) + EPS);
    if (rn && lane == 0) { rn[0] = sqrtf(s * (1.f / DM) + EPS); rn[1] = sqrtf(t * (1.f / DM) + EPS); }
    GAS unsigned long long* p = (GAS unsigned long long*)o0 + lane; GAS unsigned long long* q = (GAS unsigned long long*)o1 + lane;
#pragma unroll
    for (int j = 0; j < 4; ++j) { p[64 * j] = (unsigned long long)pk2(v[j].x * rs, v[j].y * rs) | ((unsigned long long)pk2(v[j].z * rs, v[j].w * rs) << 32);
        q[64 * j] = (unsigned long long)pk2(u[j].x * rt, u[j].y * rt) | ((unsigned long long)pk2(u[j].z * rt, u[j].w * rt) << 32); }
}

struct Args { const float* in[20]; float* out; unsigned char* ws; int ph_lo, ph_hi, att_mask, ss_dummy, bar_idx, variant; };
enum { PH_PRO = 0, PH_QKV = 1, PH_ATT = 2, PH_MERGE = 3, PH_OUT = 4, PH_QM = 5, PH_CROSS = 6, PH_OM = 7, PH_FFN1 = 8, PH_FIX = 9, PH_DOWN = 10, PH_N = 11 };

__global__ void __launch_bounds__(NWAVES * 64, 2) mega(Args args) {
    extern __shared__ __attribute__((aligned(16))) unsigned char lds_raw[];
    Frame F;
    F.lds = (LAS unsigned char*)lds_raw;
    F.tid = threadIdx.x; F.lane = F.tid & 63; F.wave = __builtin_amdgcn_readfirstlane(F.tid >> 6);
    F.G = gridDim.x; { const int bx = blockIdx.x; F.vcu = (F.G % 8 == 0) ? (bx % 8) * (F.G / 8) + bx / 8 : bx; }
    unsigned char* ws = args.ws;
    volatile LAS unsigned* MISC = (volatile LAS unsigned*)(F.lds + MISC_OFF);
    for (int u = F.tid; u < (LDS_BYTES - MISC_OFF) / 4; u += NWAVES * 64) ((LAS unsigned*)(F.lds + MISC_OFF))[u] = 0u;
    __syncthreads();
    const int lo = args.ph_lo, hi = args.ph_hi;
    unsigned* barw = (unsigned*)(ws + WS_CTL) + CW_BAR + args.bar_idx * XCD_BAR_WORDS;
    XcdBarrier bar; bar.bar = barw; bar.x = 0; bar.st = nullptr;
    if (hi - lo > 1 || (lo <= PH_DOWN && PH_DOWN < hi)) bar = xcd_barrier_post(barw, MISC + 8);
#define IN(k) (lo <= (k) && (k) < hi)
#define SEAM(k) do { if (IN(k) && IN((k) + 1)) xcd_barrier(bar); } while (0)

    const float* x = args.in[0]; const float* mem = args.in[1]; const float* w_in = args.in[2]; const float* g_mix = args.in[3]; const float* g_od = args.in[4];
    const float* g_om = args.in[5]; const float* w_out = args.in[6]; const float* rel_bias = args.in[7]; const float* g_cross = args.in[8]; const float* g_mem = args.in[9];
    const float* w_q = args.in[10]; const float* w_kv = args.in[11]; const float* w_o = args.in[12]; const float* g_ffn = args.in[13]; const float* w_gate = args.in[14];
    const float* w_up = args.in[15]; const float* conv_w = args.in[16]; const float* conv_b = args.in[17]; const float* w_down = args.in[18]; const float* g_final = args.in[19];
    float* RS0 = (float*)(ws + WS_RS0); float* RSM = (float*)(ws + WS_RSM); float* SS1 = (float*)(ws + WS_SS1); float* SS2 = (float*)(ws + WS_SS2); float* SS3 = (float*)(ws + WS_SS3);
    float* SSA = (float*)(ws + WS_SSA); float* SSB = (float*)(ws + WS_SSB);
    float* SA1 = SS1; float* SA2 = SS2; float* SA3 = SS3; float* SAA = SSA; float* SAB = SSB;
    if (0) { SA1 = SA2 = SA3 = SAA = SAB = (float*)(ws + WS_DUMMY); }
    float* LUT = (float*)(ws + WS_LUT); float* KMP = (float*)(ws + WS_KMP); float* HALOG = (float*)(ws + WS_HALOG); float* FIXG = (float*)(ws + WS_FIXG); float* FIXU = (float*)(ws + WS_FIXU); float* PS = (float*)(ws + WS_PS);
    bf16* WIN = (bf16*)(ws + WS_WIN); bf16* WOUT = (bf16*)(ws + WS_WOUT); bf16* WQ = (bf16*)(ws + WS_WQ); bf16* WKV = (bf16*)(ws + WS_WKV);
    bf16* WO = (bf16*)(ws + WS_WO); bf16* WGU = (bf16*)(ws + WS_WGU); bf16* WD = (bf16*)(ws + WS_WD);
    bf16* MEMB = (bf16*)(ws + WS_MEMB); bf16* KVM = (bf16*)(ws + WS_KVM); bf16* XB = (bf16*)(ws + WS_XB); bf16* QKV = (bf16*)(ws + WS_QKV);
    bf16* YN = (bf16*)(ws + WS_YN); bf16* Y = (bf16*)(ws + WS_Y); bf16* OP = (bf16*)(ws + WS_OP); float* LSEP = (float*)(ws + WS_LSEP); bf16* H1 = (bf16*)(ws + WS_H1); bf16* QM = (bf16*)(ws + WS_QM);
    bf16* OM = (bf16*)(ws + WS_OM); bf16* H2 = (bf16*)(ws + WS_H2); bf16* ACT = (bf16*)(ws + WS_ACT); bf16* H3 = (bf16*)(ws + WS_H3);
    const int gw = F.vcu * NWAVES + F.wave, NGW = F.G * NWAVES;
    const int gt = (int)blockIdx.x * (NWAVES * 64) + F.tid, NGT = F.G * NWAVES * 64;

    if (IN(PH_PRO)) {
        LAS float* scr = (LAS float*)(F.lds + RING_OFF + F.wave * 16384);
        constexpr int I_IN = 16 * 96, I_OUT = 16 * 32, I_Q = 16 * 32, I_KV = 16 * 64, I_O = 16 * 32, I_GU = 16 * 176, I_D = 44 * 32;
        constexpr int NITEMS = I_IN + I_OUT + I_Q + I_KV + I_O + I_GU + I_D;
        for (int it = gw; it < NITEMS; it += NGW) {
            int r = it;
            if (r < I_IN) { const int kb = r / 96, nb = r % 96; p0_titem(w_in, 3072, 32 * nb, 64 * kb, g_mix, nullptr, 0, WIN, 1024, 32 * nb, scr, F.lane); continue; } r -= I_IN;
            if (r < I_OUT) { const int kb = r / 32, nb = r % 32; p0_titem(w_out, 1024, 32 * nb, 64 * kb, g_od, g_om, 512, WOUT, 1024, 32 * nb, scr, F.lane); continue; } r -= I_OUT;
            if (r < I_Q) { const int kb = r / 32, nb = r % 32; p0_titem(w_q, 1024, 32 * nb, 64 * kb, g_cross, nullptr, 0, WQ, 1024, 32 * nb, scr, F.lane); continue; } r -= I_Q;
            if (r < I_KV) { const int kb = r / 64, nb = r % 64; p0_titem(w_kv, 2048, 32 * nb, 64 * kb, g_mem, nullptr, 0, WKV, 1024, 32 * nb, scr, F.lane); continue; } r -= I_KV;
            if (r < I_O) { const int kb = r / 32, nb = r % 32; p0_titem(w_o, 1024, 32 * nb, 64 * kb, nullptr, nullptr, 0, WO, 1024, 32 * nb, scr, F.lane); continue; } r -= I_O;
            if (r < I_GU) { const int kb = r / 176, nb = r % 176; const int nd = 32 * nb, j = nd >> 8, rr = nd & 255;
                const float* src = (rr < 128) ? w_gate : w_up; const int sc = 128 * j + (rr & 127);
                p0_titem(src, 2816, sc, 64 * kb, g_ffn, nullptr, 0, WGU, 1024, nd, scr, F.lane); continue; } r -= I_GU;
            { const int kb = r / 32, nb = r % 32; p0_titem(w_down, 1024, 32 * nb, 64 * kb, nullptr, nullptr, 0, WD, 2816, 32 * nb, scr, F.lane); }
        }
        for (int m = 2 * gw; m < NTOK; m += 2 * NGW) p0_norm_rows2(x + (size_t)m * DM, x + (size_t)(m + 1) * DM, XB + (size_t)m * DM, XB + (size_t)(m + 1) * DM, F.lane, (float*)(ws + WS_RN0) + m);
        for (int m = 2 * gw; m < NMEMTOK; m += 2 * NGW) p0_norm_rows2(mem + (size_t)m * DM, mem + (size_t)(m + 1) * DM, MEMB + (size_t)m * DM, MEMB + (size_t)(m + 1) * DM, F.lane);
        for (int i = gt; i < 16 * 2048; i += NGT) { const int h = i >> 11, n = i & 2047; int b;
            if (n < 16) b = n; else { b = 16 + (n >= 22) + (n >= 30) + (n >= 40) + (n >= 54) + (n >= 73) + (n >= 99) + (n >= 134) + (n >= 182) + (n >= 246) + (n >= 332) + (n >= 450) + (n >= 609) + (n >= 825) + (n >= 1117) + (n >= 1513); }
            LUT[i] = rel_bias[h * 32 + b]; }
        for (int i = gt; i < NTOK; i += NGT) { SA1[i] = 0.f; SA2[i] = 0.f; SAA[i] = 0.f; SAB[i] = 0.f; }
        for (int i = gt; i < NTOK + 256; i += NGT) ((unsigned*)PS)[i] = 0u;
    }
    SEAM(PH_PRO);

#define STAGGER(ticks) do { const unsigned long long t0_ = __builtin_amdgcn_s_memrealtime(); const unsigned long long d_ = (unsigned long long)((F.vcu & 3) * (ticks)); \
        while (__builtin_amdgcn_s_memrealtime() - t0_ < d_) __builtin_amdgcn_s_sleep(32); } while (0)
    if (IN(PH_QKV)) {
        { pg8::Gemm g{XB, WIN, NTOK, NQKV, 1024}; pg8::StaticOrder S; S.init(NTOK, NQKV, F.G, (int)blockIdx.x);
          pg8::EpiScale E{(0   & 128) ? (bf16*)(ws + WS_H1) : QKV, RS0, (0   & 128) ? nullptr : KMP, NQKV, ((0   & 32) ? 64 : 0) | ((0   & 64) ? 128 : 0) | ((0   & 128) ? 256 : 0)};
          pg8::gemm_phase<pg8::EpiScale, pg8::StaticOrder, true, true>(F.lds + RING_OFF, g, S, E); }
        { pg8::Gemm g{MEMB, WKV, NMEMTOK, 2048, 1024}; pg8::StaticOrder S; S.init(NMEMTOK, 2048, F.G, (int)blockIdx.x);
          pg8::EpiScale E{KVM, RSM, nullptr, 2048, 0};
          pg8::gemm_phase<pg8::EpiScale, pg8::StaticOrder, true, true>(F.lds + RING_OFF, g, S, E); }
    }
    SEAM(PH_QKV);
        if (IN(PH_ATT)) {
        if (3 & 1) att::moba_phase2(F.lds, QKV, KMP, LUT, 0   ? (bf16*)(ws + WS_H1) : Y, 0   ? nullptr : SAB, F.vcu, F.G);
        __syncthreads();
        if (3 & 2) att::dil_phase(F.lds, QKV, LUT, Y, SAA, F.vcu, F.G);
    }

    SEAM(PH_ATT);

    if (IN(PH_OUT)) {
        pg8::Gemm g{Y, WOUT, NTOK, DM, 1024}; pg8::StaticOrder S; S.init(NTOK, DM, F.G, (int)blockIdx.x);
        pg8::EpiOutProj E{H1, XB, (const float*)(ws + WS_RN0), SA1, SSA, SSB, DM, 0};
        pg8::gemm_phase<pg8::EpiOutProj, pg8::StaticOrder, true, true>(F.lds + RING_OFF, g, S, E);
    }
    SEAM(PH_OUT);
    if (IN(PH_QM)) {
        pg8::Gemm g{H1, WQ, NTOK, DM, 1024}; pg8::StaticOrder S; S.init(NTOK, DM, F.G, (int)blockIdx.x);
        pg8::EpiScale E{QM, SS1, nullptr, DM, 1};
        pg8::gemm_phase<pg8::EpiScale, pg8::StaticOrder, true, true>(F.lds + RING_OFF, g, S, E);
    }
    SEAM(PH_QM);
        if (IN(PH_CROSS)) att::cross_phase(F.lds, QM, KVM, OM, F.vcu, F.G, (0   >> 12) & 3);

    SEAM(PH_CROSS);
    if (IN(PH_OM)) {
        pg8::Gemm g{OM, WO, NTOK, DM, 1024}; pg8::StaticOrder S; S.init(NTOK, DM, F.G, (int)blockIdx.x);
        pg8::EpiResid E{H2, H1, SA2, DM, 0};
        pg8::gemm_phase<pg8::EpiResid, pg8::StaticOrder, true, true>(F.lds + RING_OFF, g, S, E);
    }
    SEAM(PH_OM);
    if (IN(PH_FFN1)) {
        pg8::Gemm g{H2, WGU, NTOK, 5632, 1024}; pg8::StaticOrder S; S.init(NTOK, 5632, F.G, (int)blockIdx.x);
        pg8::EpiFfn1 E{ACT, SS2, conv_w, conv_b, HALOG, FIXG, FIXU, (LAS float*)(F.lds + LDSX_OFF), (0   >> 8) & 3, 0};
        pg8::gemm_phase<pg8::EpiFfn1, pg8::StaticOrder, true, true>(F.lds + RING_OFF, g, S, E);
    }
    SEAM(PH_FFN1);
    if (IN(PH_FIX)) {
        for (int i = gt; i < 256 * 2816; i += NGT) { const int pm = i / 2816, c = i % 2816;
            const float g0 = FIXG[((size_t)pm * 2 + 0) * 2816 + c], g1 = FIXG[((size_t)pm * 2 + 1) * 2816 + c];
            float hm1 = 0.f, hm2 = 0.f; if (pm & 7) { hm2 = HALOG[((size_t)(pm - 1) * 2 + 0) * 2816 + c]; hm1 = HALOG[((size_t)(pm - 1) * 2 + 1) * 2816 + c]; }
            const float w0 = conv_w[c], w1 = conv_w[2816 + c], w2 = conv_w[2 * 2816 + c], cbv = conv_b[c];
            const float c0 = cbv + w2 * g0 + w1 * hm1 + w0 * hm2, c1 = cbv + w2 * g1 + w1 * g0 + w0 * hm1;
            ACT[((size_t)pm * 256 + 0) * 2816 + c] = (bf16)f2bf(c0 / (1.f + __expf(-c0)) * FIXU[((size_t)pm * 2 + 0) * 2816 + c]);
            ACT[((size_t)pm * 256 + 1) * 2816 + c] = (bf16)f2bf(c1 / (1.f + __expf(-c1)) * FIXU[((size_t)pm * 2 + 1) * 2816 + c]); }
    }
    SEAM(PH_FIX);
    if (IN(PH_DOWN)) {
        pg8::Gemm g{ACT, WD, NTOK, DM, DFF}; pg8::StaticOrder S0; S0.init(NTOK, DM, F.G, (int)blockIdx.x);
        pg8::EpiFinal<XcdBarrier> E{H2, args.out, g_final, PS, (unsigned*)(PS + NTOK)};
        { pg8::RoundOrder S{S0, 0}; pg8::gemm_phase<pg8::EpiFinal<XcdBarrier>, pg8::RoundOrder, false, true>(F.lds + RING_OFF, g, S, E); }
        __syncthreads();
        { pg8::RoundOrder S{S0, 1}; pg8::gemm_phase<pg8::EpiFinal<XcdBarrier>, pg8::RoundOrder, false, true>(F.lds + RING_OFF, g, S, E); }
        __syncthreads();
        { pg8::RoundOrder S{S0, 2}; pg8::gemm_phase<pg8::EpiFinal<XcdBarrier>, pg8::RoundOrder, false, true>(F.lds + RING_OFF, g, S, E); }
        __syncthreads();
        { pg8::RoundOrder S{S0, 3}; pg8::gemm_phase<pg8::EpiFinal<XcdBarrier>, pg8::RoundOrder, false, true>(F.lds + RING_OFF, g, S, E); }
    }
#undef IN
#undef SEAM
}


extern "C" void kernel_launch(void* const* d_in, const int* in_sizes, int n_in, void* d_out, int out_size, void* d_ws, size_t ws_size, hipStream_t stream) {
    static int grid = 0;
    if (grid == 0) {
        if (n_in != 20 || in_sizes[0] != NTOK * DM || out_size != NTOK * DM || ws_size < WS_END) { fprintf(stderr, "kernel_launch: unexpected shapes (n_in %d, ws %zu); nothing launched\n", n_in, ws_size); grid = -1; return; }
        int dev = 0, cus = 0, per_cu = 0;
        if (hipGetDevice(&dev) != hipSuccess || hipDeviceGetAttribute(&cus, hipDeviceAttributeMultiprocessorCount, dev) != hipSuccess) { grid = -1; return; }
        if (hipFuncSetAttribute((const void*)mega, hipFuncAttributeMaxDynamicSharedMemorySize, LDS_BYTES) != hipSuccess) { fprintf(stderr, "kernel_launch: hipFuncSetAttribute failed\n"); grid = -1; return; }
        if (hipOccupancyMaxActiveBlocksPerMultiprocessor(&per_cu, (const void*)mega, NWAVES * 64, LDS_BYTES) != hipSuccess || per_cu < 1) fprintf(stderr, "kernel_launch: occupancy query says %d\n", per_cu);
        (void)hipGetLastError();
        grid = cus;
        if (grid != NTOK / 256) { fprintf(stderr, "kernel_launch: this kernel needs exactly %d workgroups (one per CU of a 256-CU device); found %d CUs\n", NTOK / 256, cus); grid = NTOK / 256; }
    }
    if (grid < 0) return;
    unsigned char* ws = (unsigned char*)d_ws;
    (void)hipMemsetAsync(ws + WS_CTL, 0, CTL_ZERO_BYTES, stream);
    Args a{};
    for (int i = 0; i < 20; ++i) a.in[i] = (const float*)d_in[i];
    a.out = (float*)d_out; a.ws = ws; a.att_mask = 3;
    int nbar = 0;
    auto runx = [&](int lo, int hi, int mask, int dummy, int variant = 0) { Args b2 = a; b2.variant = variant; b2.bar_idx = (hi - lo > 1 || (lo <= PH_DOWN && PH_DOWN < hi)) ? nbar++ : 0; b2.ph_lo = lo; b2.ph_hi = hi; b2.att_mask = mask; b2.ss_dummy = dummy; hipLaunchKernelGGL(mega, dim3(grid), dim3(NWAVES * 64), LDS_BYTES, stream, b2); };
    auto run = [&](int lo, int hi) { runx(lo, hi, 3, 0); };
    run(0, PH_N);
}
```

```cpp
#include <hip/hip_runtime.h>
#include <cstdio>
#include <cstdint>

typedef unsigned short bf16;
constexpr int BATCH = 32, SEQ = 2048, DM = 1024, NTOK = BATCH * SEQ;
constexpr int NMEM = 256, NMEMTOK = BATCH * NMEM, DFF = 2816;
constexpr int NQKV = 3072;
constexpr float EPS = 1e-6f;

constexpr size_t MiB = 1u << 20;
constexpr size_t WS_CTL = 0, CTL_ZERO_BYTES = 64 * 1024;
constexpr size_t WS_RS0 = 1 * MiB;
constexpr size_t WS_RSM = WS_RS0 + 256 * 1024;
constexpr size_t WS_SS1 = WS_RSM + 256 * 1024;
constexpr size_t WS_SS2 = WS_SS1 + 256 * 1024;
constexpr size_t WS_SS3 = WS_SS2 + 256 * 1024;
constexpr size_t WS_SSA = 27 * MiB, WS_SSB = WS_SSA + 256 * 1024;
constexpr size_t WS_KMEAN = WS_SS3 + 256 * 1024;
constexpr size_t WS_LUT = WS_KMEAN + 512 * 1024;
constexpr size_t WS_KMP = 3 * MiB;
constexpr size_t WS_HALOG = 4 * MiB;
constexpr size_t WS_FIXG = WS_HALOG + 256 * 2 * 2816 * 4;
constexpr size_t WS_FIXU = WS_FIXG + 256 * 2 * 2816 * 4;
constexpr size_t WS_DUMMY = 21 * MiB;
constexpr size_t WS_PS = 22 * MiB;
constexpr size_t WS_RN0 = 24 * MiB;
constexpr size_t WS_LSEP = 23 * MiB;
constexpr size_t WS_WIN = 28 * MiB;
constexpr size_t WS_WOUT = WS_WIN + 6 * MiB;
constexpr size_t WS_WQ = WS_WOUT + 2 * MiB;
constexpr size_t WS_WKV = WS_WQ + 2 * MiB;
constexpr size_t WS_WO = WS_WKV + 4 * MiB;
constexpr size_t WS_WGU = WS_WO + 2 * MiB;
constexpr size_t WS_WD = WS_WGU + 11 * MiB;
constexpr size_t WS_MEMB = 62 * MiB;
constexpr size_t WS_KVM = 78 * MiB;
constexpr size_t WS_XB = 112 * MiB;
constexpr size_t WS_QKV = 240 * MiB;
constexpr size_t WS_Y = 624 * MiB;
constexpr size_t WS_OP = 752 * MiB;
constexpr size_t WS_YN = 240 * MiB;
constexpr size_t WS_H1 = 880 * MiB;
constexpr size_t WS_QM = 368 * MiB;
constexpr size_t WS_OM = 496 * MiB;
constexpr size_t WS_H2 = 624 * MiB;
constexpr size_t WS_ACT = 112 * MiB;
constexpr size_t WS_GU = 752 * MiB;
constexpr size_t WS_H3 = 464 * MiB;
constexpr size_t WS_END = 1024 * MiB;
static_assert(WS_FIXU + 256 * 2 * 2816 * 4 <= WS_LSEP && WS_LSEP + 5 * MiB <= WS_WIN && WS_WD + 6 * MiB <= WS_MEMB, "ws map");

__device__ __forceinline__ unsigned f2bf(float f) { unsigned u = __builtin_bit_cast(unsigned, f); return (u + 0x7fffu + ((u >> 16) & 1u)) >> 16; }
__device__ __forceinline__ float bf2f(bf16 b) { return __builtin_bit_cast(float, (unsigned)b << 16); }
__device__ __forceinline__ float bflo(unsigned w) { return __builtin_bit_cast(float, w << 16); }
__device__ __forceinline__ float bfhi(unsigned w) { return __builtin_bit_cast(float, w & 0xffff0000u); }
__device__ __forceinline__ float wave_sum(float v) {
#pragma unroll
    for (int o = 1; o < 64; o <<= 1) v += __shfl_xor(v, o);
    return v;
}


namespace pg8 {
#define PG8_LAS __attribute__((address_space(3)))
typedef unsigned short bf16_t;
typedef short bf16x8 __attribute__((ext_vector_type(8)));
typedef float f32x4 __attribute__((ext_vector_type(4)));
typedef unsigned u32x4 __attribute__((ext_vector_type(4)));
constexpr int BM = 256, BK = 64, HALF = 128, HTB = HALF * BK * 2  , STAGE_BYTES = 8 * HTB, NXCD = 8, WGM = 8;

__host__ __device__ __forceinline__ int lds_byte(int r, int c) { const int st = (r >> 4) * 2 + (c >> 5), rr = r & 15, cc = c & 31, ob = rr * 64 + cc * 2; return st * 1024 + (ob ^ (((ob >> 9) & 1) << 5)); }
__host__ __device__ __forceinline__ void stage_rc(int b, int& R, int& C) { const int st = b / 1024, sb = b % 1024, swz = sb ^ (((sb >> 9) & 1) << 5); R = (st >> 1) * 16 + swz / 64; C = (st & 1) * 32 + (swz % 64) / 2; }
__host__ __device__ __forceinline__ int perm32(int rho) { const int n = rho >> 4, i = rho & 15; return 8 * (i >> 2) + 4 * n + (i & 3); }

struct Unit { int pm, pn; };
struct Gemm { const bf16_t* A; const bf16_t* Bt; int M, N, K; };

struct StaticOrder {
    int nM, nN, nwg, G, c;
    __host__ __device__ void init(int M, int N, int G_, int c_) { nM = M / BM; nN = N / BM; nwg = nM * nN; G = G_; c = c_; }
    __host__ __device__ bool next(int i, Unit& u) const {
        const long L = (long)i * G + c; if (L >= nwg) return false;
        int wgid = (int)L; { const int q = nwg / NXCD, r = nwg % NXCD, xcd = wgid % NXCD, off = wgid / NXCD; wgid = (xcd < r ? xcd * (q + 1) : r * (q + 1) + (xcd - r) * q) + off; }
        const int nig = WGM * nN, gid = wgid / nig, fm = gid * WGM, gsz = (nM - fm) < WGM ? (nM - fm) : WGM;
        u.pm = fm + ((wgid % nig) % gsz); u.pn = (wgid % nig) / gsz; return true;
    }
    __device__ __forceinline__ void a_ready(const Unit&) const {}
    __device__ __forceinline__ void done(const Unit&) const {}
};


struct PanelOrder { int pm, nN;
    __device__ __forceinline__ bool next(int i, Unit& u) const { if (i >= nN) return false; int a = pm, b = i; asm volatile("" : "+s"(a), "+s"(b)); u.pm = a; u.pn = b; return true; }
    __device__ __forceinline__ void a_ready(const Unit&) const {}
    __device__ __forceinline__ void done(const Unit&) const {} };
__device__ __forceinline__ unsigned cvt_pk_bf16(float lo, float hi) { unsigned r; asm volatile("v_cvt_pk_bf16_f32 %0, %1, %2" : "=v"(r) : "v"(lo), "v"(hi)); return r; }
__device__ __forceinline__ float lo_f(unsigned w) { return __builtin_bit_cast(float, w << 16); }
__device__ __forceinline__ float hi_f(unsigned w) { return __builtin_bit_cast(float, w & 0xffff0000u); }

struct EpiScale {
    static constexpr bool PERM = true, AFTER_DRAIN = false, KSPLIT = false, PERM_A = false;
    bf16_t* O; const float* rs; float* kmp; int ldc; int mode;
    __device__ __forceinline__ void operator()(const f32x4 (&acc)[2][2][4][2], const Unit& u, int wr, int wc, int fr, int fq) const {
        if (mode & 64) return;
        const int row0 = u.pm * BM + wr * 64 + fr, col0 = u.pn * BM + wc * 32 + 8 * fq;
        const bool dokm = (kmp != nullptr) && (u.pn == 8 || u.pn == 9);
        const float qs = ((kmp != nullptr) && (u.pn < 2 || u.pn == 6 || u.pn == 7)) ? 0.125f * 1.4426950408889634f : 1.f;
        float cs[2][8];
#pragma unroll
        for (int bj = 0; bj < 2; ++bj)
#pragma unroll
            for (int e = 0; e < 8; ++e) cs[bj][e] = 0.f;
#pragma unroll
        for (int ai = 0; ai < 2; ++ai)
#pragma unroll
            for (int m = 0; m < 4; ++m) { const int r = row0 + ai * HALF + m * 16; float s = qs; if (mode == 1) s = rsqrtf(rs[r] * (1.f / 1024.f) + 1e-6f);
                bf16_t* rowp = (mode & 256) ? O + (size_t)(r & 255) * ldc + col0 : O + (size_t)r * ldc + col0;
#pragma unroll
                for (int bj = 0; bj < 2; ++bj) { const f32x4 v0 = acc[ai][bj][m][0] * s, v1 = acc[ai][bj][m][1] * s;
                    u32x4 w; w.x = cvt_pk_bf16(v0[0], v0[1]); w.y = cvt_pk_bf16(v0[2], v0[3]); w.z = cvt_pk_bf16(v1[0], v1[1]); w.w = cvt_pk_bf16(v1[2], v1[3]);
                    if (mode & 128) { asm volatile("" :: "v"(w.x), "v"(w.y), "v"(w.z), "v"(w.w)); } else *(u32x4*)(rowp + bj * HALF) = w;
                    if (dokm) { cs[bj][0] += lo_f(w.x); cs[bj][1] += hi_f(w.x); cs[bj][2] += lo_f(w.y); cs[bj][3] += hi_f(w.y); cs[bj][4] += lo_f(w.z); cs[bj][5] += hi_f(w.z); cs[bj][6] += lo_f(w.w); cs[bj][7] += hi_f(w.w); } } }
        if (dokm) {
#pragma unroll
            for (int bj = 0; bj < 2; ++bj)
#pragma unroll
                for (int e = 0; e < 8; ++e) { float v = cs[bj][e]; v += __shfl_xor(v, 1); v += __shfl_xor(v, 2); v += __shfl_xor(v, 4); v += __shfl_xor(v, 8); cs[bj][e] = v; }
            if (fr == 0) { float* kp = kmp + (size_t)(u.pm * 2 + wr) * 512 + (u.pn - 8) * 256 + wc * 32 + 8 * fq;
#pragma unroll
                for (int bj = 0; bj < 2; ++bj) { *(f32x4*)(kp + bj * HALF) = (f32x4){cs[bj][0], cs[bj][1], cs[bj][2], cs[bj][3]}; *(f32x4*)(kp + bj * HALF + 4) = (f32x4){cs[bj][4], cs[bj][5], cs[bj][6], cs[bj][7]}; } }
        }
    }
};

struct EpiResid {
    static constexpr bool PERM = true, AFTER_DRAIN = false, KSPLIT = false, PERM_A = false;
    bf16_t* O; const bf16_t* R; float* ss; int ldc; int pad;
    __device__ __forceinline__ void operator()(const f32x4 (&acc)[2][2][4][2], const Unit& u, int wr, int wc, int fr, int fq) const {
        const int row0 = u.pm * BM + wr * 64 + fr, col0 = u.pn * BM + wc * 32 + 8 * fq;
#pragma unroll
        for (int ai = 0; ai < 2; ++ai)
#pragma unroll
            for (int m = 0; m < 4; ++m) { const int r = row0 + ai * HALF + m * 16; const size_t off = (size_t)r * ldc + col0; float sq = 0.f;
#pragma unroll
                for (int bj = 0; bj < 2; ++bj) { const u32x4 rv = *(const u32x4*)(R + off + bj * HALF);
                    const f32x4 a0 = acc[ai][bj][m][0], a1 = acc[ai][bj][m][1];
                    u32x4 w; w.x = cvt_pk_bf16(a0[0] + lo_f(rv.x), a0[1] + hi_f(rv.x)); w.y = cvt_pk_bf16(a0[2] + lo_f(rv.y), a0[3] + hi_f(rv.y));
                    w.z = cvt_pk_bf16(a1[0] + lo_f(rv.z), a1[1] + hi_f(rv.z)); w.w = cvt_pk_bf16(a1[2] + lo_f(rv.w), a1[3] + hi_f(rv.w));
                    *(u32x4*)(O + off + bj * HALF) = w;
                    float t;
                    t = lo_f(w.x); sq += t * t; t = hi_f(w.x); sq += t * t; t = lo_f(w.y); sq += t * t; t = hi_f(w.y); sq += t * t;
                    t = lo_f(w.z); sq += t * t; t = hi_f(w.z); sq += t * t; t = lo_f(w.w); sq += t * t; t = hi_f(w.w); sq += t * t; }
                sq += __shfl_xor(sq, 16); sq += __shfl_xor(sq, 32);
                if (fq == 0) atomicAdd(ss + r, sq); }
    }
};


struct EpiResidF32 {
    static constexpr bool PERM = true, AFTER_DRAIN = false, KSPLIT = false, PERM_A = false;
    bf16_t* O; const float* R; float* ss; int ldc; int pad;
    __device__ __forceinline__ void operator()(const f32x4 (&acc)[2][2][4][2], const Unit& u, int wr, int wc, int fr, int fq) const {
        const int row0 = u.pm * BM + wr * 64 + fr, col0 = u.pn * BM + wc * 32 + 8 * fq;
#pragma unroll
        for (int ai = 0; ai < 2; ++ai)
#pragma unroll
            for (int m = 0; m < 4; ++m) { const int r = row0 + ai * HALF + m * 16; const size_t off = (size_t)r * ldc + col0; float sq = 0.f;
#pragma unroll
                for (int bj = 0; bj < 2; ++bj) { const f32x4 r0 = *(const f32x4*)(R + off + bj * HALF), r1 = *(const f32x4*)(R + off + bj * HALF + 4);
                    const f32x4 a0 = acc[ai][bj][m][0] + r0, a1 = acc[ai][bj][m][1] + r1;
                    u32x4 w; w.x = cvt_pk_bf16(a0[0], a0[1]); w.y = cvt_pk_bf16(a0[2], a0[3]); w.z = cvt_pk_bf16(a1[0], a1[1]); w.w = cvt_pk_bf16(a1[2], a1[3]);
                    *(u32x4*)(O + off + bj * HALF) = w;
                    float t;
                    t = lo_f(w.x); sq += t * t; t = hi_f(w.x); sq += t * t; t = lo_f(w.y); sq += t * t; t = hi_f(w.y); sq += t * t;
                    t = lo_f(w.z); sq += t * t; t = hi_f(w.z); sq += t * t; t = lo_f(w.w); sq += t * t; t = hi_f(w.w); sq += t * t; }
                sq += __shfl_xor(sq, 16); sq += __shfl_xor(sq, 32);
                if (fq == 0) atomicAdd(ss + r, sq); }
    }
};


struct EpiOutProj {
    static constexpr bool PERM = true, AFTER_DRAIN = false, KSPLIT = true, PERM_A = false;
    bf16_t* O; const bf16_t* R; const float* rn; float* ss; const float* ssa; const float* ssb; int ldc; int pad;
    __device__ __forceinline__ void mid(f32x4 (&acc)[2][2][4][2], const Unit& u, int wr, int fr) const {
        asm volatile("" : "+v"(fr));
#pragma unroll
        for (int ai = 0; ai < 2; ++ai) {
#pragma unroll
            for (int m = 0; m < 4; ++m) { const int r = u.pm * BM + ai * HALF + wr * 64 + m * 16 + fr;
                const float ratio = rsqrtf(ssa[r] * (1.f / 512.f) + 1e-6f) * sqrtf(ssb[r] * (1.f / 512.f) + 1e-6f);
#pragma unroll
                for (int bj = 0; bj < 2; ++bj) { acc[ai][bj][m][0] *= ratio; acc[ai][bj][m][1] *= ratio; } }
            asm volatile("" ::: "memory"); __builtin_amdgcn_sched_barrier(0); }
    }
    __device__ __forceinline__ void operator()(const f32x4 (&acc)[2][2][4][2], const Unit& u, int wr, int wc, int fr, int fq) const {
        const int row0 = u.pm * BM + wr * 64 + fr, col0 = u.pn * BM + wc * 32 + 8 * fq;
#pragma unroll
        for (int ai = 0; ai < 2; ++ai)
#pragma unroll
            for (int m = 0; m < 4; ++m) { const int r = row0 + ai * HALF + m * 16; const size_t off = (size_t)r * ldc + col0; float sq = 0.f;
                const float rsb = rsqrtf(ssb[r] * (1.f / 512.f) + 1e-6f), xs = rn[r];
#pragma unroll
                for (int bj = 0; bj < 2; ++bj) { const u32x4 rv = *(const u32x4*)(R + off + bj * HALF);
                    const f32x4 r0 = (f32x4){lo_f(rv.x), hi_f(rv.x), lo_f(rv.y), hi_f(rv.y)} * xs, r1 = (f32x4){lo_f(rv.z), hi_f(rv.z), lo_f(rv.w), hi_f(rv.w)} * xs;
                    const f32x4 a0 = acc[ai][bj][m][0] * rsb + r0, a1 = acc[ai][bj][m][1] * rsb + r1;
                    u32x4 w; w.x = cvt_pk_bf16(a0[0], a0[1]); w.y = cvt_pk_bf16(a0[2], a0[3]); w.z = cvt_pk_bf16(a1[0], a1[1]); w.w = cvt_pk_bf16(a1[2], a1[3]);
                    *(u32x4*)(O + off + bj * HALF) = w;
                    float t;
                    t = lo_f(w.x); sq += t * t; t = hi_f(w.x); sq += t * t; t = lo_f(w.y); sq += t * t; t = hi_f(w.y); sq += t * t;
                    t = lo_f(w.z); sq += t * t; t = hi_f(w.z); sq += t * t; t = lo_f(w.w); sq += t * t; t = hi_f(w.w); sq += t * t; }
                sq += __shfl_xor(sq, 16); sq += __shfl_xor(sq, 32);
                if (fq == 0) atomicAdd(ss + r, sq); }
    }
};

struct RoundOrder { StaticOrder S; int r;
    __device__ __forceinline__ bool next(int i, Unit& u) const { return i == 0 && S.next(r, u); }
    __device__ __forceinline__ void a_ready(const Unit&) const {}
    __device__ __forceinline__ void done(const Unit&) const {} };
template <class Bar> struct EpiFinal {
    static constexpr bool PERM = false, AFTER_DRAIN = true, KSPLIT = false, PERM_A = false;
    const bf16_t* R; float* out; const float* g; float* ps; unsigned* pcnt;
    __device__ __forceinline__ void fused(f32x4 (&acc)[2][2][4][2], const Unit& u, int wr, int wc, int fr, int fq, PG8_LAS unsigned char* lds, int wid, int lane) const {
        typedef unsigned u32x2v __attribute__((ext_vector_type(2)));
        PG8_LAS float* P = (PG8_LAS float*)lds;
        PG8_LAS float* S = (PG8_LAS float*)(lds + 4096);
        const int col0 = u.pn * BM + wc * 32 + 4 * fq, tid = wid * 64 + lane;
#pragma unroll
        for (int ai = 0; ai < 2; ++ai)
#pragma unroll
            for (int m = 0; m < 4; ++m) { const int rl = ai * HALF + wr * 64 + m * 16 + fr; const size_t off = (size_t)(u.pm * BM + rl) * 1024 + col0; float sq = 0.f;
#pragma unroll
                for (int bj = 0; bj < 2; ++bj)
#pragma unroll
                    for (int n = 0; n < 2; ++n) { const u32x2v rv = *(const u32x2v*)(R + off + bj * HALF + n * 16);
                        f32x4 v = acc[ai][bj][m][n]; v[0] += lo_f(rv.x); v[1] += hi_f(rv.x); v[2] += lo_f(rv.y); v[3] += hi_f(rv.y); acc[ai][bj][m][n] = v;
                        sq += (v[0] * v[0] + v[1] * v[1]) + (v[2] * v[2] + v[3] * v[3]); }
                sq += __shfl_xor(sq, 16); sq += __shfl_xor(sq, 32);
                if (fq == 0) P[rl * 4 + wc] = sq; }
        asm volatile("s_waitcnt lgkmcnt(0)" ::: "memory"); __builtin_amdgcn_s_barrier(); asm volatile("" ::: "memory");
        if (tid < 256) { const f32x4 p4 = *(const PG8_LAS f32x4*)(P + tid * 4); (void)__hip_atomic_fetch_add(ps + (size_t)u.pm * BM + tid, (p4[0] + p4[1]) + (p4[2] + p4[3]), __ATOMIC_RELAXED, __HIP_MEMORY_SCOPE_AGENT); }
        asm volatile("s_waitcnt vmcnt(0)" ::: "memory"); __syncthreads();
        if (tid == 0) { (void)__hip_atomic_fetch_add(pcnt + u.pm, 1u, __ATOMIC_RELAXED, __HIP_MEMORY_SCOPE_AGENT);
            unsigned sp = 0u; while (__hip_atomic_load(pcnt + u.pm, __ATOMIC_RELAXED, __HIP_MEMORY_SCOPE_AGENT) < 4u) { __builtin_amdgcn_s_sleep(1); if (++sp > (1u << 22)) break; } }
        __syncthreads();
        if (tid < 256) { const float q = __hip_atomic_load(ps + (size_t)u.pm * BM + tid, __ATOMIC_RELAXED, __HIP_MEMORY_SCOPE_AGENT); S[tid] = rsqrtf(q * (1.f / 1024.f) + 1e-6f); }
        asm volatile("s_waitcnt vmcnt(0) lgkmcnt(0)" ::: "memory"); __builtin_amdgcn_s_barrier(); asm volatile("" ::: "memory");
        f32x4 gv[2][2];
#pragma unroll
        for (int bj = 0; bj < 2; ++bj)
#pragma unroll
            for (int n = 0; n < 2; ++n) gv[bj][n] = *(const f32x4*)(g + col0 + bj * HALF + n * 16);
#pragma unroll
        for (int ai = 0; ai < 2; ++ai)
#pragma unroll
            for (int m = 0; m < 4; ++m) { const int rl = ai * HALF + wr * 64 + m * 16 + fr; const float rs = S[rl]; const size_t off = (size_t)(u.pm * BM + rl) * 1024 + col0;
#pragma unroll
                for (int bj = 0; bj < 2; ++bj)
#pragma unroll
                    for (int n = 0; n < 2; ++n) *(f32x4*)(out + off + bj * HALF + n * 16) = acc[ai][bj][m][n] * rs * gv[bj][n]; }
        asm volatile("s_waitcnt lgkmcnt(0)" ::: "memory"); __builtin_amdgcn_s_barrier(); asm volatile("" ::: "memory");
    }
};

__device__ __forceinline__ float dpp_shr1(float oldv, float src) { return __builtin_bit_cast(float, __builtin_amdgcn_update_dpp(__builtin_bit_cast(int, oldv), __builtin_bit_cast(int, src), 0x111, 0xf, 0xf, false)); }
__device__ __forceinline__ float dpp_shr2(float oldv, float src) { return __builtin_bit_cast(float, __builtin_amdgcn_update_dpp(__builtin_bit_cast(int, oldv), __builtin_bit_cast(int, src), 0x112, 0xf, 0xf, false)); }
__device__ __forceinline__ float dpp_ror1(float src) { return __builtin_bit_cast(float, __builtin_amdgcn_update_dpp(0, __builtin_bit_cast(int, src), 0x121, 0xf, 0xf, false)); }
__device__ __forceinline__ float dpp_ror2(float src) { return __builtin_bit_cast(float, __builtin_amdgcn_update_dpp(0, __builtin_bit_cast(int, src), 0x122, 0xf, 0xf, false)); }
struct EpiFfn1 {
    static constexpr bool PERM = true, AFTER_DRAIN = false, KSPLIT = false, PERM_A = true;
    bf16_t* ACT; const float* ss2; const float* cw; const float* cb; float* halog; float* fixg; float* fixu; PG8_LAS float* hl; int probe, pad;
    __device__ __forceinline__ void operator()(const f32x4 (&acc)[2][2][4][2], const Unit& u, int wr, int wc, int fr, int fq) const {
        constexpr int FF = 2816;
        if (probe & 1) return;
        const int ch0 = u.pn * HALF + wc * 32 + 8 * fq;
        float rsv[2][4];
#pragma unroll
        for (int ai = 0; ai < 2; ++ai) { const f32x4 s4 = *(const f32x4*)(ss2 + u.pm * BM + ai * HALF + wr * 64 + 4 * fr);
#pragma unroll
            for (int m = 0; m < 4; ++m) rsv[ai][m] = rsqrtf(s4[m] * (1.f / 1024.f) + 1e-6f); }
        if (fr == 15) {
#pragma unroll
            for (int ai = 0; ai < 2; ++ai) { const int G = 2 * ai + wr;
#pragma unroll
                for (int j = 0; j < 2; ++j) { PG8_LAS float* p = hl + (((G * 4 + wc) * 2 + j) * 4 + fq) * 8;
                    *(PG8_LAS f32x4*)p = acc[ai][0][2 + j][0] * rsv[ai][2 + j]; *(PG8_LAS f32x4*)(p + 4) = acc[ai][0][2 + j][1] * rsv[ai][2 + j]; } } }
        constexpr float L2E = 1.4426950408889634f, IL2E = 0.6931471805599453f;
        const f32x4 w0a = *(const f32x4*)(cw + ch0) * L2E, w0b = *(const f32x4*)(cw + ch0 + 4) * L2E, w1a = *(const f32x4*)(cw + FF + ch0) * L2E, w1b = *(const f32x4*)(cw + FF + ch0 + 4) * L2E;
        const f32x4 w2a = *(const f32x4*)(cw + 2 * FF + ch0) * L2E, w2b = *(const f32x4*)(cw + 2 * FF + ch0 + 4) * L2E, cba = *(const f32x4*)(cb + ch0) * L2E, cbb = *(const f32x4*)(cb + ch0 + 4) * L2E;
        asm volatile("s_waitcnt lgkmcnt(0)" ::: "memory"); __builtin_amdgcn_s_barrier(); asm volatile("" ::: "memory");
#pragma unroll
        for (int ai = 0; ai < 2; ++ai) { const int G = 2 * ai + wr; const int rbase = u.pm * BM + ai * HALF + wr * 64 + 4 * fr;
            f32x4 h2a = (f32x4){0.f, 0.f, 0.f, 0.f}, h2b = h2a, h3a = h2a, h3b = h2a;
            if (G > 0 && fr == 0) { const PG8_LAS float* p = hl + ((((G - 1) * 4 + wc) * 2) * 4 + fq) * 8; h2a = *(const PG8_LAS f32x4*)p; h2b = *(const PG8_LAS f32x4*)(p + 4); h3a = *(const PG8_LAS f32x4*)(p + 32); h3b = *(const PG8_LAS f32x4*)(p + 36); }
            f32x4 g[4][2], uu[4][2];
#pragma unroll
            for (int m = 0; m < 4; ++m) { const float s = rsv[ai][m]; g[m][0] = acc[ai][0][m][0] * s; g[m][1] = acc[ai][0][m][1] * s; uu[m][0] = acc[ai][1][m][0] * (s * IL2E); uu[m][1] = acc[ai][1][m][1] * (s * IL2E); }
            f32x4 s2[2], s3[2];
#pragma unroll
            for (int e = 0; e < 4; ++e) { s3[0][e] = dpp_shr1(h3a[e], g[3][0][e]); s3[1][e] = dpp_shr1(h3b[e], g[3][1][e]); s2[0][e] = dpp_shr1(h2a[e], g[2][0][e]); s2[1][e] = dpp_shr1(h2b[e], g[2][1][e]); }
#pragma unroll
            for (int m = 0; m < 4; ++m) {
                f32x4 o[2];
#pragma unroll
                for (int hx = 0; hx < 2; ++hx) { const f32x4 w0 = hx ? w0b : w0a, w1 = hx ? w1b : w1a, w2 = hx ? w2b : w2a, cbx = hx ? cbb : cba;
                    const f32x4 g1 = (m == 0) ? s3[hx] : g[m - 1][hx], g2 = (m == 0) ? s2[hx] : (m == 1 ? s3[hx] : g[m - 2][hx]);
#pragma unroll
                    for (int e = 0; e < 4; ++e) { const float c = __builtin_fmaf(w0[e], g2[e], __builtin_fmaf(w1[e], g1[e], __builtin_fmaf(w2[e], g[m][hx][e], cbx[e])));
                        o[hx][e] = c * __builtin_amdgcn_rcpf(1.f + __builtin_amdgcn_exp2f(-c)) * uu[m][hx][e]; } }
                const bool defer = (G == 0 && fr == 0 && m < 2);
                if (defer) { float* pg = fixg + ((size_t)u.pm * 2 + m) * FF + ch0; float* pu = fixu + ((size_t)u.pm * 2 + m) * FF + ch0;
                    *(f32x4*)pg = g[m][0]; *(f32x4*)(pg + 4) = g[m][1]; *(f32x4*)pu = uu[m][0] * L2E; *(f32x4*)(pu + 4) = uu[m][1] * L2E; }
                else { u32x4 w; w.x = cvt_pk_bf16(o[0][0], o[0][1]); w.y = cvt_pk_bf16(o[0][2], o[0][3]); w.z = cvt_pk_bf16(o[1][0], o[1][1]); w.w = cvt_pk_bf16(o[1][2], o[1][3]);
                    if (probe & 2) { asm volatile("" :: "v"(w.x), "v"(w.y), "v"(w.z), "v"(w.w)); } else *(u32x4*)(ACT + (size_t)(rbase + m) * FF + ch0) = w; }
                if (G == 3 && fr == 15 && m >= 2) { float* ph = halog + ((size_t)u.pm * 2 + (m - 2)) * FF + ch0; *(f32x4*)ph = g[m][0]; *(f32x4*)(ph + 4) = g[m][1]; } } }
    }
};

template <class Epi, class Sched, bool ALIGN_EPI = false, bool SP2 = false>
__device__ __forceinline__ void gemm_phase(PG8_LAS unsigned char* lds, const Gemm g, const Sched& S, const Epi& E) {
    int tid_ = threadIdx.x; asm volatile("" : "+v"(tid_));
    const int tid = tid_, wid = __builtin_amdgcn_readfirstlane(tid >> 6), lane = tid & 63, wr = wid >> 2, wc = wid & 3, fr = lane & 15, fq = lane >> 4;
    const int K = g.K, nt = K / BK;
    unsigned voffA[2], voffB[2];
#pragma unroll
    for (int i = 0; i < 2; ++i) { int R, C; stage_rc(tid * 16 + i * 8192, R, C); const int Rb = Epi::PERM ? ((R & ~31) + perm32(R & 31)) : R;
        const int Ra = Epi::PERM_A ? ((R & ~63) + 4 * (R & 15) + ((R >> 4) & 3)) : R;
        voffA[i] = (unsigned)(Ra * K + C) * 2u; voffB[i] = (unsigned)(Rb * K + C) * 2u; }
    const size_t kstep = (size_t)(BK * 2);
    const size_t hstep = (size_t)HALF * K * 2;
    const size_t tstep = 2 * hstep;
    const unsigned ldsw = (unsigned)wid * 1024u;
    const int aoff = lds_byte(wr * 64 + fr, fq * 8), boff = lds_byte(wc * 32 + fr, fq * 8);
#define PG8_SA(b, h) (((b) * 2 + (h)) * HTB)
#define PG8_SB(b, h) ((4 + (b) * 2 + (h)) * HTB)
#define PG8_STAGE(bufoff, gbase, voff) do { _Pragma("unroll") for (int _i = 0; _i < 2; ++_i) \
        __builtin_amdgcn_global_load_lds((const unsigned*)((const char*)(gbase) + (voff)[_i]), (PG8_LAS unsigned*)(lds + (bufoff) + ldsw + _i * 8192), 16, 0, 0); } while (0)
#define PG8_LDA(dst, b, h) do { _Pragma("unroll") for (int m = 0; m < 4; ++m) _Pragma("unroll") for (int k = 0; k < 2; ++k) dst[m][k] = *(const PG8_LAS bf16x8*)(lds + PG8_SA(b, h) + aoff + m * 2048 + k * 1024); } while (0)
#define PG8_LDB(dst, b, h) do { _Pragma("unroll") for (int n = 0; n < 2; ++n) _Pragma("unroll") for (int k = 0; k < 2; ++k) dst[n][k] = *(const PG8_LAS bf16x8*)(lds + PG8_SB(b, h) + boff + n * 2048 + k * 1024); } while (0)
#define PG8_MMA(ai, bj, At, Bt) do { __builtin_amdgcn_s_setprio(1); _Pragma("unroll") for (int m = 0; m < 4; ++m) _Pragma("unroll") for (int n = 0; n < 2; ++n) _Pragma("unroll") for (int k = 0; k < 2; ++k) \
        acc[ai][bj][m][n] = __builtin_amdgcn_mfma_f32_16x16x32_bf16(Bt[n][k], At[m][k], acc[ai][bj][m][n], 0, 0, 0); __builtin_amdgcn_s_setprio(0); } while (0)
#define PG8_WAIT_V(n) asm volatile("s_waitcnt vmcnt(" #n ")" ::: "memory")
#define PG8_WAIT_L(n) asm volatile("s_waitcnt lgkmcnt(" #n ")" ::: "memory")
#define PG8_BAR __builtin_amdgcn_s_barrier()
#define PG8_SCHED __builtin_amdgcn_sched_barrier(0)
    Unit cur, nxt; int ui = 0;
    if (!S.next(0, cur)) return;
    f32x4 acc[2][2][4][2];
#pragma unroll
    for (int a = 0; a < 2; ++a)
#pragma unroll
        for (int b = 0; b < 2; ++b)
#pragma unroll
            for (int m = 0; m < 4; ++m)
#pragma unroll
                for (int n = 0; n < 2; ++n) acc[a][b][m][n] = (f32x4){0.f, 0.f, 0.f, 0.f};
    bf16x8 At[4][2], B0[2][2], B1[2][2];
    const char* cA = (const char*)g.A + (size_t)cur.pm * tstep; const char* cB = (const char*)g.Bt + (size_t)cur.pn * tstep;
    S.a_ready(cur);
    if constexpr (SP2) {
        PG8_STAGE(PG8_SB(0, 0), cB, voffB); PG8_STAGE(PG8_SB(0, 1), cB + hstep, voffB); PG8_STAGE(PG8_SA(0, 0), cA, voffA); PG8_STAGE(PG8_SA(0, 1), cA + hstep, voffA);
        if (wr == 1) PG8_BAR;
        PG8_WAIT_V(2); PG8_BAR;
        PG8_STAGE(PG8_SB(1, 0), cB + kstep, voffB); PG8_STAGE(PG8_SA(1, 0), cA + kstep, voffA); PG8_STAGE(PG8_SB(1, 1), cB + hstep + kstep, voffB);
        PG8_WAIT_V(6); PG8_BAR;
    } else {
        PG8_STAGE(PG8_SB(0, 0), cB, voffB); PG8_STAGE(PG8_SA(0, 0), cA, voffA); PG8_STAGE(PG8_SB(0, 1), cB + hstep, voffB); PG8_STAGE(PG8_SA(0, 1), cA + hstep, voffA);
        if (wr == 1) PG8_BAR;
        PG8_WAIT_V(4); PG8_BAR;
        PG8_STAGE(PG8_SB(1, 0), cB + kstep, voffB); PG8_STAGE(PG8_SA(1, 0), cA + kstep, voffA); PG8_STAGE(PG8_SB(1, 1), cB + hstep + kstep, voffB);
        PG8_WAIT_V(6); PG8_BAR;
    }
    for (;;) {
        const bool has_next = S.next(ui + 1, nxt);
        const char* nA = has_next ? (const char*)g.A + (size_t)nxt.pm * tstep : cA; const char* nB = has_next ? (const char*)g.Bt + (size_t)nxt.pn * tstep : cB;
        for (int t = 0; t < nt; t += 2) {
            if constexpr (Epi::KSPLIT) { if (t == nt / 2) E.mid(acc, cur, wr, fr); }
            const bool last = (t == nt - 2);
            const char* a1 = cA + (size_t)(t + 1) * kstep;
            const char* a2 = last ? nA : cA + (size_t)(t + 2) * kstep; const char* b2 = last ? nB : cB + (size_t)(t + 2) * kstep;
            const char* a3 = a2 + kstep; const char* b3 = b2 + kstep;
            if (last && has_next) S.a_ready(nxt);
            if constexpr (SP2) {
            PG8_LDB(B0, 0, 0); PG8_LDB(B1, 0, 1); PG8_SCHED; PG8_LDA(At, 0, 0); PG8_STAGE(PG8_SA(1, 1), a1 + hstep, voffA);
            PG8_WAIT_V(8); PG8_WAIT_L(0); PG8_BAR; PG8_MMA(0, 0, At, B0); PG8_MMA(0, 1, At, B1); PG8_BAR; PG8_SCHED;
            PG8_LDA(At, 0, 1); PG8_STAGE(PG8_SB(0, 0), b2, voffB); PG8_STAGE(PG8_SB(0, 1), b2 + hstep, voffB); PG8_STAGE(PG8_SA(0, 0), a2, voffA);
            PG8_WAIT_V(8); PG8_WAIT_L(0); PG8_BAR; PG8_MMA(1, 0, At, B0); PG8_MMA(1, 1, At, B1); PG8_BAR; PG8_SCHED;
            PG8_LDB(B0, 1, 0); PG8_LDB(B1, 1, 1); PG8_SCHED; PG8_LDA(At, 1, 0); PG8_STAGE(PG8_SA(0, 1), a2 + hstep, voffA);
            PG8_WAIT_V(8); PG8_WAIT_L(0); PG8_BAR; PG8_MMA(0, 0, At, B0); PG8_MMA(0, 1, At, B1); PG8_BAR; PG8_SCHED;
            PG8_LDA(At, 1, 1); PG8_STAGE(PG8_SB(1, 0), b3, voffB); PG8_STAGE(PG8_SB(1, 1), b3 + hstep, voffB); PG8_STAGE(PG8_SA(1, 0), a3, voffA);
            PG8_WAIT_V(8); PG8_WAIT_L(0); PG8_BAR; PG8_MMA(1, 0, At, B0); PG8_MMA(1, 1, At, B1); PG8_BAR; PG8_SCHED;
            } else {
            PG8_LDB(B0, 0, 0); PG8_SCHED; PG8_LDA(At, 0, 0); PG8_STAGE(PG8_SA(1, 1), a1 + hstep, voffA);
            PG8_WAIT_L(8); PG8_BAR; PG8_WAIT_L(0); PG8_MMA(0, 0, At, B0); PG8_BAR; PG8_SCHED;
            PG8_LDB(B1, 0, 1); PG8_STAGE(PG8_SB(0, 0), b2, voffB);
            PG8_BAR; PG8_WAIT_L(0); PG8_MMA(0, 1, At, B1); PG8_BAR;
            PG8_LDA(At, 0, 1); PG8_STAGE(PG8_SA(0, 0), a2, voffA);
            PG8_BAR; PG8_WAIT_L(0); PG8_MMA(1, 0, At, B0); PG8_BAR; PG8_SCHED;
            PG8_STAGE(PG8_SB(0, 1), b2 + hstep, voffB);
            PG8_WAIT_V(6); PG8_BAR; PG8_MMA(1, 1, At, B1); PG8_BAR;
            PG8_LDB(B0, 1, 0); PG8_SCHED; PG8_LDA(At, 1, 0); PG8_STAGE(PG8_SA(0, 1), a2 + hstep, voffA);
            PG8_WAIT_L(8); PG8_BAR; PG8_WAIT_L(0); PG8_MMA(0, 0, At, B0); PG8_BAR; PG8_SCHED;
            PG8_LDB(B1, 1, 1); PG8_STAGE(PG8_SB(1, 0), b3, voffB);
            PG8_BAR; PG8_WAIT_L(0); PG8_MMA(0, 1, At, B1); PG8_BAR;
            PG8_LDA(At, 1, 1); PG8_STAGE(PG8_SA(1, 0), a3, voffA);
            PG8_BAR; PG8_WAIT_L(0); PG8_MMA(1, 0, At, B0); PG8_BAR; PG8_SCHED;
            PG8_STAGE(PG8_SB(1, 1), b3 + hstep, voffB);
            PG8_WAIT_V(6); PG8_BAR; PG8_MMA(1, 1, At, B1); PG8_BAR;
            }
        }
        if constexpr (ALIGN_EPI) { if (wr == 0) PG8_BAR; }
        if constexpr (!Epi::AFTER_DRAIN) { E(acc, cur, wr, wc, fr, fq); S.done(cur); }
        if (!has_next) break;
#pragma unroll
        for (int a = 0; a < 2; ++a)
#pragma unroll
            for (int b = 0; b < 2; ++b)
#pragma unroll
                for (int m = 0; m < 4; ++m)
#pragma unroll
                    for (int n = 0; n < 2; ++n) acc[a][b][m][n] = (f32x4){0.f, 0.f, 0.f, 0.f};
        cur = nxt; cA = nA; cB = nB; ++ui;
        if constexpr (ALIGN_EPI) { if (wr == 1) PG8_BAR; }
    }
    PG8_WAIT_V(0);
    if constexpr (!ALIGN_EPI) { if (wr == 0) PG8_BAR; }
    PG8_BAR;
    if constexpr (Epi::AFTER_DRAIN) { E.fused(acc, cur, wr, wc, fr, fq, lds, wid, lane); S.done(cur); }
#undef PG8_SA
#undef PG8_SB
#undef PG8_STAGE
#undef PG8_LDA
#undef PG8_LDB
#undef PG8_MMA
#undef PG8_WAIT_V
#undef PG8_WAIT_L
#undef PG8_BAR
#undef PG8_SCHED
}
}


constexpr int NWAVES = 8;
constexpr int RING_OFF = 0, RING_BYTES = 131072;
constexpr int LDSX_OFF = RING_BYTES;
constexpr int MISC_OFF = RING_BYTES + 8192;
constexpr int LDS_BYTES = 147456;
static_assert(MISC_OFF + 128 <= LDS_BYTES, "LDS map");
constexpr int CW_BAR = 1024;
constexpr int CW_FLAG = 16384;

#define GAS __attribute__((address_space(1)))
#define LAS __attribute__((address_space(3)))
typedef unsigned v4u __attribute__((ext_vector_type(4)));
typedef float f32x4 __attribute__((ext_vector_type(4)));
typedef unsigned u32x2 __attribute__((ext_vector_type(2)));
typedef GAS unsigned gu32;
#define LDS_WAIT() asm volatile("s_waitcnt lgkmcnt(0)" ::: "memory")
#define VM_WAIT() asm volatile("s_waitcnt vmcnt(0)" ::: "memory")
__device__ __forceinline__ unsigned pk2(float lo, float hi) { return f2bf(lo) | (f2bf(hi) << 16); }

#define XB_TMO      128
#define XB_XCNT(j)  (256  + 64 * (j))
#define XB_XSUB(j)  (1280 + 64 * (j))
#define XB_XGEN(j)  (2304 + 64 * (j))
#define XB_TOP      3328
#define XB_TOPGEN   3392
#define XCD_BAR_WORDS 3456
#define XB_SPIN_CAP (1u << 18)

__device__ __forceinline__ unsigned xb_ld(unsigned* p)              { return __hip_atomic_load(p, __ATOMIC_RELAXED, __HIP_MEMORY_SCOPE_AGENT); }
__device__ __forceinline__ unsigned xb_add(unsigned* p, unsigned v) { return __hip_atomic_fetch_add(p, v, __ATOMIC_RELAXED, __HIP_MEMORY_SCOPE_AGENT); }
__device__ __forceinline__ unsigned xb_xcc_id() { return (unsigned)__builtin_amdgcn_s_getreg((3 << 11) | 20) & 0xFu; }
#define XB_SPIN(cond, bar) do { unsigned _sp = 0; while (cond) { __builtin_amdgcn_s_sleep(1); \
    if ((++_sp & 255u) == 0u) { if (xb_ld(&(bar)[XB_TMO])) break; if (_sp > XB_SPIN_CAP) { atomicAdd(&(bar)[XB_TMO], 1u); break; } } } } while (0)

struct XcdBarrier {
    unsigned* bar; unsigned x;
    volatile LAS unsigned* st;
};

__device__ __forceinline__ XcdBarrier xcd_barrier_post(unsigned* bar, volatile LAS unsigned* st) {
    XcdBarrier b; b.bar = bar; b.x = xb_xcc_id(); b.st = st;
    if (threadIdx.x == 0) (void)xb_add(&bar[XB_XCNT(b.x)], 1u);
    return b;
}
__device__ __forceinline__ void xcd_barrier_complete(unsigned* bar, unsigned x, unsigned& nloc, unsigned& nx) {
    const unsigned G = gridDim.x * gridDim.y * gridDim.z;
    unsigned sum, cnt, mine, sp = 0u;
    for (;;) {
        sum = 0u; cnt = 0u; mine = 0u;
#pragma unroll
        for (unsigned j = 0; j < 16; ++j) { const unsigned c = xb_ld(&bar[XB_XCNT(j)]); sum += c; cnt += (c > 0u) ? 1u : 0u; mine = (j == x) ? c : mine; }
        if (sum == G) break;
        __builtin_amdgcn_s_sleep(1);
        if ((++sp & 255u) == 0u) { if (xb_ld(&bar[XB_TMO])) break; if (sp > XB_SPIN_CAP) { atomicAdd(&bar[XB_TMO], 1u); break; } }
    }
    nloc = mine > 0u ? mine : 1u; nx = cnt > 0u ? cnt : 1u;
}

__device__ __forceinline__ void xcd_barrier(const XcdBarrier& b) {
    asm volatile("s_waitcnt vmcnt(0)" ::: "memory");
    __syncthreads();
    if (threadIdx.x == 0) {
        unsigned* bar = b.bar;
        __builtin_amdgcn_s_waitcnt(0);
        unsigned nloc = b.st[0], nx = b.st[1];
        if (nloc == 0u) { xcd_barrier_complete(bar, b.x, nloc, nx); b.st[0] = nloc; b.st[1] = nx; }
        const unsigned old = xb_add(&bar[XB_XSUB(b.x)], 1u);
        const unsigned gen = old / nloc;
        if (old + 1u == (gen + 1u) * nloc) {
            __builtin_amdgcn_fence(__ATOMIC_RELEASE, "agent");
            asm volatile("s_waitcnt vmcnt(0)" ::: "memory");
            const unsigned og = xb_add(&bar[XB_TOP], 1u);
            const unsigned tg = og / nx;
            if (og + 1u == (tg + 1u) * nx) xb_add(&bar[XB_TOPGEN], 1u);
            else XB_SPIN(xb_ld(&bar[XB_TOPGEN]) == tg, bar);
            __builtin_amdgcn_fence(__ATOMIC_ACQUIRE, "agent");
            xb_add(&bar[XB_XGEN(b.x)], 1u);
            asm volatile("s_waitcnt vmcnt(0)" ::: "memory");
        } else {
            XB_SPIN(xb_ld(&bar[XB_XGEN(b.x)]) == gen, bar);
            __builtin_amdgcn_fence(__ATOMIC_ACQUIRE, "agent");
            asm volatile("s_waitcnt vmcnt(0)" ::: "memory");
        }
    }
    __syncthreads();
}


namespace att {
typedef short bf16x8 __attribute__((ext_vector_type(8)));
typedef short s16x4 __attribute__((ext_vector_type(4)));
typedef float f32x16 __attribute__((ext_vector_type(16)));
typedef unsigned u32x4 __attribute__((ext_vector_type(4)));
typedef unsigned u32x2 __attribute__((ext_vector_type(2)));
constexpr float LOG2E = 1.4426950408889634f;
#define LBAR() do { asm volatile("s_waitcnt lgkmcnt(0)" ::: "memory"); __builtin_amdgcn_s_barrier(); asm volatile("" ::: "memory"); } while (0)
__device__ __forceinline__ int kappa(int r) { return (r & ~12) | ((r & 4) << 1) | ((r & 8) >> 1); }
__device__ __forceinline__ f32x16 mfma32(bf16x8 a, bf16x8 b, f32x16 c) { return __builtin_amdgcn_mfma_f32_32x32x16_bf16(a, b, c, 0, 0, 0); }
__device__ __forceinline__ s16x4 vtr(const LAS unsigned char* p) { return __builtin_bit_cast(s16x4, __builtin_amdgcn_ds_read_tr16_b64_v4i16((LAS s16x4*)p)); }
__device__ __forceinline__ bf16x8 cat8(s16x4 a, s16x4 b) { return (bf16x8){a[0], a[1], a[2], a[3], b[0], b[1], b[2], b[3]}; }
typedef float f32x2_t __attribute__((ext_vector_type(2))); typedef __bf16 bf16x2_t __attribute__((ext_vector_type(2)));
__device__ __forceinline__ unsigned cvtpk(float lo, float hi) { const f32x2_t v = {lo, hi}; return __builtin_bit_cast(unsigned, __builtin_convertvector(v, bf16x2_t)); }
__device__ __forceinline__ float xhalf_max(float v) { return fmaxf(v, __shfl_xor(v, 32)); }
__device__ __forceinline__ float xhalf_sum(float v) { return v + __shfl_xor(v, 32); }
__device__ __forceinline__ bf16x8 packp(const f32x16& p, int s) {
    u32x4 w; w.x = cvtpk(p[8 * s + 0], p[8 * s + 1]); w.y = cvtpk(p[8 * s + 2], p[8 * s + 3]); w.z = cvtpk(p[8 * s + 4], p[8 * s + 5]); w.w = cvtpk(p[8 * s + 6], p[8 * s + 7]);
    return __builtin_bit_cast(bf16x8, w);
}
__device__ __forceinline__ int tr_off(int lane, int VP) { const int hi = lane >> 5, blk = (lane >> 4) & 1, q4 = (lane & 15) >> 2, p4 = lane & 3; return (8 * hi + q4) * VP + (16 * blk + 4 * p4) * 2; }


#define TR_RD(DST, ADDR, OFF) asm volatile("ds_read_b64_tr_b16 %0, %1 offset:%2" : "=v"(DST) : "v"(ADDR), "i"(OFF))
#define TR_WAIT(N, A, B) asm volatile("s_waitcnt lgkmcnt(" #N ")" : "+v"(A), "+v"(B))
#define PV_CHAIN2(ACC, ADDR, VP, F0, F1) do { s16x4 l0, h0, l1, h1; const unsigned ad_ = (ADDR); \
    TR_RD(l0, ad_, 0 * (VP)); TR_RD(h0, ad_, 4 * (VP)); TR_RD(l1, ad_, 16 * (VP)); TR_RD(h1, ad_, 20 * (VP)); \
    TR_WAIT(2, l0, h0); ACC = mfma32(cat8(l0, h0), F0, ACC); TR_WAIT(0, l1, h1); ACC = mfma32(cat8(l1, h1), F1, ACC); } while (0)
#define PV_CHAIN8(ACC, ADDR, VP, F0, F1, F2, F3, F4, F5, F6, F7) do { s16x4 l0, h0, l1, h1, l2, h2, l3, h3, l4, h4, l5, h5, l6, h6, l7, h7; const unsigned ad_ = (ADDR); \
    TR_RD(l0, ad_, 0 * (VP)); TR_RD(h0, ad_, 4 * (VP)); TR_RD(l1, ad_, 16 * (VP)); TR_RD(h1, ad_, 20 * (VP)); TR_RD(l2, ad_, 32 * (VP)); TR_RD(h2, ad_, 36 * (VP)); TR_RD(l3, ad_, 48 * (VP)); TR_RD(h3, ad_, 52 * (VP)); \
    TR_RD(l4, ad_, 64 * (VP)); TR_RD(h4, ad_, 68 * (VP)); TR_RD(l5, ad_, 80 * (VP)); TR_RD(h5, ad_, 84 * (VP)); TR_RD(l6, ad_, 96 * (VP)); TR_RD(h6, ad_, 100 * (VP)); TR_RD(l7, ad_, 112 * (VP)); TR_RD(h7, ad_, 116 * (VP)); \
    TR_WAIT(14, l0, h0); ACC = mfma32(cat8(l0, h0), F0, ACC); TR_WAIT(12, l1, h1); ACC = mfma32(cat8(l1, h1), F1, ACC); TR_WAIT(10, l2, h2); ACC = mfma32(cat8(l2, h2), F2, ACC); TR_WAIT(8, l3, h3); ACC = mfma32(cat8(l3, h3), F3, ACC); \
    TR_WAIT(6, l4, h4); ACC = mfma32(cat8(l4, h4), F4, ACC); TR_WAIT(4, l5, h5); ACC = mfma32(cat8(l5, h5), F5, ACC); TR_WAIT(2, l6, h6); ACC = mfma32(cat8(l6, h6), F6, ACC); TR_WAIT(0, l7, h7); ACC = mfma32(cat8(l7, h7), F7, ACC); } while (0)

constexpr int MB_KP = 144, MB_VP = 192, MB_TN = 2256, MB_TK = 128;
constexpr int MB_K = 0, MB_V = 2 * MB_TK * MB_KP, MB_LUT = MB_V + 2 * MB_TK * MB_VP, MB_KM = MB_LUT + 4 * MB_TN * 4, MB_END = MB_KM + 2048;
__device__ __forceinline__ f32x16 ld_c16(const LAS unsigned char* p) {
    const f32x4 a = *(const LAS f32x4*)p, b = *(const LAS f32x4*)(p + 16), c = *(const LAS f32x4*)(p + 64), d = *(const LAS f32x4*)(p + 80);
    return (f32x16){a[0], a[1], a[2], a[3], b[0], b[1], b[2], b[3], c[0], c[1], c[2], c[3], d[0], d[1], d[2], d[3]};
}
__device__ __forceinline__ float max16(const f32x16& p) { return fmaxf(fmaxf(fmaxf(fmaxf(p[0], p[1]), fmaxf(p[2], p[3])), fmaxf(fmaxf(p[4], p[5]), fmaxf(p[6], p[7]))), fmaxf(fmaxf(fmaxf(p[8], p[9]), fmaxf(p[10], p[11])), fmaxf(fmaxf(p[12], p[13]), fmaxf(p[14], p[15])))); }
__device__ __forceinline__ void moba_phase(LAS unsigned char* lds, const bf16* QKV, const float* KMP, const float* LUT, bf16* Y, float* SSB, int vcu, int G, int variant) {
    const int tid = threadIdx.x, lane = tid & 63, r32 = lane & 31, hi = lane >> 5; const int w = __builtin_amdgcn_readfirstlane(tid >> 6);
    LAS float* tab = (LAS float*)(lds + MB_LUT); LAS float* km = (LAS float*)(lds + MB_KM);
    const int troff = tr_off(lane, MB_VP);
    int htab = -1;
    for (int tau = vcu; tau < BATCH * 8 * 4; tau += G) { const int bh = tau >> 2, pr = tau & 3, b = bh >> 3, h = bh & 7;
        __syncthreads();
        if (h != htab) { htab = h; float tv[18];
#pragma unroll
            for (int j = 0; j < 18; ++j) { const int i = tid + 512 * j, sft = i / MB_TN, ii = i - sft * MB_TN, idx = 2047 - ii - sft; tv[j] = (i < 4 * MB_TN && idx >= 0) ? LUT[(8 + h) * 2048 + idx] * LOG2E : -INFINITY; }
#pragma unroll
            for (int j = 0; j < 18; ++j) { const int i = tid + 512 * j; if (i < 4 * MB_TN) tab[i] = tv[j]; } }
        { const int j = tid >> 6, d = tid & 63; km[tid] = (KMP[(size_t)((8 * b + j) * 2 + 0) * 512 + 64 * h + d] + KMP[(size_t)((8 * b + j) * 2 + 1) * 512 + 64 * h + d]) * (1.f / 256.f); }
        __syncthreads();
        const bf16* Qb = QKV + (size_t)b * SEQ * NQKV + 1536 + 64 * h; const bf16* Kb = QKV + (size_t)b * SEQ * NQKV + 2048 + 64 * h; const bf16* Vb = Kb + 512;
        for (int s2 = 0; s2 < 2; ++s2) { const int qb = s2 == 0 ? 7 - pr : pr;
            const int tq = 256 * qb + 32 * w + r32;
            bf16x8 qf[4];
#pragma unroll
            for (int d0 = 0; d0 < 4; ++d0) qf[d0] = *(const bf16x8*)(Qb + (size_t)tq * NQKV + 16 * d0 + 8 * hi);
            unsigned sel = 0;
            { float g[8];
#pragma unroll
              for (int j = 0; j < 8; ++j) g[j] = 0.f;
#pragma unroll
              for (int d0 = 0; d0 < 4; ++d0) { float qv[8];
#pragma unroll
                  for (int e = 0; e < 8; ++e) qv[e] = __builtin_bit_cast(float, (unsigned)(unsigned short)qf[d0][e] << 16);
#pragma unroll
                  for (int j = 0; j < 7; ++j) { const LAS float* kp = km + j * 64 + 16 * d0 + 8 * hi; const f32x4 k0 = *(const LAS f32x4*)kp, k1 = *(const LAS f32x4*)(kp + 4);
                      g[j] += qv[0] * k0[0] + qv[1] * k0[1] + qv[2] * k0[2] + qv[3] * k0[3] + qv[4] * k1[0] + qv[5] * k1[1] + qv[6] * k1[2] + qv[7] * k1[3]; } }
#pragma unroll
              for (int j = 0; j < 7; ++j) g[j] += __shfl_xor(g[j], 32);
              const int nsel = qb < 3 ? qb : 3;
              for (int n = 0; n < nsel; ++n) { float best = -3e38f; int bi = 0;
#pragma unroll
                  for (int j = 0; j < 7; ++j) if (j < qb && !((sel >> j) & 1u) && g[j] > best) { best = g[j]; bi = j; }
                  sel |= 1u << bi; }
              sel |= 1u << qb; }
            float l_run = 0.f; f32x16 o0 = {}, o1 = {};
            const int NT = 2 * (qb + 1);
            const int a0 = 2047 - tq + 8 * hi;
            const LAS unsigned char* cp = (const LAS unsigned char*)tab + (a0 & 3) * (MB_TN * 4) + (a0 & ~3) * 4;
            const int skey = tid >> 3, sch = tid & 7;
            const size_t srow = (size_t)skey * NQKV + 8 * sch;
#define MB_GLD(T_) do { if ((T_) < NT) { const size_t ro_ = srow + (size_t)(T_) * MB_TK * NQKV; k0r = *(const u32x4*)(Kb + ro_); k1r = *(const u32x4*)(Kb + ro_ + (size_t)64 * NQKV); v0r = *(const u32x4*)(Vb + ro_); v1r = *(const u32x4*)(Vb + ro_ + (size_t)64 * NQKV); } } while (0)
#define MB_ST(T_) do { if ((T_) < NT) { LAS unsigned char* kd_ = lds + MB_K + ((T_) & 1) * (MB_TK * MB_KP) + skey * MB_KP + sch * 16; LAS unsigned char* vd_ = lds + MB_V + ((T_) & 1) * (MB_TK * MB_VP) + skey * MB_VP + sch * 16; \
                    *(LAS u32x4*)kd_ = k0r; *(LAS u32x4*)(kd_ + 64 * MB_KP) = k1r; *(LAS u32x4*)vd_ = v0r; *(LAS u32x4*)(vd_ + 64 * MB_VP) = v1r; } } while (0)
#define MB_ACT(T_) (((T_) >> 1) < qb ? (__ballot((sel >> ((T_) >> 1)) & 1u) != 0ull) : ((MB_TK * (T_) - 256 * qb) <= 32 * w + 31))
            u32x4 k0r = {}, k1r = {}, v0r = {}, v1r = {};
            MB_GLD(0); MB_ST(0); MB_GLD(1);
            LBAR();
            for (int T = 0; T < NT; ++T) {
                if (MB_ACT(T)) {
                    const LAS unsigned char* Kt = lds + MB_K + (T & 1) * (MB_TK * MB_KP) + kappa(r32) * MB_KP + hi * 16; const LAS unsigned char* Vt = lds + MB_V + (T & 1) * (MB_TK * MB_VP) + troff;
                    const bool selb = (sel >> (T >> 1)) & 1u;
                    const LAS unsigned char* ct = selb ? cp + 512 * T : (const LAS unsigned char*)tab + 2048 * 4;
                    f32x16 p0 = ld_c16(ct), p1 = ld_c16(ct + 128), p2 = ld_c16(ct + 256), p3 = ld_c16(ct + 384);
                    if (!(variant & 4)) {
#pragma unroll
                        for (int d0 = 0; d0 < 4; ++d0) { const bf16x8 ka = *(const LAS bf16x8*)(Kt + d0 * 32), kb = *(const LAS bf16x8*)(Kt + 32 * MB_KP + d0 * 32), kc = *(const LAS bf16x8*)(Kt + 64 * MB_KP + d0 * 32), kd = *(const LAS bf16x8*)(Kt + 96 * MB_KP + d0 * 32);
                            p0 = mfma32(ka, qf[d0], p0); p1 = mfma32(kb, qf[d0], p1); p2 = mfma32(kc, qf[d0], p2); p3 = mfma32(kd, qf[d0], p3); } }
                    float ls0 = 0.f, ls1 = 0.f;
                    if (!(variant & 1)) {
#pragma unroll
                        for (int r = 0; r < 16; ++r) { p0[r] = __builtin_amdgcn_exp2f(p0[r]); p1[r] = __builtin_amdgcn_exp2f(p1[r]); p2[r] = __builtin_amdgcn_exp2f(p2[r]); p3[r] = __builtin_amdgcn_exp2f(p3[r]); ls0 += p0[r] + p1[r]; ls1 += p2[r] + p3[r]; } }
                    l_run += ls0 + ls1;
                    if (!(variant & 2)) {
                        const bf16x8 f0 = packp(p0, 0), f1 = packp(p0, 1), f2 = packp(p1, 0), f3 = packp(p1, 1), f4 = packp(p2, 0), f5 = packp(p2, 1), f6 = packp(p3, 0), f7 = packp(p3, 1);
                        const unsigned va = (unsigned)(size_t)Vt;
                        PV_CHAIN8(o0, va, MB_VP, f0, f1, f2, f3, f4, f5, f6, f7);
                        PV_CHAIN8(o1, va + 64u, MB_VP, f0, f1, f2, f3, f4, f5, f6, f7); }
                }
                MB_ST(T + 1);
                if (!(variant & 16)) LBAR();
                if (!(variant & 8)) MB_GLD(T + 2);
            }
#undef MB_GLD
#undef MB_ST
#undef MB_ACT
            const float inv = 1.f / xhalf_sum(l_run);
            bf16* yp = Y + ((size_t)b * SEQ + tq) * DM + 512 + 64 * h + 4 * hi; float sq = 0.f;
#pragma unroll
            for (int g4 = 0; g4 < 4; ++g4) { u32x2 a, c2; a.x = cvtpk(o0[4 * g4] * inv, o0[4 * g4 + 1] * inv); a.y = cvtpk(o0[4 * g4 + 2] * inv, o0[4 * g4 + 3] * inv);
                c2.x = cvtpk(o1[4 * g4] * inv, o1[4 * g4 + 1] * inv); c2.y = cvtpk(o1[4 * g4 + 2] * inv, o1[4 * g4 + 3] * inv);
                *(u32x2*)(yp + 8 * g4) = a; *(u32x2*)(yp + 32 + 8 * g4) = c2;
                sq += bflo(a.x) * bflo(a.x) + bfhi(a.x) * bfhi(a.x) + bflo(a.y) * bflo(a.y) + bfhi(a.y) * bfhi(a.y) + bflo(c2.x) * bflo(c2.x) + bfhi(c2.x) * bfhi(c2.x) + bflo(c2.y) * bflo(c2.y) + bfhi(c2.y) * bfhi(c2.y); }
            sq = xhalf_sum(sq); if (hi == 0 && SSB) atomicAdd(SSB + (size_t)b * SEQ + tq, sq);
        }
    }
}

constexpr int M2_TK = 64, M2_K = 0, M2_V = 2 * M2_TK * MB_KP, M2_LUT = M2_V + 2 * M2_TK * MB_VP, M2_KM = M2_LUT + 4 * MB_TN * 4, M2_END = M2_KM + 2048;
static_assert(M2_END <= 139264, "MoBA LDS map");
__device__ __forceinline__ unsigned mb_select(const bf16x8 (&qf)[4], const LAS float* km, int qb, int hi) {
    unsigned sel = 0; float g[8];
#pragma unroll
    for (int j = 0; j < 8; ++j) g[j] = 0.f;
#pragma unroll
    for (int d0 = 0; d0 < 4; ++d0) { float qv[8];
#pragma unroll
        for (int e = 0; e < 8; ++e) qv[e] = __builtin_bit_cast(float, (unsigned)(unsigned short)qf[d0][e] << 16);
#pragma unroll
        for (int j = 0; j < 7; ++j) { const LAS float* kp = km + j * 64 + 16 * d0 + 8 * hi; const f32x4 k0 = *(const LAS f32x4*)kp, k1 = *(const LAS f32x4*)(kp + 4);
            g[j] += qv[0] * k0[0] + qv[1] * k0[1] + qv[2] * k0[2] + qv[3] * k0[3] + qv[4] * k1[0] + qv[5] * k1[1] + qv[6] * k1[2] + qv[7] * k1[3]; } }
#pragma unroll
    for (int j = 0; j < 7; ++j) g[j] += __shfl_xor(g[j], 32);
    const int nsel = qb < 3 ? qb : 3;
    for (int n = 0; n < nsel; ++n) { float best = -3e38f; int bi = 0;
#pragma unroll
        for (int j = 0; j < 7; ++j) if (j < qb && !((sel >> j) & 1u) && g[j] > best) { best = g[j]; bi = j; }
        sel |= 1u << bi; }
    return sel | (1u << qb);
}
template <bool DA, bool DB>
__device__ __forceinline__ void mb_step2(const LAS unsigned char* Kt, unsigned va, const LAS unsigned char* ctA, const LAS unsigned char* ctB, const bf16x8 (&qa)[4], const bf16x8 (&qb)[4],
                                         f32x16& oa0, f32x16& oa1, float& la, f32x16& ob0, f32x16& ob1, float& lb) {
    f32x16 a0 = {}, a1 = {}, b0 = {}, b1 = {};
    if (DA) { a0 = ld_c16(ctA); a1 = ld_c16(ctA + 128); }
    if (DB) { b0 = ld_c16(ctB); b1 = ld_c16(ctB + 128); }
#pragma unroll
    for (int d0 = 0; d0 < 4; ++d0) { const bf16x8 k0 = *(const LAS bf16x8*)(Kt + d0 * 32), k1 = *(const LAS bf16x8*)(Kt + 32 * MB_KP + d0 * 32);
        if (DA) { a0 = mfma32(k0, qa[d0], a0); a1 = mfma32(k1, qa[d0], a1); }
        if (DB) { b0 = mfma32(k0, qb[d0], b0); b1 = mfma32(k1, qb[d0], b1); } }
    float sa = 0.f, sb = 0.f;
#pragma unroll
    for (int r = 0; r < 16; ++r) {
        if (DA) { a0[r] = __builtin_amdgcn_exp2f(a0[r]); a1[r] = __builtin_amdgcn_exp2f(a1[r]); sa += a0[r] + a1[r]; }
        if (DB) { b0[r] = __builtin_amdgcn_exp2f(b0[r]); b1[r] = __builtin_amdgcn_exp2f(b1[r]); sb += b0[r] + b1[r]; } }
    la += sa; lb += sb;
    const bf16x8 fa0 = packp(a0, 0), fa1 = packp(a0, 1), fa2 = packp(a1, 0), fa3 = packp(a1, 1), fb0 = packp(b0, 0), fb1 = packp(b0, 1), fb2 = packp(b1, 0), fb3 = packp(b1, 1);
#pragma unroll
    for (int c = 0; c < 2; ++c) { const unsigned ad = va + 64u * c; s16x4 l0, h0, l1, h1, l2, h2, l3, h3;
        TR_RD(l0, ad, 0 * MB_VP); TR_RD(h0, ad, 4 * MB_VP); TR_RD(l1, ad, 16 * MB_VP); TR_RD(h1, ad, 20 * MB_VP); TR_RD(l2, ad, 32 * MB_VP); TR_RD(h2, ad, 36 * MB_VP); TR_RD(l3, ad, 48 * MB_VP); TR_RD(h3, ad, 52 * MB_VP);
        f32x16& xa = c ? oa1 : oa0; f32x16& xb = c ? ob1 : ob0;
        TR_WAIT(6, l0, h0); { const bf16x8 v = cat8(l0, h0); if (DA) xa = mfma32(v, fa0, xa); if (DB) xb = mfma32(v, fb0, xb); }
        TR_WAIT(4, l1, h1); { const bf16x8 v = cat8(l1, h1); if (DA) xa = mfma32(v, fa1, xa); if (DB) xb = mfma32(v, fb1, xb); }
        TR_WAIT(2, l2, h2); { const bf16x8 v = cat8(l2, h2); if (DA) xa = mfma32(v, fa2, xa); if (DB) xb = mfma32(v, fb2, xb); }
        TR_WAIT(0, l3, h3); { const bf16x8 v = cat8(l3, h3); if (DA) xa = mfma32(v, fa3, xa); if (DB) xb = mfma32(v, fb3, xb); } }
}
__device__ __forceinline__ void moba_phase2(LAS unsigned char* lds, const bf16* QKV, const float* KMP, const float* LUT, bf16* Y, float* SSB, int vcu, int G) {
    const int tid_ = threadIdx.x, tid = tid_, lane = tid & 63, r32_ = lane & 31, hi_ = lane >> 5; const int w = __builtin_amdgcn_readfirstlane(tid >> 6);
    LAS float* tab = (LAS float*)(lds + M2_LUT); LAS float* km = (LAS float*)(lds + M2_KM);
    int htab = -1;
    for (int tau = vcu; tau < BATCH * 8 * 2; tau += G) { const int bh = tau >> 1, half = tau & 1, b = bh >> 3, h = bh & 7;
        __syncthreads();
        int tt = tid_; asm volatile("" : "+v"(tt));
        if (h != htab) { htab = h; float tv[18];
#pragma unroll
            for (int j = 0; j < 18; ++j) { const int i = tt + 512 * j, sft = i / MB_TN, ii = i - sft * MB_TN, idx = 2047 - ii - sft; tv[j] = (i < 4 * MB_TN && idx >= 0) ? LUT[(8 + h) * 2048 + idx] * LOG2E : -INFINITY; }
#pragma unroll
            for (int j = 0; j < 18; ++j) { const int i = tt + 512 * j; if (i < 4 * MB_TN) tab[i] = tv[j]; } }
        { const int j = tt >> 6, d = tt & 63; km[tt] = (KMP[(size_t)((8 * b + j) * 2 + 0) * 512 + 64 * h + d] + KMP[(size_t)((8 * b + j) * 2 + 1) * 512 + 64 * h + d]) * (1.f / 256.f); }
        __syncthreads();
        const bf16* Qb = QKV + (size_t)b * SEQ * NQKV + 1536 + 64 * h; const bf16* Kb = QKV + (size_t)b * SEQ * NQKV + 2048 + 64 * h; const bf16* Vb = Kb + 512;
        for (int s2 = 0; s2 < 2; ++s2) { const int jp = half == 0 ? (s2 == 0 ? 3 : 0) : (s2 == 0 ? 2 : 1); const int qA = 2 * jp, qB = qA + 1;
            int r32 = r32_, hi = hi_, tid = tid_; asm volatile("" : "+v"(r32), "+v"(hi), "+v"(tid));
            const int troff = (8 * hi + ((r32 & 15) >> 2)) * MB_VP + (16 * ((r32 >> 4) & 1) + 4 * (r32 & 3)) * 2;
            const int tqA = 256 * qA + 32 * w + r32, tqB = tqA + 256;
            bf16x8 qa[4], qb[4];
#pragma unroll
            for (int d0 = 0; d0 < 4; ++d0) { qa[d0] = *(const bf16x8*)(Qb + (size_t)tqA * NQKV + 16 * d0 + 8 * hi); qb[d0] = *(const bf16x8*)(Qb + (size_t)tqB * NQKV + 16 * d0 + 8 * hi); }
            const unsigned selA = mb_select(qa, km, qA, hi);
            int ko = 0; asm volatile("" : "+v"(ko) :: "memory");
            const unsigned selB = mb_select(qb, km + ko, qB, hi);
            float la = 0.f, lb = 0.f; f32x16 oa0 = {}, oa1 = {}, ob0 = {}, ob1 = {};
            const int NT = 4 * (qB + 1);
            const int tA = 2047 - tqA + 8 * hi, tB = tA - 256;
            const LAS unsigned char* cpA = (const LAS unsigned char*)tab + (tA & 3) * (MB_TN * 4) + (tA & ~3) * 4;
            const LAS unsigned char* cpB = (const LAS unsigned char*)tab + (tB & 3) * (MB_TN * 4) + (tB & ~3) * 4;
            const LAS unsigned char* minf = (const LAS unsigned char*)tab + 2048 * 4;
            const int skey = tid >> 3, sch = tid & 7;
            const size_t srow = (size_t)skey * NQKV + 8 * sch;
            u32x4 k0r = {}, v0r = {};
#define M2_GLD(T_) do { if ((T_) < NT) { const size_t ro_ = srow + (size_t)(T_) * M2_TK * NQKV; k0r = *(const u32x4*)(Kb + ro_); v0r = *(const u32x4*)(Vb + ro_); } } while (0)
#define M2_ST(T_) do { if ((T_) < NT) { *(LAS u32x4*)(lds + M2_K + ((T_) & 1) * (M2_TK * MB_KP) + skey * MB_KP + sch * 16) = k0r; *(LAS u32x4*)(lds + M2_V + ((T_) & 1) * (M2_TK * MB_VP) + skey * MB_VP + sch * 16) = v0r; } } while (0)
            M2_GLD(0); M2_ST(0); M2_GLD(1);
            LBAR();
            for (int T = 0; T < NT; ++T) { const int kb = T >> 2;
                const bool actA = kb < qA ? (__ballot((selA >> kb) & 1u) != 0ull) : (kb == qA && (M2_TK * T - 256 * qA) <= 32 * w + 31);
                const bool actB = kb < qB ? (__ballot((selB >> kb) & 1u) != 0ull) : ((M2_TK * T - 256 * qB) <= 32 * w + 31);
                const LAS unsigned char* Kt = lds + M2_K + (T & 1) * (M2_TK * MB_KP) + kappa(r32) * MB_KP + hi * 16; const unsigned va = (unsigned)(size_t)(lds + M2_V + (T & 1) * (M2_TK * MB_VP) + troff);
                const LAS unsigned char* ctA = ((selA >> kb) & 1u) ? cpA + 256 * T : minf; const LAS unsigned char* ctB = ((selB >> kb) & 1u) ? cpB + 256 * T : minf;
                if (actA && actB) mb_step2<true, true>(Kt, va, ctA, ctB, qa, qb, oa0, oa1, la, ob0, ob1, lb);
                else if (actB) mb_step2<false, true>(Kt, va, ctA, ctB, qa, qb, oa0, oa1, la, ob0, ob1, lb);
                else if (actA) mb_step2<true, false>(Kt, va, ctA, ctB, qa, qb, oa0, oa1, la, ob0, ob1, lb);
                M2_ST(T + 1);
                LBAR();
                M2_GLD(T + 2);
            }
#undef M2_GLD
#undef M2_ST
#pragma unroll
            for (int gsel = 0; gsel < 2; ++gsel) { const f32x16& o0 = gsel ? ob0 : oa0; const f32x16& o1 = gsel ? ob1 : oa1; const int tq = gsel ? tqB : tqA;
                const float inv = 1.f / xhalf_sum(gsel ? lb : la);
                bf16* yp = Y + ((size_t)b * SEQ + tq) * DM + 512 + 64 * h + 4 * hi; float sq = 0.f;
#pragma unroll
                for (int g4 = 0; g4 < 4; ++g4) { u32x2 a, c2; a.x = cvtpk(o0[4 * g4] * inv, o0[4 * g4 + 1] * inv); a.y = cvtpk(o0[4 * g4 + 2] * inv, o0[4 * g4 + 3] * inv);
                    c2.x = cvtpk(o1[4 * g4] * inv, o1[4 * g4 + 1] * inv); c2.y = cvtpk(o1[4 * g4 + 2] * inv, o1[4 * g4 + 3] * inv);
                    *(u32x2*)(yp + 8 * g4) = a; *(u32x2*)(yp + 32 + 8 * g4) = c2;
                    sq += bflo(a.x) * bflo(a.x) + bfhi(a.x) * bfhi(a.x) + bflo(a.y) * bflo(a.y) + bfhi(a.y) * bfhi(a.y) + bflo(c2.x) * bflo(c2.x) + bfhi(c2.x) * bfhi(c2.x) + bflo(c2.y) * bflo(c2.y) + bfhi(c2.y) * bfhi(c2.y); }
                sq = xhalf_sum(sq); if (hi == 0 && SSB) atomicAdd(SSB + (size_t)b * SEQ + tq, sq); }
        }
    }
}

constexpr int DL_VP = 192, DL_KP = 144, DL_LUT = 0, DL_TN = 208, DL_V = 16384, DL_SB = 65536, DL_SBP = 136, DL_SL = DL_SB + 512 * DL_SBP, DL_END = DL_SL + 2048;
static_assert(DL_END <= 139264, "dilated LDS map");
struct DilTile { u32x4 kr[4]; u32x4 vr[4]; };
__device__ __forceinline__ void dil_load(DilTile& t, const bf16* Kb, const bf16* Vb, int dil, int res, int base, int lane) {
#pragma unroll
    for (int i4 = 0; i4 < 4; ++i4) { const int idx = lane + 64 * i4, key = idx >> 3, ch = idx & 7; const size_t o = (size_t)(dil * (base + key) + res) * NQKV + 8 * ch;
        t.kr[i4] = *(const u32x4*)(Kb + o); t.vr[i4] = *(const u32x4*)(Vb + o); }
}
__device__ __forceinline__ void dil_unit(const bf16* Qb, const bf16* Kb, const bf16* Vb, const LAS unsigned char* tb, LAS unsigned char* Vw, int troff, int dil, int res, int gi, int lane, int r32, int hi,
                                         f32x16& o0, f32x16& o1, float& lse) {
    const int ms = 32 * gi + r32, tq = dil * ms + res;
    u32x4 qr[4];
    int lg = lane; asm volatile("" : "+v"(lg));
#pragma unroll
    for (int i4 = 0; i4 < 4; ++i4) { const int idx = lg + 64 * i4, qrow = idx >> 3, ch = idx & 7; qr[i4] = *(const u32x4*)(Qb + (size_t)(dil * (32 * gi + qrow) + res) * NQKV + 8 * ch); }
    float l_run = 0.f; o0 = f32x16{}; o1 = f32x16{};
    const int kt0 = gi >= 4 ? 0 : 4 - gi;
    const int a0 = 31 - r32 + 8 * hi;
    const LAS unsigned char* cp = tb + (a0 & 3) * (DL_TN * 4) + (a0 & ~3) * 4;
    DilTile nx, nx2; dil_load(nx, Kb, Vb, dil, res, 32 * gi - 128 + 32 * kt0, lg); nx2 = nx;
    if (kt0 < 4) dil_load(nx2, Kb, Vb, dil, res, 32 * gi - 128 + 32 * (kt0 + 1), lg);
    bf16x8 qf[4];
#pragma unroll
    for (int i4 = 0; i4 < 4; ++i4) { const int idx = lane + 64 * i4, qrow = idx >> 3, ch = idx & 7; *(LAS u32x4*)(Vw + qrow * DL_KP + ch * 16) = qr[i4]; }
#pragma unroll
    for (int d0 = 0; d0 < 4; ++d0) qf[d0] = *(const LAS bf16x8*)(Vw + r32 * DL_KP + hi * 16 + d0 * 32);
#pragma unroll 1
    for (int kt = kt0; kt < 5; ++kt) { const int base = 32 * gi - 128 + 32 * kt;
        DilTile cu = nx; nx = nx2;
        if (kt < 3) dil_load(nx2, Kb, Vb, dil, res, base + 64, lg);
        asm volatile("" ::: "memory");
#pragma unroll
        for (int i4 = 0; i4 < 4; ++i4) { const int idx = lane + 64 * i4, key = idx >> 3, ch = idx & 7; *(LAS u32x4*)(Vw + key * DL_KP + ch * 16) = cu.kr[i4]; }
        bf16x8 kf[4];
#pragma unroll
        for (int d0 = 0; d0 < 4; ++d0) kf[d0] = *(const LAS bf16x8*)(Vw + kappa(r32) * DL_KP + hi * 16 + d0 * 32);
#pragma unroll
        for (int i4 = 0; i4 < 4; ++i4) { const int idx = lane + 64 * i4, key = idx >> 3, ch = idx & 7; *(LAS u32x4*)(Vw + key * DL_VP + ch * 16) = cu.vr[i4]; }
        f32x16 p0 = ld_c16(cp + 128 * kt);
#pragma unroll
        for (int d0 = 0; d0 < 4; ++d0) p0 = mfma32(kf[d0], qf[d0], p0);
        float ls = 0.f;
#pragma unroll
        for (int r = 0; r < 16; ++r) { p0[r] = __builtin_amdgcn_exp2f(p0[r]); ls += p0[r]; }
        l_run += ls;
        const bf16x8 pf0 = packp(p0, 0), pf1 = packp(p0, 1);
        asm volatile("s_waitcnt lgkmcnt(0)" ::: "memory");
#pragma unroll
        for (int c = 0; c < 2; ++c) { const LAS unsigned char* vb = Vw + troff + c * 64;
            const bf16x8 v0 = cat8(vtr(vb), vtr(vb + 4 * DL_VP)), v1 = cat8(vtr(vb + 16 * DL_VP), vtr(vb + 20 * DL_VP));
            if (c == 0) { o0 = mfma32(v0, pf0, o0); o0 = mfma32(v1, pf1, o0); } else { o1 = mfma32(v0, pf0, o1); o1 = mfma32(v1, pf1, o1); } }
        asm volatile("s_waitcnt lgkmcnt(0)" ::: "memory");
    }
    const float lt = xhalf_sum(l_run), inv = 1.f / lt;
#pragma unroll
    for (int r = 0; r < 16; ++r) { o0[r] *= inv; o1[r] *= inv; }
    lse = __builtin_amdgcn_logf(lt);
}
template <bool DA, bool DB>
__device__ __forceinline__ void dil_step2(DilTile& cu, const bf16* Kb, const bf16* Vb, int dil, int res, int nbase, int lg, LAS unsigned char* Vw, int troff, const LAS unsigned char* cp, int kt, int lane, int r32, int hi,
                                          const bf16x8 (&qa)[4], const bf16x8 (&qb)[4], f32x16& a0, f32x16& a1, float& la, f32x16& b0, f32x16& b1, float& lb) {
#pragma unroll
    for (int i4 = 0; i4 < 4; ++i4) { const int idx = lane + 64 * i4, key = idx >> 3, ch = idx & 7; *(LAS u32x4*)(Vw + key * DL_KP + ch * 16) = cu.kr[i4]; }
    bf16x8 kf[4];
#pragma unroll
    for (int d0 = 0; d0 < 4; ++d0) kf[d0] = *(const LAS bf16x8*)(Vw + kappa(r32) * DL_KP + hi * 16 + d0 * 32);
#pragma unroll
    for (int i4 = 0; i4 < 4; ++i4) { const int idx = lane + 64 * i4, key = idx >> 3, ch = idx & 7; *(LAS u32x4*)(Vw + key * DL_VP + ch * 16) = cu.vr[i4]; }
    if (DA) dil_load(cu, Kb, Vb, dil, res, nbase, lg);
    asm volatile("" ::: "memory");
    f32x16 pa = {}, pb = {};
    if (DA) pa = ld_c16(cp + 128 * kt);
    if (DB) pb = ld_c16(cp + 128 * (kt - 1));
#pragma unroll
    for (int d0 = 0; d0 < 4; ++d0) { if (DA) pa = mfma32(kf[d0], qa[d0], pa); if (DB) pb = mfma32(kf[d0], qb[d0], pb); }
    float lsa = 0.f, lsb = 0.f;
#pragma unroll
    for (int r = 0; r < 16; ++r) { if (DA) { pa[r] = __builtin_amdgcn_exp2f(pa[r]); lsa += pa[r]; } if (DB) { pb[r] = __builtin_amdgcn_exp2f(pb[r]); lsb += pb[r]; } }
    la += lsa; lb += lsb;
    const bf16x8 fa0 = packp(pa, 0), fa1 = packp(pa, 1), fb0 = packp(pb, 0), fb1 = packp(pb, 1);
    asm volatile("s_waitcnt lgkmcnt(0)" ::: "memory");
#pragma unroll
    for (int c = 0; c < 2; ++c) { const LAS unsigned char* vb = Vw + troff + c * 64;
        const bf16x8 v0 = cat8(vtr(vb), vtr(vb + 4 * DL_VP)), v1 = cat8(vtr(vb + 16 * DL_VP), vtr(vb + 20 * DL_VP));
        if (c == 0) { if (DA) { a0 = mfma32(v0, fa0, a0); a0 = mfma32(v1, fa1, a0); } if (DB) { b0 = mfma32(v0, fb0, b0); b0 = mfma32(v1, fb1, b0); } }
        else { if (DA) { a1 = mfma32(v0, fa0, a1); a1 = mfma32(v1, fa1, a1); } if (DB) { b1 = mfma32(v0, fb0, b1); b1 = mfma32(v1, fb1, b1); } } }
    asm volatile("s_waitcnt lgkmcnt(0)" ::: "memory");
}
__device__ __forceinline__ void dil_unit2(const bf16* Qb, const bf16* Kb, const bf16* Vb, const LAS unsigned char* tb, LAS unsigned char* Vw, int troff, int dil, int res, int gi2, int lane, int r32, int hi,
                                          f32x16& a0, f32x16& a1, float& lseA, f32x16& b0, f32x16& b1, float& lseB) {
    u32x4 qr[4], qs[4];
    int lg = lane; asm volatile("" : "+v"(lg));
#pragma unroll
    for (int i4 = 0; i4 < 4; ++i4) { const int idx = lg + 64 * i4, qrow = idx >> 3, ch = idx & 7; const size_t o = (size_t)(dil * (64 * gi2 + qrow) + res) * NQKV + 8 * ch;
        qr[i4] = *(const u32x4*)(Qb + o); qs[i4] = *(const u32x4*)(Qb + o + (size_t)(dil * 32) * NQKV); }
    float la = 0.f, lb = 0.f; a0 = f32x16{}; a1 = f32x16{}; b0 = f32x16{}; b1 = f32x16{};
    const int kt0 = gi2 >= 2 ? 0 : 4 - 2 * gi2;
    const int t0 = 31 - r32 + 8 * hi;
    const LAS unsigned char* cp = tb + (t0 & 3) * (DL_TN * 4) + (t0 & ~3) * 4;
    const int base0 = 64 * gi2 - 128;
    DilTile nx; dil_load(nx, Kb, Vb, dil, res, base0 + 32 * kt0, lg);
    bf16x8 qa[4], qb[4];
#pragma unroll
    for (int i4 = 0; i4 < 4; ++i4) { const int idx = lane + 64 * i4, qrow = idx >> 3, ch = idx & 7; *(LAS u32x4*)(Vw + qrow * DL_KP + ch * 16) = qr[i4]; }
#pragma unroll
    for (int d0 = 0; d0 < 4; ++d0) qa[d0] = *(const LAS bf16x8*)(Vw + r32 * DL_KP + hi * 16 + d0 * 32);
#pragma unroll
    for (int i4 = 0; i4 < 4; ++i4) { const int idx = lane + 64 * i4, qrow = idx >> 3, ch = idx & 7; *(LAS u32x4*)(Vw + qrow * DL_KP + ch * 16) = qs[i4]; }
#pragma unroll
    for (int d0 = 0; d0 < 4; ++d0) qb[d0] = *(const LAS bf16x8*)(Vw + r32 * DL_KP + hi * 16 + d0 * 32);
    int kt = kt0;
    if (kt == 0) { dil_step2<true, false>(nx, Kb, Vb, dil, res, base0 + 32, lg, Vw, troff, cp, 0, lane, r32, hi, qa, qb, a0, a1, la, b0, b1, lb); kt = 1; }
#pragma unroll 1
    for (; kt < 5; ++kt) dil_step2<true, true>(nx, Kb, Vb, dil, res, base0 + 32 * (kt + 1), lg, Vw, troff, cp, kt, lane, r32, hi, qa, qb, a0, a1, la, b0, b1, lb);
    dil_step2<false, true>(nx, Kb, Vb, dil, res, 0, lg, Vw, troff, cp, 5, lane, r32, hi, qa, qb, a0, a1, la, b0, b1, lb);
    const float lta = xhalf_sum(la), ltb = xhalf_sum(lb), ia = 1.f / lta, ib = 1.f / ltb;
#pragma unroll
    for (int r = 0; r < 16; ++r) { a0[r] *= ia; a1[r] *= ia; b0[r] *= ib; b1[r] *= ib; }
    lseA = __builtin_amdgcn_logf(lta); lseB = __builtin_amdgcn_logf(ltb);
}
__device__ __forceinline__ void sb_store(LAS unsigned char* sb, int lt, int hi, const f32x16& o0, const f32x16& o1) {
    LAS unsigned char* p = sb + lt * DL_SBP + 8 * hi;
#pragma unroll
    for (int g4 = 0; g4 < 4; ++g4) { u32x2 a, c2; a.x = cvtpk(o0[4 * g4], o0[4 * g4 + 1]); a.y = cvtpk(o0[4 * g4 + 2], o0[4 * g4 + 3]); c2.x = cvtpk(o1[4 * g4], o1[4 * g4 + 1]); c2.y = cvtpk(o1[4 * g4 + 2], o1[4 * g4 + 3]);
        *(LAS u32x2*)(p + 16 * g4) = a; *(LAS u32x2*)(p + 64 + 16 * g4) = c2; }
}
__device__ __forceinline__ void sb_merge(const LAS unsigned char* sb, int lt, int hi, float wa, float wb, f32x16& o0, f32x16& o1) {
    const LAS unsigned char* p = sb + lt * DL_SBP + 8 * hi;
#pragma unroll
    for (int g4 = 0; g4 < 4; ++g4) { const u32x2 a = *(const LAS u32x2*)(p + 16 * g4), c2 = *(const LAS u32x2*)(p + 64 + 16 * g4);
        o0[4 * g4] = wa * bflo(a.x) + wb * o0[4 * g4]; o0[4 * g4 + 1] = wa * bfhi(a.x) + wb * o0[4 * g4 + 1]; o0[4 * g4 + 2] = wa * bflo(a.y) + wb * o0[4 * g4 + 2]; o0[4 * g4 + 3] = wa * bfhi(a.y) + wb * o0[4 * g4 + 3];
        o1[4 * g4] = wa * bflo(c2.x) + wb * o1[4 * g4]; o1[4 * g4 + 1] = wa * bfhi(c2.x) + wb * o1[4 * g4 + 1]; o1[4 * g4 + 2] = wa * bflo(c2.y) + wb * o1[4 * g4 + 2]; o1[4 * g4 + 3] = wa * bfhi(c2.y) + wb * o1[4 * g4 + 3]; }
}
__device__ __forceinline__ void dil_phase(LAS unsigned char* lds, const bf16* QKV, const float* LUT, bf16* Y, float* SSA, int vcu, int G) {
    const int tid = threadIdx.x, lane = tid & 63, r32 = lane & 31, hi = lane >> 5; const int w = __builtin_amdgcn_readfirstlane(tid >> 6);
    LAS float* dtab = (LAS float*)(lds + DL_LUT);
    LAS unsigned char* Vw = lds + DL_V + w * (32 * DL_VP);
    LAS unsigned char* sb = lds + DL_SB; LAS float* sl = (LAS float*)(lds + DL_SL);
    const int troff = tr_off(lane, DL_VP);
    for (int bh = vcu; bh < BATCH * 8; bh += G) { const int b = bh >> 3, h = bh & 7;
        __syncthreads();
        for (int i = tid; i < 3 * 4 * DL_TN; i += 512) { const int ii = i % DL_TN, sft = (i / DL_TN) & 3, pp = i / (4 * DL_TN); const int dlt = 159 - ii - sft, dist = dlt * (pp == 0 ? 1 : (pp == 1 ? 4 : 16));
            dtab[i] = (dlt >= 0 && dlt <= 128 && dist < 2048) ? LUT[h * 2048 + dist] * LOG2E : -INFINITY; }
        __syncthreads();
        const bf16* Qb = QKV + (size_t)b * SEQ * NQKV + 64 * h; const bf16* Kb = Qb + 512; const bf16* Vb = Qb + 1024;
        const LAS unsigned char* tb0 = lds + DL_LUT;
        for (int sp = 0; sp < 4; ++sp) {
            for (int x = w; x < 16; x += 8) { f32x16 o0, o1; float lse;
                dil_unit(Qb, Kb, Vb, tb0 + 2 * (4 * DL_TN * 4), Vw, troff, 16, x, sp, lane, r32, hi, o0, o1, lse);
                const int lt = 16 * r32 + x; sb_store(sb, lt, hi, o0, o1); if (hi == 0) sl[lt] = lse; }
            __syncthreads();
            { f32x16 oa0, oa1, ob0, ob1; float lsa, lsb;
                dil_unit2(Qb, Kb, Vb, tb0 + 1 * (4 * DL_TN * 4), Vw, troff, 4, w & 3, 2 * sp + (w >> 2), lane, r32, hi, oa0, oa1, lsa, ob0, ob1, lsb);
                { const int lt = 128 * (2 * (w >> 2)) + 4 * r32 + (w & 3); const float ls = sl[lt], mx = fmaxf(ls, lsa);
                  float wa = __builtin_amdgcn_exp2f(ls - mx), wb = __builtin_amdgcn_exp2f(lsa - mx); const float sw = wa + wb, isw = 1.f / sw; wa *= isw; wb *= isw;
                  sb_merge(sb, lt, hi, wa, wb, oa0, oa1); sb_store(sb, lt, hi, oa0, oa1); if (hi == 0) sl[lt] = mx + __builtin_amdgcn_logf(sw); }
                { const int lt = 128 * (2 * (w >> 2) + 1) + 4 * r32 + (w & 3); const float ls = sl[lt], mx = fmaxf(ls, lsb);
                  float wa = __builtin_amdgcn_exp2f(ls - mx), wb = __builtin_amdgcn_exp2f(lsb - mx); const float sw = wa + wb, isw = 1.f / sw; wa *= isw; wb *= isw;
                  sb_merge(sb, lt, hi, wa, wb, ob0, ob1); sb_store(sb, lt, hi, ob0, ob1); if (hi == 0) sl[lt] = mx + __builtin_amdgcn_logf(sw); } }
            __syncthreads();
            { f32x16 oa0, oa1, ob0, ob1; float lsa, lsb;
                dil_unit2(Qb, Kb, Vb, tb0, Vw, troff, 1, 0, 8 * sp + w, lane, r32, hi, oa0, oa1, lsa, ob0, ob1, lsb);
                { const int lt = 32 * (2 * w) + r32; const float ls = sl[lt], mx = fmaxf(ls, lsa);
                  float wa = __builtin_amdgcn_exp2f(ls - mx), wb = __builtin_amdgcn_exp2f(lsa - mx); const float isw = 1.f / (wa + wb); wa *= isw; wb *= isw;
                  sb_merge(sb, lt, hi, wa, wb, oa0, oa1); sb_store(sb, lt, hi, oa0, oa1); }
                { const int lt = 32 * (2 * w + 1) + r32; const float ls = sl[lt], mx = fmaxf(ls, lsb);
                  float wa = __builtin_amdgcn_exp2f(ls - mx), wb = __builtin_amdgcn_exp2f(lsb - mx); const float isw = 1.f / (wa + wb); wa *= isw; wb *= isw;
                  sb_merge(sb, lt, hi, wa, wb, ob0, ob1); sb_store(sb, lt, hi, ob0, ob1); } }
            __syncthreads();
#pragma unroll
            for (int j = 0; j < 8; ++j) { const int idx = tid + 512 * j, row = idx >> 3, ch = idx & 7;
                const LAS unsigned char* p = sb + row * DL_SBP + ch * 16; const u32x2 a = *(const LAS u32x2*)p, c2 = *(const LAS u32x2*)(p + 8);
                u32x4 v; v[0] = a.x; v[1] = a.y; v[2] = c2.x; v[3] = c2.y;
                *(u32x4*)(Y + ((size_t)b * SEQ + 512 * sp + row) * DM + 64 * h + 8 * ch) = v;
                float sq = bflo(a.x) * bflo(a.x) + bfhi(a.x) * bfhi(a.x) + bflo(a.y) * bflo(a.y) + bfhi(a.y) * bfhi(a.y) + bflo(c2.x) * bflo(c2.x) + bfhi(c2.x) * bfhi(c2.x) + bflo(c2.y) * bflo(c2.y) + bfhi(c2.y) * bfhi(c2.y);
                sq += __shfl_xor(sq, 1); sq += __shfl_xor(sq, 2); sq += __shfl_xor(sq, 4);
                if (ch == 0) atomicAdd(SSA + (size_t)b * SEQ + 512 * sp + row, sq); }
            __syncthreads();
        }
    }
}

__device__ __forceinline__ void merge_phase(const bf16* __restrict__ Y, bf16* __restrict__ YN, int gw, int NGW, int lane) {
    for (int m = gw; m < NTOK; m += NGW) {
        const u32x4 ya = *(const u32x4*)(Y + (size_t)m * DM + 8 * lane), yb = *(const u32x4*)(Y + (size_t)m * DM + 512 + 8 * lane);
        float v[8], u[8]; float sa = 0.f, sb = 0.f;
#pragma unroll
        for (int e = 0; e < 4; ++e) { v[2 * e] = bflo(ya[e]); v[2 * e + 1] = bfhi(ya[e]); u[2 * e] = bflo(yb[e]); u[2 * e + 1] = bfhi(yb[e]); }
#pragma unroll
        for (int e = 0; e < 8; ++e) { sa += v[e] * v[e]; sb += u[e] * u[e]; }
        sa = wave_sum(sa); sb = wave_sum(sb);
        const float ra = rsqrtf(sa * (1.f / 512.f) + EPS), rb = rsqrtf(sb * (1.f / 512.f) + EPS);
        u32x4 oa, ob;
#pragma unroll
        for (int e = 0; e < 4; ++e) { oa[e] = cvtpk(v[2 * e] * ra, v[2 * e + 1] * ra); ob[e] = cvtpk(u[2 * e] * rb, u[2 * e + 1] * rb); }
        *(u32x4*)(YN + (size_t)m * DM + 8 * lane) = oa; *(u32x4*)(YN + (size_t)m * DM + 512 + 8 * lane) = ob;
    }
}

constexpr int CR_KP = 272, CR_VP = 320, CR_K = 0, CR_V = 2 * 64 * CR_KP, CR_END = CR_V + 2 * 64 * CR_VP, CR_OP = 272;
static_assert(4 * 32 * CR_OP <= CR_V && 4 * 32 * CR_OP <= CR_END - CR_V && CR_END + 4 * 32 * CR_OP <= 139264, "cross LDS map");
typedef __amdgpu_buffer_rsrc_t rsrc_t;
__device__ __forceinline__ rsrc_t mkrsrc(const void* base, unsigned bytes) { return __builtin_amdgcn_make_buffer_rsrc((void*)base, 0, bytes, 0x00020000); }
__device__ __forceinline__ u32x4 bld16(rsrc_t r, unsigned voff, unsigned soff) { return __builtin_bit_cast(u32x4, __builtin_amdgcn_raw_buffer_load_b128(r, voff, soff, 0)); }
__device__ __forceinline__ void cross_phase(LAS unsigned char* lds, const bf16* QM, const bf16* KVM, bf16* OM, int vcu, int G, int pv) {
    const int tid = threadIdx.x, lane = tid & 63, r32 = lane & 31, hi = lane >> 5; const int w = __builtin_amdgcn_readfirstlane(tid >> 6);
    const int troff = tr_off(lane, CR_VP);
    const int kkey = tid >> 3, kch = tid & 7;
    const unsigned soff = (unsigned)kkey * 4096u + (unsigned)kch * 16u;
    const unsigned qoff = (unsigned)(32 * w + r32) * 2048u + (unsigned)hi * 16u;
    const int kl0 = kkey * CR_KP + kch * 16, vl0 = kkey * CR_VP + kch * 16;
    const int kfo = kappa(r32) * CR_KP + hi * 16;
    const rsrc_t rK = mkrsrc(KVM, (unsigned)NMEMTOK * 4096u), rQ = mkrsrc(QM, (unsigned)NTOK * 2048u);
    LAS unsigned char* Tw = lds + (w < 4 ? CR_K + w * (32 * CR_OP) : CR_END + (w - 4) * (32 * CR_OP));
    LAS unsigned char* Qw = lds + (w < 4 ? CR_V + w * (32 * CR_OP) : CR_END + (w - 4) * (32 * CR_OP));
    for (int un = vcu * 4; un < BATCH * 4 * 8; un += G * 4) for (int ui = 0; ui < 4; ++ui) { const int u = un + ui, qblk = u & 7, hm = (u >> 3) & 3, b = u >> 5;
        const unsigned Qs = (unsigned)(((b * SEQ + 256 * qblk) * DM + 256 * hm) * 2);
        unsigned char* Os = (unsigned char*)(OM + ((size_t)b * SEQ + 256 * qblk) * DM + 256 * hm);
        const unsigned Ks = (unsigned)((b * NMEM * 2048 + 256 * hm) * 2), Vs = Ks + 2048u;
        f32x16 sc[8];
#pragma unroll
        for (int kt = 0; kt < 8; ++kt) sc[kt] = f32x16{};
        u32x4 r0, r1;
        __syncthreads();
        r0 = bld16(rK, soff, Ks); r1 = bld16(rK, soff, Ks + 128u);
        *(LAS u32x4*)(lds + CR_K + kl0) = r0; *(LAS u32x4*)(lds + CR_K + kl0 + 128) = r1;
        __syncthreads();
#pragma unroll
        for (int half = 0; half < 2; ++half) {
            bf16x8 qf[8];
            { u32x4 qt[8];
#pragma unroll
              for (int j = 0; j < 8; ++j) qt[j] = bld16(rQ, (unsigned)(32 * w + (lane >> 4) + 4 * j) * 2048u + (unsigned)(lane & 15) * 16u, Qs + (unsigned)(256 * half));
#pragma unroll
              for (int j = 0; j < 8; ++j) *(LAS u32x4*)(Qw + ((lane >> 4) + 4 * j) * CR_OP + (lane & 15) * 16) = qt[j];
#pragma unroll
              for (int d0 = 0; d0 < 8; ++d0) qf[d0] = *(const LAS bf16x8*)(Qw + r32 * CR_OP + hi * 16 + d0 * 32); }
#pragma unroll
            for (int kp = 0; kp < 4; ++kp) { const int step = half * 4 + kp, buf = step & 1;
                if (!(pv & 2)) { if (step + 1 < 8) { const int nh = (step + 1) >> 2, nk = (step + 1) & 3; const unsigned src = Ks + (unsigned)(nk * (64 * 4096) + 256 * nh); r0 = bld16(rK, soff, src); r1 = bld16(rK, soff, src + 128u); }
                else { r0 = bld16(rK, soff, Vs); r1 = bld16(rK, soff, Vs + 128u); } }
                const LAS unsigned char* Kt = lds + CR_K + buf * (64 * CR_KP) + kfo;
#pragma unroll
                for (int d0 = 0; d0 < 8; ++d0) { sc[2 * kp] = mfma32(*(const LAS bf16x8*)(Kt + d0 * 32), qf[d0], sc[2 * kp]); sc[2 * kp + 1] = mfma32(*(const LAS bf16x8*)(Kt + 32 * CR_KP + d0 * 32), qf[d0], sc[2 * kp + 1]); if (d0 & 1) __builtin_amdgcn_sched_barrier(0); }
                if (step + 1 < 8) { *(LAS u32x4*)(lds + CR_K + (buf ^ 1) * (64 * CR_KP) + kl0) = r0; *(LAS u32x4*)(lds + CR_K + (buf ^ 1) * (64 * CR_KP) + kl0 + 128) = r1; }
                else { *(LAS u32x4*)(lds + CR_V + vl0) = r0; *(LAS u32x4*)(lds + CR_V + vl0 + 128) = r1; }
                LBAR();
            }
        }
        const float c1 = 0.0625f * LOG2E, mo = 0.f; float ls = 0.f;
        bf16x8 pf[8][2];
#pragma unroll
        for (int kt = 0; kt < 8; ++kt) {
#pragma unroll
            for (int r = 0; r < 16; ++r) { sc[kt][r] = __builtin_amdgcn_exp2f(sc[kt][r] * c1 - mo); ls += sc[kt][r]; }
            pf[kt][0] = packp(sc[kt], 0); pf[kt][1] = packp(sc[kt], 1); }
        const float inv = 1.f / xhalf_sum(ls);
#pragma unroll
        for (int hv = 0; hv < 2; ++hv) {
            f32x16 o[4];
#pragma unroll
            for (int c = 0; c < 4; ++c) o[c] = f32x16{};
            if (hv == 1) { if (!(pv & 2)) { r0 = bld16(rK, soff, Vs + 256u); r1 = bld16(rK, soff, Vs + 384u); }
                *(LAS u32x4*)(lds + CR_V + vl0) = r0; *(LAS u32x4*)(lds + CR_V + vl0 + 128) = r1; LBAR(); }
#pragma unroll
            for (int kp = 0; kp < 4; ++kp) { const int buf = kp & 1;
                if (kp + 1 < 4 && !(pv & 2)) { const unsigned src = Vs + (unsigned)((kp + 1) * (64 * 4096) + 256 * hv); r0 = bld16(rK, soff, src); r1 = bld16(rK, soff, src + 128u); }
                const LAS unsigned char* vb = lds + CR_V + buf * (64 * CR_VP) + troff;
#pragma unroll
                for (int t2 = 0; t2 < 2; ++t2) { const unsigned va = (unsigned)(size_t)(vb + t2 * 32 * CR_VP);
                    s16x4 l0, h0, l1, h1, l2, h2, l3, h3, l4, h4, l5, h5, l6, h6, l7, h7;
                    TR_RD(l0, va, 0 * CR_VP); TR_RD(h0, va, 4 * CR_VP); TR_RD(l1, va, 16 * CR_VP); TR_RD(h1, va, 20 * CR_VP); TR_RD(l2, va, 64 + 0 * CR_VP); TR_RD(h2, va, 64 + 4 * CR_VP); TR_RD(l3, va, 64 + 16 * CR_VP); TR_RD(h3, va, 64 + 20 * CR_VP);
                    TR_RD(l4, va, 128 + 0 * CR_VP); TR_RD(h4, va, 128 + 4 * CR_VP); TR_RD(l5, va, 128 + 16 * CR_VP); TR_RD(h5, va, 128 + 20 * CR_VP); TR_RD(l6, va, 192 + 0 * CR_VP); TR_RD(h6, va, 192 + 4 * CR_VP); TR_RD(l7, va, 192 + 16 * CR_VP); TR_RD(h7, va, 192 + 20 * CR_VP);
                    const bf16x8 q0 = pf[2 * kp + t2][0], q1 = pf[2 * kp + t2][1];
                    TR_WAIT(14, l0, h0); o[0] = mfma32(cat8(l0, h0), q0, o[0]); TR_WAIT(12, l1, h1); o[0] = mfma32(cat8(l1, h1), q1, o[0]); TR_WAIT(10, l2, h2); o[1] = mfma32(cat8(l2, h2), q0, o[1]); TR_WAIT(8, l3, h3); o[1] = mfma32(cat8(l3, h3), q1, o[1]);
                    TR_WAIT(6, l4, h4); o[2] = mfma32(cat8(l4, h4), q0, o[2]); TR_WAIT(4, l5, h5); o[2] = mfma32(cat8(l5, h5), q1, o[2]); TR_WAIT(2, l6, h6); o[3] = mfma32(cat8(l6, h6), q0, o[3]); TR_WAIT(0, l7, h7); o[3] = mfma32(cat8(l7, h7), q1, o[3]); }
                if (kp + 1 < 4) { *(LAS u32x4*)(lds + CR_V + (buf ^ 1) * (64 * CR_VP) + vl0) = r0; *(LAS u32x4*)(lds + CR_V + (buf ^ 1) * (64 * CR_VP) + vl0 + 128) = r1; }
                LBAR();
            }
            if (!(pv & 1)) {
#pragma unroll
                for (int c = 0; c < 4; ++c)
#pragma unroll
                    for (int g4 = 0; g4 < 4; ++g4) { u32x2 a; a.x = cvtpk(o[c][4 * g4] * inv, o[c][4 * g4 + 1] * inv); a.y = cvtpk(o[c][4 * g4 + 2] * inv, o[c][4 * g4 + 3] * inv); *(LAS u32x2*)(Tw + r32 * CR_OP + 64 * c + 16 * g4 + 8 * hi) = a; }
                unsigned char* yp = Os + 256 * hv + (lane & 15) * 16 + (size_t)(32 * w + (lane >> 4)) * 2048;
#pragma unroll
                for (int j = 0; j < 8; ++j) { const u32x4 v = *(const LAS u32x4*)(Tw + ((lane >> 4) + 4 * j) * CR_OP + (lane & 15) * 16); *(u32x4*)(yp + (size_t)j * (4 * 2048)) = v; }
            }
        }
    }
}
}


struct Frame {
    LAS unsigned char* lds;
    int tid, lane, wave, vcu, G;
};
__device__ __forceinline__ void p0_titem(const float* __restrict__ W, int Nsrc, int nsrc0, int k0, const float* __restrict__ g, const float* __restrict__ g2, int gsplit,
                                         bf16* __restrict__ WT, int K, int ndst0, LAS float* scr, int lane) {
#pragma unroll 8
    for (int i = 0; i < 32; ++i) { const int kk = 2 * i + (lane >> 5); const int k = k0 + kk;
        float gv = 1.f; if (g) gv = (g2 && k >= gsplit) ? g2[k - gsplit] : g[k];
        scr[kk * 33 + (lane & 31)] = W[(size_t)k * Nsrc + nsrc0 + (lane & 31)] * gv; }
    LDS_WAIT(); asm volatile("" ::: "memory");
    const int c = lane & 7;
#pragma unroll
    for (int j = 0; j < 4; ++j) { const int n = (lane >> 3) + 8 * j; const LAS float* s = scr + (8 * c) * 33 + n;
        v4u o; o.x = pk2(s[0 * 33], s[1 * 33]); o.y = pk2(s[2 * 33], s[3 * 33]); o.z = pk2(s[4 * 33], s[5 * 33]); o.w = pk2(s[6 * 33], s[7 * 33]);
        *(GAS v4u*)(WT + (size_t)(ndst0 + n) * K + k0 + 8 * c) = o; }
    LDS_WAIT(); asm volatile("" ::: "memory");
}
__device__ __forceinline__ void p0_norm_rows2(const float* __restrict__ x0, const float* __restrict__ x1, bf16* __restrict__ o0, bf16* __restrict__ o1, int lane, float* rn = nullptr) {
    const GAS f32x4* a = (const GAS f32x4*)x0 + lane; const GAS f32x4* b = (const GAS f32x4*)x1 + lane; f32x4 v[4], u[4]; float s = 0.f, t = 0.f;
#pragma unroll
    for (int j = 0; j < 4; ++j) { v[j] = a[64 * j]; u[j] = b[64 * j]; }
#pragma unroll
    for (int j = 0; j < 4; ++j) { s += (v[j].x * v[j].x + v[j].y * v[j].y) + (v[j].z * v[j].z + v[j].w * v[j].w); t += (u[j].x * u[j].x + u[j].y * u[j].y) + (u[j].z * u[j].z + u[j].w * u[j].w); }
    s = wave_sum(s); t = wave_sum(t);
    const float rs = rsqrtf(s * (1.f / DM) + EPS), rt = rsqrtf(t * (1.f / DM) + EPS);
    if (rn && lane == 0) { rn[0] = sqrtf(s * (1.f / DM) + EPS); rn[1] = sqrtf(t * (1.f / DM) + EPS); }
    GAS unsigned long long* p = (GAS unsigned long long*)o0 + lane; GAS unsigned long long* q = (GAS unsigned long long*)o1 + lane;
#pragma unroll
    for (int j = 0; j < 4; ++j) { p[64 * j] = (unsigned long long)pk2(v[j].x * rs, v[j].y * rs) | ((unsigned long long)pk2(v[j].z * rs, v[j].w * rs) << 32);
        q[64 * j] = (unsigned long long)pk2(u[j].x * rt, u[j].y * rt) | ((unsigned long long)pk2(u[j].z * rt, u[j].w * rt) << 32); }
}

struct Args { const float* in[20]; float* out; unsigned char* ws; int ph_lo, ph_hi, att_mask, ss_dummy, bar_idx, variant; };
enum { PH_PRO = 0, PH_QKV = 1, PH_ATT = 2, PH_MERGE = 3, PH_OUT = 4, PH_QM = 5, PH_CROSS = 6, PH_OM = 7, PH_FFN1 = 8, PH_FIX = 9, PH_DOWN = 10, PH_N = 11 };

__global__ void __launch_bounds__(NWAVES * 64, 2) mega(Args args) {
    extern __shared__ __attribute__((aligned(16))) unsigned char lds_raw[];
    Frame F;
    F.lds = (LAS unsigned char*)lds_raw;
    F.tid = threadIdx.x; F.lane = F.tid & 63; F.wave = __builtin_amdgcn_readfirstlane(F.tid >> 6);
    F.G = gridDim.x; { const int bx = blockIdx.x; F.vcu = (F.G % 8 == 0) ? (bx % 8) * (F.G / 8) + bx / 8 : bx; }
    unsigned char* ws = args.ws;
    volatile LAS unsigned* MISC = (volatile LAS unsigned*)(F.lds + MISC_OFF);
    for (int u = F.tid; u < (LDS_BYTES - MISC_OFF) / 4; u += NWAVES * 64) ((LAS unsigned*)(F.lds + MISC_OFF))[u] = 0u;
    __syncthreads();
    const int lo = args.ph_lo, hi = args.ph_hi;
    unsigned* barw = (unsigned*)(ws + WS_CTL) + CW_BAR + args.bar_idx * XCD_BAR_WORDS;
    XcdBarrier bar; bar.bar = barw; bar.x = 0; bar.st = nullptr;
    if (hi - lo > 1 || (lo <= PH_DOWN && PH_DOWN < hi)) bar = xcd_barrier_post(barw, MISC + 8);
#define IN(k) (lo <= (k) && (k) < hi)
#define SEAM(k) do { if (IN(k) && IN((k) + 1)) xcd_barrier(bar); } while (0)

    const float* x = args.in[0]; const float* mem = args.in[1]; const float* w_in = args.in[2]; const float* g_mix = args.in[3]; const float* g_od = args.in[4];
    const float* g_om = args.in[5]; const float* w_out = args.in[6]; const float* rel_bias = args.in[7]; const float* g_cross = args.in[8]; const float* g_mem = args.in[9];
    const float* w_q = args.in[10]; const float* w_kv = args.in[11]; const float* w_o = args.in[12]; const float* g_ffn = args.in[13]; const float* w_gate = args.in[14];
    const float* w_up = args.in[15]; const float* conv_w = args.in[16]; const float* conv_b = args.in[17]; const float* w_down = args.in[18]; const float* g_final = args.in[19];
    float* RS0 = (float*)(ws + WS_RS0); float* RSM = (float*)(ws + WS_RSM); float* SS1 = (float*)(ws + WS_SS1); float* SS2 = (float*)(ws + WS_SS2); float* SS3 = (float*)(ws + WS_SS3);
    float* SSA = (float*)(ws + WS_SSA); float* SSB = (float*)(ws + WS_SSB);
    float* SA1 = SS1; float* SA2 = SS2; float* SA3 = SS3; float* SAA = SSA; float* SAB = SSB;
    if (0) { SA1 = SA2 = SA3 = SAA = SAB = (float*)(ws + WS_DUMMY); }
    float* LUT = (float*)(ws + WS_LUT); float* KMP = (float*)(ws + WS_KMP); float* HALOG = (float*)(ws + WS_HALOG); float* FIXG = (float*)(ws + WS_FIXG); float* FIXU = (float*)(ws + WS_FIXU); float* PS = (float*)(ws + WS_PS);
    bf16* WIN = (bf16*)(ws + WS_WIN); bf16* WOUT = (bf16*)(ws + WS_WOUT); bf16* WQ = (bf16*)(ws + WS_WQ); bf16* WKV = (bf16*)(ws + WS_WKV);
    bf16* WO = (bf16*)(ws + WS_WO); bf16* WGU = (bf16*)(ws + WS_WGU); bf16* WD = (bf16*)(ws + WS_WD);
    bf16* MEMB = (bf16*)(ws + WS_MEMB); bf16* KVM = (bf16*)(ws + WS_KVM); bf16* XB = (bf16*)(ws + WS_XB); bf16* QKV = (bf16*)(ws + WS_QKV);
    bf16* YN = (bf16*)(ws + WS_YN); bf16* Y = (bf16*)(ws + WS_Y); bf16* OP = (bf16*)(ws + WS_OP); float* LSEP = (float*)(ws + WS_LSEP); bf16* H1 = (bf16*)(ws + WS_H1); bf16* QM = (bf16*)(ws + WS_QM);
    bf16* OM = (bf16*)(ws + WS_OM); bf16* H2 = (bf16*)(ws + WS_H2); bf16* ACT = (bf16*)(ws + WS_ACT); bf16* H3 = (bf16*)(ws + WS_H3);
    const int gw = F.vcu * NWAVES + F.wave, NGW = F.G * NWAVES;
    const int gt = (int)blockIdx.x * (NWAVES * 64) + F.tid, NGT = F.G * NWAVES * 64;

    if (IN(PH_PRO)) {
        LAS float* scr = (LAS float*)(F.lds + RING_OFF + F.wave * 16384);
        constexpr int I_IN = 16 * 96, I_OUT = 16 * 32, I_Q = 16 * 32, I_KV = 16 * 64, I_O = 16 * 32, I_GU = 16 * 176, I_D = 44 * 32;
        constexpr int NITEMS = I_IN + I_OUT + I_Q + I_KV + I_O + I_GU + I_D;
        for (int it = gw; it < NITEMS; it += NGW) {
            int r = it;
            if (r < I_IN) { const int kb = r / 96, nb = r % 96; p0_titem(w_in, 3072, 32 * nb, 64 * kb, g_mix, nullptr, 0, WIN, 1024, 32 * nb, scr, F.lane); continue; } r -= I_IN;
            if (r < I_OUT) { const int kb = r / 32, nb = r % 32; p0_titem(w_out, 1024, 32 * nb, 64 * kb, g_od, g_om, 512, WOUT, 1024, 32 * nb, scr, F.lane); continue; } r -= I_OUT;
            if (r < I_Q) { const int kb = r / 32, nb = r % 32; p0_titem(w_q, 1024, 32 * nb, 64 * kb, g_cross, nullptr, 0, WQ, 1024, 32 * nb, scr, F.lane); continue; } r -= I_Q;
            if (r < I_KV) { const int kb = r / 64, nb = r % 64; p0_titem(w_kv, 2048, 32 * nb, 64 * kb, g_mem, nullptr, 0, WKV, 1024, 32 * nb, scr, F.lane); continue; } r -= I_KV;
            if (r < I_O) { const int kb = r / 32, nb = r % 32; p0_titem(w_o, 1024, 32 * nb, 64 * kb, nullptr, nullptr, 0, WO, 1024, 32 * nb, scr, F.lane); continue; } r -= I_O;
            if (r < I_GU) { const int kb = r / 176, nb = r % 176; const int nd = 32 * nb, j = nd >> 8, rr = nd & 255;
                const float* src = (rr < 128) ? w_gate : w_up; const int sc = 128 * j + (rr & 127);
                p0_titem(src, 2816, sc, 64 * kb, g_ffn, nullptr, 0, WGU, 1024, nd, scr, F.lane); continue; } r -= I_GU;
            { const int kb = r / 32, nb = r % 32; p0_titem(w_down, 1024, 32 * nb, 64 * kb, nullptr, nullptr, 0, WD, 2816, 32 * nb, scr, F.lane); }
        }
        for (int m = 2 * gw; m < NTOK; m += 2 * NGW) p0_norm_rows2(x + (size_t)m * DM, x + (size_t)(m + 1) * DM, XB + (size_t)m * DM, XB + (size_t)(m + 1) * DM, F.lane, (float*)(ws + WS_RN0) + m);
        for (int m = 2 * gw; m < NMEMTOK; m += 2 * NGW) p0_norm_rows2(mem + (size_t)m * DM, mem + (size_t)(m + 1) * DM, MEMB + (size_t)m * DM, MEMB + (size_t)(m + 1) * DM, F.lane);
        for (int i = gt; i < 16 * 2048; i += NGT) { const int h = i >> 11, n = i & 2047; int b;
            if (n < 16) b = n; else { b = 16 + (n >= 22) + (n >= 30) + (n >= 40) + (n >= 54) + (n >= 73) + (n >= 99) + (n >= 134) + (n >= 182) + (n >= 246) + (n >= 332) + (n >= 450) + (n >= 609) + (n >= 825) + (n >= 1117) + (n >= 1513); }
            LUT[i] = rel_bias[h * 32 + b]; }
        for (int i = gt; i < NTOK; i += NGT) { SA1[i] = 0.f; SA2[i] = 0.f; SAA[i] = 0.f; SAB[i] = 0.f; }
        for (int i = gt; i < NTOK + 256; i += NGT) ((unsigned*)PS)[i] = 0u;
    }
    SEAM(PH_PRO);

#define STAGGER(ticks) do { const unsigned long long t0_ = __builtin_amdgcn_s_memrealtime(); const unsigned long long d_ = (unsigned long long)((F.vcu & 3) * (ticks)); \
        while (__builtin_amdgcn_s_memrealtime() - t0_ < d_) __builtin_amdgcn_s_sleep(32); } while (0)
    if (IN(PH_QKV)) {
        { pg8::Gemm g{XB, WIN, NTOK, NQKV, 1024}; pg8::StaticOrder S; S.init(NTOK, NQKV, F.G, (int)blockIdx.x);
          pg8::EpiScale E{(0   & 128) ? (bf16*)(ws + WS_H1) : QKV, RS0, (0   & 128) ? nullptr : KMP, NQKV, ((0   & 32) ? 64 : 0) | ((0   & 64) ? 128 : 0) | ((0   & 128) ? 256 : 0)};
          pg8::gemm_phase<pg8::EpiScale, pg8::StaticOrder, true, true>(F.lds + RING_OFF, g, S, E); }
        { pg8::Gemm g{MEMB, WKV, NMEMTOK, 2048, 1024}; pg8::StaticOrder S; S.init(NMEMTOK, 2048, F.G, (int)blockIdx.x);
          pg8::EpiScale E{KVM, RSM, nullptr, 2048, 0};
          pg8::gemm_phase<pg8::EpiScale, pg8::StaticOrder, true, true>(F.lds + RING_OFF, g, S, E); }
    }
    SEAM(PH_QKV);
        if (IN(PH_ATT)) {
        if (3 & 1) att::moba_phase2(F.lds, QKV, KMP, LUT, 0   ? (bf16*)(ws + WS_H1) : Y, 0   ? nullptr : SAB, F.vcu, F.G);
        __syncthreads();
        if (3 & 2) att::dil_phase(F.lds, QKV, LUT, Y, SAA, F.vcu, F.G);
    }

    SEAM(PH_ATT);

    if (IN(PH_OUT)) {
        pg8::Gemm g{Y, WOUT, NTOK, DM, 1024}; pg8::StaticOrder S; S.init(NTOK, DM, F.G, (int)blockIdx.x);
        pg8::EpiOutProj E{H1, XB, (const float*)(ws + WS_RN0), SA1, SSA, SSB, DM, 0};
        pg8::gemm_phase<pg8::EpiOutProj, pg8::StaticOrder, true, true>(F.lds + RING_OFF, g, S, E);
    }
    SEAM(PH_OUT);
    if (IN(PH_QM)) {
        pg8::Gemm g{H1, WQ, NTOK, DM, 1024}; pg8::StaticOrder S; S.init(NTOK, DM, F.G, (int)blockIdx.x);
        pg8::EpiScale E{QM, SS1, nullptr, DM, 1};
        pg8::gemm_phase<pg8::EpiScale, pg8::StaticOrder, true, true>(F.lds + RING_OFF, g, S, E);
    }
    SEAM(PH_QM);
        if (IN(PH_CROSS)) att::cross_phase(F.lds, QM, KVM, OM, F.vcu, F.G, (0   >> 12) & 3);

    SEAM(PH_CROSS);
    if (IN(PH_OM)) {
        pg8::Gemm g{OM, WO, NTOK, DM, 1024}; pg8::StaticOrder S; S.init(NTOK, DM, F.G, (int)blockIdx.x);
        pg8::EpiResid E{H2, H1, SA2, DM, 0};
        pg8::gemm_phase<pg8::EpiResid, pg8::StaticOrder, true, true>(F.lds + RING_OFF, g, S, E);
    }
    SEAM(PH_OM);
    if (IN(PH_FFN1)) {
        pg8::Gemm g{H2, WGU, NTOK, 5632, 1024}; pg8::StaticOrder S; S.init(NTOK, 5632, F.G, (int)blockIdx.x);
        pg8::EpiFfn1 E{ACT, SS2, conv_w, conv_b, HALOG, FIXG, FIXU, (LAS float*)(F.lds + LDSX_OFF), (0   >> 8) & 3, 0};
        pg8::gemm_phase<pg8::EpiFfn1, pg8::StaticOrder, true, true>(F.lds + RING_OFF, g, S, E);
    }
    SEAM(PH_FFN1);
    if (IN(PH_FIX)) {
        for (int i = gt; i < 256 * 2816; i += NGT) { const int pm = i / 2816, c = i % 2816;
            const float g0 = FIXG[((size_t)pm * 2 + 0) * 2816 + c], g1 = FIXG[((size_t)pm * 2 + 1) * 2816 + c];
            float hm1 = 0.f, hm2 = 0.f; if (pm & 7) { hm2 = HALOG[((size_t)(pm - 1) * 2 + 0) * 2816 + c]; hm1 = HALOG[((size_t)(pm - 1) * 2 + 1) * 2816 + c]; }
            const float w0 = conv_w[c], w1 = conv_w[2816 + c], w2 = conv_w[2 * 2816 + c], cbv = conv_b[c];
            const float c0 = cbv + w2 * g0 + w1 * hm1 + w0 * hm2, c1 = cbv + w2 * g1 + w1 * g0 + w0 * hm1;
            ACT[((size_t)pm * 256 + 0) * 2816 + c] = (bf16)f2bf(c0 / (1.f + __expf(-c0)) * FIXU[((size_t)pm * 2 + 0) * 2816 + c]);
            ACT[((size_t)pm * 256 + 1) * 2816 + c] = (bf16)f2bf(c1 / (1.f + __expf(-c1)) * FIXU[((size_t)pm * 2 + 1) * 2816 + c]); }
    }
    SEAM(PH_FIX);
    if (IN(PH_DOWN)) {
        pg8::Gemm g{ACT, WD, NTOK, DM, DFF}; pg8::StaticOrder S0; S0.init(NTOK, DM, F.G, (int)blockIdx.x);
        pg8::EpiFinal<XcdBarrier> E{H2, args.out, g_final, PS, (unsigned*)(PS + NTOK)};
        { pg8::RoundOrder S{S0, 0}; pg8::gemm_phase<pg8::EpiFinal<XcdBarrier>, pg8::RoundOrder, false, true>(F.lds + RING_OFF, g, S, E); }
        __syncthreads();
        { pg8::RoundOrder S{S0, 1}; pg8::gemm_phase<pg8::EpiFinal<XcdBarrier>, pg8::RoundOrder, false, true>(F.lds + RING_OFF, g, S, E); }
        __syncthreads();
        { pg8::RoundOrder S{S0, 2}; pg8::gemm_phase<pg8::EpiFinal<XcdBarrier>, pg8::RoundOrder, false, true>(F.lds + RING_OFF, g, S, E); }
        __syncthreads();
        { pg8::RoundOrder S{S0, 3}; pg8::gemm_phase<pg8::EpiFinal<XcdBarrier>, pg8::RoundOrder, false, true>(F.lds + RING_OFF, g, S, E); }
    }
#undef IN
#undef SEAM
}


extern "C" void kernel_launch(void* const* d_in, const int* in_sizes, int n_in, void* d_out, int out_size, void* d_ws, size_t ws_size, hipStream_t stream) {
    static int grid = 0;
    if (grid == 0) {
        if (n_in != 20 || in_sizes[0] != NTOK * DM || out_size != NTOK * DM || ws_size < WS_END) { fprintf(stderr, "kernel_launch: unexpected shapes (n_in %d, ws %zu); nothing launched\n", n_in, ws_size); grid = -1; return; }
        int dev = 0, cus = 0, per_cu = 0;
        if (hipGetDevice(&dev) != hipSuccess || hipDeviceGetAttribute(&cus, hipDeviceAttributeMultiprocessorCount, dev) != hipSuccess) { grid = -1; return; }
        if (hipFuncSetAttribute((const void*)mega, hipFuncAttributeMaxDynamicSharedMemorySize, LDS_BYTES) != hipSuccess) { fprintf(stderr, "kernel_launch: hipFuncSetAttribute failed\n"); grid = -1; return; }
        if (hipOccupancyMaxActiveBlocksPerMultiprocessor(&per_cu, (const void*)mega, NWAVES * 64, LDS_BYTES) != hipSuccess || per_cu < 1) fprintf(stderr, "kernel_launch: occupancy query says %d\n", per_cu);
        (void)hipGetLastError();
        grid = cus;
        if (grid != NTOK / 256) { fprintf(stderr, "kernel_launch: this kernel needs exactly %d workgroups (one per CU of a 256-CU device); found %d CUs\n", NTOK / 256, cus); grid = NTOK / 256; }
    }
    if (grid < 0) return;
    unsigned char* ws = (unsigned char*)d_ws;
    (void)hipMemsetAsync(ws + WS_CTL, 0, CTL_ZERO_BYTES, stream);
    Args a{};
    for (int i = 0; i < 20; ++i) a.in[i] = (const float*)d_in[i];
    a.out = (float*)d_out; a.ws = ws; a.att_mask = 3;
    int nbar = 0;
    auto runx = [&](int lo, int hi, int mask, int dummy, int variant = 0) { Args b2 = a; b2.variant = variant; b2.bar_idx = (hi - lo > 1 || (lo <= PH_DOWN && PH_DOWN < hi)) ? nbar++ : 0; b2.ph_lo = lo; b2.ph_hi = hi; b2.att_mask = mask; b2.ss_dummy = dummy; hipLaunchKernelGGL(mega, dim3(grid), dim3(NWAVES * 64), LDS_BYTES, stream, b2); };
    auto run = [&](int lo, int hi) { runx(lo, hi, 3, 0); };
    run(0, PH_N);
}
```
